# Optimizing an MI355X kernel written in HIP

```python
import math
import jax, jax.numpy as jnp
from jax import lax
import numpy as np

D_MODEL = 1024
BATCH = 8
SEQ = 2048
DEPTH = 4

GRID_W = 64
D_MIX = D_MODEL
DA_HEAD_DIM = 64
DA_WIDTH = D_MIX // 2
DA_HEADS = DA_WIDTH // (2 * DA_HEAD_DIM)
NA_HEAD_DIM = 64
NA_WIDTH = D_MIX - DA_WIDTH
NA_HEADS = NA_WIDTH // NA_HEAD_DIM
NA_ROWS_MAX = 8
NA_COLS = 16
NA_COL_BLOCK = 16
NA_KEY_COLS = NA_COL_BLOCK + NA_COLS
Q_BLOCK = 128
RMS_EPS = 1e-6
SPLITS = (DA_WIDTH, DA_WIDTH, DA_WIDTH, NA_WIDTH, NA_WIDTH, NA_WIDTH, D_MIX)
IN_WIDTH = sum(SPLITS)

kernel_name = "hybrid_diffattn_natten2d_encoder"


def rms_norm(x, g):
    xf = x.astype(jnp.float32)
    y = xf * lax.rsqrt(jnp.mean(xf * xf, axis=-1, keepdims=True) + RMS_EPS)
    return (y * g.astype(jnp.float32)).astype(x.dtype)


def alibi_slopes(n_heads):
    return jnp.asarray(2.0 ** (-8.0 * np.arange(1, n_heads + 1) / n_heads), dtype=jnp.float32)


def diff_attention(q, k, v, lam, lam_init, subln_g):
    B, S, H, _, dh = q.shape
    nb = S // Q_BLOCK
    qb = q.reshape(B, nb, Q_BLOCK, H, 2, dh).transpose(1, 0, 2, 3, 4, 5)
    slopes = alibi_slopes(H)
    kpos = jnp.arange(S)
    scale = dh ** -0.5

    def block(args):
        qi, i = args
        s = jnp.einsum('bqhcd,bkhcd->bhcqk', qi, k,
                       preferred_element_type=jnp.float32) * scale
        qpos = i * Q_BLOCK + jnp.arange(Q_BLOCK)
        dist = jnp.abs(qpos[:, None] - kpos[None, :]).astype(jnp.float32)
        s = s - slopes[None, :, None, None, None] * dist[None, None, None]
        p = jax.nn.softmax(s, axis=-1)
        a = p[:, :, 0] - lam * p[:, :, 1]
        return jnp.einsum('bhqk,bkhe->bqhe', a.astype(v.dtype), v)

    o = lax.map(block, (qb, jnp.arange(nb)))
    o = o.transpose(1, 0, 2, 3, 4).reshape(B, S, H, 2 * dh)
    o = rms_norm(o, subln_g) * (1.0 - lam_init)
    return o.reshape(B, S, H * 2 * dh)


def neighbourhood_attention(q, k, v, rpb):
    B, S, H, d = q.shape
    rows = S // GRID_W
    kr = min(NA_ROWS_MAX, rows)
    qg = q.reshape(B, rows, GRID_W, H, d)
    kg = k.reshape(B, rows, GRID_W, H, d)
    vg = v.reshape(B, rows, GRID_W, H, d)
    nbk = GRID_W // NA_COL_BLOCK
    qcol = np.arange(GRID_W).reshape(nbk, NA_COL_BLOCK)
    qcstart = np.clip(qcol - NA_COLS // 2, 0, GRID_W - NA_COLS)
    kcstart = np.clip(qcol[:, 0] - NA_COLS // 2, 0, GRID_W - NA_KEY_COLS)
    kcol = kcstart[:, None] + np.arange(NA_KEY_COLS)
    col_valid = ((kcol[:, None, :] >= qcstart[:, :, None]) &
                 (kcol[:, None, :] < qcstart[:, :, None] + NA_COLS))
    dc_idx = np.clip(kcol[:, None, :] - qcol[:, :, None],
                     -(NA_COLS - 1), NA_COLS - 1) + NA_COLS - 1
    col_bias = rpb[:, :, dc_idx]
    scale = d ** -0.5

    def row(r):
        rs = jnp.clip(r - kr // 2, 0, rows - kr)
        krows = lax.dynamic_slice_in_dim(kg, rs, kr, axis=1)
        vrows = lax.dynamic_slice_in_dim(vg, rs, kr, axis=1)
        kb = krows[:, :, kcol]
        vb = vrows[:, :, kcol]
        qr = lax.dynamic_index_in_dim(qg, r, axis=1, keepdims=False)
        qr = qr.reshape(B, nbk, NA_COL_BLOCK, H, d)
        s = jnp.einsum('bnqhd,brnkhd->bhnqrk', qr, kb,
                       preferred_element_type=jnp.float32) * scale
        dr_idx = rs + jnp.arange(kr) - r + NA_ROWS_MAX - 1
        bias = jnp.take(col_bias, dr_idx, axis=1).transpose(0, 2, 3, 1, 4)
        s = s + bias[None].astype(jnp.float32)
        s = jnp.where(col_valid[None, None, :, :, None, :], s, -jnp.inf)
        shp = s.shape
        p = jax.nn.softmax(s.reshape(B, H, nbk, NA_COL_BLOCK, kr * NA_KEY_COLS), axis=-1).reshape(shp)
        o = jnp.einsum('bhnqrk,brnkhd->bnqhd', p.astype(v.dtype), vb)
        return o.reshape(B, GRID_W, H * d)

    out = lax.map(row, jnp.arange(rows))
    return out.transpose(1, 0, 2, 3).reshape(B, S, H * d)


def hybrid_layer(x, g, w_in, w_out, lq1, lk1, lq2, lk2, subln_g, rpb, lam_init):
    B, S, _ = x.shape
    h = rms_norm(x, g)
    z = jnp.einsum('bsd,de->bse', h, w_in)
    cuts = [int(c) for c in np.cumsum(SPLITS)[:-1]]
    qd, kd, vd, qn, kn, vn, gate = jnp.split(z, cuts, axis=-1)
    qd = qd.reshape(B, S, DA_HEADS, 2, DA_HEAD_DIM)
    kd = kd.reshape(B, S, DA_HEADS, 2, DA_HEAD_DIM)
    vd = vd.reshape(B, S, DA_HEADS, 2 * DA_HEAD_DIM)
    f32 = jnp.float32
    lam = (jnp.exp(jnp.sum(lq1.astype(f32) * lk1.astype(f32)))
           - jnp.exp(jnp.sum(lq2.astype(f32) * lk2.astype(f32))) + lam_init)
    o_da = diff_attention(qd, kd, vd, lam, lam_init, subln_g)
    qn = qn.reshape(B, S, NA_HEADS, NA_HEAD_DIM)
    kn = kn.reshape(B, S, NA_HEADS, NA_HEAD_DIM)
    vn = vn.reshape(B, S, NA_HEADS, NA_HEAD_DIM)
    o_na = neighbourhood_attention(qn, kn, vn, rpb)
    o = jnp.concatenate([o_da, o_na], axis=-1) * jax.nn.silu(gate)
    return x + jnp.einsum('bse,ed->bsd', o, w_out)


def setup_inputs(seed: int = 0) -> dict:
    key = jax.random.key(seed)
    ks = jax.random.split(key, 12)
    f32 = jnp.float32
    x = jax.random.normal(ks[0], (BATCH, SEQ, D_MODEL), f32)
    norm_g = 1.0 + 0.02 * jax.random.normal(ks[1], (DEPTH, D_MODEL), f32)
    w_in = jax.random.normal(ks[2], (DEPTH, D_MODEL, IN_WIDTH), f32) * D_MODEL ** -0.5
    w_out = jax.random.normal(ks[3], (DEPTH, D_MIX, D_MODEL), f32) * D_MIX ** -0.5
    lam_q1 = 0.1 * jax.random.normal(ks[4], (DEPTH, DA_HEAD_DIM), f32)
    lam_k1 = 0.1 * jax.random.normal(ks[5], (DEPTH, DA_HEAD_DIM), f32)
    lam_q2 = 0.1 * jax.random.normal(ks[6], (DEPTH, DA_HEAD_DIM), f32)
    lam_k2 = 0.1 * jax.random.normal(ks[7], (DEPTH, DA_HEAD_DIM), f32)
    subln_g = 1.0 + 0.02 * jax.random.normal(ks[8], (DEPTH, 2 * DA_HEAD_DIM), f32)
    rpb = 0.02 * jax.random.normal(ks[9], (DEPTH, NA_HEADS, 2 * NA_ROWS_MAX - 1, 2 * NA_COLS - 1), f32)
    final_g = 1.0 + 0.02 * jax.random.normal(ks[10], (D_MODEL,), f32)
    return {"x": x, "norm_g": norm_g, "w_in": w_in, "w_out": w_out,
            "lam_q1": lam_q1, "lam_k1": lam_k1, "lam_q2": lam_q2, "lam_k2": lam_k2,
            "subln_g": subln_g, "rpb": rpb, "final_g": final_g}


def reference(x, norm_g, w_in, w_out, lam_q1, lam_k1, lam_q2, lam_k2, subln_g, rpb, final_g):
    for l in range(DEPTH):
        lam_init = 0.8 - 0.6 * math.exp(-0.3 * l)
        x = hybrid_layer(x, norm_g[l], w_in[l], w_out[l], lam_q1[l], lam_k1[l],
                         lam_q2[l], lam_k2[l], subln_g[l], rpb[l], lam_init)
    return rms_norm(x, final_g)
```

```cpp
#include <hip/hip_runtime.h>
#include <hip/hip_cooperative_groups.h>
#include <cstdio>
#include <cstdint>
namespace cg = cooperative_groups;

typedef unsigned short bf16_t;
typedef short bf16x8 __attribute__((ext_vector_type(8)));
typedef float f32x4 __attribute__((ext_vector_type(4)));
typedef float f32x16 __attribute__((ext_vector_type(16)));
typedef unsigned u32x4 __attribute__((ext_vector_type(4)));
typedef unsigned u32x2 __attribute__((ext_vector_type(2)));

constexpr int D_MODEL = 1024, BATCH = 8, SEQ = 2048, DEPTH = 4, NTOK = BATCH * SEQ;
constexpr int IN_W = 4096;
constexpr size_t ZS_QD = 0, ZS_KD = (size_t)NTOK * 512, ZS_QN = (size_t)NTOK * 1024, ZS_KN = (size_t)NTOK * 1536, ZS_GATE = (size_t)NTOK * 2048;
constexpr size_t VS_VD = 0, VS_VN = (size_t)NTOK * 512;
constexpr int ZP = 3072;
constexpr float RMS_EPS = 1e-6f;
constexpr float LOG2E = 1.4426950408889634f;
constexpr int NTHREADS = 512;
#ifndef REP_GEMM0
#define REP_GEMM0 1
#endif
#ifndef REP_DA
#define REP_DA 1
#endif
#ifndef REP_NA
#define REP_NA 1
#endif
#define REP_ATT (REP_DA > REP_NA ? REP_DA : REP_NA)

struct Params {
    const float* x; const float* norm_g; const float* w_in; const float* w_out;
    const float* lq1; const float* lk1; const float* lq2; const float* lk2;
    const float* subln_g; const float* rpb; const float* final_g;
    float* xf;
    bf16_t* wi_t;
    bf16_t* wo_t;
    bf16_t* xb;
    float* rss;
    bf16_t* z;
    bf16_t* vT;
    bf16_t* o;
    unsigned* bar;
    float lam_init[DEPTH];
    int never;
    int pad_;
};

typedef __bf16 bf16x2_t __attribute__((ext_vector_type(2)));
typedef float f32x2_t __attribute__((ext_vector_type(2)));
__device__ __forceinline__ unsigned cvt_pk_bf16(float lo, float hi) {
    const f32x2_t v = {lo, hi};
    return __builtin_bit_cast(unsigned, __builtin_convertvector(v, bf16x2_t));
}
__device__ __forceinline__ float bf2f(unsigned short b) { return __uint_as_float(((unsigned)b) << 16); }
__device__ __forceinline__ float bflo(unsigned w) { return __uint_as_float(w << 16); }
__device__ __forceinline__ float bfhi(unsigned w) { return __uint_as_float(w & 0xffff0000u); }
__device__ __forceinline__ float fast_exp2(float x) { return __builtin_amdgcn_exp2f(x); }


#define XB_TMO      128
#define XB_XCNT(j)  (256  + 64 * (j))
#define XB_XSUB(j)  (1280 + 64 * (j))
#define XB_XGEN(j)  (2304 + 64 * (j))
#define XB_TOP      3328
#define XB_TOPGEN   3392
#define XCD_BAR_WORDS 3456
#define XB_SPIN_CAP (1u << 20)
#define LAS __attribute__((address_space(3)))
__device__ __forceinline__ unsigned xb_ld(unsigned* p)              { return __hip_atomic_load(p, __ATOMIC_RELAXED, __HIP_MEMORY_SCOPE_AGENT); }
__device__ __forceinline__ unsigned xb_add(unsigned* p, unsigned v) { return __hip_atomic_fetch_add(p, v, __ATOMIC_RELAXED, __HIP_MEMORY_SCOPE_AGENT); }
__device__ __forceinline__ unsigned xb_xcc_id() { return (unsigned)__builtin_amdgcn_s_getreg((3 << 11) | 20) & 0xFu; }
#define XB_SPIN(cond, bar) do { unsigned _sp = 0; while (cond) { __builtin_amdgcn_s_sleep(1); \
    if ((++_sp & 255u) == 0u) { if (xb_ld(&(bar)[XB_TMO])) break; if (_sp > XB_SPIN_CAP) { atomicAdd(&(bar)[XB_TMO], 1u); break; } } } } while (0)
struct XcdBarrier { unsigned* bar; unsigned x; volatile LAS unsigned* st; };
__device__ __forceinline__ XcdBarrier xcd_barrier_post(unsigned* bar, volatile LAS unsigned* st) {
    XcdBarrier b; b.bar = bar; b.x = xb_xcc_id(); b.st = st;
    if (threadIdx.x == 0) (void)xb_add(&bar[XB_XCNT(b.x)], 1u);
    return b;
}
__device__ __forceinline__ void xcd_barrier_complete(unsigned* bar, unsigned x, unsigned& nloc, unsigned& nx) {
    const unsigned G = gridDim.x * gridDim.y * gridDim.z;
    unsigned sum, cnt, mine, sp = 0u;
    for (;;) {
        sum = 0u; cnt = 0u; mine = 0u;
#pragma unroll
        for (unsigned j = 0; j < 16; ++j) { const unsigned c = xb_ld(&bar[XB_XCNT(j)]); sum += c; cnt += (c > 0u) ? 1u : 0u; mine = (j == x) ? c : mine; }
        if (sum == G) break;
        __builtin_amdgcn_s_sleep(1);
        if ((++sp & 255u) == 0u) { if (xb_ld(&bar[XB_TMO])) break; if (sp > XB_SPIN_CAP) { atomicAdd(&bar[XB_TMO], 1u); break; } }
    }
    nloc = mine > 0u ? mine : 1u; nx = cnt > 0u ? cnt : 1u;
}
__device__ __forceinline__ void xcd_barrier(const XcdBarrier& b) {
    asm volatile("s_waitcnt vmcnt(0)" ::: "memory");
    __syncthreads();
    if (threadIdx.x == 0) {
        unsigned* bar = b.bar;
        unsigned bx = b.x; asm volatile("" : "+s"(bx));
        __builtin_amdgcn_s_waitcnt(0);
        unsigned nloc = b.st[0], nx = b.st[1];
        if (nloc == 0u) { xcd_barrier_complete(bar, bx, nloc, nx); b.st[0] = nloc; b.st[1] = nx; }
        const unsigned old = xb_add(&bar[XB_XSUB(bx)], 1u);
        const unsigned gen = old / nloc;
        if (old + 1u == (gen + 1u) * nloc) {
            __builtin_amdgcn_fence(__ATOMIC_RELEASE, "agent");
            asm volatile("s_waitcnt vmcnt(0)" ::: "memory");
            const unsigned og = xb_add(&bar[XB_TOP], 1u);
            const unsigned tg = og / nx;
            if (og + 1u == (tg + 1u) * nx) xb_add(&bar[XB_TOPGEN], 1u);
            else XB_SPIN(xb_ld(&bar[XB_TOPGEN]) == tg, bar);
            __builtin_amdgcn_fence(__ATOMIC_ACQUIRE, "agent");
            xb_add(&bar[XB_XGEN(bx)], 1u);
            asm volatile("s_waitcnt vmcnt(0)" ::: "memory");
        } else {
            XB_SPIN(xb_ld(&bar[XB_XGEN(bx)]) == gen, bar);
            __builtin_amdgcn_fence(__ATOMIC_ACQUIRE, "agent");
            asm volatile("s_waitcnt vmcnt(0)" ::: "memory");
        }
    }
    __syncthreads();
}

__device__ __forceinline__ int perm_col(int n) {
    if (n < 1024) return n;
    if (n < 2048) return n + 512;
    if (n < 3072) return n + 1024;
    if (n < 3584) return n - 2048;
    return n - 1024;
}

__device__ void prologue_phase(char* lds, const Params& p) {
    int tid_ = threadIdx.x; asm volatile("" : "+v"(tid_)); const int tid = tid_, lane = tid & 63, wid = tid >> 6;
    float* tile = (float*)lds;
    const int nt_in = DEPTH * 16 * 64, nt_out = DEPTH * 16 * 16;
    for (int t = blockIdx.x; t < nt_in + nt_out; t += gridDim.x) {
        const float* W; bf16_t* Wt; const float* g; int N, k0, n0, no0;
        if (t < nt_in) {
            const int l = t >> 10, rem = t & 1023; k0 = (rem >> 6) * 64; n0 = (rem & 63) * 64;
            W = p.w_in + (size_t)l * 1024 * 4096; N = 4096; Wt = p.wi_t + (size_t)l * 4096 * 1024; g = p.norm_g + l * 1024; no0 = perm_col(n0);
        } else {
            const int t2 = t - nt_in; const int l = t2 >> 8, rem = t2 & 255; k0 = (rem >> 4) * 64; n0 = (rem & 15) * 64;
            W = p.w_out + (size_t)l * 1024 * 1024; N = 1024; Wt = p.wo_t + (size_t)l * 1024 * 1024; g = nullptr; no0 = n0;
        }
        {
            const int i = tid >> 4, j4 = tid & 15;
#pragma unroll
            for (int ps = 0; ps < 2; ++ps) {
                const int kk = i + 32 * ps;
                const f32x4 v = *(const f32x4*)(W + (size_t)(k0 + kk) * N + no0 + 4 * j4);
                const float gg = g ? g[k0 + kk] : 1.0f;
                tile[kk * 65 + 4 * j4 + 0] = v[0] * gg; tile[kk * 65 + 4 * j4 + 1] = v[1] * gg;
                tile[kk * 65 + 4 * j4 + 2] = v[2] * gg; tile[kk * 65 + 4 * j4 + 3] = v[3] * gg;
            }
        }
        __syncthreads();
        {
            const int j = tid >> 3, i8 = tid & 7;
            float v[8];
#pragma unroll
            for (int e = 0; e < 8; ++e) v[e] = tile[(8 * i8 + e) * 65 + j];
            u32x4 w; w.x = cvt_pk_bf16(v[0], v[1]); w.y = cvt_pk_bf16(v[2], v[3]); w.z = cvt_pk_bf16(v[4], v[5]); w.w = cvt_pk_bf16(v[6], v[7]);
            *(u32x4*)(Wt + (size_t)(n0 + j) * 1024 + k0 + 8 * i8) = w;
        }
        __syncthreads();
    }
    for (int row = blockIdx.x * 8 + wid; row < NTOK; row += gridDim.x * 8) {
        float ss = 0.f;
#pragma unroll
        for (int i = 0; i < 4; ++i) {
            const int c = 4 * lane + 256 * i;
            const f32x4 v = *(const f32x4*)(p.x + (size_t)row * 1024 + c);
            ss += v[0] * v[0] + v[1] * v[1] + v[2] * v[2] + v[3] * v[3];
            u32x2 w; w.x = cvt_pk_bf16(v[0], v[1]); w.y = cvt_pk_bf16(v[2], v[3]);
            *(u32x2*)(p.xb + (size_t)row * 1024 + c) = w;
        }
#pragma unroll
        for (int s = 32; s >= 1; s >>= 1) ss += __shfl_xor(ss, s);
        if (lane < 16) p.rss[(size_t)row * 16 + lane] = lane == 0 ? ss : 0.f;
    }
}

__device__ void final_phase(const Params& p) {
    int tid_ = threadIdx.x; asm volatile("" : "+v"(tid_)); const int tid = tid_, lane = tid & 63, wid = tid >> 6;
    for (int row = blockIdx.x * 8 + wid; row < NTOK; row += gridDim.x * 8) {
        float ss = 0.f;
        if (lane < 16) ss = p.rss[(size_t)row * 16 + lane];
#pragma unroll
        for (int s = 8; s >= 1; s >>= 1) ss += __shfl_xor(ss, s);
        ss = __shfl(ss, 0);
        const float rstd = rsqrtf(ss * (1.0f / 1024.0f) + RMS_EPS);
#pragma unroll
        for (int i = 0; i < 4; ++i) {
            const int c = 4 * lane + 256 * i;
            f32x4 v = *(const f32x4*)(p.xf + (size_t)row * 1024 + c);
            const f32x4 g = *(const f32x4*)(p.final_g + c);
            v = v * rstd * g;
            *(f32x4*)(p.xf + (size_t)row * 1024 + c) = v;
        }
    }
}

namespace pg8 {
#define PG8_LAS __attribute__((address_space(3)))
typedef unsigned short bf16_t;
typedef short bf16x8 __attribute__((ext_vector_type(8)));
typedef float f32x4 __attribute__((ext_vector_type(4)));
typedef unsigned u32x4 __attribute__((ext_vector_type(4)));
constexpr int BM = 256, BK = 64, HALF = 128, HTB = HALF * BK * 2  , STAGE_BYTES = 8 * HTB, NXCD = 8, WGM = 8;

__host__ __device__ __forceinline__ int lds_byte(int r, int c) { const int st = (r >> 4) * 2 + (c >> 5), rr = r & 15, cc = c & 31, ob = rr * 64 + cc * 2; return st * 1024 + (ob ^ (((ob >> 9) & 1) << 5)); }
__host__ __device__ __forceinline__ void stage_rc(int b, int& R, int& C) { const int st = b / 1024, sb = b % 1024, swz = sb ^ (((sb >> 9) & 1) << 5); R = (st >> 1) * 16 + swz / 64; C = (st & 1) * 32 + (swz % 64) / 2; }
__host__ __device__ __forceinline__ int perm32(int rho) { const int n = rho >> 4, i = rho & 15; return 8 * (i >> 2) + 4 * n + (i & 3); }

struct Unit { int pm, pn; };
struct Gemm { const bf16_t* A; const bf16_t* Bt; int M, N, K; };

struct StaticOrder {
    int nM, nN, nwg, G, c;
    __host__ __device__ void init(int M, int N, int G_, int c_) { nM = M / BM; nN = N / BM; nwg = nM * nN; G = G_; c = c_; }
    __host__ __device__ bool next(int i, Unit& u) const {
        const long L = (long)i * G + c; if (L >= nwg) return false;
        int wgid = (int)L; { const int q = nwg / NXCD, r = nwg % NXCD, xcd = wgid % NXCD, off = wgid / NXCD; wgid = (xcd < r ? xcd * (q + 1) : r * (q + 1) + (xcd - r) * q) + off; }
        const int nig = WGM * nN, gid = wgid / nig, fm = gid * WGM, gsz = (nM - fm) < WGM ? (nM - fm) : WGM;
        u.pm = fm + ((wgid % nig) % gsz); u.pn = (wgid % nig) / gsz; return true;
    }
    __device__ __forceinline__ void a_ready(const Unit&) const {}
    __device__ __forceinline__ void done(const Unit&) const {}
};


template <class Epi, class Sched, bool ALIGN_EPI = false, bool SP2 = false>
__device__ __forceinline__ void gemm_phase(PG8_LAS unsigned char* lds, const Gemm g, const Sched& S, const Epi& E) {
    int tid_ = threadIdx.x; asm volatile("" : "+v"(tid_));
    const int tid = tid_, wid = __builtin_amdgcn_readfirstlane(tid >> 6), lane = tid & 63, wr = wid >> 2, wc = wid & 3, fr = lane & 15, fq = lane >> 4;
    const int K = g.K, nt = K / BK;
    unsigned voffA[2], voffB[2];
#pragma unroll
    for (int i = 0; i < 2; ++i) { int R, C; stage_rc(tid * 16 + i * 8192, R, C); const int Rb = Epi::PERM ? ((R & ~31) + perm32(R & 31)) : R;
        voffA[i] = (unsigned)(R * K + C) * 2u; voffB[i] = (unsigned)(Rb * K + C) * 2u; }
    const size_t kstep = (size_t)(BK * 2);
    const size_t hstep = (size_t)HALF * K * 2;
    const size_t tstep = 2 * hstep;
    const unsigned ldsw = (unsigned)wid * 1024u;
    const int aoff = lds_byte(wr * 64 + fr, fq * 8), boff = lds_byte(wc * 32 + fr, fq * 8);
#define PG8_SA(b, h) (((b) * 2 + (h)) * HTB)
#define PG8_SB(b, h) ((4 + (b) * 2 + (h)) * HTB)
#define PG8_STAGE(bufoff, gbase, voff) do { _Pragma("unroll") for (int _i = 0; _i < 2; ++_i) \
        __builtin_amdgcn_global_load_lds((const unsigned*)((const char*)(gbase) + (voff)[_i]), (PG8_LAS unsigned*)(lds + (bufoff) + ldsw + _i * 8192), 16, 0, 0); } while (0)
#define PG8_LDA(dst, b, h) do { _Pragma("unroll") for (int m = 0; m < 4; ++m) _Pragma("unroll") for (int k = 0; k < 2; ++k) dst[m][k] = *(const PG8_LAS bf16x8*)(lds + PG8_SA(b, h) + aoff + m * 2048 + k * 1024); } while (0)
#define PG8_LDB(dst, b, h) do { _Pragma("unroll") for (int n = 0; n < 2; ++n) _Pragma("unroll") for (int k = 0; k < 2; ++k) dst[n][k] = *(const PG8_LAS bf16x8*)(lds + PG8_SB(b, h) + boff + n * 2048 + k * 1024); } while (0)
#define PG8_MMA(ai, bj, At, Bt) do { __builtin_amdgcn_s_setprio(1); _Pragma("unroll") for (int m = 0; m < 4; ++m) _Pragma("unroll") for (int n = 0; n < 2; ++n) _Pragma("unroll") for (int k = 0; k < 2; ++k) \
        acc[ai][bj][m][n] = __builtin_amdgcn_mfma_f32_16x16x32_bf16(Bt[n][k], At[m][k], acc[ai][bj][m][n], 0, 0, 0); __builtin_amdgcn_s_setprio(0); } while (0)
#define PG8_WAIT_V(n) asm volatile("s_waitcnt vmcnt(" #n ")" ::: "memory")
#define PG8_WAIT_L(n) asm volatile("s_waitcnt lgkmcnt(" #n ")" ::: "memory")
#define PG8_BAR __builtin_amdgcn_s_barrier()
#define PG8_SCHED __builtin_amdgcn_sched_barrier(0)
    Unit cur, nxt; int ui = 0;
    if (!S.next(0, cur)) return;
    f32x4 acc[2][2][4][2];
#pragma unroll
    for (int a = 0; a < 2; ++a)
#pragma unroll
        for (int b = 0; b < 2; ++b)
#pragma unroll
            for (int m = 0; m < 4; ++m)
#pragma unroll
                for (int n = 0; n < 2; ++n) acc[a][b][m][n] = (f32x4){0.f, 0.f, 0.f, 0.f};
    bf16x8 At[4][2], B0[2][2], B1[2][2];
    const char* cA = (const char*)g.A + (size_t)cur.pm * tstep; const char* cB = (const char*)g.Bt + (size_t)cur.pn * tstep;
    S.a_ready(cur);
    if constexpr (SP2) {
        PG8_STAGE(PG8_SB(0, 0), cB, voffB); PG8_STAGE(PG8_SB(0, 1), cB + hstep, voffB); PG8_STAGE(PG8_SA(0, 0), cA, voffA); PG8_STAGE(PG8_SA(0, 1), cA + hstep, voffA);
        if (wr == 1) PG8_BAR;
        PG8_WAIT_V(2); PG8_BAR;
        PG8_STAGE(PG8_SB(1, 0), cB + kstep, voffB); PG8_STAGE(PG8_SA(1, 0), cA + kstep, voffA); PG8_STAGE(PG8_SB(1, 1), cB + hstep + kstep, voffB);
        PG8_WAIT_V(6); PG8_BAR;
    } else {
        PG8_STAGE(PG8_SB(0, 0), cB, voffB); PG8_STAGE(PG8_SA(0, 0), cA, voffA); PG8_STAGE(PG8_SB(0, 1), cB + hstep, voffB); PG8_STAGE(PG8_SA(0, 1), cA + hstep, voffA);
        if (wr == 1) PG8_BAR;
        PG8_WAIT_V(4); PG8_BAR;
        PG8_STAGE(PG8_SB(1, 0), cB + kstep, voffB); PG8_STAGE(PG8_SA(1, 0), cA + kstep, voffA); PG8_STAGE(PG8_SB(1, 1), cB + hstep + kstep, voffB);
        PG8_WAIT_V(6); PG8_BAR;
    }
    for (;;) {
        const bool has_next = S.next(ui + 1, nxt);
        const char* nA = has_next ? (const char*)g.A + (size_t)nxt.pm * tstep : cA; const char* nB = has_next ? (const char*)g.Bt + (size_t)nxt.pn * tstep : cB;
        for (int t = 0; t < nt; t += 2) {
            const bool last = (t == nt - 2);
            const char* a1 = cA + (size_t)(t + 1) * kstep;
            const char* a2 = last ? nA : cA + (size_t)(t + 2) * kstep; const char* b2 = last ? nB : cB + (size_t)(t + 2) * kstep;
            const char* a3 = a2 + kstep; const char* b3 = b2 + kstep;
            if (last && has_next) S.a_ready(nxt);
            if constexpr (SP2) {
            PG8_LDB(B0, 0, 0); PG8_LDB(B1, 0, 1); PG8_SCHED; PG8_LDA(At, 0, 0); PG8_STAGE(PG8_SA(1, 1), a1 + hstep, voffA);
            PG8_WAIT_V(8); PG8_WAIT_L(0); PG8_BAR; PG8_MMA(0, 0, At, B0); PG8_MMA(0, 1, At, B1); PG8_BAR; PG8_SCHED;
            PG8_LDA(At, 0, 1); PG8_STAGE(PG8_SB(0, 0), b2, voffB); PG8_STAGE(PG8_SB(0, 1), b2 + hstep, voffB); PG8_STAGE(PG8_SA(0, 0), a2, voffA);
            PG8_WAIT_V(8); PG8_WAIT_L(0); PG8_BAR; PG8_MMA(1, 0, At, B0); PG8_MMA(1, 1, At, B1); PG8_BAR; PG8_SCHED;
            PG8_LDB(B0, 1, 0); PG8_LDB(B1, 1, 1); PG8_SCHED; PG8_LDA(At, 1, 0); PG8_STAGE(PG8_SA(0, 1), a2 + hstep, voffA);
            PG8_WAIT_V(8); PG8_WAIT_L(0); PG8_BAR; PG8_MMA(0, 0, At, B0); PG8_MMA(0, 1, At, B1); PG8_BAR; PG8_SCHED;
            PG8_LDA(At, 1, 1); PG8_STAGE(PG8_SB(1, 0), b3, voffB); PG8_STAGE(PG8_SB(1, 1), b3 + hstep, voffB); PG8_STAGE(PG8_SA(1, 0), a3, voffA);
            PG8_WAIT_V(8); PG8_WAIT_L(0); PG8_BAR; PG8_MMA(1, 0, At, B0); PG8_MMA(1, 1, At, B1); PG8_BAR; PG8_SCHED;
            } else {
            PG8_LDB(B0, 0, 0); PG8_SCHED; PG8_LDA(At, 0, 0); PG8_STAGE(PG8_SA(1, 1), a1 + hstep, voffA);
            PG8_WAIT_L(8); PG8_BAR; PG8_WAIT_L(0); PG8_MMA(0, 0, At, B0); PG8_BAR; PG8_SCHED;
            PG8_LDB(B1, 0, 1); PG8_STAGE(PG8_SB(0, 0), b2, voffB);
            PG8_BAR; PG8_WAIT_L(0); PG8_MMA(0, 1, At, B1); PG8_BAR;
            PG8_LDA(At, 0, 1); PG8_STAGE(PG8_SA(0, 0), a2, voffA);
            PG8_BAR; PG8_WAIT_L(0); PG8_MMA(1, 0, At, B0); PG8_BAR; PG8_SCHED;
            PG8_STAGE(PG8_SB(0, 1), b2 + hstep, voffB);
            PG8_WAIT_V(6); PG8_BAR; PG8_MMA(1, 1, At, B1); PG8_BAR;
            PG8_LDB(B0, 1, 0); PG8_SCHED; PG8_LDA(At, 1, 0); PG8_STAGE(PG8_SA(0, 1), a2 + hstep, voffA);
            PG8_WAIT_L(8); PG8_BAR; PG8_WAIT_L(0); PG8_MMA(0, 0, At, B0); PG8_BAR; PG8_SCHED;
            PG8_LDB(B1, 1, 1); PG8_STAGE(PG8_SB(1, 0), b3, voffB);
            PG8_BAR; PG8_WAIT_L(0); PG8_MMA(0, 1, At, B1); PG8_BAR;
            PG8_LDA(At, 1, 1); PG8_STAGE(PG8_SA(1, 0), a3, voffA);
            PG8_BAR; PG8_WAIT_L(0); PG8_MMA(1, 0, At, B0); PG8_BAR; PG8_SCHED;
            PG8_STAGE(PG8_SB(1, 1), b3 + hstep, voffB);
            PG8_WAIT_V(6); PG8_BAR; PG8_MMA(1, 1, At, B1); PG8_BAR;
            }
        }
        if constexpr (ALIGN_EPI) { if (wr == 0) PG8_BAR; }
        if constexpr (!Epi::AFTER_DRAIN) { E(acc, cur, wr, wc, fr, fq); S.done(cur); }
        if (!has_next) break;
#pragma unroll
        for (int a = 0; a < 2; ++a)
#pragma unroll
            for (int b = 0; b < 2; ++b)
#pragma unroll
                for (int m = 0; m < 4; ++m)
#pragma unroll
                    for (int n = 0; n < 2; ++n) acc[a][b][m][n] = (f32x4){0.f, 0.f, 0.f, 0.f};
        cur = nxt; cA = nA; cB = nB; ++ui;
        if constexpr (ALIGN_EPI) { if (wr == 1) PG8_BAR; }
    }
    PG8_WAIT_V(0);
    if constexpr (!ALIGN_EPI) { if (wr == 0) PG8_BAR; }
    PG8_BAR;
    if constexpr (Epi::AFTER_DRAIN) { E.fused(acc, cur, wr, wc, fr, fq, lds, wid, lane); S.done(cur); }
#undef PG8_SA
#undef PG8_SB
#undef PG8_STAGE
#undef PG8_LDA
#undef PG8_LDB
#undef PG8_MMA
#undef PG8_WAIT_V
#undef PG8_WAIT_L
#undef PG8_BAR
#undef PG8_SCHED
}
}


namespace pg8 {
struct EpiZ {
    static constexpr bool PERM = true, AFTER_DRAIN = false;
    bf16_t* z; bf16_t* vT; const float* rss;
    __device__ __forceinline__ void operator()(const f32x4 (&acc)[2][2][4][2], const Unit& u, int wr, int wc, int fr, int fq) const {
        f32x4 part[2][4];
#pragma unroll
        for (int ai = 0; ai < 2; ++ai)
#pragma unroll
            for (int m = 0; m < 4; ++m) part[ai][m] = *(const f32x4*)(rss + (size_t)(u.pm * BM + ai * HALF + wr * 64 + m * 16 + fr) * 16 + 4 * fq);
        float rstdv[2][4];
#pragma unroll
        for (int ai = 0; ai < 2; ++ai)
#pragma unroll
            for (int m = 0; m < 4; ++m) {
                float s = (part[ai][m][0] + part[ai][m][1]) + (part[ai][m][2] + part[ai][m][3]);
                s += __shfl_xor(s, 16); s += __shfl_xor(s, 32);
                rstdv[ai][m] = rsqrtf(s * (1.0f / 1024.0f) + RMS_EPS);
            }
#pragma unroll
        for (int ai = 0; ai < 2; ++ai)
#pragma unroll
            for (int m = 0; m < 4; ++m) {
                const int row = u.pm * BM + ai * HALF + wr * 64 + m * 16 + fr;
                const float rstd = rstdv[ai][m];
                const int b = row >> 11, s = row & 2047;
#pragma unroll
                for (int bj = 0; bj < 2; ++bj) {
                    const int tn = 2 * u.pn + bj;
                    const int cw = 32 * wc + 8 * fq;
                    const f32x4 v0 = acc[ai][bj][m][0] * rstd, v1 = acc[ai][bj][m][1] * rstd;
                    u32x4 w; w.x = ::cvt_pk_bf16(v0[0], v0[1]); w.y = ::cvt_pk_bf16(v0[2], v0[3]); w.z = ::cvt_pk_bf16(v1[0], v1[1]); w.w = ::cvt_pk_bf16(v1[2], v1[3]);
                    if (tn < 24) {
                        bf16_t* dst;
                        if (tn < 8) dst = z + (size_t)(tn >> 2) * ZS_KD + ((size_t)((b * 4 + (tn & 3)) * 2048 + s)) * 128 + cw;
                        else if (tn < 16) dst = z + ZS_QN + (size_t)((tn - 8) >> 2) * (ZS_KN - ZS_QN) + ((size_t)((b * 8 + ((tn - 8) & 3) * 2 + (cw >> 6)) * 2048 + s)) * 64 + (cw & 63);
                        else dst = z + ZS_GATE + (size_t)row * 1024 + (tn - 16) * 128 + cw;
                        *(u32x4*)dst = w;
                    } else {
                        const unsigned ox = __shfl_xor(w.x, 1), oy = __shfl_xor(w.y, 1), oz = __shfl_xor(w.z, 1), ow = __shfl_xor(w.w, 1);
                        const bool odd = fr & 1;
                        const unsigned a0 = odd ? oz : w.x, a1 = odd ? ow : w.y;
                        const unsigned b0 = odd ? w.z : ox, b1 = odd ? w.w : oy;
                        const unsigned p0 = (a0 & 0xffffu) | (b0 << 16), p1 = (a0 >> 16) | (b0 & 0xffff0000u);
                        const unsigned p2 = (a1 & 0xffffu) | (b1 << 16), p3 = (a1 >> 16) | (b1 & 0xffff0000u);
                        const int ch0 = cw + (odd ? 4 : 0), se = s & ~1;
                        bf16_t* dst;
                        if (tn < 28) dst = vT + VS_VD + ((size_t)(((b * 4 + (tn - 24)) * 32 + (se >> 6)) * 128 + ch0)) * 64 + (se & 63);
                        else dst = vT + VS_VN + ((size_t)(((b * 8 + (tn - 28) * 2 + (ch0 >> 6)) * 32 + (se >> 6)) * 64 + (ch0 & 63))) * 64 + (se & 63);
                        *(unsigned*)(dst) = p0; *(unsigned*)(dst + 64) = p1; *(unsigned*)(dst + 128) = p2; *(unsigned*)(dst + 192) = p3;
                    }
                }
            }
    }
};
template <bool WRITE_XB> struct EpiRes {
    static constexpr bool PERM = true, AFTER_DRAIN = false;
    const float* xin; float* xf; bf16_t* xb; float* rss;
    __device__ __forceinline__ void operator()(const f32x4 (&acc)[2][2][4][2], const Unit& u, int wr, int wc, int fr, int fq) const {
#pragma unroll
        for (int ai = 0; ai < 2; ++ai) {
            f32x4 res[4][2][2];
#pragma unroll
            for (int m = 0; m < 4; ++m)
#pragma unroll
                for (int bj = 0; bj < 2; ++bj) {
                    const size_t off = (size_t)(u.pm * BM + ai * HALF + wr * 64 + m * 16 + fr) * 1024 + u.pn * BM + bj * HALF + 32 * wc + 8 * fq;
                    res[m][bj][0] = *(const f32x4*)(xin + off); res[m][bj][1] = *(const f32x4*)(xin + off + 4);
                }
            __builtin_amdgcn_sched_barrier(0);
#pragma unroll
            for (int m = 0; m < 4; ++m) {
                const int row = u.pm * BM + ai * HALF + wr * 64 + m * 16 + fr;
                float ss = 0.f;
#pragma unroll
                for (int bj = 0; bj < 2; ++bj) {
                    const size_t off = (size_t)row * 1024 + u.pn * BM + bj * HALF + 32 * wc + 8 * fq;
                    const f32x4 v0 = res[m][bj][0] + acc[ai][bj][m][0], v1 = res[m][bj][1] + acc[ai][bj][m][1];
                    *(f32x4*)(xf + off) = v0; *(f32x4*)(xf + off + 4) = v1;
                    if (WRITE_XB) { u32x4 w; w.x = ::cvt_pk_bf16(v0[0], v0[1]); w.y = ::cvt_pk_bf16(v0[2], v0[3]); w.z = ::cvt_pk_bf16(v1[0], v1[1]); w.w = ::cvt_pk_bf16(v1[2], v1[3]); *(u32x4*)(xb + off) = w; }
                    ss += (v0[0] * v0[0] + v0[1] * v0[1]) + (v0[2] * v0[2] + v0[3] * v0[3]) + (v1[0] * v1[0] + v1[1] * v1[1]) + (v1[2] * v1[2] + v1[3] * v1[3]);
                }
                ss += __shfl_xor(ss, 16); ss += __shfl_xor(ss, 32);
                if (fq == 0) rss[(size_t)row * 16 + u.pn * 4 + wc] = ss;
            }
            __builtin_amdgcn_sched_barrier(0);
        }
    }
};
struct EpiFinal {
    static constexpr bool PERM = true, AFTER_DRAIN = true;
    const float* xin; float* out; const float* fg; float* rss; unsigned* cnt;
    __device__ __forceinline__ void fused(f32x4 (&acc)[2][2][4][2], const Unit& u, int wr, int wc, int fr, int fq, PG8_LAS unsigned char* lds, int wid, int lane) const {
        float ssv[2][4];
#pragma unroll
        for (int ai = 0; ai < 2; ++ai) {
            f32x4 res[4][2][2];
#pragma unroll
            for (int m = 0; m < 4; ++m)
#pragma unroll
                for (int bj = 0; bj < 2; ++bj) {
                    const size_t off = (size_t)(u.pm * BM + ai * HALF + wr * 64 + m * 16 + fr) * 1024 + u.pn * BM + bj * HALF + 32 * wc + 8 * fq;
                    res[m][bj][0] = *(const f32x4*)(xin + off); res[m][bj][1] = *(const f32x4*)(xin + off + 4);
                }
#pragma unroll
            for (int m = 0; m < 4; ++m) {
                float ss = 0.f;
#pragma unroll
                for (int bj = 0; bj < 2; ++bj) {
                    const f32x4 v0 = res[m][bj][0] + acc[ai][bj][m][0], v1 = res[m][bj][1] + acc[ai][bj][m][1];
                    acc[ai][bj][m][0] = v0; acc[ai][bj][m][1] = v1;
                    ss += (v0[0] * v0[0] + v0[1] * v0[1]) + (v0[2] * v0[2] + v0[3] * v0[3]) + (v1[0] * v1[0] + v1[1] * v1[1]) + (v1[2] * v1[2] + v1[3] * v1[3]);
                }
                ss += __shfl_xor(ss, 16); ss += __shfl_xor(ss, 32);
                ssv[ai][m] = ss;
            }
        }
        if (fq == 0) {
#pragma unroll
            for (int ai = 0; ai < 2; ++ai)
#pragma unroll
                for (int m = 0; m < 4; ++m)
                    __hip_atomic_store((unsigned*)rss + (size_t)(u.pm * BM + ai * HALF + wr * 64 + m * 16 + fr) * 16 + u.pn * 4 + wc, __float_as_uint(ssv[ai][m]), __ATOMIC_RELAXED, __HIP_MEMORY_SCOPE_AGENT);
        }
        asm volatile("s_waitcnt vmcnt(0)" ::: "memory");
        if (lane == 0) __hip_atomic_fetch_add(cnt + 64 * u.pm, 1u, __ATOMIC_RELAXED, __HIP_MEMORY_SCOPE_AGENT);
        if (wid == 0) {
            unsigned spins = 0;
            while ((unsigned)__builtin_amdgcn_readfirstlane(__hip_atomic_load(cnt + 64 * u.pm, __ATOMIC_RELAXED, __HIP_MEMORY_SCOPE_AGENT)) < 32u) {
                __builtin_amdgcn_s_sleep(2);
                if (++spins > (1u << 22)) break;
            }
            __builtin_amdgcn_fence(__ATOMIC_ACQUIRE, "agent");
        }
        asm volatile("s_waitcnt vmcnt(0) lgkmcnt(0)" ::: "memory"); __builtin_amdgcn_s_barrier(); asm volatile("" ::: "memory");
        float rstdv[2][4];
#pragma unroll
        for (int ai = 0; ai < 2; ++ai)
#pragma unroll
            for (int m = 0; m < 4; ++m) {
                const unsigned* rp = (const unsigned*)rss + (size_t)(u.pm * BM + ai * HALF + wr * 64 + m * 16 + fr) * 16 + 4 * fq;
                float s = 0.f;
#pragma unroll
                for (int k = 0; k < 4; ++k) s += __uint_as_float(__hip_atomic_load(rp + k, __ATOMIC_RELAXED, __HIP_MEMORY_SCOPE_AGENT));
                s += __shfl_xor(s, 16); s += __shfl_xor(s, 32);
                rstdv[ai][m] = rsqrtf(s * (1.0f / 1024.0f) + RMS_EPS);
            }
        f32x4 gv[2][2];
#pragma unroll
        for (int bj = 0; bj < 2; ++bj) { const int c0 = u.pn * BM + bj * HALF + 32 * wc + 8 * fq; gv[bj][0] = *(const f32x4*)(fg + c0); gv[bj][1] = *(const f32x4*)(fg + c0 + 4); }
#pragma unroll
        for (int ai = 0; ai < 2; ++ai)
#pragma unroll
            for (int m = 0; m < 4; ++m)
#pragma unroll
                for (int bj = 0; bj < 2; ++bj) {
                    const size_t off = (size_t)(u.pm * BM + ai * HALF + wr * 64 + m * 16 + fr) * 1024 + u.pn * BM + bj * HALF + 32 * wc + 8 * fq;
                    *(f32x4*)(out + off) = acc[ai][bj][m][0] * rstdv[ai][m] * gv[bj][0];
                    *(f32x4*)(out + off + 4) = acc[ai][bj][m][1] * rstdv[ai][m] * gv[bj][1];
                }
    }
};
}
constexpr int LDS_PHASE_BYTES = 143360;
constexpr int LDS_RPB_OFF = LDS_PHASE_BYTES + 16, LDS_RPB_BYTES = 8 * 465 * 4;

constexpr int DA_KP = 272, DA_VP = 144;
constexpr int DA_KBYTES = 128 * DA_KP, DA_VSUB = 128 * DA_VP, DA_VBYTES = 2 * DA_VSUB, DA_STAGE = DA_KBYTES + DA_VBYTES;

__device__ __forceinline__ float silu_f(float x) { return x / (1.0f + __expf(-x)); }

__device__ void da_unit(char* lds, const Params& p, int layer, int unit) {
    int tid_ = threadIdx.x; asm volatile("" : "+v"(tid_)); const int tid = tid_, lane = tid & 63, wid = __builtin_amdgcn_readfirstlane(tid >> 6), r = lane & 31, h2 = lane >> 5;
    const int c = wid & 1, qg = wid >> 1;
    const int g8 = unit >> 3, bh = (unit & 7) * 4 + (g8 >> 4), qb = g8 & 15, b = bh >> 2, h = bh & 3;
    const float slope2 = exp2f(-2.0f * (float)(h + 1)) * LOG2E;
    const float qscale = 0.125f * LOG2E;
    float lam;
    {
        const float v1 = p.lq1[layer * 64 + lane] * p.lk1[layer * 64 + lane], v2 = p.lq2[layer * 64 + lane] * p.lk2[layer * 64 + lane];
        float s1 = v1, s2 = v2;
#pragma unroll
        for (int s = 32; s >= 1; s >>= 1) { s1 += __shfl_xor(s1, s); s2 += __shfl_xor(s2, s); }
        lam = __expf(s1) - __expf(s2) + p.lam_init[layer];
    }
    const int q0 = qb * 128 + qg * 32;
    const size_t tokq = (size_t)b * SEQ + q0 + r;
    bf16x8 qf[4];
#pragma unroll
    for (int t = 0; t < 4; ++t) {
        const u32x4 w = *(const u32x4*)(p.z + ZS_QD + ((size_t)(bh * 2048 + q0 + r)) * 128 + c * 64 + t * 16 + h2 * 8);
        u32x4 o;
        o.x = cvt_pk_bf16(bflo(w.x) * qscale, bfhi(w.x) * qscale); o.y = cvt_pk_bf16(bflo(w.y) * qscale, bfhi(w.y) * qscale);
        o.z = cvt_pk_bf16(bflo(w.z) * qscale, bfhi(w.z) * qscale); o.w = cvt_pk_bf16(bflo(w.w) * qscale, bfhi(w.w) * qscale);
        qf[t] = __builtin_bit_cast(bf16x8, o);
    }
    f32x16 O[4], Bs;
#pragma unroll
    for (int k = 0; k < 4; ++k)
#pragma unroll
        for (int e = 0; e < 16; ++e) O[k][e] = 0.f;
#pragma unroll
    for (int e = 0; e < 16; ++e) Bs[e] = -slope2 * (float)(16 * (e >> 3) + (e & 7));
    float mrow = -1e30f, lrow = 0.f;
    const float qrel = (float)(8 * h2) - (float)(q0 + r);
    const bf16_t* Kg = p.z + ZS_KD + ((size_t)bh * 2048) * 128 + tid * 8;
    const bf16_t* Vg = p.vT + VS_VD + ((size_t)bh * 32) * 8192 + tid * 8;
    const int kr_ = tid >> 4, kc_ = tid & 15, vr_ = tid >> 3, vc_ = tid & 7;
    constexpr int NT = SEQ / 128;
    auto tile_of = [&](int i) { return (i < NT - qb) ? (qb + i) : (NT - 1 - i); };
    u32x4 rk[4], rv[4];
    {
        const int t0 = tile_of(0);
#pragma unroll
        for (int j = 0; j < 4; ++j) { rk[j] = *(const u32x4*)(Kg + (size_t)t0 * 16384 + j * 4096); rv[j] = *(const u32x4*)(Vg + (size_t)t0 * 16384 + j * 4096); }
    }
    __syncthreads();
#pragma unroll
    for (int j = 0; j < 4; ++j) {
        *(u32x4*)(lds + (kr_ + 32 * j) * DA_KP + kc_ * 16) = rk[j];
        *(u32x4*)(lds + DA_KBYTES + (j >> 1) * DA_VSUB + (vr_ + 64 * (j & 1)) * DA_VP + vc_ * 16) = rv[j];
    }
    __syncthreads();
    const int pr = (r & 0x13) | ((r & 4) << 1) | ((r & 8) >> 1);
    {
        const int it = 0; const int kt = qb;
        const char* cK = lds + (it & 1) * DA_STAGE;
        const char* cV = cK + DA_KBYTES;
        char* nK = lds + ((it + 1) & 1) * DA_STAGE;
        if (it + 1 < NT) {
            const int tn = tile_of(it + 1);
#pragma unroll
            for (int j = 0; j < 4; ++j) { rk[j] = *(const u32x4*)(Kg + (size_t)tn * 16384 + j * 4096); rv[j] = *(const u32x4*)(Vg + (size_t)tn * 16384 + j * 4096); }
        }
#pragma unroll
        for (int kb = 0; kb < 4; ++kb) {
            const int k0 = kt * 128 + kb * 32;
            f32x16 s; const float A = 0.f;
            const float kq = (float)k0 + qrel;
#pragma unroll
            for (int e = 0; e < 16; ++e) s[e] = 0.f;
#pragma unroll
            for (int t = 0; t < 4; ++t) {
                const bf16x8 kf = *(const bf16x8*)(cK + (kb * 32 + pr) * DA_KP + c * 128 + t * 32 + h2 * 16);
                s = __builtin_amdgcn_mfma_f32_32x32x16_bf16(kf, qf[t], s, 0, 0, 0);
            }
#pragma unroll
            for (int e = 0; e < 16; ++e) s[e] = fmaf(fabsf(kq + (float)(16 * (e >> 3) + (e & 7))), -slope2, s[e]);
            float mx = s[0];
#pragma unroll
            for (int e = 1; e < 16; ++e) mx = fmaxf(mx, s[e]);
            mx += A;
            mx = fmaxf(mx, __shfl_xor(mx, 32));
            if (!__all(mx <= mrow + 8.0f)) {
                const float mnew = fmaxf(mrow, mx);
                const float alpha = fast_exp2(mrow - mnew);
#pragma unroll
                for (int k = 0; k < 4; ++k) O[k] = O[k] * alpha;
                lrow *= alpha; mrow = mnew;
            }
            const float mm = mrow - A;
            float ps = 0.f;
#pragma unroll
            for (int e = 0; e < 16; ++e) { s[e] = fast_exp2(s[e] - mm); ps += s[e]; }
            lrow += ps;
            bf16x8 pb[2];
#pragma unroll
            for (int sp = 0; sp < 2; ++sp) {
                u32x4 w;
                w.x = cvt_pk_bf16(s[8 * sp + 0], s[8 * sp + 1]); w.y = cvt_pk_bf16(s[8 * sp + 2], s[8 * sp + 3]);
                w.z = cvt_pk_bf16(s[8 * sp + 4], s[8 * sp + 5]); w.w = cvt_pk_bf16(s[8 * sp + 6], s[8 * sp + 7]);
                pb[sp] = __builtin_bit_cast(bf16x8, w);
            }
#pragma unroll
            for (int sp = 0; sp < 2; ++sp)
#pragma unroll
                for (int k = 0; k < 4; ++k) {
                    const bf16x8 vf = *(const bf16x8*)(cV + (kb >> 1) * DA_VSUB + (32 * k + r) * DA_VP + (32 * (kb & 1) + 16 * sp + 8 * h2) * 2);
                    O[k] = __builtin_amdgcn_mfma_f32_32x32x16_bf16(vf, pb[sp], O[k], 0, 0, 0);
                }
        }

        if (it + 1 < NT) {
#pragma unroll
            for (int j = 0; j < 4; ++j) {
                *(u32x4*)(nK + (kr_ + 32 * j) * DA_KP + kc_ * 16) = rk[j];
                *(u32x4*)(nK + DA_KBYTES + (j >> 1) * DA_VSUB + (vr_ + 64 * (j & 1)) * DA_VP + vc_ * 16) = rv[j];
            }
        }
        __syncthreads();
    }
    for (int it = 1; it < NT - qb; ++it) {
        const int kt = tile_of(it);
        const char* cK = lds + (it & 1) * DA_STAGE;
        const char* cV = cK + DA_KBYTES;
        char* nK = lds + ((it + 1) & 1) * DA_STAGE;
        const int tn = tile_of(it + 1 < NT ? it + 1 : it);
        if (it + 1 < NT) {
#pragma unroll
            for (int j = 0; j < 4; ++j) rk[j] = *(const u32x4*)(Kg + (size_t)tn * 16384 + j * 4096);
        }
#define DA_FAST_HALF(BSEL, SGN, hf) \
            { \
                f32x16 s0, s1; \
                { const bf16x8 kf0 = *(const bf16x8*)(cK + (hf * 64 + pr) * DA_KP + c * 128 + h2 * 16); \
                  const bf16x8 kf1 = *(const bf16x8*)(cK + (hf * 64 + 32 + pr) * DA_KP + c * 128 + h2 * 16); \
                  s0 = __builtin_amdgcn_mfma_f32_32x32x16_bf16(kf0, qf[0], BSEL, 0, 0, 0); \
                  s1 = __builtin_amdgcn_mfma_f32_32x32x16_bf16(kf1, qf[0], BSEL, 0, 0, 0); } \
                _Pragma("unroll") \
                for (int t = 1; t < 4; ++t) { \
                    const bf16x8 kf0 = *(const bf16x8*)(cK + (hf * 64 + pr) * DA_KP + c * 128 + t * 32 + h2 * 16); \
                    const bf16x8 kf1 = *(const bf16x8*)(cK + (hf * 64 + 32 + pr) * DA_KP + c * 128 + t * 32 + h2 * 16); \
                    s0 = __builtin_amdgcn_mfma_f32_32x32x16_bf16(kf0, qf[t], s0, 0, 0, 0); \
                    s1 = __builtin_amdgcn_mfma_f32_32x32x16_bf16(kf1, qf[t], s1, 0, 0, 0); \
                } \
                const float A0 = (SGN) * ((float)(kt * 128 + hf * 64) + qrel), A1 = A0 + (SGN) * 32.0f; \
                const float mm0 = mrow - A0, mm1 = mrow - A1; \
                float ps0 = 0.f, ps1 = 0.f; \
                _Pragma("unroll") \
                for (int e = 0; e < 16; ++e) { s0[e] = fast_exp2(s0[e] - mm0); ps0 += s0[e]; } \
                bf16x8 pb0[2], pb1[2]; \
                _Pragma("unroll") \
                for (int sp = 0; sp < 2; ++sp) { \
                    u32x4 w; \
                    w.x = cvt_pk_bf16(s0[8 * sp + 0], s0[8 * sp + 1]); w.y = cvt_pk_bf16(s0[8 * sp + 2], s0[8 * sp + 3]); \
                    w.z = cvt_pk_bf16(s0[8 * sp + 4], s0[8 * sp + 5]); w.w = cvt_pk_bf16(s0[8 * sp + 6], s0[8 * sp + 7]); \
                    pb0[sp] = __builtin_bit_cast(bf16x8, w); \
                } \
                _Pragma("unroll") \
                for (int sp = 0; sp < 2; ++sp) \
                    _Pragma("unroll") \
                    for (int k = 0; k < 4; ++k) { \
                        const bf16x8 vf0 = *(const bf16x8*)(cV + hf * DA_VSUB + (32 * k + r) * DA_VP + (16 * sp + 8 * h2) * 2); \
                        O[k] = __builtin_amdgcn_mfma_f32_32x32x16_bf16(vf0, pb0[sp], O[k], 0, 0, 0); \
                    } \
                _Pragma("unroll") \
                for (int e = 0; e < 16; ++e) { s1[e] = fast_exp2(s1[e] - mm1); ps1 += s1[e]; } \
                lrow += ps0 + ps1; \
                _Pragma("unroll") \
                for (int sp = 0; sp < 2; ++sp) { \
                    u32x4 w; \
                    w.x = cvt_pk_bf16(s1[8 * sp + 0], s1[8 * sp + 1]); w.y = cvt_pk_bf16(s1[8 * sp + 2], s1[8 * sp + 3]); \
                    w.z = cvt_pk_bf16(s1[8 * sp + 4], s1[8 * sp + 5]); w.w = cvt_pk_bf16(s1[8 * sp + 6], s1[8 * sp + 7]); \
                    pb1[sp] = __builtin_bit_cast(bf16x8, w); \
                } \
                _Pragma("unroll") \
                for (int sp = 0; sp < 2; ++sp) \
                    _Pragma("unroll") \
                    for (int k = 0; k < 4; ++k) { \
                        const bf16x8 vf1 = *(const bf16x8*)(cV + hf * DA_VSUB + (32 * k + r) * DA_VP + (32 + 16 * sp + 8 * h2) * 2); \
                        O[k] = __builtin_amdgcn_mfma_f32_32x32x16_bf16(vf1, pb1[sp], O[k], 0, 0, 0); \
                    } \
            }
        DA_FAST_HALF(Bs, -slope2, 0)
        if (it + 1 < NT) {
#pragma unroll
            for (int j = 0; j < 4; ++j) *(u32x4*)(nK + (kr_ + 32 * j) * DA_KP + kc_ * 16) = rk[j];
#pragma unroll
            for (int j = 0; j < 4; ++j) rk[j] = *(const u32x4*)(Vg + (size_t)tn * 16384 + j * 4096);
        }
        DA_FAST_HALF(Bs, -slope2, 1)
#undef DA_FAST_HALF
        if (it + 1 < NT) {
#pragma unroll
            for (int j = 0; j < 4; ++j) *(u32x4*)(nK + DA_KBYTES + (j >> 1) * DA_VSUB + (vr_ + 64 * (j & 1)) * DA_VP + vc_ * 16) = rk[j];
        }
        __syncthreads();
    }
#pragma unroll
    for (int e = 0; e < 16; ++e) Bs[e] = -Bs[e];
    for (int it = NT - qb; it < NT; ++it) {
        const int kt = tile_of(it);
        const char* cK = lds + (it & 1) * DA_STAGE;
        const char* cV = cK + DA_KBYTES;
        char* nK = lds + ((it + 1) & 1) * DA_STAGE;
        const int tn = tile_of(it + 1 < NT ? it + 1 : it);
        if (it + 1 < NT) {
#pragma unroll
            for (int j = 0; j < 4; ++j) rk[j] = *(const u32x4*)(Kg + (size_t)tn * 16384 + j * 4096);
        }
#define DA_FAST_HALF(BSEL, SGN, hf) \
            { \
                f32x16 s0, s1; \
                { const bf16x8 kf0 = *(const bf16x8*)(cK + (hf * 64 + pr) * DA_KP + c * 128 + h2 * 16); \
                  const bf16x8 kf1 = *(const bf16x8*)(cK + (hf * 64 + 32 + pr) * DA_KP + c * 128 + h2 * 16); \
                  s0 = __builtin_amdgcn_mfma_f32_32x32x16_bf16(kf0, qf[0], BSEL, 0, 0, 0); \
                  s1 = __builtin_amdgcn_mfma_f32_32x32x16_bf16(kf1, qf[0], BSEL, 0, 0, 0); } \
                _Pragma("unroll") \
                for (int t = 1; t < 4; ++t) { \
                    const bf16x8 kf0 = *(const bf16x8*)(cK + (hf * 64 + pr) * DA_KP + c * 128 + t * 32 + h2 * 16); \
                    const bf16x8 kf1 = *(const bf16x8*)(cK + (hf * 64 + 32 + pr) * DA_KP + c * 128 + t * 32 + h2 * 16); \
                    s0 = __builtin_amdgcn_mfma_f32_32x32x16_bf16(kf0, qf[t], s0, 0, 0, 0); \
                    s1 = __builtin_amdgcn_mfma_f32_32x32x16_bf16(kf1, qf[t], s1, 0, 0, 0); \
                } \
                const float A0 = (SGN) * ((float)(kt * 128 + hf * 64) + qrel), A1 = A0 + (SGN) * 32.0f; \
                const float mm0 = mrow - A0, mm1 = mrow - A1; \
                float ps0 = 0.f, ps1 = 0.f; \
                _Pragma("unroll") \
                for (int e = 0; e < 16; ++e) { s0[e] = fast_exp2(s0[e] - mm0); ps0 += s0[e]; } \
                bf16x8 pb0[2], pb1[2]; \
                _Pragma("unroll") \
                for (int sp = 0; sp < 2; ++sp) { \
                    u32x4 w; \
                    w.x = cvt_pk_bf16(s0[8 * sp + 0], s0[8 * sp + 1]); w.y = cvt_pk_bf16(s0[8 * sp + 2], s0[8 * sp + 3]); \
                    w.z = cvt_pk_bf16(s0[8 * sp + 4], s0[8 * sp + 5]); w.w = cvt_pk_bf16(s0[8 * sp + 6], s0[8 * sp + 7]); \
                    pb0[sp] = __builtin_bit_cast(bf16x8, w); \
                } \
                _Pragma("unroll") \
                for (int sp = 0; sp < 2; ++sp) \
                    _Pragma("unroll") \
                    for (int k = 0; k < 4; ++k) { \
                        const bf16x8 vf0 = *(const bf16x8*)(cV + hf * DA_VSUB + (32 * k + r) * DA_VP + (16 * sp + 8 * h2) * 2); \
                        O[k] = __builtin_amdgcn_mfma_f32_32x32x16_bf16(vf0, pb0[sp], O[k], 0, 0, 0); \
                    } \
                _Pragma("unroll") \
                for (int e = 0; e < 16; ++e) { s1[e] = fast_exp2(s1[e] - mm1); ps1 += s1[e]; } \
                lrow += ps0 + ps1; \
                _Pragma("unroll") \
                for (int sp = 0; sp < 2; ++sp) { \
                    u32x4 w; \
                    w.x = cvt_pk_bf16(s1[8 * sp + 0], s1[8 * sp + 1]); w.y = cvt_pk_bf16(s1[8 * sp + 2], s1[8 * sp + 3]); \
                    w.z = cvt_pk_bf16(s1[8 * sp + 4], s1[8 * sp + 5]); w.w = cvt_pk_bf16(s1[8 * sp + 6], s1[8 * sp + 7]); \
                    pb1[sp] = __builtin_bit_cast(bf16x8, w); \
                } \
                _Pragma("unroll") \
                for (int sp = 0; sp < 2; ++sp) \
                    _Pragma("unroll") \
                    for (int k = 0; k < 4; ++k) { \
                        const bf16x8 vf1 = *(const bf16x8*)(cV + hf * DA_VSUB + (32 * k + r) * DA_VP + (32 + 16 * sp + 8 * h2) * 2); \
                        O[k] = __builtin_amdgcn_mfma_f32_32x32x16_bf16(vf1, pb1[sp], O[k], 0, 0, 0); \
                    } \
            }
        DA_FAST_HALF(Bs, slope2, 0)
        if (it + 1 < NT) {
#pragma unroll
            for (int j = 0; j < 4; ++j) *(u32x4*)(nK + (kr_ + 32 * j) * DA_KP + kc_ * 16) = rk[j];
#pragma unroll
            for (int j = 0; j < 4; ++j) rk[j] = *(const u32x4*)(Vg + (size_t)tn * 16384 + j * 4096);
        }
        DA_FAST_HALF(Bs, slope2, 1)
#undef DA_FAST_HALF
        if (it + 1 < NT) {
#pragma unroll
            for (int j = 0; j < 4; ++j) *(u32x4*)(nK + DA_KBYTES + (j >> 1) * DA_VSUB + (vr_ + 64 * (j & 1)) * DA_VP + vc_ * 16) = rk[j];
        }
        __syncthreads();
    }
    {
        const float lchk = lrow + __shfl_xor(lrow, 32);
        const int bad = !(lchk < 1e30f);
        volatile unsigned* bflag = (volatile unsigned*)(lds + LDS_PHASE_BYTES + 8);
        if (tid == 0) *bflag = 0u;
        __syncthreads();
        if (__any(bad) && lane == 0) *bflag = 1u;
        __syncthreads();
        if (*bflag != 0u) {
#pragma unroll
            for (int k = 0; k < 4; ++k)
#pragma unroll
                for (int e = 0; e < 16; ++e) O[k][e] = 0.f;
            mrow = -1e30f; lrow = 0.f;
            {
                const int t0 = tile_of(0);
#pragma unroll
                for (int j = 0; j < 4; ++j) { rk[j] = *(const u32x4*)(Kg + (size_t)t0 * 16384 + j * 4096); rv[j] = *(const u32x4*)(Vg + (size_t)t0 * 16384 + j * 4096); }
            }
#pragma unroll
            for (int j = 0; j < 4; ++j) {
                *(u32x4*)(lds + (kr_ + 32 * j) * DA_KP + kc_ * 16) = rk[j];
                *(u32x4*)(lds + DA_KBYTES + (j >> 1) * DA_VSUB + (vr_ + 64 * (j & 1)) * DA_VP + vc_ * 16) = rv[j];
            }
            __syncthreads();
        for (int it = 0; it < NT; ++it) {
            const int kt = tile_of(it);
        const char* cK = lds + (it & 1) * DA_STAGE;
        const char* cV = cK + DA_KBYTES;
        char* nK = lds + ((it + 1) & 1) * DA_STAGE;
        if (it + 1 < NT) {
            const int tn = tile_of(it + 1);
#pragma unroll
            for (int j = 0; j < 4; ++j) { rk[j] = *(const u32x4*)(Kg + (size_t)tn * 16384 + j * 4096); rv[j] = *(const u32x4*)(Vg + (size_t)tn * 16384 + j * 4096); }
        }
#pragma unroll
        for (int kb = 0; kb < 4; ++kb) {
            const int k0 = kt * 128 + kb * 32;
            f32x16 s; const float A = 0.f;
            const float kq = (float)k0 + qrel;
#pragma unroll
            for (int e = 0; e < 16; ++e) s[e] = 0.f;
#pragma unroll
            for (int t = 0; t < 4; ++t) {
                const bf16x8 kf = *(const bf16x8*)(cK + (kb * 32 + pr) * DA_KP + c * 128 + t * 32 + h2 * 16);
                s = __builtin_amdgcn_mfma_f32_32x32x16_bf16(kf, qf[t], s, 0, 0, 0);
            }
#pragma unroll
            for (int e = 0; e < 16; ++e) s[e] = fmaf(fabsf(kq + (float)(16 * (e >> 3) + (e & 7))), -slope2, s[e]);
            float mx = s[0];
#pragma unroll
            for (int e = 1; e < 16; ++e) mx = fmaxf(mx, s[e]);
            mx += A;
            mx = fmaxf(mx, __shfl_xor(mx, 32));
            if (!__all(mx <= mrow + 8.0f)) {
                const float mnew = fmaxf(mrow, mx);
                const float alpha = fast_exp2(mrow - mnew);
#pragma unroll
                for (int k = 0; k < 4; ++k) O[k] = O[k] * alpha;
                lrow *= alpha; mrow = mnew;
            }
            const float mm = mrow - A;
            float ps = 0.f;
#pragma unroll
            for (int e = 0; e < 16; ++e) { s[e] = fast_exp2(s[e] - mm); ps += s[e]; }
            lrow += ps;
            bf16x8 pb[2];
#pragma unroll
            for (int sp = 0; sp < 2; ++sp) {
                u32x4 w;
                w.x = cvt_pk_bf16(s[8 * sp + 0], s[8 * sp + 1]); w.y = cvt_pk_bf16(s[8 * sp + 2], s[8 * sp + 3]);
                w.z = cvt_pk_bf16(s[8 * sp + 4], s[8 * sp + 5]); w.w = cvt_pk_bf16(s[8 * sp + 6], s[8 * sp + 7]);
                pb[sp] = __builtin_bit_cast(bf16x8, w);
            }
#pragma unroll
            for (int sp = 0; sp < 2; ++sp)
#pragma unroll
                for (int k = 0; k < 4; ++k) {
                    const bf16x8 vf = *(const bf16x8*)(cV + (kb >> 1) * DA_VSUB + (32 * k + r) * DA_VP + (32 * (kb & 1) + 16 * sp + 8 * h2) * 2);
                    O[k] = __builtin_amdgcn_mfma_f32_32x32x16_bf16(vf, pb[sp], O[k], 0, 0, 0);
                }
        }

        if (it + 1 < NT) {
#pragma unroll
            for (int j = 0; j < 4; ++j) {
                *(u32x4*)(nK + (kr_ + 32 * j) * DA_KP + kc_ * 16) = rk[j];
                *(u32x4*)(nK + DA_KBYTES + (j >> 1) * DA_VSUB + (vr_ + 64 * (j & 1)) * DA_VP + vc_ * 16) = rv[j];
            }
        }
        __syncthreads();
    }
        }
    }
    const float lsum = lrow + __shfl_xor(lrow, 32);
    float* xch = (float*)lds + qg * 4096;
    if (c == 1) {
        const float i1 = lam / lsum;
#pragma unroll
        for (int k = 0; k < 4; ++k)
#pragma unroll
            for (int e = 0; e < 16; ++e) xch[(k * 16 + e) * 64 + lane] = O[k][e] * i1;
    }
    __syncthreads();
    if (c == 0) {
        const float i0 = 1.0f / lsum;
        float ss = 0.f;
#pragma unroll
        for (int k = 0; k < 4; ++k)
#pragma unroll
            for (int e = 0; e < 16; ++e) { const float a = O[k][e] * i0 - xch[(k * 16 + e) * 64 + lane]; O[k][e] = a; ss += a * a; }
        ss += __shfl_xor(ss, 32);
        const float rstd = rsqrtf(ss * (1.0f / 128.0f) + RMS_EPS) * (1.0f - p.lam_init[layer]);
        const float* sg = p.subln_g + layer * 128;
#pragma unroll
        for (int k = 0; k < 4; ++k)
#pragma unroll
            for (int g = 0; g < 4; ++g) {
                const int d0 = 32 * k + 8 * g + 4 * h2;
                const f32x4 gg = *(const f32x4*)(sg + d0);
                const u32x2 gw = *(const u32x2*)(p.z + ZS_GATE + tokq * 1024 + h * 128 + d0);
                const float o0 = O[k][4 * g + 0] * rstd * gg[0] * silu_f(bflo(gw.x));
                const float o1 = O[k][4 * g + 1] * rstd * gg[1] * silu_f(bfhi(gw.x));
                const float o2 = O[k][4 * g + 2] * rstd * gg[2] * silu_f(bflo(gw.y));
                const float o3 = O[k][4 * g + 3] * rstd * gg[3] * silu_f(bfhi(gw.y));
                u32x2 w; w.x = cvt_pk_bf16(o0, o1); w.y = cvt_pk_bf16(o2, o3);
                *(u32x2*)(p.o + tokq * 1024 + h * 128 + d0) = w;
            }
    }
}

__device__ void na_unit(char* lds, const Params& p, int layer, int unit) {
    int tid_ = threadIdx.x; asm volatile("" : "+v"(tid_)); const int tid = tid_, lane = tid & 63, wid = __builtin_amdgcn_readfirstlane(tid >> 6), fr = lane & 15, fq = lane >> 4;
    const int hp = unit & 3, rr0 = (unit >> 2) & 31, b = unit >> 7;
    const int h = 2 * hp + (wid >> 2), n = wid & 3;
    const float* rph = (const float*)(lds + LDS_RPB_OFF) + h * 465;
    const int r = rr0;
    const int rs = min(max(r - 4, 0), 24);
    const int kcstart = min(max(16 * n - 8, 0), 32);
    const int qcol = 16 * n + fr;
    const int qcstart = min(max(qcol - 8, 0), 48);
    const size_t tokq = (size_t)b * SEQ + r * 64 + qcol;
    bf16x8 qf[2];
#pragma unroll
    for (int t = 0; t < 2; ++t) qf[t] = *(const bf16x8*)(p.z + ZS_QN + ((size_t)((b * 8 + h) * 2048 + r * 64 + qcol)) * 64 + t * 32 + fq * 8);
    bf16x8 kfr[8][4];
    {
        const int kc = kcstart + 8 * (fr >> 2) + (fr & 3);
        const bf16_t* kg0 = p.z + ZS_KN + ((size_t)((b * 8 + h) * 2048 + rs * 64 + kc)) * 64 + fq * 8;
#pragma unroll
        for (int rr = 0; rr < 8; ++rr)
#pragma unroll
            for (int T = 0; T < 2; ++T) {
                const bf16_t* kg = kg0 + (size_t)(rr * 64 + 4 * T) * 64;
                kfr[rr][2 * T] = *(const bf16x8*)(kg); kfr[rr][2 * T + 1] = *(const bf16x8*)(kg + 32);
            }
    }
    __builtin_amdgcn_sched_barrier(0);
    const float c1 = 0.125f * LOG2E;
    float sc[8][8];
    float mx = -1e30f;
#pragma unroll
    for (int rr = 0; rr < 8; ++rr) {
#pragma unroll
        for (int T = 0; T < 2; ++T) {
            f32x4 s = (f32x4){0.f, 0.f, 0.f, 0.f};
            s = __builtin_amdgcn_mfma_f32_16x16x32_bf16(kfr[rr][2 * T], qf[0], s, 0, 0, 0);
            s = __builtin_amdgcn_mfma_f32_16x16x32_bf16(kfr[rr][2 * T + 1], qf[1], s, 0, 0, 0);
            const int dr = rs + rr - r + 7;
#pragma unroll
            for (int e = 0; e < 4; ++e) {
                const int kcol = kcstart + 8 * fq + e + 4 * T;
                const bool valid = (kcol >= qcstart) && (kcol < qcstart + 16);
                const int dc = min(max(kcol - qcol, -15), 15) + 15;
                const float bias = rph[dr * 31 + dc];
                const float v = valid ? fmaf(s[e], c1, bias) : -1e30f;
                sc[rr][4 * T + e] = v;
                mx = fmaxf(mx, v);
            }
        }
    }
    __builtin_amdgcn_sched_barrier(0);
    bf16x8 vfr[4][8];
    {
        const bf16_t* vg0 = p.vT + VS_VN + ((size_t)(((b * 8 + h) * 32 + rs) * 64 + fr)) * 64 + kcstart + 8 * fq;
#pragma unroll
        for (int dt = 0; dt < 4; ++dt)
#pragma unroll
            for (int rr = 0; rr < 8; ++rr) vfr[dt][rr] = *(const bf16x8*)(vg0 + (size_t)(rr * 64 + 16 * dt) * 64);
    }
    mx = fmaxf(mx, __shfl_xor(mx, 16)); mx = fmaxf(mx, __shfl_xor(mx, 32));
    float l = 0.f;
    bf16x8 pb[8];
#pragma unroll
    for (int rr = 0; rr < 8; ++rr) {
#pragma unroll
        for (int e = 0; e < 8; ++e) { sc[rr][e] = fast_exp2(sc[rr][e] - mx); l += sc[rr][e]; }
        u32x4 w;
        w.x = cvt_pk_bf16(sc[rr][0], sc[rr][1]); w.y = cvt_pk_bf16(sc[rr][2], sc[rr][3]);
        w.z = cvt_pk_bf16(sc[rr][4], sc[rr][5]); w.w = cvt_pk_bf16(sc[rr][6], sc[rr][7]);
        pb[rr] = __builtin_bit_cast(bf16x8, w);
    }
    l += __shfl_xor(l, 16); l += __shfl_xor(l, 32);
    const float il = 1.0f / l;
    f32x4 O[4];
#pragma unroll
    for (int dt = 0; dt < 4; ++dt) {
        O[dt] = (f32x4){0.f, 0.f, 0.f, 0.f};
#pragma unroll
        for (int rr = 0; rr < 8; ++rr) O[dt] = __builtin_amdgcn_mfma_f32_16x16x32_bf16(vfr[dt][rr], pb[rr], O[dt], 0, 0, 0);
    }
#pragma unroll
    for (int dt = 0; dt < 4; ++dt) {
        const int d0 = 16 * dt + 4 * fq;
        const u32x2 gw = *(const u32x2*)(p.z + ZS_GATE + tokq * 1024 + 512 + h * 64 + d0);
        const float o0 = O[dt][0] * il * silu_f(bflo(gw.x)), o1 = O[dt][1] * il * silu_f(bfhi(gw.x));
        const float o2 = O[dt][2] * il * silu_f(bflo(gw.y)), o3 = O[dt][3] * il * silu_f(bfhi(gw.y));
        u32x2 w; w.x = cvt_pk_bf16(o0, o1); w.y = cvt_pk_bf16(o2, o3);
        *(u32x2*)(p.o + tokq * 1024 + 512 + h * 64 + d0) = w;
    }
}


constexpr int NA_P = 144, NA_KBYTES = 128 * NA_P, NA_STAGE = 2 * NA_KBYTES;

__device__ void na_super_online(char* lds, const Params& p, int layer, int su) {
    int tid_ = threadIdx.x; asm volatile("" : "+v"(tid_)); const int tid = tid_, lane = tid & 63, wid = __builtin_amdgcn_readfirstlane(tid >> 6), fr = lane & 15, fq = lane >> 4;
    const int bh = (su & 7) * 8 + (su >> 5), g = (su >> 3) & 3, b = bh >> 3, h = bh & 7;
    const float* rph = (const float*)(lds + LDS_RPB_OFF) + h * 465;
    const float c1 = 0.125f * LOG2E;
    const int rq = 8 * g + wid, rsw = min(max(rq - 4, 0), 24);
    bf16x8 qf[4][2];
    f32x4 O[4][4];
    float mrow[4], lrow[4];
#pragma unroll
    for (int n = 0; n < 4; ++n) {
#pragma unroll
        for (int t = 0; t < 2; ++t) qf[n][t] = *(const bf16x8*)(p.z + ZS_QN + ((size_t)(bh * 2048 + rq * 64 + 16 * n + fr)) * 64 + t * 32 + fq * 8);
#pragma unroll
        for (int dt = 0; dt < 4; ++dt) O[n][dt] = (f32x4){0.f, 0.f, 0.f, 0.f};
        mrow[n] = -1e30f; lrow[n] = 0.f;
    }
    const int klo = min(max(8 * g - 4, 0), 24);
    const int nsteps = (g == 0 || g == 3) ? 6 : 8;
    const bf16_t* Kg = p.z + ZS_KN + ((size_t)(bh * 2048 + klo * 64)) * 64 + tid * 8;
    const bf16_t* Vg = p.vT + VS_VN + ((size_t)((bh * 32 + klo) * 64)) * 64 + tid * 8;
    const int lw = (tid >> 3) * NA_P + (tid & 7) * 16;
    u32x4 rk[2], rv[2];
    rk[0] = *(const u32x4*)(Kg); rk[1] = *(const u32x4*)(Kg + 4096);
    rv[0] = *(const u32x4*)(Vg); rv[1] = *(const u32x4*)(Vg + 4096);
    __syncthreads();
    *(u32x4*)(lds + lw) = rk[0]; *(u32x4*)(lds + lw + 64 * NA_P) = rk[1];
    *(u32x4*)(lds + NA_KBYTES + lw) = rv[0]; *(u32x4*)(lds + NA_KBYTES + lw + 64 * NA_P) = rv[1];
    __syncthreads();
    const int krow_off = (8 * (fr >> 2) + (fr & 3)) * NA_P + fq * 16;
    const int vrow_off = fr * NA_P + (8 * fq) * 2;
    for (int st = 0; st < nsteps; ++st) {
        const char* cur = lds + (st & 1) * NA_STAGE;
        char* nxt = lds + ((st + 1) & 1) * NA_STAGE;
        if (st + 1 < nsteps) {
            const bf16_t* kg = Kg + (size_t)(st + 1) * 8192; const bf16_t* vg = Vg + (size_t)(st + 1) * 8192;
            rk[0] = *(const u32x4*)(kg); rk[1] = *(const u32x4*)(kg + 4096);
            rv[0] = *(const u32x4*)(vg); rv[1] = *(const u32x4*)(vg + 4096);
        }
#pragma unroll 1
        for (int slot = 0; slot < 2; ++slot) {
            const int kr = klo + 2 * st + slot;
            if (kr >= rsw && kr <= rsw + 7) {
                const char* cK = cur + slot * 64 * NA_P + krow_off;
                const char* cV = cur + NA_KBYTES + slot * 64 * NA_P + vrow_off;
                const float* rpr = rph + (kr - rq + 7) * 31;
                float v[4][8], mx[4];
#pragma unroll
                for (int n = 0; n < 4; ++n) {
                    const int kcstart = n == 0 ? 0 : (n == 1 ? 8 : (n == 2 ? 24 : 32));
                    const int qcol = 16 * n + fr;
                    const int qcstart = min(max(qcol - 8, 0), 48);
                    float bias[8];
#pragma unroll
                    for (int e = 0; e < 8; ++e) bias[e] = rpr[min(max(kcstart + 8 * fq + e - qcol, -15), 15) + 15];
#pragma unroll
                    for (int e = 0; e < 8; ++e) asm volatile("" : "+v"(bias[e]));
#pragma unroll
                    for (int T = 0; T < 2; ++T) {
                        const bf16x8 k0 = *(const bf16x8*)(cK + (kcstart + T * 4) * NA_P), k1 = *(const bf16x8*)(cK + (kcstart + T * 4) * NA_P + 64);
                        f32x4 s = (f32x4){0.f, 0.f, 0.f, 0.f};
                        s = __builtin_amdgcn_mfma_f32_16x16x32_bf16(k0, qf[n][0], s, 0, 0, 0);
                        s = __builtin_amdgcn_mfma_f32_16x16x32_bf16(k1, qf[n][1], s, 0, 0, 0);
#pragma unroll
                        for (int e = 0; e < 4; ++e) {
                            const int kcol = kcstart + 8 * fq + e + 4 * T;
                            const bool valid = (kcol >= qcstart) && (kcol < qcstart + 16);
                            v[n][4 * T + e] = valid ? fmaf(s[e], c1, bias[4 * T + e]) : -1e30f;
                        }
                    }
                    mx[n] = fmaxf(fmaxf(fmaxf(v[n][0], v[n][1]), fmaxf(v[n][2], v[n][3])), fmaxf(fmaxf(v[n][4], v[n][5]), fmaxf(v[n][6], v[n][7])));
                }
#pragma unroll
                for (int n = 0; n < 4; ++n) mx[n] = fmaxf(mx[n], __shfl_xor(mx[n], 16));
#pragma unroll
                for (int n = 0; n < 4; ++n) mx[n] = fmaxf(mx[n], __shfl_xor(mx[n], 32));
#pragma unroll
                for (int n = 0; n < 4; ++n) {
                    const int kcstart = n == 0 ? 0 : (n == 1 ? 8 : (n == 2 ? 24 : 32));
                    const float mnew = fmaxf(mrow[n], mx[n]);
                    const float alpha = fast_exp2(mrow[n] - mnew);
                    mrow[n] = mnew;
                    float ps = 0.f;
#pragma unroll
                    for (int e = 0; e < 8; ++e) { v[n][e] = fast_exp2(v[n][e] - mnew); ps += v[n][e]; }
                    lrow[n] = lrow[n] * alpha + ps;
                    u32x4 w;
                    w.x = cvt_pk_bf16(v[n][0], v[n][1]); w.y = cvt_pk_bf16(v[n][2], v[n][3]); w.z = cvt_pk_bf16(v[n][4], v[n][5]); w.w = cvt_pk_bf16(v[n][6], v[n][7]);
                    const bf16x8 pb = __builtin_bit_cast(bf16x8, w);
#pragma unroll
                    for (int dt = 0; dt < 4; ++dt) {
                        const bf16x8 vf = *(const bf16x8*)(cV + dt * 16 * NA_P + kcstart * 2);
                        O[n][dt] = __builtin_amdgcn_mfma_f32_16x16x32_bf16(vf, pb, O[n][dt] * alpha, 0, 0, 0);
                    }
                }
            }
        }
        if (st + 1 < nsteps) {
            *(u32x4*)(nxt + lw) = rk[0]; *(u32x4*)(nxt + lw + 64 * NA_P) = rk[1];
            *(u32x4*)(nxt + NA_KBYTES + lw) = rv[0]; *(u32x4*)(nxt + NA_KBYTES + lw + 64 * NA_P) = rv[1];
        }
        __syncthreads();
    }
#pragma unroll
    for (int n = 0; n < 4; ++n) {
        float l = lrow[n];
        l += __shfl_xor(l, 16); l += __shfl_xor(l, 32);
        const float il = 1.0f / l;
        const size_t tokq = (size_t)b * SEQ + rq * 64 + 16 * n + fr;
#pragma unroll
        for (int dt = 0; dt < 4; ++dt) {
            const int d0 = 16 * dt + 4 * fq;
            const u32x2 gw = *(const u32x2*)(p.z + ZS_GATE + tokq * 1024 + 512 + h * 64 + d0);
            const float o0 = O[n][dt][0] * il * silu_f(bflo(gw.x)), o1 = O[n][dt][1] * il * silu_f(bfhi(gw.x));
            const float o2 = O[n][dt][2] * il * silu_f(bflo(gw.y)), o3 = O[n][dt][3] * il * silu_f(bfhi(gw.y));
            u32x2 w; w.x = cvt_pk_bf16(o0, o1); w.y = cvt_pk_bf16(o2, o3);
            *(u32x2*)(p.o + tokq * 1024 + 512 + h * 64 + d0) = w;
        }
    }
}

__device__ void na_super(char* lds, const Params& p, int layer, int su) {
    int tid_ = threadIdx.x; asm volatile("" : "+v"(tid_)); const int tid = tid_, lane = tid & 63, wid = __builtin_amdgcn_readfirstlane(tid >> 6), fr = lane & 15, fq = lane >> 4;
    const int bh = (su & 7) * 8 + (su >> 5), g = (su >> 3) & 3, b = bh >> 3, h = bh & 7;
    const float* rph = (const float*)(lds + LDS_RPB_OFF) + h * 465;
    const float c1 = 0.125f * LOG2E;
    const int rq = 8 * g + wid, rsw = min(max(rq - 4, 0), 24);
    bf16x8 qf[4][2];
    f32x4 O[4][4];
    float mrow[4], lrow[4];
#pragma unroll
    for (int n = 0; n < 4; ++n) {
#pragma unroll
        for (int t = 0; t < 2; ++t) qf[n][t] = *(const bf16x8*)(p.z + ZS_QN + ((size_t)(bh * 2048 + rq * 64 + 16 * n + fr)) * 64 + t * 32 + fq * 8);
#pragma unroll
        for (int dt = 0; dt < 4; ++dt) O[n][dt] = (f32x4){0.f, 0.f, 0.f, 0.f};
        lrow[n] = 0.f;
        {
            const u32x4 k0 = *(const u32x4*)(p.z + ZS_KN + ((size_t)(bh * 2048 + rq * 64 + 16 * n + fr)) * 64 + fq * 8);
            const u32x4 k1 = *(const u32x4*)(p.z + ZS_KN + ((size_t)(bh * 2048 + rq * 64 + 16 * n + fr)) * 64 + 32 + fq * 8);
            const u32x4 q0 = __builtin_bit_cast(u32x4, qf[n][0]), q1 = __builtin_bit_cast(u32x4, qf[n][1]);
            float d = 0.f;
#pragma unroll
            for (int w = 0; w < 4; ++w) { d += bflo(q0[w]) * bflo(k0[w]) + bfhi(q0[w]) * bfhi(k0[w]); d += bflo(q1[w]) * bflo(k1[w]) + bfhi(q1[w]) * bfhi(k1[w]); }
            d += __shfl_xor(d, 16); d += __shfl_xor(d, 32);
            mrow[n] = -d;
        }
    }
    const int klo = min(max(8 * g - 4, 0), 24);
    const int nsteps = (g == 0 || g == 3) ? 6 : 8;
    const bf16_t* Kg = p.z + ZS_KN + ((size_t)(bh * 2048 + klo * 64)) * 64 + tid * 8;
    const bf16_t* Vg = p.vT + VS_VN + ((size_t)((bh * 32 + klo) * 64)) * 64 + tid * 8;
    const int lw = (tid >> 3) * NA_P + (tid & 7) * 16;
    u32x4 rk[2], rv[2];
    rk[0] = *(const u32x4*)(Kg); rk[1] = *(const u32x4*)(Kg + 4096);
    rv[0] = *(const u32x4*)(Vg); rv[1] = *(const u32x4*)(Vg + 4096);
    __syncthreads();
    *(u32x4*)(lds + lw) = rk[0]; *(u32x4*)(lds + lw + 64 * NA_P) = rk[1];
    *(u32x4*)(lds + NA_KBYTES + lw) = rv[0]; *(u32x4*)(lds + NA_KBYTES + lw + 64 * NA_P) = rv[1];
    __syncthreads();
    const int krow_off = (8 * (fr >> 2) + (fr & 3)) * NA_P + fq * 16;
    const int vrow_off = fr * NA_P + (8 * fq) * 2;
    for (int st = 0; st < nsteps; ++st) {
        const char* cur = lds + (st & 1) * NA_STAGE;
        char* nxt = lds + ((st + 1) & 1) * NA_STAGE;
        if (st + 1 < nsteps) {
            const bf16_t* kg = Kg + (size_t)(st + 1) * 8192; const bf16_t* vg = Vg + (size_t)(st + 1) * 8192;
            rk[0] = *(const u32x4*)(kg); rk[1] = *(const u32x4*)(kg + 4096);
            rv[0] = *(const u32x4*)(vg); rv[1] = *(const u32x4*)(vg + 4096);
        }
#pragma unroll 1
        for (int slot = 0; slot < 2; ++slot) {
            const int kr = klo + 2 * st + slot;
            if (kr >= rsw && kr <= rsw + 7) {
                const char* cK = cur + slot * 64 * NA_P + krow_off;
                const char* cV = cur + NA_KBYTES + slot * 64 * NA_P + vrow_off;
                const float* rpr = rph + (kr - rq + 7) * 31;
                float v[4][8];
#pragma unroll
                for (int n = 0; n < 4; ++n) {
                    const int kcstart = n == 0 ? 0 : (n == 1 ? 8 : (n == 2 ? 24 : 32));
                    const int qcol = 16 * n + fr;
#pragma unroll
                    for (int e = 0; e < 8; ++e) v[n][e] = rpr[min(max(kcstart + 8 * fq + e - qcol, -15), 15) + 15];
                }
#pragma unroll
                for (int n = 0; n < 4; ++n)
#pragma unroll
                    for (int e = 0; e < 8; ++e) asm volatile("" : "+v"(v[n][e]));
#pragma unroll
                for (int np = 0; np < 2; ++np) {
                    bf16x8 kfr[2][4];
#pragma unroll
                    for (int q = 0; q < 2; ++q) {
                        const int n = 2 * np + q;
                        const int kcstart = n == 0 ? 0 : (n == 1 ? 8 : (n == 2 ? 24 : 32));
#pragma unroll
                        for (int T = 0; T < 2; ++T) { kfr[q][2 * T] = *(const bf16x8*)(cK + (kcstart + T * 4) * NA_P); kfr[q][2 * T + 1] = *(const bf16x8*)(cK + (kcstart + T * 4) * NA_P + 64); }
                    }
#pragma unroll
                    for (int q = 0; q < 2; ++q) {
                        const int n = 2 * np + q;
                        const int kcstart = n == 0 ? 0 : (n == 1 ? 8 : (n == 2 ? 24 : 32));
                        const int qcol = 16 * n + fr;
                        const int qcstart = min(max(qcol - 8, 0), 48);
#pragma unroll
                        for (int T = 0; T < 2; ++T) {
                            f32x4 s = (f32x4){mrow[n], mrow[n], mrow[n], mrow[n]};
                            s = __builtin_amdgcn_mfma_f32_16x16x32_bf16(kfr[q][2 * T], qf[n][0], s, 0, 0, 0);
                            s = __builtin_amdgcn_mfma_f32_16x16x32_bf16(kfr[q][2 * T + 1], qf[n][1], s, 0, 0, 0);
#pragma unroll
                            for (int e = 0; e < 4; ++e) {
                                const int kcol = kcstart + 8 * fq + e + 4 * T;
                                const bool valid = (kcol >= qcstart) && (kcol < qcstart + 16);
                                v[n][4 * T + e] = valid ? fmaf(s[e], c1, v[n][4 * T + e]) : -1e30f;
                            }
                        }
                    }
                }
#pragma unroll
                for (int n = 0; n < 4; ++n) {
                    const int kcstart = n == 0 ? 0 : (n == 1 ? 8 : (n == 2 ? 24 : 32));
                    float ps = 0.f;
#pragma unroll
                    for (int e = 0; e < 8; ++e) { v[n][e] = fast_exp2(v[n][e]); ps += v[n][e]; }
                    lrow[n] += ps;
                    u32x4 w;
                    w.x = cvt_pk_bf16(v[n][0], v[n][1]); w.y = cvt_pk_bf16(v[n][2], v[n][3]); w.z = cvt_pk_bf16(v[n][4], v[n][5]); w.w = cvt_pk_bf16(v[n][6], v[n][7]);
                    const bf16x8 pb = __builtin_bit_cast(bf16x8, w);
#pragma unroll
                    for (int dt = 0; dt < 4; ++dt) {
                        const bf16x8 vf = *(const bf16x8*)(cV + dt * 16 * NA_P + kcstart * 2);
                        O[n][dt] = __builtin_amdgcn_mfma_f32_16x16x32_bf16(vf, pb, O[n][dt], 0, 0, 0);
                    }
                }
            }
        }
        if (st + 1 < nsteps) {
            *(u32x4*)(nxt + lw) = rk[0]; *(u32x4*)(nxt + lw + 64 * NA_P) = rk[1];
            *(u32x4*)(nxt + NA_KBYTES + lw) = rv[0]; *(u32x4*)(nxt + NA_KBYTES + lw + 64 * NA_P) = rv[1];
        }
        __syncthreads();
    }
    int bad = 0;
#pragma unroll
    for (int n = 0; n < 4; ++n) { lrow[n] += __shfl_xor(lrow[n], 16); lrow[n] += __shfl_xor(lrow[n], 32); bad |= !(lrow[n] < 1e30f); }
    {
        volatile unsigned* bflag = (volatile unsigned*)(lds + LDS_PHASE_BYTES + 8);
        if (tid == 0) *bflag = 0u;
        __syncthreads();
        if (__any(bad) && lane == 0) *bflag = 1u;
        __syncthreads();
        if (*bflag != 0u) { if (tid == 0) *(volatile unsigned*)(lds + LDS_PHASE_BYTES + 12) = 1u; return; }
    }
#pragma unroll
    for (int n = 0; n < 4; ++n) {
        const float l = lrow[n];
        const float il = 1.0f / l;
        const size_t tokq = (size_t)b * SEQ + rq * 64 + 16 * n + fr;
#pragma unroll
        for (int dt = 0; dt < 4; ++dt) {
            const int d0 = 16 * dt + 4 * fq;
            const u32x2 gw = *(const u32x2*)(p.z + ZS_GATE + tokq * 1024 + 512 + h * 64 + d0);
            const float o0 = O[n][dt][0] * il * silu_f(bflo(gw.x)), o1 = O[n][dt][1] * il * silu_f(bfhi(gw.x));
            const float o2 = O[n][dt][2] * il * silu_f(bflo(gw.y)), o3 = O[n][dt][3] * il * silu_f(bfhi(gw.y));
            u32x2 w; w.x = cvt_pk_bf16(o0, o1); w.y = cvt_pk_bf16(o2, o3);
            *(u32x2*)(p.o + tokq * 1024 + 512 + h * 64 + d0) = w;
        }
    }
}

__global__ void __launch_bounds__(NTHREADS) fwd_megakernel(Params p) {
    extern __shared__ __attribute__((aligned(16))) char lds[];
    if (p.never) cg::this_grid().sync();
    volatile LAS unsigned* st = (volatile LAS unsigned*)(lds + LDS_PHASE_BYTES);
    if (threadIdx.x < 4) st[threadIdx.x] = 0u;
    __syncthreads();
    const XcdBarrier gb = xcd_barrier_post(p.bar, st);
    prologue_phase(lds, p);
    xcd_barrier(gb);
    for (int layer = 0; layer < DEPTH; ++layer) {
        for (int rep = 0; rep < REP_GEMM0; ++rep) {
        { pg8::Gemm g{p.xb, p.wi_t + (size_t)layer * 4096 * 1024, NTOK, IN_W, 1024}; pg8::StaticOrder S; S.init(NTOK, IN_W, (int)gridDim.x, (int)blockIdx.x);
          pg8::EpiZ E{p.z, p.vT, p.rss};
          pg8::gemm_phase<pg8::EpiZ, pg8::StaticOrder, true, true>((PG8_LAS unsigned char*)lds, g, S, E); }
        xcd_barrier(gb);
        }
        { int t0_ = threadIdx.x; asm volatile("" : "+v"(t0_));
          for (int i = t0_; i < 8 * 465; i += NTHREADS) ((float*)(lds + LDS_RPB_OFF))[i] = p.rpb[(size_t)layer * 8 * 465 + i] * LOG2E;
          if (t0_ == 0) *(volatile unsigned*)(lds + LDS_PHASE_BYTES + 12) = 0u; }
        __syncthreads();
        for (int rep = 0; rep < REP_ATT; ++rep) {
        for (int u = blockIdx.x; u < 512 + 256; u += gridDim.x) {
            if (u < 512) { if (rep < REP_DA) da_unit(lds, p, layer, u); } else { if (rep < REP_NA) na_super(lds, p, layer, u - 512); }
        }
        __syncthreads();
        if (*(volatile unsigned*)(lds + LDS_PHASE_BYTES + 12) != 0u) {
            for (int u = blockIdx.x; u < 512 + 256; u += gridDim.x) if (u >= 512) na_super_online(lds, p, layer, u - 512);
        }
        xcd_barrier(gb);
        }
        { pg8::Gemm g{p.o, p.wo_t + (size_t)layer * 1024 * 1024, NTOK, 1024, 1024}; pg8::StaticOrder S; S.init(NTOK, 1024, (int)gridDim.x, (int)blockIdx.x);
          if (layer + 1 < DEPTH) { pg8::EpiRes<true> E{layer == 0 ? p.x : p.xf, p.xf, p.xb, p.rss};
            pg8::gemm_phase<pg8::EpiRes<true>, pg8::StaticOrder, true, true>((PG8_LAS unsigned char*)lds, g, S, E); }
          else if (gridDim.x == 256) { pg8::EpiFinal E{p.xf, p.xf, p.final_g, p.rss, p.bar + XCD_BAR_WORDS};
            pg8::gemm_phase<pg8::EpiFinal, pg8::StaticOrder, false, true>((PG8_LAS unsigned char*)lds, g, S, E); return; }
          else { pg8::EpiRes<false> E{p.xf, p.xf, p.xb, p.rss};
            pg8::gemm_phase<pg8::EpiRes<false>, pg8::StaticOrder, true, true>((PG8_LAS unsigned char*)lds, g, S, E); } }
        xcd_barrier(gb);
    }
    final_phase(p);
}

constexpr size_t LDS_BYTES = LDS_RPB_OFF + LDS_RPB_BYTES;

extern "C" void kernel_launch(void* const* d_in, const int* in_sizes, int n_in, void* d_out, int out_size, void* d_ws, size_t ws_size, hipStream_t stream) {
    static int grid_blocks = 0;
    if (!grid_blocks) {
        int dev = 0, cus = 0, per_cu = 0;
        hipGetDevice(&dev);
        hipDeviceGetAttribute(&cus, hipDeviceAttributeMultiprocessorCount, dev);
        hipFuncSetAttribute((const void*)fwd_megakernel, hipFuncAttributeMaxDynamicSharedMemorySize, (int)LDS_BYTES);
        hipOccupancyMaxActiveBlocksPerMultiprocessor(&per_cu, fwd_megakernel, NTHREADS, LDS_BYTES);
        if (per_cu < 1) per_cu = 1;
        if (per_cu > 1) per_cu = 1;
        grid_blocks = cus * per_cu;
    }
    Params p{};
    p.x = (const float*)d_in[0]; p.norm_g = (const float*)d_in[1]; p.w_in = (const float*)d_in[2]; p.w_out = (const float*)d_in[3];
    p.lq1 = (const float*)d_in[4]; p.lk1 = (const float*)d_in[5]; p.lq2 = (const float*)d_in[6]; p.lk2 = (const float*)d_in[7];
    p.subln_g = (const float*)d_in[8]; p.rpb = (const float*)d_in[9]; p.final_g = (const float*)d_in[10];
    p.xf = (float*)d_out;
    char* w = (char*)d_ws; size_t off = 0;
    auto take = [&](size_t bytes) { char* r = w + off; off += (bytes + 255) & ~(size_t)255; return r; };
    p.wi_t = (bf16_t*)take((size_t)DEPTH * 4096 * 1024 * 2);
    p.wo_t = (bf16_t*)take((size_t)DEPTH * 1024 * 1024 * 2);
    p.xb = (bf16_t*)take((size_t)NTOK * 1024 * 2);
    p.rss = (float*)take((size_t)NTOK * 16 * 4);
    p.z = (bf16_t*)take((size_t)NTOK * ZP * 2);
    p.vT = (bf16_t*)take((size_t)BATCH * 1024 * SEQ * 2);
    p.o = (bf16_t*)take((size_t)NTOK * 1024 * 2);
    p.bar = (unsigned*)take((size_t)(XCD_BAR_WORDS + 64 * 64) * 4);
    (void)hipMemsetAsync(p.bar, 0, (size_t)(XCD_BAR_WORDS + 64 * 64) * 4, stream);
    for (int l = 0; l < DEPTH; ++l) p.lam_init[l] = (float)(0.8 - 0.6 * exp(-0.3 * (double)l));
    void* args[] = {&p};
    hipError_t e = hipLaunchCooperativeKernel((const void*)fwd_megakernel, dim3(grid_blocks), dim3(NTHREADS), args, LDS_BYTES, stream);
    if (e != hipSuccess) fprintf(stderr, "cooperative launch failed: %s (grid %d)\n", hipGetErrorString(e), grid_blocks);
}
```

```cpp
#include <hip/hip_runtime.h>
#include <hip/hip_cooperative_groups.h>
#include <cstdio>
#include <cstdint>
namespace cg = cooperative_groups;

typedef unsigned short bf16_t;
typedef short bf16x8 __attribute__((ext_vector_type(8)));
typedef float f32x4 __attribute__((ext_vector_type(4)));
typedef float f32x16 __attribute__((ext_vector_type(16)));
typedef unsigned u32x4 __attribute__((ext_vector_type(4)));
typedef unsigned u32x2 __attribute__((ext_vector_type(2)));

constexpr int D_MODEL = 1024, BATCH = 8, SEQ = 2048, DEPTH = 4, NTOK = BATCH * SEQ;
constexpr int IN_W = 4096;
constexpr size_t ZS_QD = 0, ZS_KD = (size_t)NTOK * 512, ZS_QN = (size_t)NTOK * 1024, ZS_KN = (size_t)NTOK * 1536, ZS_GATE = (size_t)NTOK * 2048;
constexpr size_t VS_VD = 0, VS_VN = (size_t)NTOK * 512;
constexpr int ZP = 3072;
constexpr float RMS_EPS = 1e-6f;
constexpr float LOG2E = 1.4426950408889634f;
constexpr int NTHREADS = 512;
#ifndef REP_GEMM0
#define REP_GEMM0 1
#endif
#ifndef REP_DA
#define REP_DA 1
#endif
#ifndef REP_NA
#define REP_NA 1
#endif
#define REP_ATT (REP_DA > REP_NA ? REP_DA : REP_NA)

struct Params {
    const float* x; const float* norm_g; const float* w_in; const float* w_out;
    const float* lq1; const float* lk1; const float* lq2; const float* lk2;
    const float* subln_g; const float* rpb; const float* final_g;
    float* xf;
    bf16_t* wi_t;
    bf16_t* wo_t;
    bf16_t* xb;
    float* rss;
    bf16_t* z;
    bf16_t* vT;
    bf16_t* o;
    unsigned* bar;
    float lam_init[DEPTH];
    int never;
    int pad_;
};

typedef __bf16 bf16x2_t __attribute__((ext_vector_type(2)));
typedef float f32x2_t __attribute__((ext_vector_type(2)));
__device__ __forceinline__ unsigned cvt_pk_bf16(float lo, float hi) {
    const f32x2_t v = {lo, hi};
    return __builtin_bit_cast(unsigned, __builtin_convertvector(v, bf16x2_t));
}
__device__ __forceinline__ float bf2f(unsigned short b) { return __uint_as_float(((unsigned)b) << 16); }
__device__ __forceinline__ float bflo(unsigned w) { return __uint_as_float(w << 16); }
__device__ __forceinline__ float bfhi(unsigned w) { return __uint_as_float(w & 0xffff0000u); }
__device__ __forceinline__ float fast_exp2(float x) { return __builtin_amdgcn_exp2f(x); }


#define XB_TMO      128
#define XB_XCNT(j)  (256  + 64 * (j))
#define XB_XSUB(j)  (1280 + 64 * (j))
#define XB_XGEN(j)  (2304 + 64 * (j))
#define XB_TOP      3328
#define XB_TOPGEN   3392
#define XCD_BAR_WORDS 3456
#define XB_SPIN_CAP (1u << 20)
#define LAS __attribute__((address_space(3)))
__device__ __forceinline__ unsigned xb_ld(unsigned* p)              { return __hip_atomic_load(p, __ATOMIC_RELAXED, __HIP_MEMORY_SCOPE_AGENT); }
__device__ __forceinline__ unsigned xb_add(unsigned* p, unsigned v) { return __hip_atomic_fetch_add(p, v, __ATOMIC_RELAXED, __HIP_MEMORY_SCOPE_AGENT); }
__device__ __forceinline__ unsigned xb_xcc_id() { return (unsigned)__builtin_amdgcn_s_getreg((3 << 11) | 20) & 0xFu; }
#define XB_SPIN(cond, bar) do { unsigned _sp = 0; while (cond) { __builtin_amdgcn_s_sleep(1); \
    if ((++_sp & 255u) == 0u) { if (xb_ld(&(bar)[XB_TMO])) break; if (_sp > XB_SPIN_CAP) { atomicAdd(&(bar)[XB_TMO], 1u); break; } } } } while (0)
struct XcdBarrier { unsigned* bar; unsigned x; volatile LAS unsigned* st; };
__device__ __forceinline__ XcdBarrier xcd_barrier_post(unsigned* bar, volatile LAS unsigned* st) {
    XcdBarrier b; b.bar = bar; b.x = xb_xcc_id(); b.st = st;
    if (threadIdx.x == 0) (void)xb_add(&bar[XB_XCNT(b.x)], 1u);
    return b;
}
__device__ __forceinline__ void xcd_barrier_complete(unsigned* bar, unsigned x, unsigned& nloc, unsigned& nx) {
    const unsigned G = gridDim.x * gridDim.y * gridDim.z;
    unsigned sum, cnt, mine, sp = 0u;
    for (;;) {
        sum = 0u; cnt = 0u; mine = 0u;
#pragma unroll
        for (unsigned j = 0; j < 16; ++j) { const unsigned c = xb_ld(&bar[XB_XCNT(j)]); sum += c; cnt += (c > 0u) ? 1u : 0u; mine = (j == x) ? c : mine; }
        if (sum == G) break;
        __builtin_amdgcn_s_sleep(1);
        if ((++sp & 255u) == 0u) { if (xb_ld(&bar[XB_TMO])) break; if (sp > XB_SPIN_CAP) { atomicAdd(&bar[XB_TMO], 1u); break; } }
    }
    nloc = mine > 0u ? mine : 1u; nx = cnt > 0u ? cnt : 1u;
}
__device__ __forceinline__ void xcd_barrier(const XcdBarrier& b) {
    asm volatile("s_waitcnt vmcnt(0)" ::: "memory");
    __syncthreads();
    if (threadIdx.x == 0) {
        unsigned* bar = b.bar;
        unsigned bx = b.x; asm volatile("" : "+s"(bx));
        __builtin_amdgcn_s_waitcnt(0);
        unsigned nloc = b.st[0], nx = b.st[1];
        if (nloc == 0u) { xcd_barrier_complete(bar, bx, nloc, nx); b.st[0] = nloc; b.st[1] = nx; }
        const unsigned old = xb_add(&bar[XB_XSUB(bx)], 1u);
        const unsigned gen = old / nloc;
        if (old + 1u == (gen + 1u) * nloc) {
            __builtin_amdgcn_fence(__ATOMIC_RELEASE, "agent");
            asm volatile("s_waitcnt vmcnt(0)" ::: "memory");
            const unsigned og = xb_add(&bar[XB_TOP], 1u);
            const unsigned tg = og / nx;
            if (og + 1u == (tg + 1u) * nx) xb_add(&bar[XB_TOPGEN], 1u);
            else XB_SPIN(xb_ld(&bar[XB_TOPGEN]) == tg, bar);
            __builtin_amdgcn_fence(__ATOMIC_ACQUIRE, "agent");
            xb_add(&bar[XB_XGEN(bx)], 1u);
            asm volatile("s_waitcnt vmcnt(0)" ::: "memory");
        } else {
            XB_SPIN(xb_ld(&bar[XB_XGEN(bx)]) == gen, bar);
            __builtin_amdgcn_fence(__ATOMIC_ACQUIRE, "agent");
            asm volatile("s_waitcnt vmcnt(0)" ::: "memory");
        }
    }
    __syncthreads();
}

__device__ __forceinline__ int perm_col(int n) {
    if (n < 1024) return n;
    if (n < 2048) return n + 512;
    if (n < 3072) return n + 1024;
    if (n < 3584) return n - 2048;
    return n - 1024;
}

__device__ void prologue_phase(char* lds, const Params& p) {
    int tid_ = threadIdx.x; asm volatile("" : "+v"(tid_)); const int tid = tid_, lane = tid & 63, wid = tid >> 6;
    float* tile = (float*)lds;
    const int nt_in = DEPTH * 16 * 64, nt_out = DEPTH * 16 * 16;
    for (int t = blockIdx.x; t < nt_in + nt_out; t += gridDim.x) {
        const float* W; bf16_t* Wt; const float* g; int N, k0, n0, no0;
        if (t < nt_in) {
            const int l = t >> 10, rem = t & 1023; k0 = (rem >> 6) * 64; n0 = (rem & 63) * 64;
            W = p.w_in + (size_t)l * 1024 * 4096; N = 4096; Wt = p.wi_t + (size_t)l * 4096 * 1024; g = p.norm_g + l * 1024; no0 = perm_col(n0);
        } else {
            const int t2 = t - nt_in; const int l = t2 >> 8, rem = t2 & 255; k0 = (rem >> 4) * 64; n0 = (rem & 15) * 64;
            W = p.w_out + (size_t)l * 1024 * 1024; N = 1024; Wt = p.wo_t + (size_t)l * 1024 * 1024; g = nullptr; no0 = n0;
        }
        {
            const int i = tid >> 4, j4 = tid & 15;
#pragma unroll
            for (int ps = 0; ps < 2; ++ps) {
                const int kk = i + 32 * ps;
                const f32x4 v = *(const f32x4*)(W + (size_t)(k0 + kk) * N + no0 + 4 * j4);
                const float gg = g ? g[k0 + kk] : 1.0f;
                tile[kk * 65 + 4 * j4 + 0] = v[0] * gg; tile[kk * 65 + 4 * j4 + 1] = v[1] * gg;
                tile[kk * 65 + 4 * j4 + 2] = v[2] * gg; tile[kk * 65 + 4 * j4 + 3] = v[3] * gg;
            }
        }
        __syncthreads();
        {
            const int j = tid >> 3, i8 = tid & 7;
            float v[8];
#pragma unroll
            for (int e = 0; e < 8; ++e) v[e] = tile[(8 * i8 + e) * 65 + j];
            u32x4 w; w.x = cvt_pk_bf16(v[0], v[1]); w.y = cvt_pk_bf16(v[2], v[3]); w.z = cvt_pk_bf16(v[4], v[5]); w.w = cvt_pk_bf16(v[6], v[7]);
            *(u32x4*)(Wt + (size_t)(n0 + j) * 1024 + k0 + 8 * i8) = w;
        }
        __syncthreads();
    }
    for (int row = blockIdx.x * 8 + wid; row < NTOK; row += gridDim.x * 8) {
        float ss = 0.f;
#pragma unroll
        for (int i = 0; i < 4; ++i) {
            const int c = 4 * lane + 256 * i;
            const f32x4 v = *(const f32x4*)(p.x + (size_t)row * 1024 + c);
            ss += v[0] * v[0] + v[1] * v[1] + v[2] * v[2] + v[3] * v[3];
            u32x2 w; w.x = cvt_pk_bf16(v[0], v[1]); w.y = cvt_pk_bf16(v[2], v[3]);
            *(u32x2*)(p.xb + (size_t)row * 1024 + c) = w;
        }
#pragma unroll
        for (int s = 32; s >= 1; s >>= 1) ss += __shfl_xor(ss, s);
        if (lane < 16) p.rss[(size_t)row * 16 + lane] = lane == 0 ? ss : 0.f;
    }
}

__device__ void final_phase(const Params& p) {
    int tid_ = threadIdx.x; asm volatile("" : "+v"(tid_)); const int tid = tid_, lane = tid & 63, wid = tid >> 6;
    for (int row = blockIdx.x * 8 + wid; row < NTOK; row += gridDim.x * 8) {
        float ss = 0.f;
        if (lane < 16) ss = p.rss[(size_t)row * 16 + lane];
#pragma unroll
        for (int s = 8; s >= 1; s >>= 1) ss += __shfl_xor(ss, s);
        ss = __shfl(ss, 0);
        const float rstd = rsqrtf(ss * (1.0f / 1024.0f) + RMS_EPS);
#pragma unroll
        for (int i = 0; i < 4; ++i) {
            const int c = 4 * lane + 256 * i;
            f32x4 v = *(const f32x4*)(p.xf + (size_t)row * 1024 + c);
            const f32x4 g = *(const f32x4*)(p.final_g + c);
            v = v * rstd * g;
            *(f32x4*)(p.xf + (size_t)row * 1024 + c) = v;
        }
    }
}

namespace pg8 {
#define PG8_LAS __attribute__((address_space(3)))
typedef unsigned short bf16_t;
typedef short bf16x8 __attribute__((ext_vector_type(8)));
typedef float f32x4 __attribute__((ext_vector_type(4)));
typedef unsigned u32x4 __attribute__((ext_vector_type(4)));
constexpr int BM = 256, BK = 64, HALF = 128, HTB = HALF * BK * 2  , STAGE_BYTES = 8 * HTB, NXCD = 8, WGM = 8;

__host__ __device__ __forceinline__ int lds_byte(int r, int c) { const int st = (r >> 4) * 2 + (c >> 5), rr = r & 15, cc = c & 31, ob = rr * 64 + cc * 2; return st * 1024 + (ob ^ (((ob >> 9) & 1) << 5)); }
__host__ __device__ __forceinline__ void stage_rc(int b, int& R, int& C) { const int st = b / 1024, sb = b % 1024, swz = sb ^ (((sb >> 9) & 1) << 5); R = (st >> 1) * 16 + swz / 64; C = (st & 1) * 32 + (swz % 64) / 2; }
__host__ __device__ __forceinline__ int perm32(int rho) { const int n = rho >> 4, i = rho & 15; return 8 * (i >> 2) + 4 * n + (i & 3); }

struct Unit { int pm, pn; };
struct Gemm { const bf16_t* A; const bf16_t* Bt; int M, N, K; };

struct StaticOrder {
    int nM, nN, nwg, G, c;
    __host__ __device__ void init(int M, int N, int G_, int c_) { nM = M / BM; nN = N / BM; nwg = nM * nN; G = G_; c = c_; }
    __host__ __device__ bool next(int i, Unit& u) const {
        const long L = (long)i * G + c; if (L >= nwg) return false;
        int wgid = (int)L; { const int q = nwg / NXCD, r = nwg % NXCD, xcd = wgid % NXCD, off = wgid / NXCD; wgid = (xcd < r ? xcd * (q + 1) : r * (q + 1) + (xcd - r) * q) + off; }
        const int nig = WGM * nN, gid = wgid / nig, fm = gid * WGM, gsz = (nM - fm) < WGM ? (nM - fm) : WGM;
        u.pm = fm + ((wgid % nig) % gsz); u.pn = (wgid % nig) / gsz; return true;
    }
    __device__ __forceinline__ void a_ready(const Unit&) const {}
    __device__ __forceinline__ void done(const Unit&) const {}
};


template <class Epi, class Sched, bool ALIGN_EPI = false, bool SP2 = false>
__device__ __forceinline__ void gemm_phase(PG8_LAS unsigned char* lds, const Gemm g, const Sched& S, const Epi& E) {
    int tid_ = threadIdx.x; asm volatile("" : "+v"(tid_));
    const int tid = tid_, wid = __builtin_amdgcn_readfirstlane(tid >> 6), lane = tid & 63, wr = wid >> 2, wc = wid & 3, fr = lane & 15, fq = lane >> 4;
    const int K = g.K, nt = K / BK;
    unsigned voffA[2], voffB[2];
#pragma unroll
    for (int i = 0; i < 2; ++i) { int R, C; stage_rc(tid * 16 + i * 8192, R, C); const int Rb = Epi::PERM ? ((R & ~31) + perm32(R & 31)) : R;
        voffA[i] = (unsigned)(R * K + C) * 2u; voffB[i] = (unsigned)(Rb * K + C) * 2u; }
    const size_t kstep = (size_t)(BK * 2);
    const size_t hstep = (size_t)HALF * K * 2;
    const size_t tstep = 2 * hstep;
    const unsigned ldsw = (unsigned)wid * 1024u;
    const int aoff = lds_byte(wr * 64 + fr, fq * 8), boff = lds_byte(wc * 32 + fr, fq * 8);
#define PG8_SA(b, h) (((b) * 2 + (h)) * HTB)
#define PG8_SB(b, h) ((4 + (b) * 2 + (h)) * HTB)
#define PG8_STAGE(bufoff, gbase, voff) do { _Pragma("unroll") for (int _i = 0; _i < 2; ++_i) \
        __builtin_amdgcn_global_load_lds((const unsigned*)((const char*)(gbase) + (voff)[_i]), (PG8_LAS unsigned*)(lds + (bufoff) + ldsw + _i * 8192), 16, 0, 0); } while (0)
#define PG8_LDA(dst, b, h) do { _Pragma("unroll") for (int m = 0; m < 4; ++m) _Pragma("unroll") for (int k = 0; k < 2; ++k) dst[m][k] = *(const PG8_LAS bf16x8*)(lds + PG8_SA(b, h) + aoff + m * 2048 + k * 1024); } while (0)
#define PG8_LDB(dst, b, h) do { _Pragma("unroll") for (int n = 0; n < 2; ++n) _Pragma("unroll") for (int k = 0; k < 2; ++k) dst[n][k] = *(const PG8_LAS bf16x8*)(lds + PG8_SB(b, h) + boff + n * 2048 + k * 1024); } while (0)
#define PG8_MMA(ai, bj, At, Bt) do { __builtin_amdgcn_s_setprio(1); _Pragma("unroll") for (int m = 0; m < 4; ++m) _Pragma("unroll") for (int n = 0; n < 2; ++n) _Pragma("unroll") for (int k = 0; k < 2; ++k) \
        acc[ai][bj][m][n] = __builtin_amdgcn_mfma_f32_16x16x32_bf16(Bt[n][k], At[m][k], acc[ai][bj][m][n], 0, 0, 0); __builtin_amdgcn_s_setprio(0); } while (0)
#define PG8_WAIT_V(n) asm volatile("s_waitcnt vmcnt(" #n ")" ::: "memory")
#define PG8_WAIT_L(n) asm volatile("s_waitcnt lgkmcnt(" #n ")" ::: "memory")
#define PG8_BAR __builtin_amdgcn_s_barrier()
#define PG8_SCHED __builtin_amdgcn_sched_barrier(0)
    Unit cur, nxt; int ui = 0;
    if (!S.next(0, cur)) return;
    f32x4 acc[2][2][4][2];
#pragma unroll
    for (int a = 0; a < 2; ++a)
#pragma unroll
        for (int b = 0; b < 2; ++b)
#pragma unroll
            for (int m = 0; m < 4; ++m)
#pragma unroll
                for (int n = 0; n < 2; ++n) acc[a][b][m][n] = (f32x4){0.f, 0.f, 0.f, 0.f};
    bf16x8 At[4][2], B0[2][2], B1[2][2];
    const char* cA = (const char*)g.A + (size_t)cur.pm * tstep; const char* cB = (const char*)g.Bt + (size_t)cur.pn * tstep;
    S.a_ready(cur);
    if constexpr (SP2) {
        PG8_STAGE(PG8_SB(0, 0), cB, voffB); PG8_STAGE(PG8_SB(0, 1), cB + hstep, voffB); PG8_STAGE(PG8_SA(0, 0), cA, voffA); PG8_STAGE(PG8_SA(0, 1), cA + hstep, voffA);
        if (wr == 1) PG8_BAR;
        PG8_WAIT_V(2); PG8_BAR;
        PG8_STAGE(PG8_SB(1, 0), cB + kstep, voffB); PG8_STAGE(PG8_SA(1, 0), cA + kstep, voffA); PG8_STAGE(PG8_SB(1, 1), cB + hstep + kstep, voffB);
        PG8_WAIT_V(6); PG8_BAR;
    } else {
        PG8_STAGE(PG8_SB(0, 0), cB, voffB); PG8_STAGE(PG8_SA(0, 0), cA, voffA); PG8_STAGE(PG8_SB(0, 1), cB + hstep, voffB); PG8_STAGE(PG8_SA(0, 1), cA + hstep, voffA);
        if (wr == 1) PG8_BAR;
        PG8_WAIT_V(4); PG8_BAR;
        PG8_STAGE(PG8_SB(1, 0), cB + kstep, voffB); PG8_STAGE(PG8_SA(1, 0), cA + kstep, voffA); PG8_STAGE(PG8_SB(1, 1), cB + hstep + kstep, voffB);
        PG8_WAIT_V(6); PG8_BAR;
    }
    for (;;) {
        const bool has_next = S.next(ui + 1, nxt);
        const char* nA = has_next ? (const char*)g.A + (size_t)nxt.pm * tstep : cA; const char* nB = has_next ? (const char*)g.Bt + (size_t)nxt.pn * tstep : cB;
        for (int t = 0; t < nt; t += 2) {
            const bool last = (t == nt - 2);
            const char* a1 = cA + (size_t)(t + 1) * kstep;
            const char* a2 = last ? nA : cA + (size_t)(t + 2) * kstep; const char* b2 = last ? nB : cB + (size_t)(t + 2) * kstep;
            const char* a3 = a2 + kstep; const char* b3 = b2 + kstep;
            if (last && has_next) S.a_ready(nxt);
            if constexpr (SP2) {
            PG8_LDB(B0, 0, 0); PG8_LDB(B1, 0, 1); PG8_SCHED; PG8_LDA(At, 0, 0); PG8_STAGE(PG8_SA(1, 1), a1 + hstep, voffA);
            PG8_WAIT_V(8); PG8_WAIT_L(0); PG8_BAR; PG8_MMA(0, 0, At, B0); PG8_MMA(0, 1, At, B1); PG8_BAR; PG8_SCHED;
            PG8_LDA(At, 0, 1); PG8_STAGE(PG8_SB(0, 0), b2, voffB); PG8_STAGE(PG8_SB(0, 1), b2 + hstep, voffB); PG8_STAGE(PG8_SA(0, 0), a2, voffA);
            PG8_WAIT_V(8); PG8_WAIT_L(0); PG8_BAR; PG8_MMA(1, 0, At, B0); PG8_MMA(1, 1, At, B1); PG8_BAR; PG8_SCHED;
            PG8_LDB(B0, 1, 0); PG8_LDB(B1, 1, 1); PG8_SCHED; PG8_LDA(At, 1, 0); PG8_STAGE(PG8_SA(0, 1), a2 + hstep, voffA);
            PG8_WAIT_V(8); PG8_WAIT_L(0); PG8_BAR; PG8_MMA(0, 0, At, B0); PG8_MMA(0, 1, At, B1); PG8_BAR; PG8_SCHED;
            PG8_LDA(At, 1, 1); PG8_STAGE(PG8_SB(1, 0), b3, voffB); PG8_STAGE(PG8_SB(1, 1), b3 + hstep, voffB); PG8_STAGE(PG8_SA(1, 0), a3, voffA);
            PG8_WAIT_V(8); PG8_WAIT_L(0); PG8_BAR; PG8_MMA(1, 0, At, B0); PG8_MMA(1, 1, At, B1); PG8_BAR; PG8_SCHED;
            } else {
            PG8_LDB(B0, 0, 0); PG8_SCHED; PG8_LDA(At, 0, 0); PG8_STAGE(PG8_SA(1, 1), a1 + hstep, voffA);
            PG8_WAIT_L(8); PG8_BAR; PG8_WAIT_L(0); PG8_MMA(0, 0, At, B0); PG8_BAR; PG8_SCHED;
            PG8_LDB(B1, 0, 1); PG8_STAGE(PG8_SB(0, 0), b2, voffB);
            PG8_BAR; PG8_WAIT_L(0); PG8_MMA(0, 1, At, B1); PG8_BAR;
            PG8_LDA(At, 0, 1); PG8_STAGE(PG8_SA(0, 0), a2, voffA);
            PG8_BAR; PG8_WAIT_L(0); PG8_MMA(1, 0, At, B0); PG8_BAR; PG8_SCHED;
            PG8_STAGE(PG8_SB(0, 1), b2 + hstep, voffB);
            PG8_WAIT_V(6); PG8_BAR; PG8_MMA(1, 1, At, B1); PG8_BAR;
            PG8_LDB(B0, 1, 0); PG8_SCHED; PG8_LDA(At, 1, 0); PG8_STAGE(PG8_SA(0, 1), a2 + hstep, voffA);
            PG8_WAIT_L(8); PG8_BAR; PG8_WAIT_L(0); PG8_MMA(0, 0, At, B0); PG8_BAR; PG8_SCHED;
            PG8_LDB(B1, 1, 1); PG8_STAGE(PG8_SB(1, 0), b3, voffB);
            PG8_BAR; PG8_WAIT_L(0); PG8_MMA(0, 1, At, B1); PG8_BAR;
            PG8_LDA(At, 1, 1); PG8_STAGE(PG8_SA(1, 0), a3, voffA);
            PG8_BAR; PG8_WAIT_L(0); PG8_MMA(1, 0, At, B0); PG8_BAR; PG8_SCHED;
            PG8_STAGE(PG8_SB(1, 1), b3 + hstep, voffB);
            PG8_WAIT_V(6); PG8_BAR; PG8_MMA(1, 1, At, B1); PG8_BAR;
            }
        }
        if constexpr (ALIGN_EPI) { if (wr == 0) PG8_BAR; }
        if constexpr (!Epi::AFTER_DRAIN) { E(acc, cur, wr, wc, fr, fq); S.done(cur); }
        if (!has_next) break;
#pragma unroll
        for (int a = 0; a < 2; ++a)
#pragma unroll
            for (int b = 0; b < 2; ++b)
#pragma unroll
                for (int m = 0; m < 4; ++m)
#pragma unroll
                    for (int n = 0; n < 2; ++n) acc[a][b][m][n] = (f32x4){0.f, 0.f, 0.f, 0.f};
        cur = nxt; cA = nA; cB = nB; ++ui;
        if constexpr (ALIGN_EPI) { if (wr == 1) PG8_BAR; }
    }
    PG8_WAIT_V(0);
    if constexpr (!ALIGN_EPI) { if (wr == 0) PG8_BAR; }
    PG8_BAR;
    if constexpr (Epi::AFTER_DRAIN) { E.fused(acc, cur, wr, wc, fr, fq, lds, wid, lane); S.done(cur); }
#undef PG8_SA
#undef PG8_SB
#undef PG8_STAGE
#undef PG8_LDA
#undef PG8_LDB
#undef PG8_MMA
#undef PG8_WAIT_V
#undef PG8_WAIT_L
#undef PG8_BAR
#undef PG8_SCHED
}
}


namespace pg8 {
struct EpiZ {
    static constexpr bool PERM = true, AFTER_DRAIN = false;
    bf16_t* z; bf16_t* vT; const float* rss;
    __device__ __forceinline__ void operator()(const f32x4 (&acc)[2][2][4][2], const Unit& u, int wr, int wc, int fr, int fq) const {
        f32x4 part[2][4];
#pragma unroll
        for (int ai = 0; ai < 2; ++ai)
#pragma unroll
            for (int m = 0; m < 4; ++m) part[ai][m] = *(const f32x4*)(rss + (size_t)(u.pm * BM + ai * HALF + wr * 64 + m * 16 + fr) * 16 + 4 * fq);
        float rstdv[2][4];
#pragma unroll
        for (int ai = 0; ai < 2; ++ai)
#pragma unroll
            for (int m = 0; m < 4; ++m) {
                float s = (part[ai][m][0] + part[ai][m][1]) + (part[ai][m][2] + part[ai][m][3]);
                s += __shfl_xor(s, 16); s += __shfl_xor(s, 32);
                rstdv[ai][m] = rsqrtf(s * (1.0f / 1024.0f) + RMS_EPS);
            }
#pragma unroll
        for (int ai = 0; ai < 2; ++ai)
#pragma unroll
            for (int m = 0; m < 4; ++m) {
                const int row = u.pm * BM + ai * HALF + wr * 64 + m * 16 + fr;
                const float rstd = rstdv[ai][m];
                const int b = row >> 11, s = row & 2047;
#pragma unroll
                for (int bj = 0; bj < 2; ++bj) {
                    const int tn = 2 * u.pn + bj;
                    const int cw = 32 * wc + 8 * fq;
                    const f32x4 v0 = acc[ai][bj][m][0] * rstd, v1 = acc[ai][bj][m][1] * rstd;
                    u32x4 w; w.x = ::cvt_pk_bf16(v0[0], v0[1]); w.y = ::cvt_pk_bf16(v0[2], v0[3]); w.z = ::cvt_pk_bf16(v1[0], v1[1]); w.w = ::cvt_pk_bf16(v1[2], v1[3]);
                    if (tn < 24) {
                        bf16_t* dst;
                        if (tn < 8) dst = z + (size_t)(tn >> 2) * ZS_KD + ((size_t)((b * 4 + (tn & 3)) * 2048 + s)) * 128 + cw;
                        else if (tn < 16) dst = z + ZS_QN + (size_t)((tn - 8) >> 2) * (ZS_KN - ZS_QN) + ((size_t)((b * 8 + ((tn - 8) & 3) * 2 + (cw >> 6)) * 2048 + s)) * 64 + (cw & 63);
                        else dst = z + ZS_GATE + (size_t)row * 1024 + (tn - 16) * 128 + cw;
                        *(u32x4*)dst = w;
                    } else {
                        const unsigned ox = __shfl_xor(w.x, 1), oy = __shfl_xor(w.y, 1), oz = __shfl_xor(w.z, 1), ow = __shfl_xor(w.w, 1);
                        const bool odd = fr & 1;
                        const unsigned a0 = odd ? oz : w.x, a1 = odd ? ow : w.y;
                        const unsigned b0 = odd ? w.z : ox, b1 = odd ? w.w : oy;
                        const unsigned p0 = (a0 & 0xffffu) | (b0 << 16), p1 = (a0 >> 16) | (b0 & 0xffff0000u);
                        const unsigned p2 = (a1 & 0xffffu) | (b1 << 16), p3 = (a1 >> 16) | (b1 & 0xffff0000u);
                        const int ch0 = cw + (odd ? 4 : 0), se = s & ~1;
                        bf16_t* dst;
                        if (tn < 28) dst = vT + VS_VD + ((size_t)(((b * 4 + (tn - 24)) * 32 + (se >> 6)) * 128 + ch0)) * 64 + (se & 63);
                        else dst = vT + VS_VN + ((size_t)(((b * 8 + (tn - 28) * 2 + (ch0 >> 6)) * 32 + (se >> 6)) * 64 + (ch0 & 63))) * 64 + (se & 63);
                        *(unsigned*)(dst) = p0; *(unsigned*)(dst + 64) = p1; *(unsigned*)(dst + 128) = p2; *(unsigned*)(dst + 192) = p3;
                    }
                }
            }
    }
};
template <bool WRITE_XB> struct EpiRes {
    static constexpr bool PERM = true, AFTER_DRAIN = false;
    const float* xin; float* xf; bf16_t* xb; float* rss;
    __device__ __forceinline__ void operator()(const f32x4 (&acc)[2][2][4][2], const Unit& u, int wr, int wc, int fr, int fq) const {
#pragma unroll
        for (int ai = 0; ai < 2; ++ai) {
            f32x4 res[4][2][2];
#pragma unroll
            for (int m = 0; m < 4; ++m)
#pragma unroll
                for (int bj = 0; bj < 2; ++bj) {
                    const size_t off = (size_t)(u.pm * BM + ai * HALF + wr * 64 + m * 16 + fr) * 1024 + u.pn * BM + bj * HALF + 32 * wc + 8 * fq;
                    res[m][bj][0] = *(const f32x4*)(xin + off); res[m][bj][1] = *(const f32x4*)(xin + off + 4);
                }
            __builtin_amdgcn_sched_barrier(0);
#pragma unroll
            for (int m = 0; m < 4; ++m) {
                const int row = u.pm * BM + ai * HALF + wr * 64 + m * 16 + fr;
                float ss = 0.f;
#pragma unroll
                for (int bj = 0; bj < 2; ++bj) {
                    const size_t off = (size_t)row * 1024 + u.pn * BM + bj * HALF + 32 * wc + 8 * fq;
                    const f32x4 v0 = res[m][bj][0] + acc[ai][bj][m][0], v1 = res[m][bj][1] + acc[ai][bj][m][1];
                    *(f32x4*)(xf + off) = v0; *(f32x4*)(xf + off + 4) = v1;
                    if (WRITE_XB) { u32x4 w; w.x = ::cvt_pk_bf16(v0[0], v0[1]); w.y = ::cvt_pk_bf16(v0[2], v0[3]); w.z = ::cvt_pk_bf16(v1[0], v1[1]); w.w = ::cvt_pk_bf16(v1[2], v1[3]); *(u32x4*)(xb + off) = w; }
                    ss += (v0[0] * v0[0] + v0[1] * v0[1]) + (v0[2] * v0[2] + v0[3] * v0[3]) + (v1[0] * v1[0] + v1[1] * v1[1]) + (v1[2] * v1[2] + v1[3] * v1[3]);
                }
                ss += __shfl_xor(ss, 16); ss += __shfl_xor(ss, 32);
                if (fq == 0) rss[(size_t)row * 16 + u.pn * 4 + wc] = ss;
            }
            __builtin_amdgcn_sched_barrier(0);
        }
    }
};
struct EpiFinal {
    static constexpr bool PERM = true, AFTER_DRAIN = true;
    const float* xin; float* out; const float* fg; float* rss; unsigned* cnt;
    __device__ __forceinline__ void fused(f32x4 (&acc)[2][2][4][2], const Unit& u, int wr, int wc, int fr, int fq, PG8_LAS unsigned char* lds, int wid, int lane) const {
        float ssv[2][4];
#pragma unroll
        for (int ai = 0; ai < 2; ++ai) {
            f32x4 res[4][2][2];
#pragma unroll
            for (int m = 0; m < 4; ++m)
#pragma unroll
                for (int bj = 0; bj < 2; ++bj) {
                    const size_t off = (size_t)(u.pm * BM + ai * HALF + wr * 64 + m * 16 + fr) * 1024 + u.pn * BM + bj * HALF + 32 * wc + 8 * fq;
                    res[m][bj][0] = *(const f32x4*)(xin + off); res[m][bj][1] = *(const f32x4*)(xin + off + 4);
                }
#pragma unroll
            for (int m = 0; m < 4; ++m) {
                float ss = 0.f;
#pragma unroll
                for (int bj = 0; bj < 2; ++bj) {
                    const f32x4 v0 = res[m][bj][0] + acc[ai][bj][m][0], v1 = res[m][bj][1] + acc[ai][bj][m][1];
                    acc[ai][bj][m][0] = v0; acc[ai][bj][m][1] = v1;
                    ss += (v0[0] * v0[0] + v0[1] * v0[1]) + (v0[2] * v0[2] + v0[3] * v0[3]) + (v1[0] * v1[0] + v1[1] * v1[1]) + (v1[2] * v1[2] + v1[3] * v1[3]);
                }
                ss += __shfl_xor(ss, 16); ss += __shfl_xor(ss, 32);
                ssv[ai][m] = ss;
            }
        }
        if (fq == 0) {
#pragma unroll
            for (int ai = 0; ai < 2; ++ai)
#pragma unroll
                for (int m = 0; m < 4; ++m)
                    __hip_atomic_store((unsigned*)rss + (size_t)(u.pm * BM + ai * HALF + wr * 64 + m * 16 + fr) * 16 + u.pn * 4 + wc, __float_as_uint(ssv[ai][m]), __ATOMIC_RELAXED, __HIP_MEMORY_SCOPE_AGENT);
        }
        asm volatile("s_waitcnt vmcnt(0)" ::: "memory");
        if (lane == 0) __hip_atomic_fetch_add(cnt + 64 * u.pm, 1u, __ATOMIC_RELAXED, __HIP_MEMORY_SCOPE_AGENT);
        if (wid == 0) {
            unsigned spins = 0;
            while ((unsigned)__builtin_amdgcn_readfirstlane(__hip_atomic_load(cnt + 64 * u.pm, __ATOMIC_RELAXED, __HIP_MEMORY_SCOPE_AGENT)) < 32u) {
                __builtin_amdgcn_s_sleep(2);
                if (++spins > (1u << 22)) break;
            }
            __builtin_amdgcn_fence(__ATOMIC_ACQUIRE, "agent");
        }
        asm volatile("s_waitcnt vmcnt(0) lgkmcnt(0)" ::: "memory"); __builtin_amdgcn_s_barrier(); asm volatile("" ::: "memory");
        float rstdv[2][4];
#pragma unroll
        for (int ai = 0; ai < 2; ++ai)
#pragma unroll
            for (int m = 0; m < 4; ++m) {
                const unsigned* rp = (const unsigned*)rss + (size_t)(u.pm * BM + ai * HALF + wr * 64 + m * 16 + fr) * 16 + 4 * fq;
                float s = 0.f;
#pragma unroll
                for (int k = 0; k < 4; ++k) s += __uint_as_float(__hip_atomic_load(rp + k, __ATOMIC_RELAXED, __HIP_MEMORY_SCOPE_AGENT));
                s += __shfl_xor(s, 16); s += __shfl_xor(s, 32);
                rstdv[ai][m] = rsqrtf(s * (1.0f / 1024.0f) + RMS_EPS);
            }
        f32x4 gv[2][2];
#pragma unroll
        for (int bj = 0; bj < 2; ++bj) { const int c0 = u.pn * BM + bj * HALF + 32 * wc + 8 * fq; gv[bj][0] = *(const f32x4*)(fg + c0); gv[bj][1] = *(const f32x4*)(fg + c0 + 4); }
#pragma unroll
        for (int ai = 0; ai < 2; ++ai)
#pragma unroll
            for (int m = 0; m < 4; ++m)
#pragma unroll
                for (int bj = 0; bj < 2; ++bj) {
                    const size_t off = (size_t)(u.pm * BM + ai * HALF + wr * 64 + m * 16 + fr) * 1024 + u.pn * BM + bj * HALF + 32 * wc + 8 * fq;
                    *(f32x4*)(out + off) = acc[ai][bj][m][0] * rstdv[ai][m] * gv[bj][0];
                    *(f32x4*)(out + off + 4) = acc[ai][bj][m][1] * rstdv[ai][m] * gv[bj][1];
                }
    }
};
}
constexpr int LDS_PHASE_BYTES = 143360;
constexpr int LDS_RPB_OFF = LDS_PHASE_BYTES + 16, LDS_RPB_BYTES = 8 * 465 * 4;

constexpr int DA_KP = 272, DA_VP = 144;
constexpr int DA_KBYTES = 128 * DA_KP, DA_VSUB = 128 * DA_VP, DA_VBYTES = 2 * DA_VSUB, DA_STAGE = DA_KBYTES + DA_VBYTES;

__device__ __forceinline__ float silu_f(float x) { return x / (1.0f + __expf(-x)); }

__device__ void da_unit(char* lds, const Params& p, int layer, int unit) {
    int tid_ = threadIdx.x; asm volatile("" : "+v"(tid_)); const int tid = tid_, lane = tid & 63, wid = __builtin_amdgcn_readfirstlane(tid >> 6), r = lane & 31, h2 = lane >> 5;
    const int c = wid & 1, qg = wid >> 1;
    const int g8 = unit >> 3, bh = (unit & 7) * 4 + (g8 >> 4), qb = g8 & 15, b = bh >> 2, h = bh & 3;
    const float slope2 = exp2f(-2.0f * (float)(h + 1)) * LOG2E;
    const float qscale = 0.125f * LOG2E;
    float lam;
    {
        const float v1 = p.lq1[layer * 64 + lane] * p.lk1[layer * 64 + lane], v2 = p.lq2[layer * 64 + lane] * p.lk2[layer * 64 + lane];
        float s1 = v1, s2 = v2;
#pragma unroll
        for (int s = 32; s >= 1; s >>= 1) { s1 += __shfl_xor(s1, s); s2 += __shfl_xor(s2, s); }
        lam = __expf(s1) - __expf(s2) + p.lam_init[layer];
    }
    const int q0 = qb * 128 + qg * 32;
    const size_t tokq = (size_t)b * SEQ + q0 + r;
    bf16x8 qf[4];
#pragma unroll
    for (int t = 0; t < 4; ++t) {
        const u32x4 w = *(const u32x4*)(p.z + ZS_QD + ((size_t)(bh * 2048 + q0 + r)) * 128 + c * 64 + t * 16 + h2 * 8);
        u32x4 o;
        o.x = cvt_pk_bf16(bflo(w.x) * qscale, bfhi(w.x) * qscale); o.y = cvt_pk_bf16(bflo(w.y) * qscale, bfhi(w.y) * qscale);
        o.z = cvt_pk_bf16(bflo(w.z) * qscale, bfhi(w.z) * qscale); o.w = cvt_pk_bf16(bflo(w.w) * qscale, bfhi(w.w) * qscale);
        qf[t] = __builtin_bit_cast(bf16x8, o);
    }
    f32x16 O[4], Bs;
#pragma unroll
    for (int k = 0; k < 4; ++k)
#pragma unroll
        for (int e = 0; e < 16; ++e) O[k][e] = 0.f;
#pragma unroll
    for (int e = 0; e < 16; ++e) Bs[e] = -slope2 * (float)(16 * (e >> 3) + (e & 7));
    float mrow = -1e30f, lrow = 0.f;
    const float qrel = (float)(8 * h2) - (float)(q0 + r);
    const bf16_t* Kg = p.z + ZS_KD + ((size_t)bh * 2048) * 128 + tid * 8;
    const bf16_t* Vg = p.vT + VS_VD + ((size_t)bh * 32) * 8192 + tid * 8;
    const int kr_ = tid >> 4, kc_ = tid & 15, vr_ = tid >> 3, vc_ = tid & 7;
    constexpr int NT = SEQ / 128;
    auto tile_of = [&](int i) { return (i < NT - qb) ? (qb + i) : (NT - 1 - i); };
    u32x4 rk[4], rv[4];
    {
        const int t0 = tile_of(0);
#pragma unroll
        for (int j = 0; j < 4; ++j) { rk[j] = *(const u32x4*)(Kg + (size_t)t0 * 16384 + j * 4096); rv[j] = *(const u32x4*)(Vg + (size_t)t0 * 16384 + j * 4096); }
    }
    __syncthreads();
#pragma unroll
    for (int j = 0; j < 4; ++j) {
        *(u32x4*)(lds + (kr_ + 32 * j) * DA_KP + kc_ * 16) = rk[j];
        *(u32x4*)(lds + DA_KBYTES + (j >> 1) * DA_VSUB + (vr_ + 64 * (j & 1)) * DA_VP + vc_ * 16) = rv[j];
    }
    __syncthreads();
    const int pr = (r & 0x13) | ((r & 4) << 1) | ((r & 8) >> 1);
    {
        const int it = 0; const int kt = qb;
        const char* cK = lds + (it & 1) * DA_STAGE;
        const char* cV = cK + DA_KBYTES;
        char* nK = lds + ((it + 1) & 1) * DA_STAGE;
        if (it + 1 < NT) {
            const int tn = tile_of(it + 1);
#pragma unroll
            for (int j = 0; j < 4; ++j) { rk[j] = *(const u32x4*)(Kg + (size_t)tn * 16384 + j * 4096); rv[j] = *(const u32x4*)(Vg + (size_t)tn * 16384 + j * 4096); }
        }
#pragma unroll
        for (int kb = 0; kb < 4; ++kb) {
            const int k0 = kt * 128 + kb * 32;
            f32x16 s; const float A = 0.f;
            const float kq = (float)k0 + qrel;
#pragma unroll
            for (int e = 0; e < 16; ++e) s[e] = 0.f;
#pragma unroll
            for (int t = 0; t < 4; ++t) {
                const bf16x8 kf = *(const bf16x8*)(cK + (kb * 32 + pr) * DA_KP + c * 128 + t * 32 + h2 * 16);
                s = __builtin_amdgcn_mfma_f32_32x32x16_bf16(kf, qf[t], s, 0, 0, 0);
            }
#pragma unroll
            for (int e = 0; e < 16; ++e) s[e] = fmaf(fabsf(kq + (float)(16 * (e >> 3) + (e & 7))), -slope2, s[e]);
            float mx = s[0];
#pragma unroll
            for (int e = 1; e < 16; ++e) mx = fmaxf(mx, s[e]);
            mx += A;
            mx = fmaxf(mx, __shfl_xor(mx, 32));
            if (!__all(mx <= mrow + 8.0f)) {
                const float mnew = fmaxf(mrow, mx);
                const float alpha = fast_exp2(mrow - mnew);
#pragma unroll
                for (int k = 0; k < 4; ++k) O[k] = O[k] * alpha;
                lrow *= alpha; mrow = mnew;
            }
            const float mm = mrow - A;
            float ps = 0.f;
#pragma unroll
            for (int e = 0; e < 16; ++e) { s[e] = fast_exp2(s[e] - mm); ps += s[e]; }
            lrow += ps;
            bf16x8 pb[2];
#pragma unroll
            for (int sp = 0; sp < 2; ++sp) {
                u32x4 w;
                w.x = cvt_pk_bf16(s[8 * sp + 0], s[8 * sp + 1]); w.y = cvt_pk_bf16(s[8 * sp + 2], s[8 * sp + 3]);
                w.z = cvt_pk_bf16(s[8 * sp + 4], s[8 * sp + 5]); w.w = cvt_pk_bf16(s[8 * sp + 6], s[8 * sp + 7]);
                pb[sp] = __builtin_bit_cast(bf16x8, w);
            }
#pragma unroll
            for (int sp = 0; sp < 2; ++sp)
#pragma unroll
                for (int k = 0; k < 4; ++k) {
                    const bf16x8 vf = *(const bf16x8*)(cV + (kb >> 1) * DA_VSUB + (32 * k + r) * DA_VP + (32 * (kb & 1) + 16 * sp + 8 * h2) * 2);
                    O[k] = __builtin_amdgcn_mfma_f32_32x32x16_bf16(vf, pb[sp], O[k], 0, 0, 0);
                }
        }

        if (it + 1 < NT) {
#pragma unroll
            for (int j = 0; j < 4; ++j) {
                *(u32x4*)(nK + (kr_ + 32 * j) * DA_KP + kc_ * 16) = rk[j];
                *(u32x4*)(nK + DA_KBYTES + (j >> 1) * DA_VSUB + (vr_ + 64 * (j & 1)) * DA_VP + vc_ * 16) = rv[j];
            }
        }
        __syncthreads();
    }
    for (int it = 1; it < NT - qb; ++it) {
        const int kt = tile_of(it);
        const char* cK = lds + (it & 1) * DA_STAGE;
        const char* cV = cK + DA_KBYTES;
        char* nK = lds + ((it + 1) & 1) * DA_STAGE;
        const int tn = tile_of(it + 1 < NT ? it + 1 : it);
        if (it + 1 < NT) {
#pragma unroll
            for (int j = 0; j < 4; ++j) rk[j] = *(const u32x4*)(Kg + (size_t)tn * 16384 + j * 4096);
        }
#define DA_FAST_HALF(BSEL, SGN, hf) \
            { \
                f32x16 s0, s1; \
                { const bf16x8 kf0 = *(const bf16x8*)(cK + (hf * 64 + pr) * DA_KP + c * 128 + h2 * 16); \
                  const bf16x8 kf1 = *(const bf16x8*)(cK + (hf * 64 + 32 + pr) * DA_KP + c * 128 + h2 * 16); \
                  s0 = __builtin_amdgcn_mfma_f32_32x32x16_bf16(kf0, qf[0], BSEL, 0, 0, 0); \
                  s1 = __builtin_amdgcn_mfma_f32_32x32x16_bf16(kf1, qf[0], BSEL, 0, 0, 0); } \
                _Pragma("unroll") \
                for (int t = 1; t < 4; ++t) { \
                    const bf16x8 kf0 = *(const bf16x8*)(cK + (hf * 64 + pr) * DA_KP + c * 128 + t * 32 + h2 * 16); \
                    const bf16x8 kf1 = *(const bf16x8*)(cK + (hf * 64 + 32 + pr) * DA_KP + c * 128 + t * 32 + h2 * 16); \
                    s0 = __builtin_amdgcn_mfma_f32_32x32x16_bf16(kf0, qf[t], s0, 0, 0, 0); \
                    s1 = __builtin_amdgcn_mfma_f32_32x32x16_bf16(kf1, qf[t], s1, 0, 0, 0); \
                } \
                const float A0 = (SGN) * ((float)(kt * 128 + hf * 64) + qrel), A1 = A0 + (SGN) * 32.0f; \
                const float mm0 = mrow - A0, mm1 = mrow - A1; \
                float ps0 = 0.f, ps1 = 0.f; \
                _Pragma("unroll") \
                for (int e = 0; e < 16; ++e) { s0[e] = fast_exp2(s0[e] - mm0); ps0 += s0[e]; } \
                bf16x8 pb0[2], pb1[2]; \
                _Pragma("unroll") \
                for (int sp = 0; sp < 2; ++sp) { \
                    u32x4 w; \
                    w.x = cvt_pk_bf16(s0[8 * sp + 0], s0[8 * sp + 1]); w.y = cvt_pk_bf16(s0[8 * sp + 2], s0[8 * sp + 3]); \
                    w.z = cvt_pk_bf16(s0[8 * sp + 4], s0[8 * sp + 5]); w.w = cvt_pk_bf16(s0[8 * sp + 6], s0[8 * sp + 7]); \
                    pb0[sp] = __builtin_bit_cast(bf16x8, w); \
                } \
                _Pragma("unroll") \
                for (int sp = 0; sp < 2; ++sp) \
                    _Pragma("unroll") \
                    for (int k = 0; k < 4; ++k) { \
                        const bf16x8 vf0 = *(const bf16x8*)(cV + hf * DA_VSUB + (32 * k + r) * DA_VP + (16 * sp + 8 * h2) * 2); \
                        O[k] = __builtin_amdgcn_mfma_f32_32x32x16_bf16(vf0, pb0[sp], O[k], 0, 0, 0); \
                    } \
                _Pragma("unroll") \
                for (int e = 0; e < 16; ++e) { s1[e] = fast_exp2(s1[e] - mm1); ps1 += s1[e]; } \
                lrow += ps0 + ps1; \
                _Pragma("unroll") \
                for (int sp = 0; sp < 2; ++sp) { \
                    u32x4 w; \
                    w.x = cvt_pk_bf16(s1[8 * sp + 0], s1[8 * sp + 1]); w.y = cvt_pk_bf16(s1[8 * sp + 2], s1[8 * sp + 3]); \
                    w.z = cvt_pk_bf16(s1[8 * sp + 4], s1[8 * sp + 5]); w.w = cvt_pk_bf16(s1[8 * sp + 6], s1[8 * sp + 7]); \
                    pb1[sp] = __builtin_bit_cast(bf16x8, w); \
                } \
                _Pragma("unroll") \
                for (int sp = 0; sp < 2; ++sp) \
                    _Pragma("unroll") \
                    for (int k = 0; k < 4; ++k) { \
                        const bf16x8 vf1 = *(const bf16x8*)(cV + hf * DA_VSUB + (32 * k + r) * DA_VP + (32 + 16 * sp + 8 * h2) * 2); \
                        O[k] = __builtin_amdgcn_mfma_f32_32x32x16_bf16(vf1, pb1[sp], O[k], 0, 0, 0); \
                    } \
            }
        DA_FAST_HALF(Bs, -slope2, 0)
        if (it + 1 < NT) {
#pragma unroll
            for (int j = 0; j < 4; ++j) *(u32x4*)(nK + (kr_ + 32 * j) * DA_KP + kc_ * 16) = rk[j];
#pragma unroll
            for (int j = 0; j < 4; ++j) rk[j] = *(const u32x4*)(Vg + (size_t)tn * 16384 + j * 4096);
        }
        DA_FAST_HALF(Bs, -slope2, 1)
#undef DA_FAST_HALF
        if (it + 1 < NT) {
#pragma unroll
            for (int j = 0; j < 4; ++j) *(u32x4*)(nK + DA_KBYTES + (j >> 1) * DA_VSUB + (vr_ + 64 * (j & 1)) * DA_VP + vc_ * 16) = rk[j];
        }
        __syncthreads();
    }
#pragma unroll
    for (int e = 0; e < 16; ++e) Bs[e] = -Bs[e];
    for (int it = NT - qb; it < NT; ++it) {
        const int kt = tile_of(it);
        const char* cK = lds + (it & 1) * DA_STAGE;
        const char* cV = cK + DA_KBYTES;
        char* nK = lds + ((it + 1) & 1) * DA_STAGE;
        const int tn = tile_of(it + 1 < NT ? it + 1 : it);
        if (it + 1 < NT) {
#pragma unroll
            for (int j = 0; j < 4; ++j) rk[j] = *(const u32x4*)(Kg + (size_t)tn * 16384 + j * 4096);
        }
#define DA_FAST_HALF(BSEL, SGN, hf) \
            { \
                f32x16 s0, s1; \
                { const bf16x8 kf0 = *(const bf16x8*)(cK + (hf * 64 + pr) * DA_KP + c * 128 + h2 * 16); \
                  const bf16x8 kf1 = *(const bf16x8*)(cK + (hf * 64 + 32 + pr) * DA_KP + c * 128 + h2 * 16); \
                  s0 = __builtin_amdgcn_mfma_f32_32x32x16_bf16(kf0, qf[0], BSEL, 0, 0, 0); \
                  s1 = __builtin_amdgcn_mfma_f32_32x32x16_bf16(kf1, qf[0], BSEL, 0, 0, 0); } \
                _Pragma("unroll") \
                for (int t = 1; t < 4; ++t) { \
                    const bf16x8 kf0 = *(const bf16x8*)(cK + (hf * 64 + pr) * DA_KP + c * 128 + t * 32 + h2 * 16); \
                    const bf16x8 kf1 = *(const bf16x8*)(cK + (hf * 64 + 32 + pr) * DA_KP + c * 128 + t * 32 + h2 * 16); \
                    s0 = __builtin_amdgcn_mfma_f32_32x32x16_bf16(kf0, qf[t], s0, 0, 0, 0); \
                    s1 = __builtin_amdgcn_mfma_f32_32x32x16_bf16(kf1, qf[t], s1, 0, 0, 0); \
                } \
                const float A0 = (SGN) * ((float)(kt * 128 + hf * 64) + qrel), A1 = A0 + (SGN) * 32.0f; \
                const float mm0 = mrow - A0, mm1 = mrow - A1; \
                float ps0 = 0.f, ps1 = 0.f; \
                _Pragma("unroll") \
                for (int e = 0; e < 16; ++e) { s0[e] = fast_exp2(s0[e] - mm0); ps0 += s0[e]; } \
                bf16x8 pb0[2], pb1[2]; \
                _Pragma("unroll") \
                for (int sp = 0; sp < 2; ++sp) { \
                    u32x4 w; \
                    w.x = cvt_pk_bf16(s0[8 * sp + 0], s0[8 * sp + 1]); w.y = cvt_pk_bf16(s0[8 * sp + 2], s0[8 * sp + 3]); \
                    w.z = cvt_pk_bf16(s0[8 * sp + 4], s0[8 * sp + 5]); w.w = cvt_pk_bf16(s0[8 * sp + 6], s0[8 * sp + 7]); \
                    pb0[sp] = __builtin_bit_cast(bf16x8, w); \
                } \
                _Pragma("unroll") \
                for (int sp = 0; sp < 2; ++sp) \
                    _Pragma("unroll") \
                    for (int k = 0; k < 4; ++k) { \
                        const bf16x8 vf0 = *(const bf16x8*)(cV + hf * DA_VSUB + (32 * k + r) * DA_VP + (16 * sp + 8 * h2) * 2); \
                        O[k] = __builtin_amdgcn_mfma_f32_32x32x16_bf16(vf0, pb0[sp], O[k], 0, 0, 0); \
                    } \
                _Pragma("unroll") \
                for (int e = 0; e < 16; ++e) { s1[e] = fast_exp2(s1[e] - mm1); ps1 += s1[e]; } \
                lrow += ps0 + ps1; \
                _Pragma("unroll") \
                for (int sp = 0; sp < 2; ++sp) { \
                    u32x4 w; \
                    w.x = cvt_pk_bf16(s1[8 * sp + 0], s1[8 * sp + 1]); w.y = cvt_pk_bf16(s1[8 * sp + 2], s1[8 * sp + 3]); \
                    w.z = cvt_pk_bf16(s1[8 * sp + 4], s1[8 * sp + 5]); w.w = cvt_pk_bf16(s1[8 * sp + 6], s1[8 * sp + 7]); \
                    pb1[sp] = __builtin_bit_cast(bf16x8, w); \
                } \
                _Pragma("unroll") \
                for (int sp = 0; sp < 2; ++sp) \
                    _Pragma("unroll") \
                    for (int k = 0; k < 4; ++k) { \
                        const bf16x8 vf1 = *(const bf16x8*)(cV + hf * DA_VSUB + (32 * k + r) * DA_VP + (32 + 16 * sp + 8 * h2) * 2); \
                        O[k] = __builtin_amdgcn_mfma_f32_32x32x16_bf16(vf1, pb1[sp], O[k], 0, 0, 0); \
                    } \
            }
        DA_FAST_HALF(Bs, slope2, 0)
        if (it + 1 < NT) {
#pragma unroll
            for (int j = 0; j < 4; ++j) *(u32x4*)(nK + (kr_ + 32 * j) * DA_KP + kc_ * 16) = rk[j];
#pragma unroll
            for (int j = 0; j < 4; ++j) rk[j] = *(const u32x4*)(Vg + (size_t)tn * 16384 + j * 4096);
        }
        DA_FAST_HALF(Bs, slope2, 1)
#undef DA_FAST_HALF
        if (it + 1 < NT) {
#pragma unroll
            for (int j = 0; j < 4; ++j) *(u32x4*)(nK + DA_KBYTES + (j >> 1) * DA_VSUB + (vr_ + 64 * (j & 1)) * DA_VP + vc_ * 16) = rk[j];
        }
        __syncthreads();
    }
    {
        const float lchk = lrow + __shfl_xor(lrow, 32);
        const int bad = !(lchk < 1e30f);
        volatile unsigned* bflag = (volatile unsigned*)(lds + LDS_PHASE_BYTES + 8);
        if (tid == 0) *bflag = 0u;
        __syncthreads();
        if (__any(bad) && lane == 0) *bflag = 1u;
        __syncthreads();
        if (*bflag != 0u) {
#pragma unroll
            for (int k = 0; k < 4; ++k)
#pragma unroll
                for (int e = 0; e < 16; ++e) O[k][e] = 0.f;
            mrow = -1e30f; lrow = 0.f;
            {
                const int t0 = tile_of(0);
#pragma unroll
                for (int j = 0; j < 4; ++j) { rk[j] = *(const u32x4*)(Kg + (size_t)t0 * 16384 + j * 4096); rv[j] = *(const u32x4*)(Vg + (size_t)t0 * 16384 + j * 4096); }
            }
#pragma unroll
            for (int j = 0; j < 4; ++j) {
                *(u32x4*)(lds + (kr_ + 32 * j) * DA_KP + kc_ * 16) = rk[j];
                *(u32x4*)(lds + DA_KBYTES + (j >> 1) * DA_VSUB + (vr_ + 64 * (j & 1)) * DA_VP + vc_ * 16) = rv[j];
            }
            __syncthreads();
        for (int it = 0; it < NT; ++it) {
            const int kt = tile_of(it);
        const char* cK = lds + (it & 1) * DA_STAGE;
        const char* cV = cK + DA_KBYTES;
        char* nK = lds + ((it + 1) & 1) * DA_STAGE;
        if (it + 1 < NT) {
            const int tn = tile_of(it + 1);
#pragma unroll
            for (int j = 0; j < 4; ++j) { rk[j] = *(const u32x4*)(Kg + (size_t)tn * 16384 + j * 4096); rv[j] = *(const u32x4*)(Vg + (size_t)tn * 16384 + j * 4096); }
        }
#pragma unroll
        for (int kb = 0; kb < 4; ++kb) {
            const int k0 = kt * 128 + kb * 32;
            f32x16 s; const float A = 0.f;
            const float kq = (float)k0 + qrel;
#pragma unroll
            for (int e = 0; e < 16; ++e) s[e] = 0.f;
#pragma unroll
            for (int t = 0; t < 4; ++t) {
                const bf16x8 kf = *(const bf16x8*)(cK + (kb * 32 + pr) * DA_KP + c * 128 + t * 32 + h2 * 16);
                s = __builtin_amdgcn_mfma_f32_32x32x16_bf16(kf, qf[t], s, 0, 0, 0);
            }
#pragma unroll
            for (int e = 0; e < 16; ++e) s[e] = fmaf(fabsf(kq + (float)(16 * (e >> 3) + (e & 7))), -slope2, s[e]);
            float mx = s[0];
#pragma unroll
            for (int e = 1; e < 16; ++e) mx = fmaxf(mx, s[e]);
            mx += A;
            mx = fmaxf(mx, __shfl_xor(mx, 32));
            if (!__all(mx <= mrow + 8.0f)) {
                const float mnew = fmaxf(mrow, mx);
                const float alpha = fast_exp2(mrow - mnew);
#pragma unroll
                for (int k = 0; k < 4; ++k) O[k] = O[k] * alpha;
                lrow *= alpha; mrow = mnew;
            }
            const float mm = mrow - A;
            float ps = 0.f;
#pragma unroll
            for (int e = 0; e < 16; ++e) { s[e] = fast_exp2(s[e] - mm); ps += s[e]; }
            lrow += ps;
            bf16x8 pb[2];
#pragma unroll
            for (int sp = 0; sp < 2; ++sp) {
                u32x4 w;
                w.x = cvt_pk_bf16(s[8 * sp + 0], s[8 * sp + 1]); w.y = cvt_pk_bf16(s[8 * sp + 2], s[8 * sp + 3]);
                w.z = cvt_pk_bf16(s[8 * sp + 4], s[8 * sp + 5]); w.w = cvt_pk_bf16(s[8 * sp + 6], s[8 * sp + 7]);
                pb[sp] = __builtin_bit_cast(bf16x8, w);
            }
#pragma unroll
            for (int sp = 0; sp < 2; ++sp)
#pragma unroll
                for (int k = 0; k < 4; ++k) {
                    const bf16x8 vf = *(const bf16x8*)(cV + (kb >> 1) * DA_VSUB + (32 * k + r) * DA_VP + (32 * (kb & 1) + 16 * sp + 8 * h2) * 2);
                    O[k] = __builtin_amdgcn_mfma_f32_32x32x16_bf16(vf, pb[sp], O[k], 0, 0, 0);
                }
        }

        if (it + 1 < NT) {
#pragma unroll
            for (int j = 0; j < 4; ++j) {
                *(u32x4*)(nK + (kr_ + 32 * j) * DA_KP + kc_ * 16) = rk[j];
                *(u32x4*)(nK + DA_KBYTES + (j >> 1) * DA_VSUB + (vr_ + 64 * (j & 1)) * DA_VP + vc_ * 16) = rv[j];
            }
        }
        __syncthreads();
    }
        }
    }
    const float lsum = lrow + __shfl_xor(lrow, 32);
    float* xch = (float*)lds + qg * 4096;
    if (c == 1) {
        const float i1 = lam / lsum;
#pragma unroll
        for (int k = 0; k < 4; ++k)
#pragma unroll
            for (int e = 0; e < 16; ++e) xch[(k * 16 + e) * 64 + lane] = O[k][e] * i1;
    }
    __syncthreads();
    if (c == 0) {
        const float i0 = 1.0f / lsum;
        float ss = 0.f;
#pragma unroll
        for (int k = 0; k < 4; ++k)
#pragma unroll
            for (int e = 0; e < 16; ++e) { const float a = O[k][e] * i0 - xch[(k * 16 + e) * 64 + lane]; O[k][e] = a; ss += a * a; }
        ss += __shfl_xor(ss, 32);
        const float rstd = rsqrtf(ss * (1.0f / 128.0f) + RMS_EPS) * (1.0f - p.lam_init[layer]);
        const float* sg = p.subln_g + layer * 128;
        u32x2 gwv[16]; f32x4 ggv[16];
#pragma unroll
        for (int k = 0; k < 4; ++k)
#pragma unroll
            for (int g = 0; g < 4; ++g) {
                const int d0 = 32 * k + 8 * g + 4 * h2;
                ggv[k * 4 + g] = *(const f32x4*)(sg + d0);
                gwv[k * 4 + g] = *(const u32x2*)(p.z + ZS_GATE + tokq * 1024 + h * 128 + d0);
            }
        __builtin_amdgcn_sched_barrier(0);
#pragma unroll
        for (int k = 0; k < 4; ++k)
#pragma unroll
            for (int g = 0; g < 4; ++g) {
                const int d0 = 32 * k + 8 * g + 4 * h2;
                const f32x4 gg = ggv[k * 4 + g];
                const u32x2 gw = gwv[k * 4 + g];
                const float o0 = O[k][4 * g + 0] * rstd * gg[0] * silu_f(bflo(gw.x));
                const float o1 = O[k][4 * g + 1] * rstd * gg[1] * silu_f(bfhi(gw.x));
                const float o2 = O[k][4 * g + 2] * rstd * gg[2] * silu_f(bflo(gw.y));
                const float o3 = O[k][4 * g + 3] * rstd * gg[3] * silu_f(bfhi(gw.y));
                u32x2 w; w.x = cvt_pk_bf16(o0, o1); w.y = cvt_pk_bf16(o2, o3);
                *(u32x2*)(p.o + tokq * 1024 + h * 128 + d0) = w;
            }
    }
}

__device__ void na_unit(char* lds, const Params& p, int layer, int unit) {
    int tid_ = threadIdx.x; asm volatile("" : "+v"(tid_)); const int tid = tid_, lane = tid & 63, wid = __builtin_amdgcn_readfirstlane(tid >> 6), fr = lane & 15, fq = lane >> 4;
    const int hp = unit & 3, rr0 = (unit >> 2) & 31, b = unit >> 7;
    const int h = 2 * hp + (wid >> 2), n = wid & 3;
    const float* rph = (const float*)(lds + LDS_RPB_OFF) + h * 465;
    const int r = rr0;
    const int rs = min(max(r - 4, 0), 24);
    const int kcstart = min(max(16 * n - 8, 0), 32);
    const int qcol = 16 * n + fr;
    const int qcstart = min(max(qcol - 8, 0), 48);
    const size_t tokq = (size_t)b * SEQ + r * 64 + qcol;
    bf16x8 qf[2];
#pragma unroll
    for (int t = 0; t < 2; ++t) qf[t] = *(const bf16x8*)(p.z + ZS_QN + ((size_t)((b * 8 + h) * 2048 + r * 64 + qcol)) * 64 + t * 32 + fq * 8);
    bf16x8 kfr[8][4];
    {
        const int kc = kcstart + 8 * (fr >> 2) + (fr & 3);
        const bf16_t* kg0 = p.z + ZS_KN + ((size_t)((b * 8 + h) * 2048 + rs * 64 + kc)) * 64 + fq * 8;
#pragma unroll
        for (int rr = 0; rr < 8; ++rr)
#pragma unroll
            for (int T = 0; T < 2; ++T) {
                const bf16_t* kg = kg0 + (size_t)(rr * 64 + 4 * T) * 64;
                kfr[rr][2 * T] = *(const bf16x8*)(kg); kfr[rr][2 * T + 1] = *(const bf16x8*)(kg + 32);
            }
    }
    __builtin_amdgcn_sched_barrier(0);
    const float c1 = 0.125f * LOG2E;
    float sc[8][8];
    float mx = -1e30f;
#pragma unroll
    for (int rr = 0; rr < 8; ++rr) {
#pragma unroll
        for (int T = 0; T < 2; ++T) {
            f32x4 s = (f32x4){0.f, 0.f, 0.f, 0.f};
            s = __builtin_amdgcn_mfma_f32_16x16x32_bf16(kfr[rr][2 * T], qf[0], s, 0, 0, 0);
            s = __builtin_amdgcn_mfma_f32_16x16x32_bf16(kfr[rr][2 * T + 1], qf[1], s, 0, 0, 0);
            const int dr = rs + rr - r + 7;
#pragma unroll
            for (int e = 0; e < 4; ++e) {
                const int kcol = kcstart + 8 * fq + e + 4 * T;
                const bool valid = (kcol >= qcstart) && (kcol < qcstart + 16);
                const int dc = min(max(kcol - qcol, -15), 15) + 15;
                const float bias = rph[dr * 31 + dc];
                const float v = valid ? fmaf(s[e], c1, bias) : -1e30f;
                sc[rr][4 * T + e] = v;
                mx = fmaxf(mx, v);
            }
        }
    }
    __builtin_amdgcn_sched_barrier(0);
    bf16x8 vfr[4][8];
    {
        const bf16_t* vg0 = p.vT + VS_VN + ((size_t)(((b * 8 + h) * 32 + rs) * 64 + fr)) * 64 + kcstart + 8 * fq;
#pragma unroll
        for (int dt = 0; dt < 4; ++dt)
#pragma unroll
            for (int rr = 0; rr < 8; ++rr) vfr[dt][rr] = *(const bf16x8*)(vg0 + (size_t)(rr * 64 + 16 * dt) * 64);
    }
    mx = fmaxf(mx, __shfl_xor(mx, 16)); mx = fmaxf(mx, __shfl_xor(mx, 32));
    float l = 0.f;
    bf16x8 pb[8];
#pragma unroll
    for (int rr = 0; rr < 8; ++rr) {
#pragma unroll
        for (int e = 0; e < 8; ++e) { sc[rr][e] = fast_exp2(sc[rr][e] - mx); l += sc[rr][e]; }
        u32x4 w;
        w.x = cvt_pk_bf16(sc[rr][0], sc[rr][1]); w.y = cvt_pk_bf16(sc[rr][2], sc[rr][3]);
        w.z = cvt_pk_bf16(sc[rr][4], sc[rr][5]); w.w = cvt_pk_bf16(sc[rr][6], sc[rr][7]);
        pb[rr] = __builtin_bit_cast(bf16x8, w);
    }
    l += __shfl_xor(l, 16); l += __shfl_xor(l, 32);
    const float il = 1.0f / l;
    f32x4 O[4];
#pragma unroll
    for (int dt = 0; dt < 4; ++dt) {
        O[dt] = (f32x4){0.f, 0.f, 0.f, 0.f};
#pragma unroll
        for (int rr = 0; rr < 8; ++rr) O[dt] = __builtin_amdgcn_mfma_f32_16x16x32_bf16(vfr[dt][rr], pb[rr], O[dt], 0, 0, 0);
    }
#pragma unroll
    for (int dt = 0; dt < 4; ++dt) {
        const int d0 = 16 * dt + 4 * fq;
        const u32x2 gw = *(const u32x2*)(p.z + ZS_GATE + tokq * 1024 + 512 + h * 64 + d0);
        const float o0 = O[dt][0] * il * silu_f(bflo(gw.x)), o1 = O[dt][1] * il * silu_f(bfhi(gw.x));
        const float o2 = O[dt][2] * il * silu_f(bflo(gw.y)), o3 = O[dt][3] * il * silu_f(bfhi(gw.y));
        u32x2 w; w.x = cvt_pk_bf16(o0, o1); w.y = cvt_pk_bf16(o2, o3);
        *(u32x2*)(p.o + tokq * 1024 + 512 + h * 64 + d0) = w;
    }
}


constexpr int NA_P = 144, NA_KBYTES = 128 * NA_P, NA_STAGE = 2 * NA_KBYTES;

__device__ void na_super_online(char* lds, const Params& p, int layer, int su) {
    int tid_ = threadIdx.x; asm volatile("" : "+v"(tid_)); const int tid = tid_, lane = tid & 63, wid = __builtin_amdgcn_readfirstlane(tid >> 6), fr = lane & 15, fq = lane >> 4;
    const int bh = (su & 7) * 8 + (su >> 5), g = (su >> 3) & 3, b = bh >> 3, h = bh & 7;
    const float* rph = (const float*)(lds + LDS_RPB_OFF) + h * 465;
    const float c1 = 0.125f * LOG2E;
    const int rq = 8 * g + wid, rsw = min(max(rq - 4, 0), 24);
    bf16x8 qf[4][2];
    f32x4 O[4][4];
    float mrow[4], lrow[4];
#pragma unroll
    for (int n = 0; n < 4; ++n) {
#pragma unroll
        for (int t = 0; t < 2; ++t) qf[n][t] = *(const bf16x8*)(p.z + ZS_QN + ((size_t)(bh * 2048 + rq * 64 + 16 * n + fr)) * 64 + t * 32 + fq * 8);
#pragma unroll
        for (int dt = 0; dt < 4; ++dt) O[n][dt] = (f32x4){0.f, 0.f, 0.f, 0.f};
        mrow[n] = -1e30f; lrow[n] = 0.f;
    }
    const int klo = min(max(8 * g - 4, 0), 24);
    const int nsteps = (g == 0 || g == 3) ? 6 : 8;
    const bf16_t* Kg = p.z + ZS_KN + ((size_t)(bh * 2048 + klo * 64)) * 64 + tid * 8;
    const bf16_t* Vg = p.vT + VS_VN + ((size_t)((bh * 32 + klo) * 64)) * 64 + tid * 8;
    const int lw = (tid >> 3) * NA_P + (tid & 7) * 16;
    u32x4 rk[2], rv[2];
    rk[0] = *(const u32x4*)(Kg); rk[1] = *(const u32x4*)(Kg + 4096);
    rv[0] = *(const u32x4*)(Vg); rv[1] = *(const u32x4*)(Vg + 4096);
    __syncthreads();
    *(u32x4*)(lds + lw) = rk[0]; *(u32x4*)(lds + lw + 64 * NA_P) = rk[1];
    *(u32x4*)(lds + NA_KBYTES + lw) = rv[0]; *(u32x4*)(lds + NA_KBYTES + lw + 64 * NA_P) = rv[1];
    __syncthreads();
    const int krow_off = (8 * (fr >> 2) + (fr & 3)) * NA_P + fq * 16;
    const int vrow_off = fr * NA_P + (8 * fq) * 2;
    for (int st = 0; st < nsteps; ++st) {
        const char* cur = lds + (st & 1) * NA_STAGE;
        char* nxt = lds + ((st + 1) & 1) * NA_STAGE;
        if (st + 1 < nsteps) {
            const bf16_t* kg = Kg + (size_t)(st + 1) * 8192; const bf16_t* vg = Vg + (size_t)(st + 1) * 8192;
            rk[0] = *(const u32x4*)(kg); rk[1] = *(const u32x4*)(kg + 4096);
            rv[0] = *(const u32x4*)(vg); rv[1] = *(const u32x4*)(vg + 4096);
        }
#pragma unroll 1
        for (int slot = 0; slot < 2; ++slot) {
            const int kr = klo + 2 * st + slot;
            if (kr >= rsw && kr <= rsw + 7) {
                const char* cK = cur + slot * 64 * NA_P + krow_off;
                const char* cV = cur + NA_KBYTES + slot * 64 * NA_P + vrow_off;
                const float* rpr = rph + (kr - rq + 7) * 31;
                float v[4][8], mx[4];
#pragma unroll
                for (int n = 0; n < 4; ++n) {
                    const int kcstart = n == 0 ? 0 : (n == 1 ? 8 : (n == 2 ? 24 : 32));
                    const int qcol = 16 * n + fr;
                    const int qcstart = min(max(qcol - 8, 0), 48);
                    float bias[8];
#pragma unroll
                    for (int e = 0; e < 8; ++e) bias[e] = rpr[min(max(kcstart + 8 * fq + e - qcol, -15), 15) + 15];
#pragma unroll
                    for (int e = 0; e < 8; ++e) asm volatile("" : "+v"(bias[e]));
#pragma unroll
                    for (int T = 0; T < 2; ++T) {
                        const bf16x8 k0 = *(const bf16x8*)(cK + (kcstart + T * 4) * NA_P), k1 = *(const bf16x8*)(cK + (kcstart + T * 4) * NA_P + 64);
                        f32x4 s = (f32x4){0.f, 0.f, 0.f, 0.f};
                        s = __builtin_amdgcn_mfma_f32_16x16x32_bf16(k0, qf[n][0], s, 0, 0, 0);
                        s = __builtin_amdgcn_mfma_f32_16x16x32_bf16(k1, qf[n][1], s, 0, 0, 0);
#pragma unroll
                        for (int e = 0; e < 4; ++e) {
                            const int kcol = kcstart + 8 * fq + e + 4 * T;
                            const bool valid = (kcol >= qcstart) && (kcol < qcstart + 16);
                            v[n][4 * T + e] = valid ? fmaf(s[e], c1, bias[4 * T + e]) : -1e30f;
                        }
                    }
                    mx[n] = fmaxf(fmaxf(fmaxf(v[n][0], v[n][1]), fmaxf(v[n][2], v[n][3])), fmaxf(fmaxf(v[n][4], v[n][5]), fmaxf(v[n][6], v[n][7])));
                }
#pragma unroll
                for (int n = 0; n < 4; ++n) mx[n] = fmaxf(mx[n], __shfl_xor(mx[n], 16));
#pragma unroll
                for (int n = 0; n < 4; ++n) mx[n] = fmaxf(mx[n], __shfl_xor(mx[n], 32));
#pragma unroll
                for (int n = 0; n < 4; ++n) {
                    const int kcstart = n == 0 ? 0 : (n == 1 ? 8 : (n == 2 ? 24 : 32));
                    const float mnew = fmaxf(mrow[n], mx[n]);
                    const float alpha = fast_exp2(mrow[n] - mnew);
                    mrow[n] = mnew;
                    float ps = 0.f;
#pragma unroll
                    for (int e = 0; e < 8; ++e) { v[n][e] = fast_exp2(v[n][e] - mnew); ps += v[n][e]; }
                    lrow[n] = lrow[n] * alpha + ps;
                    u32x4 w;
                    w.x = cvt_pk_bf16(v[n][0], v[n][1]); w.y = cvt_pk_bf16(v[n][2], v[n][3]); w.z = cvt_pk_bf16(v[n][4], v[n][5]); w.w = cvt_pk_bf16(v[n][6], v[n][7]);
                    const bf16x8 pb = __builtin_bit_cast(bf16x8, w);
#pragma unroll
                    for (int dt = 0; dt < 4; ++dt) {
                        const bf16x8 vf = *(const bf16x8*)(cV + dt * 16 * NA_P + kcstart * 2);
                        O[n][dt] = __builtin_amdgcn_mfma_f32_16x16x32_bf16(vf, pb, O[n][dt] * alpha, 0, 0, 0);
                    }
                }
            }
        }
        if (st + 1 < nsteps) {
            *(u32x4*)(nxt + lw) = rk[0]; *(u32x4*)(nxt + lw + 64 * NA_P) = rk[1];
            *(u32x4*)(nxt + NA_KBYTES + lw) = rv[0]; *(u32x4*)(nxt + NA_KBYTES + lw + 64 * NA_P) = rv[1];
        }
        __syncthreads();
    }
    u32x2 gwv[4][4];
#pragma unroll
    for (int n = 0; n < 4; ++n)
#pragma unroll
        for (int dt = 0; dt < 4; ++dt) gwv[n][dt] = *(const u32x2*)(p.z + ZS_GATE + ((size_t)b * SEQ + rq * 64 + 16 * n + fr) * 1024 + 512 + h * 64 + 16 * dt + 4 * fq);
    __builtin_amdgcn_sched_barrier(0);
#pragma unroll
    for (int n = 0; n < 4; ++n) {
        float l = lrow[n];
        l += __shfl_xor(l, 16); l += __shfl_xor(l, 32);
        const float il = 1.0f / l;
        const size_t tokq = (size_t)b * SEQ + rq * 64 + 16 * n + fr;
#pragma unroll
        for (int dt = 0; dt < 4; ++dt) {
            const int d0 = 16 * dt + 4 * fq;
            const u32x2 gw = gwv[n][dt];
            const float o0 = O[n][dt][0] * il * silu_f(bflo(gw.x)), o1 = O[n][dt][1] * il * silu_f(bfhi(gw.x));
            const float o2 = O[n][dt][2] * il * silu_f(bflo(gw.y)), o3 = O[n][dt][3] * il * silu_f(bfhi(gw.y));
            u32x2 w; w.x = cvt_pk_bf16(o0, o1); w.y = cvt_pk_bf16(o2, o3);
            *(u32x2*)(p.o + tokq * 1024 + 512 + h * 64 + d0) = w;
        }
    }
}

__device__ void na_super(char* lds, const Params& p, int layer, int su) {
    int tid_ = threadIdx.x; asm volatile("" : "+v"(tid_)); const int tid = tid_, lane = tid & 63, wid = __builtin_amdgcn_readfirstlane(tid >> 6), fr = lane & 15, fq = lane >> 4;
    const int bh = (su & 7) * 8 + (su >> 5), g = (su >> 3) & 3, b = bh >> 3, h = bh & 7;
    const float* rph = (const float*)(lds + LDS_RPB_OFF) + h * 465;
    const float c1 = 0.125f * LOG2E;
    const int rq = 8 * g + wid, rsw = min(max(rq - 4, 0), 24);
    bf16x8 qf[4][2];
    f32x4 O[4][4];
    float mrow[4], lrow[4];
#pragma unroll
    for (int n = 0; n < 4; ++n) {
#pragma unroll
        for (int t = 0; t < 2; ++t) qf[n][t] = *(const bf16x8*)(p.z + ZS_QN + ((size_t)(bh * 2048 + rq * 64 + 16 * n + fr)) * 64 + t * 32 + fq * 8);
#pragma unroll
        for (int dt = 0; dt < 4; ++dt) O[n][dt] = (f32x4){0.f, 0.f, 0.f, 0.f};
        lrow[n] = 0.f;
        {
            const u32x4 k0 = *(const u32x4*)(p.z + ZS_KN + ((size_t)(bh * 2048 + rq * 64 + 16 * n + fr)) * 64 + fq * 8);
            const u32x4 k1 = *(const u32x4*)(p.z + ZS_KN + ((size_t)(bh * 2048 + rq * 64 + 16 * n + fr)) * 64 + 32 + fq * 8);
            const u32x4 q0 = __builtin_bit_cast(u32x4, qf[n][0]), q1 = __builtin_bit_cast(u32x4, qf[n][1]);
            float d = 0.f;
#pragma unroll
            for (int w = 0; w < 4; ++w) { d += bflo(q0[w]) * bflo(k0[w]) + bfhi(q0[w]) * bfhi(k0[w]); d += bflo(q1[w]) * bflo(k1[w]) + bfhi(q1[w]) * bfhi(k1[w]); }
            d += __shfl_xor(d, 16); d += __shfl_xor(d, 32);
            mrow[n] = -d;
        }
    }
    const int klo = min(max(8 * g - 4, 0), 24);
    const int nsteps = (g == 0 || g == 3) ? 6 : 8;
    const bf16_t* Kg = p.z + ZS_KN + ((size_t)(bh * 2048 + klo * 64)) * 64 + tid * 8;
    const bf16_t* Vg = p.vT + VS_VN + ((size_t)((bh * 32 + klo) * 64)) * 64 + tid * 8;
    const int lw = (tid >> 3) * NA_P + (tid & 7) * 16;
    u32x4 rk[2], rv[2];
    rk[0] = *(const u32x4*)(Kg); rk[1] = *(const u32x4*)(Kg + 4096);
    rv[0] = *(const u32x4*)(Vg); rv[1] = *(const u32x4*)(Vg + 4096);
    __syncthreads();
    *(u32x4*)(lds + lw) = rk[0]; *(u32x4*)(lds + lw + 64 * NA_P) = rk[1];
    *(u32x4*)(lds + NA_KBYTES + lw) = rv[0]; *(u32x4*)(lds + NA_KBYTES + lw + 64 * NA_P) = rv[1];
    __syncthreads();
    const int krow_off = (8 * (fr >> 2) + (fr & 3)) * NA_P + fq * 16;
    const int vrow_off = fr * NA_P + (8 * fq) * 2;
    for (int st = 0; st < nsteps; ++st) {
        const char* cur = lds + (st & 1) * NA_STAGE;
        char* nxt = lds + ((st + 1) & 1) * NA_STAGE;
        if (st + 1 < nsteps) {
            const bf16_t* kg = Kg + (size_t)(st + 1) * 8192; const bf16_t* vg = Vg + (size_t)(st + 1) * 8192;
            rk[0] = *(const u32x4*)(kg); rk[1] = *(const u32x4*)(kg + 4096);
            rv[0] = *(const u32x4*)(vg); rv[1] = *(const u32x4*)(vg + 4096);
        }
#pragma unroll 1
        for (int slot = 0; slot < 2; ++slot) {
            const int kr = klo + 2 * st + slot;
            if (kr >= rsw && kr <= rsw + 7) {
                const char* cK = cur + slot * 64 * NA_P + krow_off;
                const char* cV = cur + NA_KBYTES + slot * 64 * NA_P + vrow_off;
                const float* rpr = rph + (kr - rq + 7) * 31;
                float v[4][8];
#pragma unroll
                for (int n = 0; n < 4; ++n) {
                    const int kcstart = n == 0 ? 0 : (n == 1 ? 8 : (n == 2 ? 24 : 32));
                    const int qcol = 16 * n + fr;
#pragma unroll
                    for (int e = 0; e < 8; ++e) v[n][e] = rpr[min(max(kcstart + 8 * fq + e - qcol, -15), 15) + 15];
                }
#pragma unroll
                for (int n = 0; n < 4; ++n)
#pragma unroll
                    for (int e = 0; e < 8; ++e) asm volatile("" : "+v"(v[n][e]));
#pragma unroll
                for (int np = 0; np < 2; ++np) {
                    bf16x8 kfr[2][4];
#pragma unroll
                    for (int q = 0; q < 2; ++q) {
                        const int n = 2 * np + q;
                        const int kcstart = n == 0 ? 0 : (n == 1 ? 8 : (n == 2 ? 24 : 32));
#pragma unroll
                        for (int T = 0; T < 2; ++T) { kfr[q][2 * T] = *(const bf16x8*)(cK + (kcstart + T * 4) * NA_P); kfr[q][2 * T + 1] = *(const bf16x8*)(cK + (kcstart + T * 4) * NA_P + 64); }
                    }
#pragma unroll
                    for (int q = 0; q < 2; ++q) {
                        const int n = 2 * np + q;
                        const int kcstart = n == 0 ? 0 : (n == 1 ? 8 : (n == 2 ? 24 : 32));
                        const int qcol = 16 * n + fr;
                        const int qcstart = min(max(qcol - 8, 0), 48);
#pragma unroll
                        for (int T = 0; T < 2; ++T) {
                            f32x4 s = (f32x4){mrow[n], mrow[n], mrow[n], mrow[n]};
                            s = __builtin_amdgcn_mfma_f32_16x16x32_bf16(kfr[q][2 * T], qf[n][0], s, 0, 0, 0);
                            s = __builtin_amdgcn_mfma_f32_16x16x32_bf16(kfr[q][2 * T + 1], qf[n][1], s, 0, 0, 0);
#pragma unroll
                            for (int e = 0; e < 4; ++e) {
                                const int kcol = kcstart + 8 * fq + e + 4 * T;
                                const bool valid = (kcol >= qcstart) && (kcol < qcstart + 16);
                                v[n][4 * T + e] = valid ? fmaf(s[e], c1, v[n][4 * T + e]) : -1e30f;
                            }
                        }
                    }
                }
#pragma unroll
                for (int n = 0; n < 4; ++n) {
                    const int kcstart = n == 0 ? 0 : (n == 1 ? 8 : (n == 2 ? 24 : 32));
                    float ps = 0.f;
#pragma unroll
                    for (int e = 0; e < 8; ++e) { v[n][e] = fast_exp2(v[n][e]); ps += v[n][e]; }
                    lrow[n] += ps;
                    u32x4 w;
                    w.x = cvt_pk_bf16(v[n][0], v[n][1]); w.y = cvt_pk_bf16(v[n][2], v[n][3]); w.z = cvt_pk_bf16(v[n][4], v[n][5]); w.w = cvt_pk_bf16(v[n][6], v[n][7]);
                    const bf16x8 pb = __builtin_bit_cast(bf16x8, w);
#pragma unroll
                    for (int dt = 0; dt < 4; ++dt) {
                        const bf16x8 vf = *(const bf16x8*)(cV + dt * 16 * NA_P + kcstart * 2);
                        O[n][dt] = __builtin_amdgcn_mfma_f32_16x16x32_bf16(vf, pb, O[n][dt], 0, 0, 0);
                    }
                }
            }
        }
        if (st + 1 < nsteps) {
            *(u32x4*)(nxt + lw) = rk[0]; *(u32x4*)(nxt + lw + 64 * NA_P) = rk[1];
            *(u32x4*)(nxt + NA_KBYTES + lw) = rv[0]; *(u32x4*)(nxt + NA_KBYTES + lw + 64 * NA_P) = rv[1];
        }
        __syncthreads();
    }
    int bad = 0;
#pragma unroll
    for (int n = 0; n < 4; ++n) { lrow[n] += __shfl_xor(lrow[n], 16); lrow[n] += __shfl_xor(lrow[n], 32); bad |= !(lrow[n] < 1e30f); }
    {
        volatile unsigned* bflag = (volatile unsigned*)(lds + LDS_PHASE_BYTES + 8);
        if (tid == 0) *bflag = 0u;
        __syncthreads();
        if (__any(bad) && lane == 0) *bflag = 1u;
        __syncthreads();
        if (*bflag != 0u) { if (tid == 0) *(volatile unsigned*)(lds + LDS_PHASE_BYTES + 12) = 1u; return; }
    }
    u32x2 gwv[4][4];
#pragma unroll
    for (int n = 0; n < 4; ++n)
#pragma unroll
        for (int dt = 0; dt < 4; ++dt) gwv[n][dt] = *(const u32x2*)(p.z + ZS_GATE + ((size_t)b * SEQ + rq * 64 + 16 * n + fr) * 1024 + 512 + h * 64 + 16 * dt + 4 * fq);
    __builtin_amdgcn_sched_barrier(0);
#pragma unroll
    for (int n = 0; n < 4; ++n) {
        const float l = lrow[n];
        const float il = 1.0f / l;
        const size_t tokq = (size_t)b * SEQ + rq * 64 + 16 * n + fr;
#pragma unroll
        for (int dt = 0; dt < 4; ++dt) {
            const int d0 = 16 * dt + 4 * fq;
            const u32x2 gw = gwv[n][dt];
            const float o0 = O[n][dt][0] * il * silu_f(bflo(gw.x)), o1 = O[n][dt][1] * il * silu_f(bfhi(gw.x));
            const float o2 = O[n][dt][2] * il * silu_f(bflo(gw.y)), o3 = O[n][dt][3] * il * silu_f(bfhi(gw.y));
            u32x2 w; w.x = cvt_pk_bf16(o0, o1); w.y = cvt_pk_bf16(o2, o3);
            *(u32x2*)(p.o + tokq * 1024 + 512 + h * 64 + d0) = w;
        }
    }
}

__global__ void __launch_bounds__(NTHREADS) fwd_megakernel(Params p) {
    extern __shared__ __attribute__((aligned(16))) char lds[];
    if (p.never) cg::this_grid().sync();
    volatile LAS unsigned* st = (volatile LAS unsigned*)(lds + LDS_PHASE_BYTES);
    if (threadIdx.x < 4) st[threadIdx.x] = 0u;
    __syncthreads();
    const XcdBarrier gb = xcd_barrier_post(p.bar, st);
    prologue_phase(lds, p);
    xcd_barrier(gb);
    for (int layer = 0; layer < DEPTH; ++layer) {
        for (int rep = 0; rep < REP_GEMM0; ++rep) {
        { pg8::Gemm g{p.xb, p.wi_t + (size_t)layer * 4096 * 1024, NTOK, IN_W, 1024}; pg8::StaticOrder S; S.init(NTOK, IN_W, (int)gridDim.x, (int)blockIdx.x);
          pg8::EpiZ E{p.z, p.vT, p.rss};
          pg8::gemm_phase<pg8::EpiZ, pg8::StaticOrder, true, true>((PG8_LAS unsigned char*)lds, g, S, E); }
        xcd_barrier(gb);
        }
        { int t0_ = threadIdx.x; asm volatile("" : "+v"(t0_));
          for (int i = t0_; i < 8 * 465; i += NTHREADS) ((float*)(lds + LDS_RPB_OFF))[i] = p.rpb[(size_t)layer * 8 * 465 + i] * LOG2E;
          if (t0_ == 0) *(volatile unsigned*)(lds + LDS_PHASE_BYTES + 12) = 0u; }
        __syncthreads();
        for (int rep = 0; rep < REP_ATT; ++rep) {
        for (int u = blockIdx.x; u < 512 + 256; u += gridDim.x) {
            if (u < 512) { if (rep < REP_DA) da_unit(lds, p, layer, u); } else { if (rep < REP_NA) na_super(lds, p, layer, u - 512); }
        }
        __syncthreads();
        if (*(volatile unsigned*)(lds + LDS_PHASE_BYTES + 12) != 0u) {
            for (int u = blockIdx.x; u < 512 + 256; u += gridDim.x) if (u >= 512) na_super_online(lds, p, layer, u - 512);
        }
        xcd_barrier(gb);
        }
        { pg8::Gemm g{p.o, p.wo_t + (size_t)layer * 1024 * 1024, NTOK, 1024, 1024}; pg8::StaticOrder S; S.init(NTOK, 1024, (int)gridDim.x, (int)blockIdx.x);
          if (layer + 1 < DEPTH) { pg8::EpiRes<true> E{layer == 0 ? p.x : p.xf, p.xf, p.xb, p.rss};
            pg8::gemm_phase<pg8::EpiRes<true>, pg8::StaticOrder, true, true>((PG8_LAS unsigned char*)lds, g, S, E); }
          else if (gridDim.x == 256) { pg8::EpiFinal E{p.xf, p.xf, p.final_g, p.rss, p.bar + XCD_BAR_WORDS};
            pg8::gemm_phase<pg8::EpiFinal, pg8::StaticOrder, false, true>((PG8_LAS unsigned char*)lds, g, S, E); return; }
          else { pg8::EpiRes<false> E{p.xf, p.xf, p.xb, p.rss};
            pg8::gemm_phase<pg8::EpiRes<false>, pg8::StaticOrder, true, true>((PG8_LAS unsigned char*)lds, g, S, E); } }
        xcd_barrier(gb);
    }
    final_phase(p);
}

constexpr size_t LDS_BYTES = LDS_RPB_OFF + LDS_RPB_BYTES;

extern "C" void kernel_launch(void* const* d_in, const int* in_sizes, int n_in, void* d_out, int out_size, void* d_ws, size_t ws_size, hipStream_t stream) {
    static int grid_blocks = 0;
    if (!grid_blocks) {
        int dev = 0, cus = 0, per_cu = 0;
        hipGetDevice(&dev);
        hipDeviceGetAttribute(&cus, hipDeviceAttributeMultiprocessorCount, dev);
        hipFuncSetAttribute((const void*)fwd_megakernel, hipFuncAttributeMaxDynamicSharedMemorySize, (int)LDS_BYTES);
        hipOccupancyMaxActiveBlocksPerMultiprocessor(&per_cu, fwd_megakernel, NTHREADS, LDS_BYTES);
        if (per_cu < 1) per_cu = 1;
        if (per_cu > 1) per_cu = 1;
        grid_blocks = cus * per_cu;
    }
    Params p{};
    p.x = (const float*)d_in[0]; p.norm_g = (const float*)d_in[1]; p.w_in = (const float*)d_in[2]; p.w_out = (const float*)d_in[3];
    p.lq1 = (const float*)d_in[4]; p.lk1 = (const float*)d_in[5]; p.lq2 = (const float*)d_in[6]; p.lk2 = (const float*)d_in[7];
    p.subln_g = (const float*)d_in[8]; p.rpb = (const float*)d_in[9]; p.final_g = (const float*)d_in[10];
    p.xf = (float*)d_out;
    char* w = (char*)d_ws; size_t off = 0;
    auto take = [&](size_t bytes) { char* r = w + off; off += (bytes + 255) & ~(size_t)255; return r; };
    p.wi_t = (bf16_t*)take((size_t)DEPTH * 4096 * 1024 * 2);
    p.wo_t = (bf16_t*)take((size_t)DEPTH * 1024 * 1024 * 2);
    p.xb = (bf16_t*)take((size_t)NTOK * 1024 * 2);
    p.rss = (float*)take((size_t)NTOK * 16 * 4);
    p.z = (bf16_t*)take((size_t)NTOK * ZP * 2);
    p.vT = (bf16_t*)take((size_t)BATCH * 1024 * SEQ * 2);
    p.o = (bf16_t*)take((size_t)NTOK * 1024 * 2);
    p.bar = (unsigned*)take((size_t)(XCD_BAR_WORDS + 64 * 64) * 4);
    (void)hipMemsetAsync(p.bar, 0, (size_t)(XCD_BAR_WORDS + 64 * 64) * 4, stream);
    for (int l = 0; l < DEPTH; ++l) p.lam_init[l] = (float)(0.8 - 0.6 * exp(-0.3 * (double)l));
    void* args[] = {&p};
    hipError_t e = hipLaunchCooperativeKernel((const void*)fwd_megakernel, dim3(grid_blocks), dim3(NTHREADS), args, LDS_BYTES, stream);
    if (e != hipSuccess) fprintf(stderr, "cooperative launch failed: %s (grid %d)\n", hipGetErrorString(e), grid_blocks);
}
```

```cpp
#include <hip/hip_runtime.h>
#include <hip/hip_cooperative_groups.h>
#include <cstdio>
#include <cstdint>
namespace cg = cooperative_groups;

typedef unsigned short bf16_t;
typedef short bf16x8 __attribute__((ext_vector_type(8)));
typedef float f32x4 __attribute__((ext_vector_type(4)));
typedef float f32x16 __attribute__((ext_vector_type(16)));
typedef unsigned u32x4 __attribute__((ext_vector_type(4)));
typedef unsigned u32x2 __attribute__((ext_vector_type(2)));

constexpr int D_MODEL = 1024, BATCH = 8, SEQ = 2048, DEPTH = 4, NTOK = BATCH * SEQ;
constexpr int IN_W = 4096;
constexpr size_t ZS_QD = 0, ZS_KD = (size_t)NTOK * 512, ZS_QN = (size_t)NTOK * 1024, ZS_KN = (size_t)NTOK * 1536, ZS_GATE = (size_t)NTOK * 2048;
constexpr size_t VS_VD = 0, VS_VN = (size_t)NTOK * 512;
constexpr int ZP = 3072;
constexpr float RMS_EPS = 1e-6f;
constexpr float LOG2E = 1.4426950408889634f;
constexpr int NTHREADS = 512;
#ifndef REP_GEMM0
#define REP_GEMM0 1
#endif
#ifndef REP_DA
#define REP_DA 1
#endif
#ifndef REP_NA
#define REP_NA 1
#endif
#define REP_ATT (REP_DA > REP_NA ? REP_DA : REP_NA)

struct Params {
    const float* x; const float* norm_g; const float* w_in; const float* w_out;
    const float* lq1; const float* lk1; const float* lq2; const float* lk2;
    const float* subln_g; const float* rpb; const float* final_g;
    float* xf;
    bf16_t* wi_t;
    bf16_t* wo_t;
    bf16_t* xb;
    float* rss;
    bf16_t* z;
    bf16_t* vT;
    bf16_t* o;
    unsigned* bar;
    float lam_init[DEPTH];
    int never;
    int pad_;
};

typedef __bf16 bf16x2_t __attribute__((ext_vector_type(2)));
typedef float f32x2_t __attribute__((ext_vector_type(2)));
__device__ __forceinline__ unsigned cvt_pk_bf16(float lo, float hi) {
    const f32x2_t v = {lo, hi};
    return __builtin_bit_cast(unsigned, __builtin_convertvector(v, bf16x2_t));
}
__device__ __forceinline__ float bf2f(unsigned short b) { return __uint_as_float(((unsigned)b) << 16); }
__device__ __forceinline__ float bflo(unsigned w) { return __uint_as_float(w << 16); }
__device__ __forceinline__ float bfhi(unsigned w) { return __uint_as_float(w & 0xffff0000u); }
__device__ __forceinline__ float fast_exp2(float x) { return __builtin_amdgcn_exp2f(x); }


#define XB_TMO      128
#define XB_XCNT(j)  (256  + 64 * (j))
#define XB_XSUB(j)  (1280 + 64 * (j))
#define XB_XGEN(j)  (2304 + 64 * (j))
#define XB_TOP      3328
#define XB_TOPGEN   3392
#define XCD_BAR_WORDS 3456
#define XB_SPIN_CAP (1u << 20)
#define LAS __attribute__((address_space(3)))
__device__ __forceinline__ unsigned xb_ld(unsigned* p)              { return __hip_atomic_load(p, __ATOMIC_RELAXED, __HIP_MEMORY_SCOPE_AGENT); }
__device__ __forceinline__ unsigned xb_add(unsigned* p, unsigned v) { return __hip_atomic_fetch_add(p, v, __ATOMIC_RELAXED, __HIP_MEMORY_SCOPE_AGENT); }
__device__ __forceinline__ unsigned xb_xcc_id() { return (unsigned)__builtin_amdgcn_s_getreg((3 << 11) | 20) & 0xFu; }
#define XB_SPIN(cond, bar) do { unsigned _sp = 0; while (cond) { __builtin_amdgcn_s_sleep(1); \
    if ((++_sp & 255u) == 0u) { if (xb_ld(&(bar)[XB_TMO])) break; if (_sp > XB_SPIN_CAP) { atomicAdd(&(bar)[XB_TMO], 1u); break; } } } } while (0)
struct XcdBarrier { unsigned* bar; unsigned x; volatile LAS unsigned* st; };
__device__ __forceinline__ XcdBarrier xcd_barrier_post(unsigned* bar, volatile LAS unsigned* st) {
    XcdBarrier b; b.bar = bar; b.x = xb_xcc_id(); b.st = st;
    if (threadIdx.x == 0) (void)xb_add(&bar[XB_XCNT(b.x)], 1u);
    return b;
}
__device__ __forceinline__ void xcd_barrier_complete(unsigned* bar, unsigned x, unsigned& nloc, unsigned& nx) {
    const unsigned G = gridDim.x * gridDim.y * gridDim.z;
    unsigned sum, cnt, mine, sp = 0u;
    for (;;) {
        sum = 0u; cnt = 0u; mine = 0u;
#pragma unroll
        for (unsigned j = 0; j < 16; ++j) { const unsigned c = xb_ld(&bar[XB_XCNT(j)]); sum += c; cnt += (c > 0u) ? 1u : 0u; mine = (j == x) ? c : mine; }
        if (sum == G) break;
        __builtin_amdgcn_s_sleep(1);
        if ((++sp & 255u) == 0u) { if (xb_ld(&bar[XB_TMO])) break; if (sp > XB_SPIN_CAP) { atomicAdd(&bar[XB_TMO], 1u); break; } }
    }
    nloc = mine > 0u ? mine : 1u; nx = cnt > 0u ? cnt : 1u;
}
__device__ __forceinline__ void xcd_barrier(const XcdBarrier& b) {
    asm volatile("s_waitcnt vmcnt(0)" ::: "memory");
    __syncthreads();
    if (threadIdx.x == 0) {
        unsigned* bar = b.bar;
        unsigned bx = b.x; asm volatile("" : "+s"(bx));
        __builtin_amdgcn_s_waitcnt(0);
        unsigned nloc = b.st[0], nx = b.st[1];
        if (nloc == 0u) { xcd_barrier_complete(bar, bx, nloc, nx); b.st[0] = nloc; b.st[1] = nx; }
        const unsigned old = xb_add(&bar[XB_XSUB(bx)], 1u);
        const unsigned gen = old / nloc;
        if (old + 1u == (gen + 1u) * nloc) {
            __builtin_amdgcn_fence(__ATOMIC_RELEASE, "agent");
            asm volatile("s_waitcnt vmcnt(0)" ::: "memory");
            const unsigned og = xb_add(&bar[XB_TOP], 1u);
            const unsigned tg = og / nx;
            if (og + 1u == (tg + 1u) * nx) xb_add(&bar[XB_TOPGEN], 1u);
            else XB_SPIN(xb_ld(&bar[XB_TOPGEN]) == tg, bar);
            __builtin_amdgcn_fence(__ATOMIC_ACQUIRE, "agent");
            xb_add(&bar[XB_XGEN(bx)], 1u);
            asm volatile("s_waitcnt vmcnt(0)" ::: "memory");
        } else {
            XB_SPIN(xb_ld(&bar[XB_XGEN(bx)]) == gen, bar);
            __builtin_amdgcn_fence(__ATOMIC_ACQUIRE, "agent");
            asm volatile("s_waitcnt vmcnt(0)" ::: "memory");
        }
    }
    __syncthreads();
}

__device__ __forceinline__ int perm_col(int n) {
    if (n < 1024) return n;
    if (n < 2048) return n + 512;
    if (n < 3072) return n + 1024;
    if (n < 3584) return n - 2048;
    return n - 1024;
}

__device__ void prologue_phase(char* lds, const Params& p) {
    int tid_ = threadIdx.x; asm volatile("" : "+v"(tid_)); const int tid = tid_, lane = tid & 63, wid = tid >> 6;
    float* tile = (float*)lds;
    const int nt_in = DEPTH * 16 * 64, nt_out = DEPTH * 16 * 16;
    for (int t = blockIdx.x; t < nt_in + nt_out; t += gridDim.x) {
        const float* W; bf16_t* Wt; const float* g; int N, k0, n0, no0;
        if (t < nt_in) {
            const int l = t >> 10, rem = t & 1023; k0 = (rem >> 6) * 64; n0 = (rem & 63) * 64;
            W = p.w_in + (size_t)l * 1024 * 4096; N = 4096; Wt = p.wi_t + (size_t)l * 4096 * 1024; g = p.norm_g + l * 1024; no0 = perm_col(n0);
        } else {
            const int t2 = t - nt_in; const int l = t2 >> 8, rem = t2 & 255; k0 = (rem >> 4) * 64; n0 = (rem & 15) * 64;
            W = p.w_out + (size_t)l * 1024 * 1024; N = 1024; Wt = p.wo_t + (size_t)l * 1024 * 1024; g = nullptr; no0 = n0;
        }
        {
            const int i = tid >> 4, j4 = tid & 15;
#pragma unroll
            for (int ps = 0; ps < 2; ++ps) {
                const int kk = i + 32 * ps;
                const f32x4 v = *(const f32x4*)(W + (size_t)(k0 + kk) * N + no0 + 4 * j4);
                const float gg = g ? g[k0 + kk] : 1.0f;
                tile[kk * 65 + 4 * j4 + 0] = v[0] * gg; tile[kk * 65 + 4 * j4 + 1] = v[1] * gg;
                tile[kk * 65 + 4 * j4 + 2] = v[2] * gg; tile[kk * 65 + 4 * j4 + 3] = v[3] * gg;
            }
        }
        __syncthreads();
        {
            const int j = tid >> 3, i8 = tid & 7;
            float v[8];
#pragma unroll
            for (int e = 0; e < 8; ++e) v[e] = tile[(8 * i8 + e) * 65 + j];
            u32x4 w; w.x = cvt_pk_bf16(v[0], v[1]); w.y = cvt_pk_bf16(v[2], v[3]); w.z = cvt_pk_bf16(v[4], v[5]); w.w = cvt_pk_bf16(v[6], v[7]);
            *(u32x4*)(Wt + (size_t)(n0 + j) * 1024 + k0 + 8 * i8) = w;
        }
        __syncthreads();
    }
    for (int row = blockIdx.x * 8 + wid; row < NTOK; row += gridDim.x * 8) {
        float ss = 0.f;
#pragma unroll
        for (int i = 0; i < 4; ++i) {
            const int c = 4 * lane + 256 * i;
            const f32x4 v = *(const f32x4*)(p.x + (size_t)row * 1024 + c);
            ss += v[0] * v[0] + v[1] * v[1] + v[2] * v[2] + v[3] * v[3];
            u32x2 w; w.x = cvt_pk_bf16(v[0], v[1]); w.y = cvt_pk_bf16(v[2], v[3]);
            *(u32x2*)(p.xb + (size_t)row * 1024 + c) = w;
        }
#pragma unroll
        for (int s = 32; s >= 1; s >>= 1) ss += __shfl_xor(ss, s);
        if (lane < 16) p.rss[(size_t)row * 16 + lane] = lane == 0 ? ss : 0.f;
    }
}

__device__ void final_phase(const Params& p) {
    int tid_ = threadIdx.x; asm volatile("" : "+v"(tid_)); const int tid = tid_, lane = tid & 63, wid = tid >> 6;
    for (int row = blockIdx.x * 8 + wid; row < NTOK; row += gridDim.x * 8) {
        float ss = 0.f;
        if (lane < 16) ss = p.rss[(size_t)row * 16 + lane];
#pragma unroll
        for (int s = 8; s >= 1; s >>= 1) ss += __shfl_xor(ss, s);
        ss = __shfl(ss, 0);
        const float rstd = rsqrtf(ss * (1.0f / 1024.0f) + RMS_EPS);
#pragma unroll
        for (int i = 0; i < 4; ++i) {
            const int c = 4 * lane + 256 * i;
            f32x4 v = *(const f32x4*)(p.xf + (size_t)row * 1024 + c);
            const f32x4 g = *(const f32x4*)(p.final_g + c);
            v = v * rstd * g;
            *(f32x4*)(p.xf + (size_t)row * 1024 + c) = v;
        }
    }
}

namespace pg8 {
#define PG8_LAS __attribute__((address_space(3)))
typedef unsigned short bf16_t;
typedef short bf16x8 __attribute__((ext_vector_type(8)));
typedef float f32x4 __attribute__((ext_vector_type(4)));
typedef unsigned u32x4 __attribute__((ext_vector_type(4)));
constexpr int BM = 256, BK = 64, HALF = 128, HTB = HALF * BK * 2  , STAGE_BYTES = 8 * HTB, NXCD = 8, WGM = 8;

__host__ __device__ __forceinline__ int lds_byte(int r, int c) { const int st = (r >> 4) * 2 + (c >> 5), rr = r & 15, cc = c & 31, ob = rr * 64 + cc * 2; return st * 1024 + (ob ^ (((ob >> 9) & 1) << 5)); }
__host__ __device__ __forceinline__ void stage_rc(int b, int& R, int& C) { const int st = b / 1024, sb = b % 1024, swz = sb ^ (((sb >> 9) & 1) << 5); R = (st >> 1) * 16 + swz / 64; C = (st & 1) * 32 + (swz % 64) / 2; }
__host__ __device__ __forceinline__ int perm32(int rho) { const int n = rho >> 4, i = rho & 15; return 8 * (i >> 2) + 4 * n + (i & 3); }

struct Unit { int pm, pn; };
struct Gemm { const bf16_t* A; const bf16_t* Bt; int M, N, K; };

struct StaticOrder {
    int nM, nN, nwg, G, c;
    __host__ __device__ void init(int M, int N, int G_, int c_) { nM = M / BM; nN = N / BM; nwg = nM * nN; G = G_; c = c_; }
    __host__ __device__ bool next(int i, Unit& u) const {
        const long L = (long)i * G + c; if (L >= nwg) return false;
        int wgid = (int)L; { const int q = nwg / NXCD, r = nwg % NXCD, xcd = wgid % NXCD, off = wgid / NXCD; wgid = (xcd < r ? xcd * (q + 1) : r * (q + 1) + (xcd - r) * q) + off; }
        const int nig = WGM * nN, gid = wgid / nig, fm = gid * WGM, gsz = (nM - fm) < WGM ? (nM - fm) : WGM;
        u.pm = fm + ((wgid % nig) % gsz); u.pn = (wgid % nig) / gsz; return true;
    }
    __device__ __forceinline__ void a_ready(const Unit&) const {}
    __device__ __forceinline__ void done(const Unit&) const {}
};


template <class Epi, class Sched, bool ALIGN_EPI = false, bool SP2 = false>
__device__ __forceinline__ void gemm_phase(PG8_LAS unsigned char* lds, const Gemm g, const Sched& S, const Epi& E) {
    int tid_ = threadIdx.x; asm volatile("" : "+v"(tid_));
    const int tid = tid_, wid = __builtin_amdgcn_readfirstlane(tid >> 6), lane = tid & 63, wr = wid >> 2, wc = wid & 3, fr = lane & 15, fq = lane >> 4;
    const int K = g.K, nt = K / BK;
    unsigned voffA[2], voffB[2];
#pragma unroll
    for (int i = 0; i < 2; ++i) { int R, C; stage_rc(tid * 16 + i * 8192, R, C); const int Rb = Epi::PERM ? ((R & ~31) + perm32(R & 31)) : R;
        voffA[i] = (unsigned)(R * K + C) * 2u; voffB[i] = (unsigned)(Rb * K + C) * 2u; }
    const size_t kstep = (size_t)(BK * 2);
    const size_t hstep = (size_t)HALF * K * 2;
    const size_t tstep = 2 * hstep;
    const unsigned ldsw = (unsigned)wid * 1024u;
    const int aoff = lds_byte(wr * 64 + fr, fq * 8), boff = lds_byte(wc * 32 + fr, fq * 8);
#define PG8_SA(b, h) (((b) * 2 + (h)) * HTB)
#define PG8_SB(b, h) ((4 + (b) * 2 + (h)) * HTB)
#define PG8_STAGE(bufoff, gbase, voff) do { _Pragma("unroll") for (int _i = 0; _i < 2; ++_i) \
        __builtin_amdgcn_global_load_lds((const unsigned*)((const char*)(gbase) + (voff)[_i]), (PG8_LAS unsigned*)(lds + (bufoff) + ldsw + _i * 8192), 16, 0, 0); } while (0)
#define PG8_LDA(dst, b, h) do { _Pragma("unroll") for (int m = 0; m < 4; ++m) _Pragma("unroll") for (int k = 0; k < 2; ++k) dst[m][k] = *(const PG8_LAS bf16x8*)(lds + PG8_SA(b, h) + aoff + m * 2048 + k * 1024); } while (0)
#define PG8_LDB(dst, b, h) do { _Pragma("unroll") for (int n = 0; n < 2; ++n) _Pragma("unroll") for (int k = 0; k < 2; ++k) dst[n][k] = *(const PG8_LAS bf16x8*)(lds + PG8_SB(b, h) + boff + n * 2048 + k * 1024); } while (0)
#define PG8_MMA(ai, bj, At, Bt) do { __builtin_amdgcn_s_setprio(1); _Pragma("unroll") for (int m = 0; m < 4; ++m) _Pragma("unroll") for (int n = 0; n < 2; ++n) _Pragma("unroll") for (int k = 0; k < 2; ++k) \
        acc[ai][bj][m][n] = __builtin_amdgcn_mfma_f32_16x16x32_bf16(Bt[n][k], At[m][k], acc[ai][bj][m][n], 0, 0, 0); __builtin_amdgcn_s_setprio(0); } while (0)
#define PG8_WAIT_V(n) asm volatile("s_waitcnt vmcnt(" #n ")" ::: "memory")
#define PG8_WAIT_L(n) asm volatile("s_waitcnt lgkmcnt(" #n ")" ::: "memory")
#define PG8_BAR __builtin_amdgcn_s_barrier()
#define PG8_SCHED __builtin_amdgcn_sched_barrier(0)
    Unit cur, nxt; int ui = 0;
    if (!S.next(0, cur)) return;
    f32x4 acc[2][2][4][2];
#pragma unroll
    for (int a = 0; a < 2; ++a)
#pragma unroll
        for (int b = 0; b < 2; ++b)
#pragma unroll
            for (int m = 0; m < 4; ++m)
#pragma unroll
                for (int n = 0; n < 2; ++n) acc[a][b][m][n] = (f32x4){0.f, 0.f, 0.f, 0.f};
    bf16x8 At[4][2], B0[2][2], B1[2][2];
    const char* cA = (const char*)g.A + (size_t)cur.pm * tstep; const char* cB = (const char*)g.Bt + (size_t)cur.pn * tstep;
    S.a_ready(cur);
    if constexpr (SP2) {
        PG8_STAGE(PG8_SB(0, 0), cB, voffB); PG8_STAGE(PG8_SB(0, 1), cB + hstep, voffB); PG8_STAGE(PG8_SA(0, 0), cA, voffA); PG8_STAGE(PG8_SA(0, 1), cA + hstep, voffA);
        if (wr == 1) PG8_BAR;
        PG8_WAIT_V(2); PG8_BAR;
        PG8_STAGE(PG8_SB(1, 0), cB + kstep, voffB); PG8_STAGE(PG8_SA(1, 0), cA + kstep, voffA); PG8_STAGE(PG8_SB(1, 1), cB + hstep + kstep, voffB);
        PG8_WAIT_V(6); PG8_BAR;
    } else {
        PG8_STAGE(PG8_SB(0, 0), cB, voffB); PG8_STAGE(PG8_SA(0, 0), cA, voffA); PG8_STAGE(PG8_SB(0, 1), cB + hstep, voffB); PG8_STAGE(PG8_SA(0, 1), cA + hstep, voffA);
        if (wr == 1) PG8_BAR;
        PG8_WAIT_V(4); PG8_BAR;
        PG8_STAGE(PG8_SB(1, 0), cB + kstep, voffB); PG8_STAGE(PG8_SA(1, 0), cA + kstep, voffA); PG8_STAGE(PG8_SB(1, 1), cB + hstep + kstep, voffB);
        PG8_WAIT_V(6); PG8_BAR;
    }
    for (;;) {
        const bool has_next = S.next(ui + 1, nxt);
        const char* nA = has_next ? (const char*)g.A + (size_t)nxt.pm * tstep : cA; const char* nB = has_next ? (const char*)g.Bt + (size_t)nxt.pn * tstep : cB;
        for (int t = 0; t < nt; t += 2) {
            const bool last = (t == nt - 2);
            const char* a1 = cA + (size_t)(t + 1) * kstep;
            const char* a2 = last ? nA : cA + (size_t)(t + 2) * kstep; const char* b2 = last ? nB : cB + (size_t)(t + 2) * kstep;
            const char* a3 = a2 + kstep; const char* b3 = b2 + kstep;
            if (last && has_next) S.a_ready(nxt);
            if constexpr (SP2) {
            PG8_LDB(B0, 0, 0); PG8_LDB(B1, 0, 1); PG8_SCHED; PG8_LDA(At, 0, 0); PG8_STAGE(PG8_SA(1, 1), a1 + hstep, voffA);
            PG8_WAIT_V(8); PG8_WAIT_L(0); PG8_BAR; PG8_MMA(0, 0, At, B0); PG8_MMA(0, 1, At, B1); PG8_BAR; PG8_SCHED;
            PG8_LDA(At, 0, 1); PG8_STAGE(PG8_SB(0, 0), b2, voffB); PG8_STAGE(PG8_SB(0, 1), b2 + hstep, voffB); PG8_STAGE(PG8_SA(0, 0), a2, voffA);
            PG8_WAIT_V(8); PG8_WAIT_L(0); PG8_BAR; PG8_MMA(1, 0, At, B0); PG8_MMA(1, 1, At, B1); PG8_BAR; PG8_SCHED;
            PG8_LDB(B0, 1, 0); PG8_LDB(B1, 1, 1); PG8_SCHED; PG8_LDA(At, 1, 0); PG8_STAGE(PG8_SA(0, 1), a2 + hstep, voffA);
            PG8_WAIT_V(8); PG8_WAIT_L(0); PG8_BAR; PG8_MMA(0, 0, At, B0); PG8_MMA(0, 1, At, B1); PG8_BAR; PG8_SCHED;
            PG8_LDA(At, 1, 1); PG8_STAGE(PG8_SB(1, 0), b3, voffB); PG8_STAGE(PG8_SB(1, 1), b3 + hstep, voffB); PG8_STAGE(PG8_SA(1, 0), a3, voffA);
            PG8_WAIT_V(8); PG8_WAIT_L(0); PG8_BAR; PG8_MMA(1, 0, At, B0); PG8_MMA(1, 1, At, B1); PG8_BAR; PG8_SCHED;
            } else {
            PG8_LDB(B0, 0, 0); PG8_SCHED; PG8_LDA(At, 0, 0); PG8_STAGE(PG8_SA(1, 1), a1 + hstep, voffA);
            PG8_WAIT_L(8); PG8_BAR; PG8_WAIT_L(0); PG8_MMA(0, 0, At, B0); PG8_BAR; PG8_SCHED;
            PG8_LDB(B1, 0, 1); PG8_STAGE(PG8_SB(0, 0), b2, voffB);
            PG8_BAR; PG8_WAIT_L(0); PG8_MMA(0, 1, At, B1); PG8_BAR;
            PG8_LDA(At, 0, 1); PG8_STAGE(PG8_SA(0, 0), a2, voffA);
            PG8_BAR; PG8_WAIT_L(0); PG8_MMA(1, 0, At, B0); PG8_BAR; PG8_SCHED;
            PG8_STAGE(PG8_SB(0, 1), b2 + hstep, voffB);
            PG8_WAIT_V(6); PG8_BAR; PG8_MMA(1, 1, At, B1); PG8_BAR;
            PG8_LDB(B0, 1, 0); PG8_SCHED; PG8_LDA(At, 1, 0); PG8_STAGE(PG8_SA(0, 1), a2 + hstep, voffA);
            PG8_WAIT_L(8); PG8_BAR; PG8_WAIT_L(0); PG8_MMA(0, 0, At, B0); PG8_BAR; PG8_SCHED;
            PG8_LDB(B1, 1, 1); PG8_STAGE(PG8_SB(1, 0), b3, voffB);
            PG8_BAR; PG8_WAIT_L(0); PG8_MMA(0, 1, At, B1); PG8_BAR;
            PG8_LDA(At, 1, 1); PG8_STAGE(PG8_SA(1, 0), a3, voffA);
            PG8_BAR; PG8_WAIT_L(0); PG8_MMA(1, 0, At, B0); PG8_BAR; PG8_SCHED;
            PG8_STAGE(PG8_SB(1, 1), b3 + hstep, voffB);
            PG8_WAIT_V(6); PG8_BAR; PG8_MMA(1, 1, At, B1); PG8_BAR;
            }
        }
        if constexpr (ALIGN_EPI) { if (wr == 0) PG8_BAR; }
        if constexpr (!Epi::AFTER_DRAIN) { E(acc, cur, wr, wc, fr, fq); S.done(cur); }
        if (!has_next) break;
#pragma unroll
        for (int a = 0; a < 2; ++a)
#pragma unroll
            for (int b = 0; b < 2; ++b)
#pragma unroll
                for (int m = 0; m < 4; ++m)
#pragma unroll
                    for (int n = 0; n < 2; ++n) acc[a][b][m][n] = (f32x4){0.f, 0.f, 0.f, 0.f};
        cur = nxt; cA = nA; cB = nB; ++ui;
        if constexpr (ALIGN_EPI) { if (wr == 1) PG8_BAR; }
    }
    PG8_WAIT_V(0);
    if constexpr (!ALIGN_EPI) { if (wr == 0) PG8_BAR; }
    PG8_BAR;
    if constexpr (Epi::AFTER_DRAIN) { E.fused(acc, cur, wr, wc, fr, fq, lds, wid, lane); S.done(cur); }
#undef PG8_SA
#undef PG8_SB
#undef PG8_STAGE
#undef PG8_LDA
#undef PG8_LDB
#undef PG8_MMA
#undef PG8_WAIT_V
#undef PG8_WAIT_L
#undef PG8_BAR
#undef PG8_SCHED
}
}


namespace pg8 {
struct EpiZ {
    static constexpr bool PERM = true, AFTER_DRAIN = false;
    bf16_t* z; bf16_t* vT; const float* rss;
    __device__ __forceinline__ void operator()(const f32x4 (&acc)[2][2][4][2], const Unit& u, int wr, int wc, int fr, int fq) const {
        f32x4 part[2][4];
#pragma unroll
        for (int ai = 0; ai < 2; ++ai)
#pragma unroll
            for (int m = 0; m < 4; ++m) part[ai][m] = *(const f32x4*)(rss + (size_t)(u.pm * BM + ai * HALF + wr * 64 + m * 16 + fr) * 16 + 4 * fq);
        float rstdv[2][4];
#pragma unroll
        for (int ai = 0; ai < 2; ++ai)
#pragma unroll
            for (int m = 0; m < 4; ++m) {
                float s = (part[ai][m][0] + part[ai][m][1]) + (part[ai][m][2] + part[ai][m][3]);
                s += __shfl_xor(s, 16); s += __shfl_xor(s, 32);
                rstdv[ai][m] = rsqrtf(s * (1.0f / 1024.0f) + RMS_EPS);
            }
#pragma unroll
        for (int ai = 0; ai < 2; ++ai)
#pragma unroll
            for (int m = 0; m < 4; ++m) {
                const int row = u.pm * BM + ai * HALF + wr * 64 + m * 16 + fr;
                const float rstd = rstdv[ai][m];
                const int b = row >> 11, s = row & 2047;
#pragma unroll
                for (int bj = 0; bj < 2; ++bj) {
                    const int tn = 2 * u.pn + bj;
                    const int cw = 32 * wc + 8 * fq;
                    const f32x4 v0 = acc[ai][bj][m][0] * rstd, v1 = acc[ai][bj][m][1] * rstd;
                    u32x4 w; w.x = ::cvt_pk_bf16(v0[0], v0[1]); w.y = ::cvt_pk_bf16(v0[2], v0[3]); w.z = ::cvt_pk_bf16(v1[0], v1[1]); w.w = ::cvt_pk_bf16(v1[2], v1[3]);
                    if (tn < 24) {
                        bf16_t* dst;
                        if (tn < 8) dst = z + (size_t)(tn >> 2) * ZS_KD + ((size_t)((b * 4 + (tn & 3)) * 2048 + s)) * 128 + cw;
                        else if (tn < 16) dst = z + ZS_QN + (size_t)((tn - 8) >> 2) * (ZS_KN - ZS_QN) + ((size_t)((b * 8 + ((tn - 8) & 3) * 2 + (cw >> 6)) * 2048 + s)) * 64 + (cw & 63);
                        else dst = z + ZS_GATE + (size_t)row * 1024 + (tn - 16) * 128 + cw;
                        *(u32x4*)dst = w;
                    } else {
                        const unsigned ox = __shfl_xor(w.x, 1), oy = __shfl_xor(w.y, 1), oz = __shfl_xor(w.z, 1), ow = __shfl_xor(w.w, 1);
                        const bool odd = fr & 1;
                        const unsigned a0 = odd ? oz : w.x, a1 = odd ? ow : w.y;
                        const unsigned b0 = odd ? w.z : ox, b1 = odd ? w.w : oy;
                        const unsigned p0 = (a0 & 0xffffu) | (b0 << 16), p1 = (a0 >> 16) | (b0 & 0xffff0000u);
                        const unsigned p2 = (a1 & 0xffffu) | (b1 << 16), p3 = (a1 >> 16) | (b1 & 0xffff0000u);
                        const int ch0 = cw + (odd ? 4 : 0), se = s & ~1;
                        bf16_t* dst;
                        if (tn < 28) dst = vT + VS_VD + ((size_t)(((b * 4 + (tn - 24)) * 32 + (se >> 6)) * 128 + ch0)) * 64 + (se & 63);
                        else dst = vT + VS_VN + ((size_t)(((b * 8 + (tn - 28) * 2 + (ch0 >> 6)) * 32 + (se >> 6)) * 64 + (ch0 & 63))) * 64 + (se & 63);
                        *(unsigned*)(dst) = p0; *(unsigned*)(dst + 64) = p1; *(unsigned*)(dst + 128) = p2; *(unsigned*)(dst + 192) = p3;
                    }
                }
            }
    }
};
template <bool WRITE_XB> struct EpiRes {
    static constexpr bool PERM = true, AFTER_DRAIN = false;
    const float* xin; float* xf; bf16_t* xb; float* rss;
    __device__ __forceinline__ void operator()(const f32x4 (&acc)[2][2][4][2], const Unit& u, int wr, int wc, int fr, int fq) const {
#pragma unroll
        for (int ai = 0; ai < 2; ++ai) {
            f32x4 res[4][2][2];
#pragma unroll
            for (int m = 0; m < 4; ++m)
#pragma unroll
                for (int bj = 0; bj < 2; ++bj) {
                    const size_t off = (size_t)(u.pm * BM + ai * HALF + wr * 64 + m * 16 + fr) * 1024 + u.pn * BM + bj * HALF + 32 * wc + 8 * fq;
                    res[m][bj][0] = *(const f32x4*)(xin + off); res[m][bj][1] = *(const f32x4*)(xin + off + 4);
                }
            __builtin_amdgcn_sched_barrier(0);
#pragma unroll
            for (int m = 0; m < 4; ++m) {
                const int row = u.pm * BM + ai * HALF + wr * 64 + m * 16 + fr;
                float ss = 0.f;
#pragma unroll
                for (int bj = 0; bj < 2; ++bj) {
                    const size_t off = (size_t)row * 1024 + u.pn * BM + bj * HALF + 32 * wc + 8 * fq;
                    const f32x4 v0 = res[m][bj][0] + acc[ai][bj][m][0], v1 = res[m][bj][1] + acc[ai][bj][m][1];
                    *(f32x4*)(xf + off) = v0; *(f32x4*)(xf + off + 4) = v1;
                    if (WRITE_XB) { u32x4 w; w.x = ::cvt_pk_bf16(v0[0], v0[1]); w.y = ::cvt_pk_bf16(v0[2], v0[3]); w.z = ::cvt_pk_bf16(v1[0], v1[1]); w.w = ::cvt_pk_bf16(v1[2], v1[3]); *(u32x4*)(xb + off) = w; }
                    ss += (v0[0] * v0[0] + v0[1] * v0[1]) + (v0[2] * v0[2] + v0[3] * v0[3]) + (v1[0] * v1[0] + v1[1] * v1[1]) + (v1[2] * v1[2] + v1[3] * v1[3]);
                }
                ss += __shfl_xor(ss, 16); ss += __shfl_xor(ss, 32);
                if (fq == 0) rss[(size_t)row * 16 + u.pn * 4 + wc] = ss;
            }
            __builtin_amdgcn_sched_barrier(0);
        }
    }
};
struct EpiFinal {
    static constexpr bool PERM = true, AFTER_DRAIN = true;
    const float* xin; float* out; const float* fg; float* rss; unsigned* cnt;
    __device__ __forceinline__ void fused(f32x4 (&acc)[2][2][4][2], const Unit& u, int wr, int wc, int fr, int fq, PG8_LAS unsigned char* lds, int wid, int lane) const {
        float ssv[2][4];
#pragma unroll
        for (int ai = 0; ai < 2; ++ai) {
            f32x4 res[4][2][2];
#pragma unroll
            for (int m = 0; m < 4; ++m)
#pragma unroll
                for (int bj = 0; bj < 2; ++bj) {
                    const size_t off = (size_t)(u.pm * BM + ai * HALF + wr * 64 + m * 16 + fr) * 1024 + u.pn * BM + bj * HALF + 32 * wc + 8 * fq;
                    res[m][bj][0] = *(const f32x4*)(xin + off); res[m][bj][1] = *(const f32x4*)(xin + off + 4);
                }
#pragma unroll
            for (int m = 0; m < 4; ++m) {
                float ss = 0.f;
#pragma unroll
                for (int bj = 0; bj < 2; ++bj) {
                    const f32x4 v0 = res[m][bj][0] + acc[ai][bj][m][0], v1 = res[m][bj][1] + acc[ai][bj][m][1];
                    acc[ai][bj][m][0] = v0; acc[ai][bj][m][1] = v1;
                    ss += (v0[0] * v0[0] + v0[1] * v0[1]) + (v0[2] * v0[2] + v0[3] * v0[3]) + (v1[0] * v1[0] + v1[1] * v1[1]) + (v1[2] * v1[2] + v1[3] * v1[3]);
                }
                ss += __shfl_xor(ss, 16); ss += __shfl_xor(ss, 32);
                ssv[ai][m] = ss;
            }
        }
        if (fq == 0) {
#pragma unroll
            for (int ai = 0; ai < 2; ++ai)
#pragma unroll
                for (int m = 0; m < 4; ++m)
                    __hip_atomic_store((unsigned*)rss + (size_t)(u.pm * BM + ai * HALF + wr * 64 + m * 16 + fr) * 16 + u.pn * 4 + wc, __float_as_uint(ssv[ai][m]), __ATOMIC_RELAXED, __HIP_MEMORY_SCOPE_AGENT);
        }
        asm volatile("s_waitcnt vmcnt(0)" ::: "memory");
        if (lane == 0) __hip_atomic_fetch_add(cnt + 64 * u.pm, 1u, __ATOMIC_RELAXED, __HIP_MEMORY_SCOPE_AGENT);
        if (wid == 0) {
            unsigned spins = 0;
            while ((unsigned)__builtin_amdgcn_readfirstlane(__hip_atomic_load(cnt + 64 * u.pm, __ATOMIC_RELAXED, __HIP_MEMORY_SCOPE_AGENT)) < 32u) {
                __builtin_amdgcn_s_sleep(2);
                if (++spins > (1u << 22)) break;
            }
            __builtin_amdgcn_fence(__ATOMIC_ACQUIRE, "agent");
        }
        asm volatile("s_waitcnt vmcnt(0) lgkmcnt(0)" ::: "memory"); __builtin_amdgcn_s_barrier(); asm volatile("" ::: "memory");
        float rstdv[2][4];
#pragma unroll
        for (int ai = 0; ai < 2; ++ai)
#pragma unroll
            for (int m = 0; m < 4; ++m) {
                const unsigned* rp = (const unsigned*)rss + (size_t)(u.pm * BM + ai * HALF + wr * 64 + m * 16 + fr) * 16 + 4 * fq;
                float s = 0.f;
#pragma unroll
                for (int k = 0; k < 4; ++k) s += __uint_as_float(__hip_atomic_load(rp + k, __ATOMIC_RELAXED, __HIP_MEMORY_SCOPE_AGENT));
                s += __shfl_xor(s, 16); s += __shfl_xor(s, 32);
                rstdv[ai][m] = rsqrtf(s * (1.0f / 1024.0f) + RMS_EPS);
            }
        f32x4 gv[2][2];
#pragma unroll
        for (int bj = 0; bj < 2; ++bj) { const int c0 = u.pn * BM + bj * HALF + 32 * wc + 8 * fq; gv[bj][0] = *(const f32x4*)(fg + c0); gv[bj][1] = *(const f32x4*)(fg + c0 + 4); }
#pragma unroll
        for (int ai = 0; ai < 2; ++ai)
#pragma unroll
            for (int m = 0; m < 4; ++m)
#pragma unroll
                for (int bj = 0; bj < 2; ++bj) {
                    const size_t off = (size_t)(u.pm * BM + ai * HALF + wr * 64 + m * 16 + fr) * 1024 + u.pn * BM + bj * HALF + 32 * wc + 8 * fq;
                    *(f32x4*)(out + off) = acc[ai][bj][m][0] * rstdv[ai][m] * gv[bj][0];
                    *(f32x4*)(out + off + 4) = acc[ai][bj][m][1] * rstdv[ai][m] * gv[bj][1];
                }
    }
};
}
constexpr int LDS_PHASE_BYTES = 143360;
constexpr int LDS_RPB_OFF = LDS_PHASE_BYTES + 16, LDS_RPB_BYTES = 8 * 465 * 4;

constexpr int DA_KP = 272, DA_VP = 144;
constexpr int DA_KBYTES = 128 * DA_KP, DA_VSUB = 128 * DA_VP, DA_VBYTES = 2 * DA_VSUB, DA_STAGE = DA_KBYTES + DA_VBYTES;

__device__ __forceinline__ float silu_f(float x) { return x / (1.0f + __expf(-x)); }

__device__ void da_unit(char* lds, const Params& p, int layer, int unit) {
    int tid_ = threadIdx.x; asm volatile("" : "+v"(tid_)); const int tid = tid_, lane = tid & 63, wid = __builtin_amdgcn_readfirstlane(tid >> 6), r = lane & 31, h2 = lane >> 5;
    const int c = wid & 1, qg = wid >> 1;
    const int g8 = unit >> 3, bh = (unit & 7) * 4 + (g8 >> 4), qb = g8 & 15, b = bh >> 2, h = bh & 3;
    const float slope2 = exp2f(-2.0f * (float)(h + 1)) * LOG2E;
    const float qscale = 0.125f * LOG2E;
    float lam;
    {
        const float v1 = p.lq1[layer * 64 + lane] * p.lk1[layer * 64 + lane], v2 = p.lq2[layer * 64 + lane] * p.lk2[layer * 64 + lane];
        float s1 = v1, s2 = v2;
#pragma unroll
        for (int s = 32; s >= 1; s >>= 1) { s1 += __shfl_xor(s1, s); s2 += __shfl_xor(s2, s); }
        lam = __expf(s1) - __expf(s2) + p.lam_init[layer];
    }
    const int q0 = qb * 128 + qg * 32;
    const size_t tokq = (size_t)b * SEQ + q0 + r;
    bf16x8 qf[4];
#pragma unroll
    for (int t = 0; t < 4; ++t) {
        const u32x4 w = *(const u32x4*)(p.z + ZS_QD + ((size_t)(bh * 2048 + q0 + r)) * 128 + c * 64 + t * 16 + h2 * 8);
        u32x4 o;
        o.x = cvt_pk_bf16(bflo(w.x) * qscale, bfhi(w.x) * qscale); o.y = cvt_pk_bf16(bflo(w.y) * qscale, bfhi(w.y) * qscale);
        o.z = cvt_pk_bf16(bflo(w.z) * qscale, bfhi(w.z) * qscale); o.w = cvt_pk_bf16(bflo(w.w) * qscale, bfhi(w.w) * qscale);
        qf[t] = __builtin_bit_cast(bf16x8, o);
    }
    f32x16 O[4], Bs;
#pragma unroll
    for (int k = 0; k < 4; ++k)
#pragma unroll
        for (int e = 0; e < 16; ++e) O[k][e] = 0.f;
#pragma unroll
    for (int e = 0; e < 16; ++e) Bs[e] = -slope2 * (float)(16 * (e >> 3) + (e & 7));
    float mrow = -1e30f, lrow = 0.f;
    const float qrel = (float)(8 * h2) - (float)(q0 + r);
    const bf16_t* Kg = p.z + ZS_KD + ((size_t)bh * 2048) * 128 + tid * 8;
    const bf16_t* Vg = p.vT + VS_VD + ((size_t)bh * 32) * 8192 + tid * 8;
    const int kr_ = tid >> 4, kc_ = tid & 15, vr_ = tid >> 3, vc_ = tid & 7;
    constexpr int NT = SEQ / 128;
    auto tile_of = [&](int i) { return (i < NT - qb) ? (qb + i) : (NT - 1 - i); };
    u32x4 rk[4], rv[4];
    {
        const int t0 = tile_of(0);
#pragma unroll
        for (int j = 0; j < 4; ++j) { rk[j] = *(const u32x4*)(Kg + (size_t)t0 * 16384 + j * 4096); rv[j] = *(const u32x4*)(Vg + (size_t)t0 * 16384 + j * 4096); }
    }
    __syncthreads();
#pragma unroll
    for (int j = 0; j < 4; ++j) {
        *(u32x4*)(lds + (kr_ + 32 * j) * DA_KP + kc_ * 16) = rk[j];
        *(u32x4*)(lds + DA_KBYTES + (j >> 1) * DA_VSUB + (vr_ + 64 * (j & 1)) * DA_VP + vc_ * 16) = rv[j];
    }
    __syncthreads();
    const int pr = (r & 0x13) | ((r & 4) << 1) | ((r & 8) >> 1);
    if (wid >= 4) __builtin_amdgcn_s_setprio(1);
    {
        const int it = 0; const int kt = qb;
        const char* cK = lds + (it & 1) * DA_STAGE;
        const char* cV = cK + DA_KBYTES;
        char* nK = lds + ((it + 1) & 1) * DA_STAGE;
        if (it + 1 < NT) {
            const int tn = tile_of(it + 1);
#pragma unroll
            for (int j = 0; j < 4; ++j) { rk[j] = *(const u32x4*)(Kg + (size_t)tn * 16384 + j * 4096); rv[j] = *(const u32x4*)(Vg + (size_t)tn * 16384 + j * 4096); }
        }
#pragma unroll
        for (int kb = 0; kb < 4; ++kb) {
            const int k0 = kt * 128 + kb * 32;
            f32x16 s; const float A = 0.f;
            const float kq = (float)k0 + qrel;
#pragma unroll
            for (int e = 0; e < 16; ++e) s[e] = 0.f;
#pragma unroll
            for (int t = 0; t < 4; ++t) {
                const bf16x8 kf = *(const bf16x8*)(cK + (kb * 32 + pr) * DA_KP + c * 128 + t * 32 + h2 * 16);
                s = __builtin_amdgcn_mfma_f32_32x32x16_bf16(kf, qf[t], s, 0, 0, 0);
            }
#pragma unroll
            for (int e = 0; e < 16; ++e) s[e] = fmaf(fabsf(kq + (float)(16 * (e >> 3) + (e & 7))), -slope2, s[e]);
            float mx = s[0];
#pragma unroll
            for (int e = 1; e < 16; ++e) mx = fmaxf(mx, s[e]);
            mx += A;
            mx = fmaxf(mx, __shfl_xor(mx, 32));
            if (!__all(mx <= mrow + 8.0f)) {
                const float mnew = fmaxf(mrow, mx);
                const float alpha = fast_exp2(mrow - mnew);
#pragma unroll
                for (int k = 0; k < 4; ++k) O[k] = O[k] * alpha;
                lrow *= alpha; mrow = mnew;
            }
            const float mm = mrow - A;
            float ps = 0.f;
#pragma unroll
            for (int e = 0; e < 16; ++e) { s[e] = fast_exp2(s[e] - mm); ps += s[e]; }
            lrow += ps;
            bf16x8 pb[2];
#pragma unroll
            for (int sp = 0; sp < 2; ++sp) {
                u32x4 w;
                w.x = cvt_pk_bf16(s[8 * sp + 0], s[8 * sp + 1]); w.y = cvt_pk_bf16(s[8 * sp + 2], s[8 * sp + 3]);
                w.z = cvt_pk_bf16(s[8 * sp + 4], s[8 * sp + 5]); w.w = cvt_pk_bf16(s[8 * sp + 6], s[8 * sp + 7]);
                pb[sp] = __builtin_bit_cast(bf16x8, w);
            }
#pragma unroll
            for (int sp = 0; sp < 2; ++sp)
#pragma unroll
                for (int k = 0; k < 4; ++k) {
                    const bf16x8 vf = *(const bf16x8*)(cV + (kb >> 1) * DA_VSUB + (32 * k + r) * DA_VP + (32 * (kb & 1) + 16 * sp + 8 * h2) * 2);
                    O[k] = __builtin_amdgcn_mfma_f32_32x32x16_bf16(vf, pb[sp], O[k], 0, 0, 0);
                }
        }

        if (it + 1 < NT) {
#pragma unroll
            for (int j = 0; j < 4; ++j) {
                *(u32x4*)(nK + (kr_ + 32 * j) * DA_KP + kc_ * 16) = rk[j];
                *(u32x4*)(nK + DA_KBYTES + (j >> 1) * DA_VSUB + (vr_ + 64 * (j & 1)) * DA_VP + vc_ * 16) = rv[j];
            }
        }
        __syncthreads();
    }
    for (int it = 1; it < NT - qb; ++it) {
        const int kt = tile_of(it);
        const char* cK = lds + (it & 1) * DA_STAGE;
        const char* cV = cK + DA_KBYTES;
        char* nK = lds + ((it + 1) & 1) * DA_STAGE;
        const int tn = tile_of(it + 1 < NT ? it + 1 : it);
        if (it + 1 < NT) {
#pragma unroll
            for (int j = 0; j < 4; ++j) rk[j] = *(const u32x4*)(Kg + (size_t)tn * 16384 + j * 4096);
        }
#define DA_FAST_HALF(BSEL, SGN, hf) \
            { \
                f32x16 s0, s1; \
                { const bf16x8 kf0 = *(const bf16x8*)(cK + (hf * 64 + pr) * DA_KP + c * 128 + h2 * 16); \
                  const bf16x8 kf1 = *(const bf16x8*)(cK + (hf * 64 + 32 + pr) * DA_KP + c * 128 + h2 * 16); \
                  s0 = __builtin_amdgcn_mfma_f32_32x32x16_bf16(kf0, qf[0], BSEL, 0, 0, 0); \
                  s1 = __builtin_amdgcn_mfma_f32_32x32x16_bf16(kf1, qf[0], BSEL, 0, 0, 0); } \
                _Pragma("unroll") \
                for (int t = 1; t < 4; ++t) { \
                    const bf16x8 kf0 = *(const bf16x8*)(cK + (hf * 64 + pr) * DA_KP + c * 128 + t * 32 + h2 * 16); \
                    const bf16x8 kf1 = *(const bf16x8*)(cK + (hf * 64 + 32 + pr) * DA_KP + c * 128 + t * 32 + h2 * 16); \
                    s0 = __builtin_amdgcn_mfma_f32_32x32x16_bf16(kf0, qf[t], s0, 0, 0, 0); \
                    s1 = __builtin_amdgcn_mfma_f32_32x32x16_bf16(kf1, qf[t], s1, 0, 0, 0); \
                } \
                const float A0 = (SGN) * ((float)(kt * 128 + hf * 64) + qrel), A1 = A0 + (SGN) * 32.0f; \
                const float mm0 = mrow - A0, mm1 = mrow - A1; \
                float ps0 = 0.f, ps1 = 0.f; \
                _Pragma("unroll") \
                for (int e = 0; e < 16; ++e) { s0[e] = fast_exp2(s0[e] - mm0); ps0 += s0[e]; } \
                bf16x8 pb0[2], pb1[2]; \
                _Pragma("unroll") \
                for (int sp = 0; sp < 2; ++sp) { \
                    u32x4 w; \
                    w.x = cvt_pk_bf16(s0[8 * sp + 0], s0[8 * sp + 1]); w.y = cvt_pk_bf16(s0[8 * sp + 2], s0[8 * sp + 3]); \
                    w.z = cvt_pk_bf16(s0[8 * sp + 4], s0[8 * sp + 5]); w.w = cvt_pk_bf16(s0[8 * sp + 6], s0[8 * sp + 7]); \
                    pb0[sp] = __builtin_bit_cast(bf16x8, w); \
                } \
                _Pragma("unroll") \
                for (int sp = 0; sp < 2; ++sp) \
                    _Pragma("unroll") \
                    for (int k = 0; k < 4; ++k) { \
                        const bf16x8 vf0 = *(const bf16x8*)(cV + hf * DA_VSUB + (32 * k + r) * DA_VP + (16 * sp + 8 * h2) * 2); \
                        O[k] = __builtin_amdgcn_mfma_f32_32x32x16_bf16(vf0, pb0[sp], O[k], 0, 0, 0); \
                    } \
                _Pragma("unroll") \
                for (int e = 0; e < 16; ++e) { s1[e] = fast_exp2(s1[e] - mm1); ps1 += s1[e]; } \
                lrow += ps0 + ps1; \
                _Pragma("unroll") \
                for (int sp = 0; sp < 2; ++sp) { \
                    u32x4 w; \
                    w.x = cvt_pk_bf16(s1[8 * sp + 0], s1[8 * sp + 1]); w.y = cvt_pk_bf16(s1[8 * sp + 2], s1[8 * sp + 3]); \
                    w.z = cvt_pk_bf16(s1[8 * sp + 4], s1[8 * sp + 5]); w.w = cvt_pk_bf16(s1[8 * sp + 6], s1[8 * sp + 7]); \
                    pb1[sp] = __builtin_bit_cast(bf16x8, w); \
                } \
                _Pragma("unroll") \
                for (int sp = 0; sp < 2; ++sp) \
                    _Pragma("unroll") \
                    for (int k = 0; k < 4; ++k) { \
                        const bf16x8 vf1 = *(const bf16x8*)(cV + hf * DA_VSUB + (32 * k + r) * DA_VP + (32 + 16 * sp + 8 * h2) * 2); \
                        O[k] = __builtin_amdgcn_mfma_f32_32x32x16_bf16(vf1, pb1[sp], O[k], 0, 0, 0); \
                    } \
            }
        DA_FAST_HALF(Bs, -slope2, 0)
        if (it + 1 < NT) {
#pragma unroll
            for (int j = 0; j < 4; ++j) *(u32x4*)(nK + (kr_ + 32 * j) * DA_KP + kc_ * 16) = rk[j];
#pragma unroll
            for (int j = 0; j < 4; ++j) rk[j] = *(const u32x4*)(Vg + (size_t)tn * 16384 + j * 4096);
        }
        DA_FAST_HALF(Bs, -slope2, 1)
#undef DA_FAST_HALF
        if (it + 1 < NT) {
#pragma unroll
            for (int j = 0; j < 4; ++j) *(u32x4*)(nK + DA_KBYTES + (j >> 1) * DA_VSUB + (vr_ + 64 * (j & 1)) * DA_VP + vc_ * 16) = rk[j];
        }
        __syncthreads();
    }
#pragma unroll
    for (int e = 0; e < 16; ++e) Bs[e] = -Bs[e];
    for (int it = NT - qb; it < NT; ++it) {
        const int kt = tile_of(it);
        const char* cK = lds + (it & 1) * DA_STAGE;
        const char* cV = cK + DA_KBYTES;
        char* nK = lds + ((it + 1) & 1) * DA_STAGE;
        const int tn = tile_of(it + 1 < NT ? it + 1 : it);
        if (it + 1 < NT) {
#pragma unroll
            for (int j = 0; j < 4; ++j) rk[j] = *(const u32x4*)(Kg + (size_t)tn * 16384 + j * 4096);
        }
#define DA_FAST_HALF(BSEL, SGN, hf) \
            { \
                f32x16 s0, s1; \
                { const bf16x8 kf0 = *(const bf16x8*)(cK + (hf * 64 + pr) * DA_KP + c * 128 + h2 * 16); \
                  const bf16x8 kf1 = *(const bf16x8*)(cK + (hf * 64 + 32 + pr) * DA_KP + c * 128 + h2 * 16); \
                  s0 = __builtin_amdgcn_mfma_f32_32x32x16_bf16(kf0, qf[0], BSEL, 0, 0, 0); \
                  s1 = __builtin_amdgcn_mfma_f32_32x32x16_bf16(kf1, qf[0], BSEL, 0, 0, 0); } \
                _Pragma("unroll") \
                for (int t = 1; t < 4; ++t) { \
                    const bf16x8 kf0 = *(const bf16x8*)(cK + (hf * 64 + pr) * DA_KP + c * 128 + t * 32 + h2 * 16); \
                    const bf16x8 kf1 = *(const bf16x8*)(cK + (hf * 64 + 32 + pr) * DA_KP + c * 128 + t * 32 + h2 * 16); \
                    s0 = __builtin_amdgcn_mfma_f32_32x32x16_bf16(kf0, qf[t], s0, 0, 0, 0); \
                    s1 = __builtin_amdgcn_mfma_f32_32x32x16_bf16(kf1, qf[t], s1, 0, 0, 0); \
                } \
                const float A0 = (SGN) * ((float)(kt * 128 + hf * 64) + qrel), A1 = A0 + (SGN) * 32.0f; \
                const float mm0 = mrow - A0, mm1 = mrow - A1; \
                float ps0 = 0.f, ps1 = 0.f; \
                _Pragma("unroll") \
                for (int e = 0; e < 16; ++e) { s0[e] = fast_exp2(s0[e] - mm0); ps0 += s0[e]; } \
                bf16x8 pb0[2], pb1[2]; \
                _Pragma("unroll") \
                for (int sp = 0; sp < 2; ++sp) { \
                    u32x4 w; \
                    w.x = cvt_pk_bf16(s0[8 * sp + 0], s0[8 * sp + 1]); w.y = cvt_pk_bf16(s0[8 * sp + 2], s0[8 * sp + 3]); \
                    w.z = cvt_pk_bf16(s0[8 * sp + 4], s0[8 * sp + 5]); w.w = cvt_pk_bf16(s0[8 * sp + 6], s0[8 * sp + 7]); \
                    pb0[sp] = __builtin_bit_cast(bf16x8, w); \
                } \
                _Pragma("unroll") \
                for (int sp = 0; sp < 2; ++sp) \
                    _Pragma("unroll") \
                    for (int k = 0; k < 4; ++k) { \
                        const bf16x8 vf0 = *(const bf16x8*)(cV + hf * DA_VSUB + (32 * k + r) * DA_VP + (16 * sp + 8 * h2) * 2); \
                        O[k] = __builtin_amdgcn_mfma_f32_32x32x16_bf16(vf0, pb0[sp], O[k], 0, 0, 0); \
                    } \
                _Pragma("unroll") \
                for (int e = 0; e < 16; ++e) { s1[e] = fast_exp2(s1[e] - mm1); ps1 += s1[e]; } \
                lrow += ps0 + ps1; \
                _Pragma("unroll") \
                for (int sp = 0; sp < 2; ++sp) { \
                    u32x4 w; \
                    w.x = cvt_pk_bf16(s1[8 * sp + 0], s1[8 * sp + 1]); w.y = cvt_pk_bf16(s1[8 * sp + 2], s1[8 * sp + 3]); \
                    w.z = cvt_pk_bf16(s1[8 * sp + 4], s1[8 * sp + 5]); w.w = cvt_pk_bf16(s1[8 * sp + 6], s1[8 * sp + 7]); \
                    pb1[sp] = __builtin_bit_cast(bf16x8, w); \
                } \
                _Pragma("unroll") \
                for (int sp = 0; sp < 2; ++sp) \
                    _Pragma("unroll") \
                    for (int k = 0; k < 4; ++k) { \
                        const bf16x8 vf1 = *(const bf16x8*)(cV + hf * DA_VSUB + (32 * k + r) * DA_VP + (32 + 16 * sp + 8 * h2) * 2); \
                        O[k] = __builtin_amdgcn_mfma_f32_32x32x16_bf16(vf1, pb1[sp], O[k], 0, 0, 0); \
                    } \
            }
        DA_FAST_HALF(Bs, slope2, 0)
        if (it + 1 < NT) {
#pragma unroll
            for (int j = 0; j < 4; ++j) *(u32x4*)(nK + (kr_ + 32 * j) * DA_KP + kc_ * 16) = rk[j];
#pragma unroll
            for (int j = 0; j < 4; ++j) rk[j] = *(const u32x4*)(Vg + (size_t)tn * 16384 + j * 4096);
        }
        DA_FAST_HALF(Bs, slope2, 1)
#undef DA_FAST_HALF
        if (it + 1 < NT) {
#pragma unroll
            for (int j = 0; j < 4; ++j) *(u32x4*)(nK + DA_KBYTES + (j >> 1) * DA_VSUB + (vr_ + 64 * (j & 1)) * DA_VP + vc_ * 16) = rk[j];
        }
        __syncthreads();
    }
    __builtin_amdgcn_s_setprio(0);
    {
        const float lchk = lrow + __shfl_xor(lrow, 32);
        const int bad = !(lchk < 1e30f);
        volatile unsigned* bflag = (volatile unsigned*)(lds + LDS_PHASE_BYTES + 8);
        if (tid == 0) *bflag = 0u;
        __syncthreads();
        if (__any(bad) && lane == 0) *bflag = 1u;
        __syncthreads();
        if (*bflag != 0u) {
#pragma unroll
            for (int k = 0; k < 4; ++k)
#pragma unroll
                for (int e = 0; e < 16; ++e) O[k][e] = 0.f;
            mrow = -1e30f; lrow = 0.f;
            {
                const int t0 = tile_of(0);
#pragma unroll
                for (int j = 0; j < 4; ++j) { rk[j] = *(const u32x4*)(Kg + (size_t)t0 * 16384 + j * 4096); rv[j] = *(const u32x4*)(Vg + (size_t)t0 * 16384 + j * 4096); }
            }
#pragma unroll
            for (int j = 0; j < 4; ++j) {
                *(u32x4*)(lds + (kr_ + 32 * j) * DA_KP + kc_ * 16) = rk[j];
                *(u32x4*)(lds + DA_KBYTES + (j >> 1) * DA_VSUB + (vr_ + 64 * (j & 1)) * DA_VP + vc_ * 16) = rv[j];
            }
            __syncthreads();
        for (int it = 0; it < NT; ++it) {
            const int kt = tile_of(it);
        const char* cK = lds + (it & 1) * DA_STAGE;
        const char* cV = cK + DA_KBYTES;
        char* nK = lds + ((it + 1) & 1) * DA_STAGE;
        if (it + 1 < NT) {
            const int tn = tile_of(it + 1);
#pragma unroll
            for (int j = 0; j < 4; ++j) { rk[j] = *(const u32x4*)(Kg + (size_t)tn * 16384 + j * 4096); rv[j] = *(const u32x4*)(Vg + (size_t)tn * 16384 + j * 4096); }
        }
#pragma unroll
        for (int kb = 0; kb < 4; ++kb) {
            const int k0 = kt * 128 + kb * 32;
            f32x16 s; const float A = 0.f;
            const float kq = (float)k0 + qrel;
#pragma unroll
            for (int e = 0; e < 16; ++e) s[e] = 0.f;
#pragma unroll
            for (int t = 0; t < 4; ++t) {
                const bf16x8 kf = *(const bf16x8*)(cK + (kb * 32 + pr) * DA_KP + c * 128 + t * 32 + h2 * 16);
                s = __builtin_amdgcn_mfma_f32_32x32x16_bf16(kf, qf[t], s, 0, 0, 0);
            }
#pragma unroll
            for (int e = 0; e < 16; ++e) s[e] = fmaf(fabsf(kq + (float)(16 * (e >> 3) + (e & 7))), -slope2, s[e]);
            float mx = s[0];
#pragma unroll
            for (int e = 1; e < 16; ++e) mx = fmaxf(mx, s[e]);
            mx += A;
            mx = fmaxf(mx, __shfl_xor(mx, 32));
            if (!__all(mx <= mrow + 8.0f)) {
                const float mnew = fmaxf(mrow, mx);
                const float alpha = fast_exp2(mrow - mnew);
#pragma unroll
                for (int k = 0; k < 4; ++k) O[k] = O[k] * alpha;
                lrow *= alpha; mrow = mnew;
            }
            const float mm = mrow - A;
            float ps = 0.f;
#pragma unroll
            for (int e = 0; e < 16; ++e) { s[e] = fast_exp2(s[e] - mm); ps += s[e]; }
            lrow += ps;
            bf16x8 pb[2];
#pragma unroll
            for (int sp = 0; sp < 2; ++sp) {
                u32x4 w;
                w.x = cvt_pk_bf16(s[8 * sp + 0], s[8 * sp + 1]); w.y = cvt_pk_bf16(s[8 * sp + 2], s[8 * sp + 3]);
                w.z = cvt_pk_bf16(s[8 * sp + 4], s[8 * sp + 5]); w.w = cvt_pk_bf16(s[8 * sp + 6], s[8 * sp + 7]);
                pb[sp] = __builtin_bit_cast(bf16x8, w);
            }
#pragma unroll
            for (int sp = 0; sp < 2; ++sp)
#pragma unroll
                for (int k = 0; k < 4; ++k) {
                    const bf16x8 vf = *(const bf16x8*)(cV + (kb >> 1) * DA_VSUB + (32 * k + r) * DA_VP + (32 * (kb & 1) + 16 * sp + 8 * h2) * 2);
                    O[k] = __builtin_amdgcn_mfma_f32_32x32x16_bf16(vf, pb[sp], O[k], 0, 0, 0);
                }
        }

        if (it + 1 < NT) {
#pragma unroll
            for (int j = 0; j < 4; ++j) {
                *(u32x4*)(nK + (kr_ + 32 * j) * DA_KP + kc_ * 16) = rk[j];
                *(u32x4*)(nK + DA_KBYTES + (j >> 1) * DA_VSUB + (vr_ + 64 * (j & 1)) * DA_VP + vc_ * 16) = rv[j];
            }
        }
        __syncthreads();
    }
        }
    }
    const float lsum = lrow + __shfl_xor(lrow, 32);
    float* xch = (float*)lds + qg * 4096;
    if (c == 1) {
        const float i1 = lam / lsum;
#pragma unroll
        for (int k = 0; k < 4; ++k)
#pragma unroll
            for (int e = 0; e < 16; ++e) xch[(k * 16 + e) * 64 + lane] = O[k][e] * i1;
    }
    __syncthreads();
    if (c == 0) {
        const float i0 = 1.0f / lsum;
        float ss = 0.f;
#pragma unroll
        for (int k = 0; k < 4; ++k)
#pragma unroll
            for (int e = 0; e < 16; ++e) { const float a = O[k][e] * i0 - xch[(k * 16 + e) * 64 + lane]; O[k][e] = a; ss += a * a; }
        ss += __shfl_xor(ss, 32);
        const float rstd = rsqrtf(ss * (1.0f / 128.0f) + RMS_EPS) * (1.0f - p.lam_init[layer]);
        const float* sg = p.subln_g + layer * 128;
        u32x2 gwv[16]; f32x4 ggv[16];
#pragma unroll
        for (int k = 0; k < 4; ++k)
#pragma unroll
            for (int g = 0; g < 4; ++g) {
                const int d0 = 32 * k + 8 * g + 4 * h2;
                ggv[k * 4 + g] = *(const f32x4*)(sg + d0);
                gwv[k * 4 + g] = *(const u32x2*)(p.z + ZS_GATE + tokq * 1024 + h * 128 + d0);
            }
        __builtin_amdgcn_sched_barrier(0);
#pragma unroll
        for (int k = 0; k < 4; ++k)
#pragma unroll
            for (int g = 0; g < 4; ++g) {
                const int d0 = 32 * k + 8 * g + 4 * h2;
                const f32x4 gg = ggv[k * 4 + g];
                const u32x2 gw = gwv[k * 4 + g];
                const float o0 = O[k][4 * g + 0] * rstd * gg[0] * silu_f(bflo(gw.x));
                const float o1 = O[k][4 * g + 1] * rstd * gg[1] * silu_f(bfhi(gw.x));
                const float o2 = O[k][4 * g + 2] * rstd * gg[2] * silu_f(bflo(gw.y));
                const float o3 = O[k][4 * g + 3] * rstd * gg[3] * silu_f(bfhi(gw.y));
                u32x2 w; w.x = cvt_pk_bf16(o0, o1); w.y = cvt_pk_bf16(o2, o3);
                *(u32x2*)(p.o + tokq * 1024 + h * 128 + d0) = w;
            }
    }
}

__device__ void na_unit(char* lds, const Params& p, int layer, int unit) {
    int tid_ = threadIdx.x; asm volatile("" : "+v"(tid_)); const int tid = tid_, lane = tid & 63, wid = __builtin_amdgcn_readfirstlane(tid >> 6), fr = lane & 15, fq = lane >> 4;
    const int hp = unit & 3, rr0 = (unit >> 2) & 31, b = unit >> 7;
    const int h = 2 * hp + (wid >> 2), n = wid & 3;
    const float* rph = (const float*)(lds + LDS_RPB_OFF) + h * 465;
    const int r = rr0;
    const int rs = min(max(r - 4, 0), 24);
    const int kcstart = min(max(16 * n - 8, 0), 32);
    const int qcol = 16 * n + fr;
    const int qcstart = min(max(qcol - 8, 0), 48);
    const size_t tokq = (size_t)b * SEQ + r * 64 + qcol;
    bf16x8 qf[2];
#pragma unroll
    for (int t = 0; t < 2; ++t) qf[t] = *(const bf16x8*)(p.z + ZS_QN + ((size_t)((b * 8 + h) * 2048 + r * 64 + qcol)) * 64 + t * 32 + fq * 8);
    bf16x8 kfr[8][4];
    {
        const int kc = kcstart + 8 * (fr >> 2) + (fr & 3);
        const bf16_t* kg0 = p.z + ZS_KN + ((size_t)((b * 8 + h) * 2048 + rs * 64 + kc)) * 64 + fq * 8;
#pragma unroll
        for (int rr = 0; rr < 8; ++rr)
#pragma unroll
            for (int T = 0; T < 2; ++T) {
                const bf16_t* kg = kg0 + (size_t)(rr * 64 + 4 * T) * 64;
                kfr[rr][2 * T] = *(const bf16x8*)(kg); kfr[rr][2 * T + 1] = *(const bf16x8*)(kg + 32);
            }
    }
    __builtin_amdgcn_sched_barrier(0);
    const float c1 = 0.125f * LOG2E;
    float sc[8][8];
    float mx = -1e30f;
#pragma unroll
    for (int rr = 0; rr < 8; ++rr) {
#pragma unroll
        for (int T = 0; T < 2; ++T) {
            f32x4 s = (f32x4){0.f, 0.f, 0.f, 0.f};
            s = __builtin_amdgcn_mfma_f32_16x16x32_bf16(kfr[rr][2 * T], qf[0], s, 0, 0, 0);
            s = __builtin_amdgcn_mfma_f32_16x16x32_bf16(kfr[rr][2 * T + 1], qf[1], s, 0, 0, 0);
            const int dr = rs + rr - r + 7;
#pragma unroll
            for (int e = 0; e < 4; ++e) {
                const int kcol = kcstart + 8 * fq + e + 4 * T;
                const bool valid = (kcol >= qcstart) && (kcol < qcstart + 16);
                const int dc = min(max(kcol - qcol, -15), 15) + 15;
                const float bias = rph[dr * 31 + dc];
                const float v = valid ? fmaf(s[e], c1, bias) : -1e30f;
                sc[rr][4 * T + e] = v;
                mx = fmaxf(mx, v);
            }
        }
    }
    __builtin_amdgcn_sched_barrier(0);
    bf16x8 vfr[4][8];
    {
        const bf16_t* vg0 = p.vT + VS_VN + ((size_t)(((b * 8 + h) * 32 + rs) * 64 + fr)) * 64 + kcstart + 8 * fq;
#pragma unroll
        for (int dt = 0; dt < 4; ++dt)
#pragma unroll
            for (int rr = 0; rr < 8; ++rr) vfr[dt][rr] = *(const bf16x8*)(vg0 + (size_t)(rr * 64 + 16 * dt) * 64);
    }
    mx = fmaxf(mx, __shfl_xor(mx, 16)); mx = fmaxf(mx, __shfl_xor(mx, 32));
    float l = 0.f;
    bf16x8 pb[8];
#pragma unroll
    for (int rr = 0; rr < 8; ++rr) {
#pragma unroll
        for (int e = 0; e < 8; ++e) { sc[rr][e] = fast_exp2(sc[rr][e] - mx); l += sc[rr][e]; }
        u32x4 w;
        w.x = cvt_pk_bf16(sc[rr][0], sc[rr][1]); w.y = cvt_pk_bf16(sc[rr][2], sc[rr][3]);
        w.z = cvt_pk_bf16(sc[rr][4], sc[rr][5]); w.w = cvt_pk_bf16(sc[rr][6], sc[rr][7]);
        pb[rr] = __builtin_bit_cast(bf16x8, w);
    }
    l += __shfl_xor(l, 16); l += __shfl_xor(l, 32);
    const float il = 1.0f / l;
    f32x4 O[4];
#pragma unroll
    for (int dt = 0; dt < 4; ++dt) {
        O[dt] = (f32x4){0.f, 0.f, 0.f, 0.f};
#pragma unroll
        for (int rr = 0; rr < 8; ++rr) O[dt] = __builtin_amdgcn_mfma_f32_16x16x32_bf16(vfr[dt][rr], pb[rr], O[dt], 0, 0, 0);
    }
#pragma unroll
    for (int dt = 0; dt < 4; ++dt) {
        const int d0 = 16 * dt + 4 * fq;
        const u32x2 gw = *(const u32x2*)(p.z + ZS_GATE + tokq * 1024 + 512 + h * 64 + d0);
        const float o0 = O[dt][0] * il * silu_f(bflo(gw.x)), o1 = O[dt][1] * il * silu_f(bfhi(gw.x));
        const float o2 = O[dt][2] * il * silu_f(bflo(gw.y)), o3 = O[dt][3] * il * silu_f(bfhi(gw.y));
        u32x2 w; w.x = cvt_pk_bf16(o0, o1); w.y = cvt_pk_bf16(o2, o3);
        *(u32x2*)(p.o + tokq * 1024 + 512 + h * 64 + d0) = w;
    }
}


constexpr int NA_P = 144, NA_KBYTES = 128 * NA_P, NA_STAGE = 2 * NA_KBYTES;

__device__ void na_super_online(char* lds, const Params& p, int layer, int su) {
    int tid_ = threadIdx.x; asm volatile("" : "+v"(tid_)); const int tid = tid_, lane = tid & 63, wid = __builtin_amdgcn_readfirstlane(tid >> 6), fr = lane & 15, fq = lane >> 4;
    const int bh = (su & 7) * 8 + (su >> 5), g = (su >> 3) & 3, b = bh >> 3, h = bh & 7;
    const float* rph = (const float*)(lds + LDS_RPB_OFF) + h * 465;
    const float c1 = 0.125f * LOG2E;
    const int rq = 8 * g + wid, rsw = min(max(rq - 4, 0), 24);
    bf16x8 qf[4][2];
    f32x4 O[4][4];
    float mrow[4], lrow[4];
#pragma unroll
    for (int n = 0; n < 4; ++n) {
#pragma unroll
        for (int t = 0; t < 2; ++t) qf[n][t] = *(const bf16x8*)(p.z + ZS_QN + ((size_t)(bh * 2048 + rq * 64 + 16 * n + fr)) * 64 + t * 32 + fq * 8);
#pragma unroll
        for (int dt = 0; dt < 4; ++dt) O[n][dt] = (f32x4){0.f, 0.f, 0.f, 0.f};
        mrow[n] = -1e30f; lrow[n] = 0.f;
    }
    const int klo = min(max(8 * g - 4, 0), 24);
    const int nsteps = (g == 0 || g == 3) ? 6 : 8;
    const bf16_t* Kg = p.z + ZS_KN + ((size_t)(bh * 2048 + klo * 64)) * 64 + tid * 8;
    const bf16_t* Vg = p.vT + VS_VN + ((size_t)((bh * 32 + klo) * 64)) * 64 + tid * 8;
    const int lw = (tid >> 3) * NA_P + (tid & 7) * 16;
    u32x4 rk[2], rv[2];
    rk[0] = *(const u32x4*)(Kg); rk[1] = *(const u32x4*)(Kg + 4096);
    rv[0] = *(const u32x4*)(Vg); rv[1] = *(const u32x4*)(Vg + 4096);
    __syncthreads();
    *(u32x4*)(lds + lw) = rk[0]; *(u32x4*)(lds + lw + 64 * NA_P) = rk[1];
    *(u32x4*)(lds + NA_KBYTES + lw) = rv[0]; *(u32x4*)(lds + NA_KBYTES + lw + 64 * NA_P) = rv[1];
    __syncthreads();
    const int krow_off = (8 * (fr >> 2) + (fr & 3)) * NA_P + fq * 16;
    const int vrow_off = fr * NA_P + (8 * fq) * 2;
    for (int st = 0; st < nsteps; ++st) {
        const char* cur = lds + (st & 1) * NA_STAGE;
        char* nxt = lds + ((st + 1) & 1) * NA_STAGE;
        if (st + 1 < nsteps) {
            const bf16_t* kg = Kg + (size_t)(st + 1) * 8192; const bf16_t* vg = Vg + (size_t)(st + 1) * 8192;
            rk[0] = *(const u32x4*)(kg); rk[1] = *(const u32x4*)(kg + 4096);
            rv[0] = *(const u32x4*)(vg); rv[1] = *(const u32x4*)(vg + 4096);
        }
#pragma unroll 1
        for (int slot = 0; slot < 2; ++slot) {
            const int kr = klo + 2 * st + slot;
            if (kr >= rsw && kr <= rsw + 7) {
                const char* cK = cur + slot * 64 * NA_P + krow_off;
                const char* cV = cur + NA_KBYTES + slot * 64 * NA_P + vrow_off;
                const float* rpr = rph + (kr - rq + 7) * 31;
                float v[4][8], mx[4];
#pragma unroll
                for (int n = 0; n < 4; ++n) {
                    const int kcstart = n == 0 ? 0 : (n == 1 ? 8 : (n == 2 ? 24 : 32));
                    const int qcol = 16 * n + fr;
                    const int qcstart = min(max(qcol - 8, 0), 48);
                    float bias[8];
#pragma unroll
                    for (int e = 0; e < 8; ++e) bias[e] = rpr[min(max(kcstart + 8 * fq + e - qcol, -15), 15) + 15];
#pragma unroll
                    for (int e = 0; e < 8; ++e) asm volatile("" : "+v"(bias[e]));
#pragma unroll
                    for (int T = 0; T < 2; ++T) {
                        const bf16x8 k0 = *(const bf16x8*)(cK + (kcstart + T * 4) * NA_P), k1 = *(const bf16x8*)(cK + (kcstart + T * 4) * NA_P + 64);
                        f32x4 s = (f32x4){0.f, 0.f, 0.f, 0.f};
                        s = __builtin_amdgcn_mfma_f32_16x16x32_bf16(k0, qf[n][0], s, 0, 0, 0);
                        s = __builtin_amdgcn_mfma_f32_16x16x32_bf16(k1, qf[n][1], s, 0, 0, 0);
#pragma unroll
                        for (int e = 0; e < 4; ++e) {
                            const int kcol = kcstart + 8 * fq + e + 4 * T;
                            const bool valid = (kcol >= qcstart) && (kcol < qcstart + 16);
                            v[n][4 * T + e] = valid ? fmaf(s[e], c1, bias[4 * T + e]) : -1e30f;
                        }
                    }
                    mx[n] = fmaxf(fmaxf(fmaxf(v[n][0], v[n][1]), fmaxf(v[n][2], v[n][3])), fmaxf(fmaxf(v[n][4], v[n][5]), fmaxf(v[n][6], v[n][7])));
                }
#pragma unroll
                for (int n = 0; n < 4; ++n) mx[n] = fmaxf(mx[n], __shfl_xor(mx[n], 16));
#pragma unroll
                for (int n = 0; n < 4; ++n) mx[n] = fmaxf(mx[n], __shfl_xor(mx[n], 32));
#pragma unroll
                for (int n = 0; n < 4; ++n) {
                    const int kcstart = n == 0 ? 0 : (n == 1 ? 8 : (n == 2 ? 24 : 32));
                    const float mnew = fmaxf(mrow[n], mx[n]);
                    const float alpha = fast_exp2(mrow[n] - mnew);
                    mrow[n] = mnew;
                    float ps = 0.f;
#pragma unroll
                    for (int e = 0; e < 8; ++e) { v[n][e] = fast_exp2(v[n][e] - mnew); ps += v[n][e]; }
                    lrow[n] = lrow[n] * alpha + ps;
                    u32x4 w;
                    w.x = cvt_pk_bf16(v[n][0], v[n][1]); w.y = cvt_pk_bf16(v[n][2], v[n][3]); w.z = cvt_pk_bf16(v[n][4], v[n][5]); w.w = cvt_pk_bf16(v[n][6], v[n][7]);
                    const bf16x8 pb = __builtin_bit_cast(bf16x8, w);
#pragma unroll
                    for (int dt = 0; dt < 4; ++dt) {
                        const bf16x8 vf = *(const bf16x8*)(cV + dt * 16 * NA_P + kcstart * 2);
                        O[n][dt] = __builtin_amdgcn_mfma_f32_16x16x32_bf16(vf, pb, O[n][dt] * alpha, 0, 0, 0);
                    }
                }
            }
        }
        if (st + 1 < nsteps) {
            *(u32x4*)(nxt + lw) = rk[0]; *(u32x4*)(nxt + lw + 64 * NA_P) = rk[1];
            *(u32x4*)(nxt + NA_KBYTES + lw) = rv[0]; *(u32x4*)(nxt + NA_KBYTES + lw + 64 * NA_P) = rv[1];
        }
        __syncthreads();
    }
    u32x2 gwv[4][4];
#pragma unroll
    for (int n = 0; n < 4; ++n)
#pragma unroll
        for (int dt = 0; dt < 4; ++dt) gwv[n][dt] = *(const u32x2*)(p.z + ZS_GATE + ((size_t)b * SEQ + rq * 64 + 16 * n + fr) * 1024 + 512 + h * 64 + 16 * dt + 4 * fq);
    __builtin_amdgcn_sched_barrier(0);
#pragma unroll
    for (int n = 0; n < 4; ++n) {
        float l = lrow[n];
        l += __shfl_xor(l, 16); l += __shfl_xor(l, 32);
        const float il = 1.0f / l;
        const size_t tokq = (size_t)b * SEQ + rq * 64 + 16 * n + fr;
#pragma unroll
        for (int dt = 0; dt < 4; ++dt) {
            const int d0 = 16 * dt + 4 * fq;
            const u32x2 gw = gwv[n][dt];
            const float o0 = O[n][dt][0] * il * silu_f(bflo(gw.x)), o1 = O[n][dt][1] * il * silu_f(bfhi(gw.x));
            const float o2 = O[n][dt][2] * il * silu_f(bflo(gw.y)), o3 = O[n][dt][3] * il * silu_f(bfhi(gw.y));
            u32x2 w; w.x = cvt_pk_bf16(o0, o1); w.y = cvt_pk_bf16(o2, o3);
            *(u32x2*)(p.o + tokq * 1024 + 512 + h * 64 + d0) = w;
        }
    }
}

__device__ void na_super(char* lds, const Params& p, int layer, int su) {
    int tid_ = threadIdx.x; asm volatile("" : "+v"(tid_)); const int tid = tid_, lane = tid & 63, wid = __builtin_amdgcn_readfirstlane(tid >> 6), fr = lane & 15, fq = lane >> 4;
    const int bh = (su & 7) * 8 + (su >> 5), g = (su >> 3) & 3, b = bh >> 3, h = bh & 7;
    const float* rph = (const float*)(lds + LDS_RPB_OFF) + h * 465;
    const float c1 = 0.125f * LOG2E;
    const int rq = 8 * g + wid, rsw = min(max(rq - 4, 0), 24);
    bf16x8 qf[4][2];
    f32x4 O[4][4];
    float mrow[4], lrow[4];
#pragma unroll
    for (int n = 0; n < 4; ++n) {
#pragma unroll
        for (int t = 0; t < 2; ++t) qf[n][t] = *(const bf16x8*)(p.z + ZS_QN + ((size_t)(bh * 2048 + rq * 64 + 16 * n + fr)) * 64 + t * 32 + fq * 8);
#pragma unroll
        for (int dt = 0; dt < 4; ++dt) O[n][dt] = (f32x4){0.f, 0.f, 0.f, 0.f};
        lrow[n] = 0.f;
        {
            const u32x4 k0 = *(const u32x4*)(p.z + ZS_KN + ((size_t)(bh * 2048 + rq * 64 + 16 * n + fr)) * 64 + fq * 8);
            const u32x4 k1 = *(const u32x4*)(p.z + ZS_KN + ((size_t)(bh * 2048 + rq * 64 + 16 * n + fr)) * 64 + 32 + fq * 8);
            const u32x4 q0 = __builtin_bit_cast(u32x4, qf[n][0]), q1 = __builtin_bit_cast(u32x4, qf[n][1]);
            float d = 0.f;
#pragma unroll
            for (int w = 0; w < 4; ++w) { d += bflo(q0[w]) * bflo(k0[w]) + bfhi(q0[w]) * bfhi(k0[w]); d += bflo(q1[w]) * bflo(k1[w]) + bfhi(q1[w]) * bfhi(k1[w]); }
            d += __shfl_xor(d, 16); d += __shfl_xor(d, 32);
            mrow[n] = -d;
        }
    }
    const int klo = min(max(8 * g - 4, 0), 24);
    const int nsteps = (g == 0 || g == 3) ? 6 : 8;
    const bf16_t* Kg = p.z + ZS_KN + ((size_t)(bh * 2048 + klo * 64)) * 64 + tid * 8;
    const bf16_t* Vg = p.vT + VS_VN + ((size_t)((bh * 32 + klo) * 64)) * 64 + tid * 8;
    const int lw = (tid >> 3) * NA_P + (tid & 7) * 16;
    u32x4 rk[2], rv[2];
    rk[0] = *(const u32x4*)(Kg); rk[1] = *(const u32x4*)(Kg + 4096);
    rv[0] = *(const u32x4*)(Vg); rv[1] = *(const u32x4*)(Vg + 4096);
    __syncthreads();
    *(u32x4*)(lds + lw) = rk[0]; *(u32x4*)(lds + lw + 64 * NA_P) = rk[1];
    *(u32x4*)(lds + NA_KBYTES + lw) = rv[0]; *(u32x4*)(lds + NA_KBYTES + lw + 64 * NA_P) = rv[1];
    __syncthreads();
    const int krow_off = (8 * (fr >> 2) + (fr & 3)) * NA_P + fq * 16;
    const int vrow_off = fr * NA_P + (8 * fq) * 2;
    for (int st = 0; st < nsteps; ++st) {
        const char* cur = lds + (st & 1) * NA_STAGE;
        char* nxt = lds + ((st + 1) & 1) * NA_STAGE;
        if (st + 1 < nsteps) {
            const bf16_t* kg = Kg + (size_t)(st + 1) * 8192; const bf16_t* vg = Vg + (size_t)(st + 1) * 8192;
            rk[0] = *(const u32x4*)(kg); rk[1] = *(const u32x4*)(kg + 4096);
            rv[0] = *(const u32x4*)(vg); rv[1] = *(const u32x4*)(vg + 4096);
        }
#pragma unroll 1
        for (int slot = 0; slot < 2; ++slot) {
            const int kr = klo + 2 * st + slot;
            if (kr >= rsw && kr <= rsw + 7) {
                const char* cK = cur + slot * 64 * NA_P + krow_off;
                const char* cV = cur + NA_KBYTES + slot * 64 * NA_P + vrow_off;
                const float* rpr = rph + (kr - rq + 7) * 31;
                float v[4][8];
#pragma unroll
                for (int n = 0; n < 4; ++n) {
                    const int kcstart = n == 0 ? 0 : (n == 1 ? 8 : (n == 2 ? 24 : 32));
                    const int qcol = 16 * n + fr;
#pragma unroll
                    for (int e = 0; e < 8; ++e) v[n][e] = rpr[min(max(kcstart + 8 * fq + e - qcol, -15), 15) + 15];
                }
#pragma unroll
                for (int n = 0; n < 4; ++n)
#pragma unroll
                    for (int e = 0; e < 8; ++e) asm volatile("" : "+v"(v[n][e]));
#pragma unroll
                for (int np = 0; np < 2; ++np) {
                    bf16x8 kfr[2][4];
#pragma unroll
                    for (int q = 0; q < 2; ++q) {
                        const int n = 2 * np + q;
                        const int kcstart = n == 0 ? 0 : (n == 1 ? 8 : (n == 2 ? 24 : 32));
#pragma unroll
                        for (int T = 0; T < 2; ++T) { kfr[q][2 * T] = *(const bf16x8*)(cK + (kcstart + T * 4) * NA_P); kfr[q][2 * T + 1] = *(const bf16x8*)(cK + (kcstart + T * 4) * NA_P + 64); }
                    }
#pragma unroll
                    for (int q = 0; q < 2; ++q) {
                        const int n = 2 * np + q;
                        const int kcstart = n == 0 ? 0 : (n == 1 ? 8 : (n == 2 ? 24 : 32));
                        const int qcol = 16 * n + fr;
                        const int qcstart = min(max(qcol - 8, 0), 48);
#pragma unroll
                        for (int T = 0; T < 2; ++T) {
                            f32x4 s = (f32x4){mrow[n], mrow[n], mrow[n], mrow[n]};
                            s = __builtin_amdgcn_mfma_f32_16x16x32_bf16(kfr[q][2 * T], qf[n][0], s, 0, 0, 0);
                            s = __builtin_amdgcn_mfma_f32_16x16x32_bf16(kfr[q][2 * T + 1], qf[n][1], s, 0, 0, 0);
#pragma unroll
                            for (int e = 0; e < 4; ++e) {
                                const int kcol = kcstart + 8 * fq + e + 4 * T;
                                const bool valid = (kcol >= qcstart) && (kcol < qcstart + 16);
                                v[n][4 * T + e] = valid ? fmaf(s[e], c1, v[n][4 * T + e]) : -1e30f;
                            }
                        }
                    }
                }
#pragma unroll
                for (int n = 0; n < 4; ++n) {
                    const int kcstart = n == 0 ? 0 : (n == 1 ? 8 : (n == 2 ? 24 : 32));
                    float ps = 0.f;
#pragma unroll
                    for (int e = 0; e < 8; ++e) { v[n][e] = fast_exp2(v[n][e]); ps += v[n][e]; }
                    lrow[n] += ps;
                    u32x4 w;
                    w.x = cvt_pk_bf16(v[n][0], v[n][1]); w.y = cvt_pk_bf16(v[n][2], v[n][3]); w.z = cvt_pk_bf16(v[n][4], v[n][5]); w.w = cvt_pk_bf16(v[n][6], v[n][7]);
                    const bf16x8 pb = __builtin_bit_cast(bf16x8, w);
#pragma unroll
                    for (int dt = 0; dt < 4; ++dt) {
                        const bf16x8 vf = *(const bf16x8*)(cV + dt * 16 * NA_P + kcstart * 2);
                        O[n][dt] = __builtin_amdgcn_mfma_f32_16x16x32_bf16(vf, pb, O[n][dt], 0, 0, 0);
                    }
                }
            }
        }
        if (st + 1 < nsteps) {
            *(u32x4*)(nxt + lw) = rk[0]; *(u32x4*)(nxt + lw + 64 * NA_P) = rk[1];
            *(u32x4*)(nxt + NA_KBYTES + lw) = rv[0]; *(u32x4*)(nxt + NA_KBYTES + lw + 64 * NA_P) = rv[1];
        }
        __syncthreads();
    }
    int bad = 0;
#pragma unroll
    for (int n = 0; n < 4; ++n) { lrow[n] += __shfl_xor(lrow[n], 16); lrow[n] += __shfl_xor(lrow[n], 32); bad |= !(lrow[n] < 1e30f); }
    {
        volatile unsigned* bflag = (volatile unsigned*)(lds + LDS_PHASE_BYTES + 8);
        if (tid == 0) *bflag = 0u;
        __syncthreads();
        if (__any(bad) && lane == 0) *bflag = 1u;
        __syncthreads();
        if (*bflag != 0u) { if (tid == 0) *(volatile unsigned*)(lds + LDS_PHASE_BYTES + 12) = 1u; return; }
    }
    u32x2 gwv[4][4];
#pragma unroll
    for (int n = 0; n < 4; ++n)
#pragma unroll
        for (int dt = 0; dt < 4; ++dt) gwv[n][dt] = *(const u32x2*)(p.z + ZS_GATE + ((size_t)b * SEQ + rq * 64 + 16 * n + fr) * 1024 + 512 + h * 64 + 16 * dt + 4 * fq);
    __builtin_amdgcn_sched_barrier(0);
#pragma unroll
    for (int n = 0; n < 4; ++n) {
        const float l = lrow[n];
        const float il = 1.0f / l;
        const size_t tokq = (size_t)b * SEQ + rq * 64 + 16 * n + fr;
#pragma unroll
        for (int dt = 0; dt < 4; ++dt) {
            const int d0 = 16 * dt + 4 * fq;
            const u32x2 gw = gwv[n][dt];
            const float o0 = O[n][dt][0] * il * silu_f(bflo(gw.x)), o1 = O[n][dt][1] * il * silu_f(bfhi(gw.x));
            const float o2 = O[n][dt][2] * il * silu_f(bflo(gw.y)), o3 = O[n][dt][3] * il * silu_f(bfhi(gw.y));
            u32x2 w; w.x = cvt_pk_bf16(o0, o1); w.y = cvt_pk_bf16(o2, o3);
            *(u32x2*)(p.o + tokq * 1024 + 512 + h * 64 + d0) = w;
        }
    }
}

__global__ void __launch_bounds__(NTHREADS) fwd_megakernel(Params p) {
    extern __shared__ __attribute__((aligned(16))) char lds[];
    if (p.never) cg::this_grid().sync();
    volatile LAS unsigned* st = (volatile LAS unsigned*)(lds + LDS_PHASE_BYTES);
    if (threadIdx.x < 4) st[threadIdx.x] = 0u;
    __syncthreads();
    const XcdBarrier gb = xcd_barrier_post(p.bar, st);
    prologue_phase(lds, p);
    xcd_barrier(gb);
    for (int layer = 0; layer < DEPTH; ++layer) {
        for (int rep = 0; rep < REP_GEMM0; ++rep) {
        { pg8::Gemm g{p.xb, p.wi_t + (size_t)layer * 4096 * 1024, NTOK, IN_W, 1024}; pg8::StaticOrder S; S.init(NTOK, IN_W, (int)gridDim.x, (int)blockIdx.x);
          pg8::EpiZ E{p.z, p.vT, p.rss};
          pg8::gemm_phase<pg8::EpiZ, pg8::StaticOrder, true, true>((PG8_LAS unsigned char*)lds, g, S, E); }
        xcd_barrier(gb);
        }
        { int t0_ = threadIdx.x; asm volatile("" : "+v"(t0_));
          for (int i = t0_; i < 8 * 465; i += NTHREADS) ((float*)(lds + LDS_RPB_OFF))[i] = p.rpb[(size_t)layer * 8 * 465 + i] * LOG2E;
          if (t0_ == 0) *(volatile unsigned*)(lds + LDS_PHASE_BYTES + 12) = 0u; }
        __syncthreads();
        for (int rep = 0; rep < REP_ATT; ++rep) {
        for (int u = blockIdx.x; u < 512 + 256; u += gridDim.x) {
            if (u < 512) { if (rep < REP_DA) da_unit(lds, p, layer, u); } else { if (rep < REP_NA) na_super(lds, p, layer, u - 512); }
        }
        __syncthreads();
        if (*(volatile unsigned*)(lds + LDS_PHASE_BYTES + 12) != 0u) {
            for (int u = blockIdx.x; u < 512 + 256; u += gridDim.x) if (u >= 512) na_super_online(lds, p, layer, u - 512);
        }
        xcd_barrier(gb);
        }
        { pg8::Gemm g{p.o, p.wo_t + (size_t)layer * 1024 * 1024, NTOK, 1024, 1024}; pg8::StaticOrder S; S.init(NTOK, 1024, (int)gridDim.x, (int)blockIdx.x);
          if (layer + 1 < DEPTH) { pg8::EpiRes<true> E{layer == 0 ? p.x : p.xf, p.xf, p.xb, p.rss};
            pg8::gemm_phase<pg8::EpiRes<true>, pg8::StaticOrder, true, true>((PG8_LAS unsigned char*)lds, g, S, E); }
          else if (gridDim.x == 256) { pg8::EpiFinal E{p.xf, p.xf, p.final_g, p.rss, p.bar + XCD_BAR_WORDS};
            pg8::gemm_phase<pg8::EpiFinal, pg8::StaticOrder, false, true>((PG8_LAS unsigned char*)lds, g, S, E); return; }
          else { pg8::EpiRes<false> E{p.xf, p.xf, p.xb, p.rss};
            pg8::gemm_phase<pg8::EpiRes<false>, pg8::StaticOrder, true, true>((PG8_LAS unsigned char*)lds, g, S, E); } }
        xcd_barrier(gb);
    }
    final_phase(p);
}

constexpr size_t LDS_BYTES = LDS_RPB_OFF + LDS_RPB_BYTES;

extern "C" void kernel_launch(void* const* d_in, const int* in_sizes, int n_in, void* d_out, int out_size, void* d_ws, size_t ws_size, hipStream_t stream) {
    static int grid_blocks = 0;
    if (!grid_blocks) {
        int dev = 0, cus = 0, per_cu = 0;
        hipGetDevice(&dev);
        hipDeviceGetAttribute(&cus, hipDeviceAttributeMultiprocessorCount, dev);
        hipFuncSetAttribute((const void*)fwd_megakernel, hipFuncAttributeMaxDynamicSharedMemorySize, (int)LDS_BYTES);
        hipOccupancyMaxActiveBlocksPerMultiprocessor(&per_cu, fwd_megakernel, NTHREADS, LDS_BYTES);
        if (per_cu < 1) per_cu = 1;
        if (per_cu > 1) per_cu = 1;
        grid_blocks = cus * per_cu;
    }
    Params p{};
    p.x = (const float*)d_in[0]; p.norm_g = (const float*)d_in[1]; p.w_in = (const float*)d_in[2]; p.w_out = (const float*)d_in[3];
    p.lq1 = (const float*)d_in[4]; p.lk1 = (const float*)d_in[5]; p.lq2 = (const float*)d_in[6]; p.lk2 = (const float*)d_in[7];
    p.subln_g = (const float*)d_in[8]; p.rpb = (const float*)d_in[9]; p.final_g = (const float*)d_in[10];
    p.xf = (float*)d_out;
    char* w = (char*)d_ws; size_t off = 0;
    auto take = [&](size_t bytes) { char* r = w + off; off += (bytes + 255) & ~(size_t)255; return r; };
    p.wi_t = (bf16_t*)take((size_t)DEPTH * 4096 * 1024 * 2);
    p.wo_t = (bf16_t*)take((size_t)DEPTH * 1024 * 1024 * 2);
    p.xb = (bf16_t*)take((size_t)NTOK * 1024 * 2);
    p.rss = (float*)take((size_t)NTOK * 16 * 4);
    p.z = (bf16_t*)take((size_t)NTOK * ZP * 2);
    p.vT = (bf16_t*)take((size_t)BATCH * 1024 * SEQ * 2);
    p.o = (bf16_t*)take((size_t)NTOK * 1024 * 2);
    p.bar = (unsigned*)take((size_t)(XCD_BAR_WORDS + 64 * 64) * 4);
    (void)hipMemsetAsync(p.bar, 0, (size_t)(XCD_BAR_WORDS + 64 * 64) * 4, stream);
    for (int l = 0; l < DEPTH; ++l) p.lam_init[l] = (float)(0.8 - 0.6 * exp(-0.3 * (double)l));
    void* args[] = {&p};
    hipError_t e = hipLaunchCooperativeKernel((const void*)fwd_megakernel, dim3(grid_blocks), dim3(NTHREADS), args, LDS_BYTES, stream);
    if (e != hipSuccess) fprintf(stderr, "cooperative launch failed: %s (grid %d)\n", hipGetErrorString(e), grid_blocks);
}
```

```cpp
#include <hip/hip_runtime.h>
#include <hip/hip_cooperative_groups.h>
#include <cstdio>
#include <cstdint>
namespace cg = cooperative_groups;

typedef unsigned short bf16_t;
typedef short bf16x8 __attribute__((ext_vector_type(8)));
typedef float f32x4 __attribute__((ext_vector_type(4)));
typedef float f32x16 __attribute__((ext_vector_type(16)));
typedef unsigned u32x4 __attribute__((ext_vector_type(4)));
typedef unsigned u32x2 __attribute__((ext_vector_type(2)));

constexpr int D_MODEL = 1024, BATCH = 8, SEQ = 2048, DEPTH = 4, NTOK = BATCH * SEQ;
constexpr int IN_W = 4096;
constexpr size_t ZS_QD = 0, ZS_KD = (size_t)NTOK * 512, ZS_QN = (size_t)NTOK * 1024, ZS_KN = (size_t)NTOK * 1536, ZS_GATE = (size_t)NTOK * 2048;
constexpr size_t VS_VD = 0, VS_VN = (size_t)NTOK * 512;
constexpr int ZP = 3072;
constexpr float RMS_EPS = 1e-6f;
constexpr float LOG2E = 1.4426950408889634f;
constexpr int NTHREADS = 512;
#ifndef REP_GEMM0
#define REP_GEMM0 1
#endif
#ifndef REP_DA
#define REP_DA 1
#endif
#ifndef REP_NA
#define REP_NA 1
#endif
#define REP_ATT (REP_DA > REP_NA ? REP_DA : REP_NA)

struct Params {
    const float* x; const float* norm_g; const float* w_in; const float* w_out;
    const float* lq1; const float* lk1; const float* lq2; const float* lk2;
    const float* subln_g; const float* rpb; const float* final_g;
    float* xf;
    bf16_t* wi_t;
    bf16_t* wo_t;
    bf16_t* xb;
    float* rss;
    bf16_t* z;
    bf16_t* vT;
    bf16_t* o;
    unsigned* bar;
    float lam_init[DEPTH];
    int never;
    int pad_;
};

typedef __bf16 bf16x2_t __attribute__((ext_vector_type(2)));
typedef float f32x2_t __attribute__((ext_vector_type(2)));
__device__ __forceinline__ unsigned cvt_pk_bf16(float lo, float hi) {
    const f32x2_t v = {lo, hi};
    return __builtin_bit_cast(unsigned, __builtin_convertvector(v, bf16x2_t));
}
__device__ __forceinline__ float bf2f(unsigned short b) { return __uint_as_float(((unsigned)b) << 16); }
__device__ __forceinline__ float bflo(unsigned w) { return __uint_as_float(w << 16); }
__device__ __forceinline__ float bfhi(unsigned w) { return __uint_as_float(w & 0xffff0000u); }
__device__ __forceinline__ float fast_exp2(float x) { return __builtin_amdgcn_exp2f(x); }


#define XB_TMO      128
#define XB_XCNT(j)  (256  + 64 * (j))
#define XB_XSUB(j)  (1280 + 64 * (j))
#define XB_XGEN(j)  (2304 + 64 * (j))
#define XB_TOP      3328
#define XB_TOPGEN   3392
#define XCD_BAR_WORDS 3456
#define XB_SPIN_CAP (1u << 20)
#define LAS __attribute__((address_space(3)))
__device__ __forceinline__ unsigned xb_ld(unsigned* p)              { return __hip_atomic_load(p, __ATOMIC_RELAXED, __HIP_MEMORY_SCOPE_AGENT); }
__device__ __forceinline__ unsigned xb_add(unsigned* p, unsigned v) { return __hip_atomic_fetch_add(p, v, __ATOMIC_RELAXED, __HIP_MEMORY_SCOPE_AGENT); }
__device__ __forceinline__ unsigned xb_xcc_id() { return (unsigned)__builtin_amdgcn_s_getreg((3 << 11) | 20) & 0xFu; }
#define XB_SPIN(cond, bar) do { unsigned _sp = 0; while (cond) { __builtin_amdgcn_s_sleep(1); \
    if ((++_sp & 255u) == 0u) { if (xb_ld(&(bar)[XB_TMO])) break; if (_sp > XB_SPIN_CAP) { atomicAdd(&(bar)[XB_TMO], 1u); break; } } } } while (0)
struct XcdBarrier { unsigned* bar; unsigned x; volatile LAS unsigned* st; };
__device__ __forceinline__ XcdBarrier xcd_barrier_post(unsigned* bar, volatile LAS unsigned* st) {
    XcdBarrier b; b.bar = bar; b.x = xb_xcc_id(); b.st = st;
    if (threadIdx.x == 0) (void)xb_add(&bar[XB_XCNT(b.x)], 1u);
    return b;
}
__device__ __forceinline__ void xcd_barrier_complete(unsigned* bar, unsigned x, unsigned& nloc, unsigned& nx) {
    const unsigned G = gridDim.x * gridDim.y * gridDim.z;
    unsigned sum, cnt, mine, sp = 0u;
    for (;;) {
        sum = 0u; cnt = 0u; mine = 0u;
#pragma unroll
        for (unsigned j = 0; j < 16; ++j) { const unsigned c = xb_ld(&bar[XB_XCNT(j)]); sum += c; cnt += (c > 0u) ? 1u : 0u; mine = (j == x) ? c : mine; }
        if (sum == G) break;
        __builtin_amdgcn_s_sleep(1);
        if ((++sp & 255u) == 0u) { if (xb_ld(&bar[XB_TMO])) break; if (sp > XB_SPIN_CAP) { atomicAdd(&bar[XB_TMO], 1u); break; } }
    }
    nloc = mine > 0u ? mine : 1u; nx = cnt > 0u ? cnt : 1u;
}
__device__ __forceinline__ void xcd_barrier(const XcdBarrier& b) {
    asm volatile("s_waitcnt vmcnt(0)" ::: "memory");
    __syncthreads();
    if (threadIdx.x == 0) {
        unsigned* bar = b.bar;
        unsigned bx = b.x; asm volatile("" : "+s"(bx));
        __builtin_amdgcn_s_waitcnt(0);
        unsigned nloc = b.st[0], nx = b.st[1];
        if (nloc == 0u) { xcd_barrier_complete(bar, bx, nloc, nx); b.st[0] = nloc; b.st[1] = nx; }
        const unsigned old = xb_add(&bar[XB_XSUB(bx)], 1u);
        const unsigned gen = old / nloc;
        if (old + 1u == (gen + 1u) * nloc) {
            __builtin_amdgcn_fence(__ATOMIC_RELEASE, "agent");
            asm volatile("s_waitcnt vmcnt(0)" ::: "memory");
            const unsigned og = xb_add(&bar[XB_TOP], 1u);
            const unsigned tg = og / nx;
            if (og + 1u == (tg + 1u) * nx) xb_add(&bar[XB_TOPGEN], 1u);
            else XB_SPIN(xb_ld(&bar[XB_TOPGEN]) == tg, bar);
            __builtin_amdgcn_fence(__ATOMIC_ACQUIRE, "agent");
            xb_add(&bar[XB_XGEN(bx)], 1u);
            asm volatile("s_waitcnt vmcnt(0)" ::: "memory");
        } else {
            XB_SPIN(xb_ld(&bar[XB_XGEN(bx)]) == gen, bar);
            __builtin_amdgcn_fence(__ATOMIC_ACQUIRE, "agent");
            asm volatile("s_waitcnt vmcnt(0)" ::: "memory");
        }
    }
    __syncthreads();
}

__device__ __forceinline__ int perm_col(int n) {
    if (n < 1024) return n;
    if (n < 2048) return n + 512;
    if (n < 3072) return n + 1024;
    if (n < 3584) return n - 2048;
    return n - 1024;
}

__device__ void prologue_phase(char* lds, const Params& p) {
    int tid_ = threadIdx.x; asm volatile("" : "+v"(tid_)); const int tid = tid_, lane = tid & 63, wid = tid >> 6;
    float* tile = (float*)lds;
    const int nt_in = DEPTH * 16 * 64, nt_out = DEPTH * 16 * 16;
    for (int t = blockIdx.x; t < nt_in + nt_out; t += gridDim.x) {
        const float* W; bf16_t* Wt; const float* g; int N, k0, n0, no0;
        if (t < nt_in) {
            const int l = t >> 10, rem = t & 1023; k0 = (rem >> 6) * 64; n0 = (rem & 63) * 64;
            W = p.w_in + (size_t)l * 1024 * 4096; N = 4096; Wt = p.wi_t + (size_t)l * 4096 * 1024; g = p.norm_g + l * 1024; no0 = perm_col(n0);
        } else {
            const int t2 = t - nt_in; const int l = t2 >> 8, rem = t2 & 255; k0 = (rem >> 4) * 64; n0 = (rem & 15) * 64;
            W = p.w_out + (size_t)l * 1024 * 1024; N = 1024; Wt = p.wo_t + (size_t)l * 1024 * 1024; g = nullptr; no0 = n0;
        }
        {
            const int i = tid >> 4, j4 = tid & 15;
#pragma unroll
            for (int ps = 0; ps < 2; ++ps) {
                const int kk = i + 32 * ps;
                const f32x4 v = *(const f32x4*)(W + (size_t)(k0 + kk) * N + no0 + 4 * j4);
                const float gg = g ? g[k0 + kk] : 1.0f;
                tile[kk * 65 + 4 * j4 + 0] = v[0] * gg; tile[kk * 65 + 4 * j4 + 1] = v[1] * gg;
                tile[kk * 65 + 4 * j4 + 2] = v[2] * gg; tile[kk * 65 + 4 * j4 + 3] = v[3] * gg;
            }
        }
        __syncthreads();
        {
            const int j = tid >> 3, i8 = tid & 7;
            float v[8];
#pragma unroll
            for (int e = 0; e < 8; ++e) v[e] = tile[(8 * i8 + e) * 65 + j];
            u32x4 w; w.x = cvt_pk_bf16(v[0], v[1]); w.y = cvt_pk_bf16(v[2], v[3]); w.z = cvt_pk_bf16(v[4], v[5]); w.w = cvt_pk_bf16(v[6], v[7]);
            *(u32x4*)(Wt + (size_t)(n0 + j) * 1024 + k0 + 8 * i8) = w;
        }
        __syncthreads();
    }
    for (int row = blockIdx.x * 8 + wid; row < NTOK; row += gridDim.x * 8) {
        float ss = 0.f;
#pragma unroll
        for (int i = 0; i < 4; ++i) {
            const int c = 4 * lane + 256 * i;
            const f32x4 v = *(const f32x4*)(p.x + (size_t)row * 1024 + c);
            ss += v[0] * v[0] + v[1] * v[1] + v[2] * v[2] + v[3] * v[3];
            u32x2 w; w.x = cvt_pk_bf16(v[0], v[1]); w.y = cvt_pk_bf16(v[2], v[3]);
            *(u32x2*)(p.xb + (size_t)row * 1024 + c) = w;
        }
#pragma unroll
        for (int s = 32; s >= 1; s >>= 1) ss += __shfl_xor(ss, s);
        if (lane < 16) p.rss[(size_t)row * 16 + lane] = lane == 0 ? ss : 0.f;
    }
}

__device__ void final_phase(const Params& p) {
    int tid_ = threadIdx.x; asm volatile("" : "+v"(tid_)); const int tid = tid_, lane = tid & 63, wid = tid >> 6;
    for (int row = blockIdx.x * 8 + wid; row < NTOK; row += gridDim.x * 8) {
        float ss = 0.f;
        if (lane < 16) ss = p.rss[(size_t)row * 16 + lane];
#pragma unroll
        for (int s = 8; s >= 1; s >>= 1) ss += __shfl_xor(ss, s);
        ss = __shfl(ss, 0);
        const float rstd = rsqrtf(ss * (1.0f / 1024.0f) + RMS_EPS);
#pragma unroll
        for (int i = 0; i < 4; ++i) {
            const int c = 4 * lane + 256 * i;
            f32x4 v = *(const f32x4*)(p.xf + (size_t)row * 1024 + c);
            const f32x4 g = *(const f32x4*)(p.final_g + c);
            v = v * rstd * g;
            *(f32x4*)(p.xf + (size_t)row * 1024 + c) = v;
        }
    }
}

namespace pg8 {
#define PG8_LAS __attribute__((address_space(3)))
typedef unsigned short bf16_t;
typedef short bf16x8 __attribute__((ext_vector_type(8)));
typedef float f32x4 __attribute__((ext_vector_type(4)));
typedef unsigned u32x4 __attribute__((ext_vector_type(4)));
constexpr int BM = 256, BK = 64, HALF = 128, HTB = HALF * BK * 2  , STAGE_BYTES = 8 * HTB, NXCD = 8, WGM = 8;

__host__ __device__ __forceinline__ int lds_byte(int r, int c) { const int st = (r >> 4) * 2 + (c >> 5), rr = r & 15, cc = c & 31, ob = rr * 64 + cc * 2; return st * 1024 + (ob ^ (((ob >> 9) & 1) << 5)); }
__host__ __device__ __forceinline__ void stage_rc(int b, int& R, int& C) { const int st = b / 1024, sb = b % 1024, swz = sb ^ (((sb >> 9) & 1) << 5); R = (st >> 1) * 16 + swz / 64; C = (st & 1) * 32 + (swz % 64) / 2; }
__host__ __device__ __forceinline__ int perm32(int rho) { const int n = rho >> 4, i = rho & 15; return 8 * (i >> 2) + 4 * n + (i & 3); }

struct Unit { int pm, pn; };
struct Gemm { const bf16_t* A; const bf16_t* Bt; int M, N, K; };

struct StaticOrder {
    int nM, nN, nwg, G, c;
    __host__ __device__ void init(int M, int N, int G_, int c_) { nM = M / BM; nN = N / BM; nwg = nM * nN; G = G_; c = c_; }
    __host__ __device__ bool next(int i, Unit& u) const {
        const long L = (long)i * G + c; if (L >= nwg) return false;
        int wgid = (int)L; { const int q = nwg / NXCD, r = nwg % NXCD, xcd = wgid % NXCD, off = wgid / NXCD; wgid = (xcd < r ? xcd * (q + 1) : r * (q + 1) + (xcd - r) * q) + off; }
        const int nig = WGM * nN, gid = wgid / nig, fm = gid * WGM, gsz = (nM - fm) < WGM ? (nM - fm) : WGM;
        u.pm = fm + ((wgid % nig) % gsz); u.pn = (wgid % nig) / gsz; return true;
    }
    __device__ __forceinline__ void a_ready(const Unit&) const {}
    __device__ __forceinline__ void done(const Unit&) const {}
};


template <class Epi, class Sched, bool ALIGN_EPI = false, bool SP2 = false>
__device__ __forceinline__ void gemm_phase(PG8_LAS unsigned char* lds, const Gemm g, const Sched& S, const Epi& E) {
    int tid_ = threadIdx.x; asm volatile("" : "+v"(tid_));
    const int tid = tid_, wid = __builtin_amdgcn_readfirstlane(tid >> 6), lane = tid & 63, wr = wid >> 2, wc = wid & 3, fr = lane & 15, fq = lane >> 4;
    const int K = g.K, nt = K / BK;
    unsigned voffA[2], voffB[2];
#pragma unroll
    for (int i = 0; i < 2; ++i) { int R, C; stage_rc(tid * 16 + i * 8192, R, C); const int Rb = Epi::PERM ? ((R & ~31) + perm32(R & 31)) : R;
        voffA[i] = (unsigned)(R * K + C) * 2u; voffB[i] = (unsigned)(Rb * K + C) * 2u; }
    const size_t kstep = (size_t)(BK * 2);
    const size_t hstep = (size_t)HALF * K * 2;
    const size_t tstep = 2 * hstep;
    const unsigned ldsw = (unsigned)wid * 1024u;
    const int aoff = lds_byte(wr * 64 + fr, fq * 8), boff = lds_byte(wc * 32 + fr, fq * 8);
#define PG8_SA(b, h) (((b) * 2 + (h)) * HTB)
#define PG8_SB(b, h) ((4 + (b) * 2 + (h)) * HTB)
#define PG8_STAGE(bufoff, gbase, voff) do { _Pragma("unroll") for (int _i = 0; _i < 2; ++_i) \
        __builtin_amdgcn_global_load_lds((const unsigned*)((const char*)(gbase) + (voff)[_i]), (PG8_LAS unsigned*)(lds + (bufoff) + ldsw + _i * 8192), 16, 0, 0); } while (0)
#define PG8_LDA(dst, b, h) do { _Pragma("unroll") for (int m = 0; m < 4; ++m) _Pragma("unroll") for (int k = 0; k < 2; ++k) dst[m][k] = *(const PG8_LAS bf16x8*)(lds + PG8_SA(b, h) + aoff + m * 2048 + k * 1024); } while (0)
#define PG8_LDB(dst, b, h) do { _Pragma("unroll") for (int n = 0; n < 2; ++n) _Pragma("unroll") for (int k = 0; k < 2; ++k) dst[n][k] = *(const PG8_LAS bf16x8*)(lds + PG8_SB(b, h) + boff + n * 2048 + k * 1024); } while (0)
#define PG8_MMA(ai, bj, At, Bt) do { __builtin_amdgcn_s_setprio(1); _Pragma("unroll") for (int m = 0; m < 4; ++m) _Pragma("unroll") for (int n = 0; n < 2; ++n) _Pragma("unroll") for (int k = 0; k < 2; ++k) \
        acc[ai][bj][m][n] = __builtin_amdgcn_mfma_f32_16x16x32_bf16(Bt[n][k], At[m][k], acc[ai][bj][m][n], 0, 0, 0); __builtin_amdgcn_s_setprio(0); } while (0)
#define PG8_WAIT_V(n) asm volatile("s_waitcnt vmcnt(" #n ")" ::: "memory")
#define PG8_WAIT_L(n) asm volatile("s_waitcnt lgkmcnt(" #n ")" ::: "memory")
#define PG8_BAR __builtin_amdgcn_s_barrier()
#define PG8_SCHED __builtin_amdgcn_sched_barrier(0)
    Unit cur, nxt; int ui = 0;
    if (!S.next(0, cur)) return;
    f32x4 acc[2][2][4][2];
#pragma unroll
    for (int a = 0; a < 2; ++a)
#pragma unroll
        for (int b = 0; b < 2; ++b)
#pragma unroll
            for (int m = 0; m < 4; ++m)
#pragma unroll
                for (int n = 0; n < 2; ++n) acc[a][b][m][n] = (f32x4){0.f, 0.f, 0.f, 0.f};
    bf16x8 At[4][2], B0[2][2], B1[2][2];
    const char* cA = (const char*)g.A + (size_t)cur.pm * tstep; const char* cB = (const char*)g.Bt + (size_t)cur.pn * tstep;
    S.a_ready(cur);
    if constexpr (SP2) {
        PG8_STAGE(PG8_SB(0, 0), cB, voffB); PG8_STAGE(PG8_SB(0, 1), cB + hstep, voffB); PG8_STAGE(PG8_SA(0, 0), cA, voffA); PG8_STAGE(PG8_SA(0, 1), cA + hstep, voffA);
        if (wr == 1) PG8_BAR;
        PG8_WAIT_V(2); PG8_BAR;
        PG8_STAGE(PG8_SB(1, 0), cB + kstep, voffB); PG8_STAGE(PG8_SA(1, 0), cA + kstep, voffA); PG8_STAGE(PG8_SB(1, 1), cB + hstep + kstep, voffB);
        PG8_WAIT_V(6); PG8_BAR;
    } else {
        PG8_STAGE(PG8_SB(0, 0), cB, voffB); PG8_STAGE(PG8_SA(0, 0), cA, voffA); PG8_STAGE(PG8_SB(0, 1), cB + hstep, voffB); PG8_STAGE(PG8_SA(0, 1), cA + hstep, voffA);
        if (wr == 1) PG8_BAR;
        PG8_WAIT_V(4); PG8_BAR;
        PG8_STAGE(PG8_SB(1, 0), cB + kstep, voffB); PG8_STAGE(PG8_SA(1, 0), cA + kstep, voffA); PG8_STAGE(PG8_SB(1, 1), cB + hstep + kstep, voffB);
        PG8_WAIT_V(6); PG8_BAR;
    }
    for (;;) {
        const bool has_next = S.next(ui + 1, nxt);
        const char* nA = has_next ? (const char*)g.A + (size_t)nxt.pm * tstep : cA; const char* nB = has_next ? (const char*)g.Bt + (size_t)nxt.pn * tstep : cB;
        for (int t = 0; t < nt; t += 2) {
            const bool last = (t == nt - 2);
            const char* a1 = cA + (size_t)(t + 1) * kstep;
            const char* a2 = last ? nA : cA + (size_t)(t + 2) * kstep; const char* b2 = last ? nB : cB + (size_t)(t + 2) * kstep;
            const char* a3 = a2 + kstep; const char* b3 = b2 + kstep;
            if (last && has_next) S.a_ready(nxt);
            if constexpr (SP2) {
            PG8_LDB(B0, 0, 0); PG8_LDB(B1, 0, 1); PG8_SCHED; PG8_LDA(At, 0, 0); PG8_STAGE(PG8_SA(1, 1), a1 + hstep, voffA);
            PG8_WAIT_V(8); PG8_WAIT_L(0); PG8_BAR; PG8_MMA(0, 0, At, B0); PG8_MMA(0, 1, At, B1); PG8_BAR; PG8_SCHED;
            PG8_LDA(At, 0, 1); PG8_STAGE(PG8_SB(0, 0), b2, voffB); PG8_STAGE(PG8_SB(0, 1), b2 + hstep, voffB); PG8_STAGE(PG8_SA(0, 0), a2, voffA);
            PG8_WAIT_V(8); PG8_WAIT_L(0); PG8_BAR; PG8_MMA(1, 0, At, B0); PG8_MMA(1, 1, At, B1); PG8_BAR; PG8_SCHED;
            PG8_LDB(B0, 1, 0); PG8_LDB(B1, 1, 1); PG8_SCHED; PG8_LDA(At, 1, 0); PG8_STAGE(PG8_SA(0, 1), a2 + hstep, voffA);
            PG8_WAIT_V(8); PG8_WAIT_L(0); PG8_BAR; PG8_MMA(0, 0, At, B0); PG8_MMA(0, 1, At, B1); PG8_BAR; PG8_SCHED;
            PG8_LDA(At, 1, 1); PG8_STAGE(PG8_SB(1, 0), b3, voffB); PG8_STAGE(PG8_SB(1, 1), b3 + hstep, voffB); PG8_STAGE(PG8_SA(1, 0), a3, voffA);
            PG8_WAIT_V(8); PG8_WAIT_L(0); PG8_BAR; PG8_MMA(1, 0, At, B0); PG8_MMA(1, 1, At, B1); PG8_BAR; PG8_SCHED;
            } else {
            PG8_LDB(B0, 0, 0); PG8_SCHED; PG8_LDA(At, 0, 0); PG8_STAGE(PG8_SA(1, 1), a1 + hstep, voffA);
            PG8_WAIT_L(8); PG8_BAR; PG8_WAIT_L(0); PG8_MMA(0, 0, At, B0); PG8_BAR; PG8_SCHED;
            PG8_LDB(B1, 0, 1); PG8_STAGE(PG8_SB(0, 0), b2, voffB);
            PG8_BAR; PG8_WAIT_L(0); PG8_MMA(0, 1, At, B1); PG8_BAR;
            PG8_LDA(At, 0, 1); PG8_STAGE(PG8_SA(0, 0), a2, voffA);
            PG8_BAR; PG8_WAIT_L(0); PG8_MMA(1, 0, At, B0); PG8_BAR; PG8_SCHED;
            PG8_STAGE(PG8_SB(0, 1), b2 + hstep, voffB);
            PG8_WAIT_V(6); PG8_BAR; PG8_MMA(1, 1, At, B1); PG8_BAR;
            PG8_LDB(B0, 1, 0); PG8_SCHED; PG8_LDA(At, 1, 0); PG8_STAGE(PG8_SA(0, 1), a2 + hstep, voffA);
            PG8_WAIT_L(8); PG8_BAR; PG8_WAIT_L(0); PG8_MMA(0, 0, At, B0); PG8_BAR; PG8_SCHED;
            PG8_LDB(B1, 1, 1); PG8_STAGE(PG8_SB(1, 0), b3, voffB);
            PG8_BAR; PG8_WAIT_L(0); PG8_MMA(0, 1, At, B1); PG8_BAR;
            PG8_LDA(At, 1, 1); PG8_STAGE(PG8_SA(1, 0), a3, voffA);
            PG8_BAR; PG8_WAIT_L(0); PG8_MMA(1, 0, At, B0); PG8_BAR; PG8_SCHED;
            PG8_STAGE(PG8_SB(1, 1), b3 + hstep, voffB);
            PG8_WAIT_V(6); PG8_BAR; PG8_MMA(1, 1, At, B1); PG8_BAR;
            }
        }
        if constexpr (ALIGN_EPI) { if (wr == 0) PG8_BAR; }
        if constexpr (!Epi::AFTER_DRAIN) { E(acc, cur, wr, wc, fr, fq); S.done(cur); }
        if (!has_next) break;
#pragma unroll
        for (int a = 0; a < 2; ++a)
#pragma unroll
            for (int b = 0; b < 2; ++b)
#pragma unroll
                for (int m = 0; m < 4; ++m)
#pragma unroll
                    for (int n = 0; n < 2; ++n) acc[a][b][m][n] = (f32x4){0.f, 0.f, 0.f, 0.f};
        cur = nxt; cA = nA; cB = nB; ++ui;
        if constexpr (ALIGN_EPI) { if (wr == 1) PG8_BAR; }
    }
    PG8_WAIT_V(0);
    if constexpr (!ALIGN_EPI) { if (wr == 0) PG8_BAR; }
    PG8_BAR;
    if constexpr (Epi::AFTER_DRAIN) { E.fused(acc, cur, wr, wc, fr, fq, lds, wid, lane); S.done(cur); }
#undef PG8_SA
#undef PG8_SB
#undef PG8_STAGE
#undef PG8_LDA
#undef PG8_LDB
#undef PG8_MMA
#undef PG8_WAIT_V
#undef PG8_WAIT_L
#undef PG8_BAR
#undef PG8_SCHED
}
}


namespace pg8 {
struct EpiZ {
    static constexpr bool PERM = true, AFTER_DRAIN = false;
    bf16_t* z; bf16_t* vT; const float* rss;
    __device__ __forceinline__ void operator()(const f32x4 (&acc)[2][2][4][2], const Unit& u, int wr, int wc, int fr, int fq) const {
        f32x4 part[2][4];
#pragma unroll
        for (int ai = 0; ai < 2; ++ai)
#pragma unroll
            for (int m = 0; m < 4; ++m) part[ai][m] = *(const f32x4*)(rss + (size_t)(u.pm * BM + ai * HALF + wr * 64 + m * 16 + fr) * 16 + 4 * fq);
        float rstdv[2][4];
#pragma unroll
        for (int ai = 0; ai < 2; ++ai)
#pragma unroll
            for (int m = 0; m < 4; ++m) {
                float s = (part[ai][m][0] + part[ai][m][1]) + (part[ai][m][2] + part[ai][m][3]);
                s += __shfl_xor(s, 16); s += __shfl_xor(s, 32);
                rstdv[ai][m] = rsqrtf(s * (1.0f / 1024.0f) + RMS_EPS);
            }
#pragma unroll
        for (int ai = 0; ai < 2; ++ai)
#pragma unroll
            for (int m = 0; m < 4; ++m) {
                const int row = u.pm * BM + ai * HALF + wr * 64 + m * 16 + fr;
                const float rstd = rstdv[ai][m];
                const int b = row >> 11, s = row & 2047;
#pragma unroll
                for (int bj = 0; bj < 2; ++bj) {
                    const int tn = 2 * u.pn + bj;
                    const int cw = 32 * wc + 8 * fq;
                    const f32x4 v0 = acc[ai][bj][m][0] * rstd, v1 = acc[ai][bj][m][1] * rstd;
                    u32x4 w; w.x = ::cvt_pk_bf16(v0[0], v0[1]); w.y = ::cvt_pk_bf16(v0[2], v0[3]); w.z = ::cvt_pk_bf16(v1[0], v1[1]); w.w = ::cvt_pk_bf16(v1[2], v1[3]);
                    if (tn < 24) {
                        bf16_t* dst;
                        if (tn < 8) dst = z + (size_t)(tn >> 2) * ZS_KD + ((size_t)((b * 4 + (tn & 3)) * 2048 + s)) * 128 + cw;
                        else if (tn < 16) dst = z + ZS_QN + (size_t)((tn - 8) >> 2) * (ZS_KN - ZS_QN) + ((size_t)((b * 8 + ((tn - 8) & 3) * 2 + (cw >> 6)) * 2048 + s)) * 64 + (cw & 63);
                        else dst = z + ZS_GATE + (size_t)row * 1024 + (tn - 16) * 128 + cw;
                        *(u32x4*)dst = w;
                    } else {
                        const unsigned ox = __shfl_xor(w.x, 1), oy = __shfl_xor(w.y, 1), oz = __shfl_xor(w.z, 1), ow = __shfl_xor(w.w, 1);
                        const bool odd = fr & 1;
                        const unsigned a0 = odd ? oz : w.x, a1 = odd ? ow : w.y;
                        const unsigned b0 = odd ? w.z : ox, b1 = odd ? w.w : oy;
                        const unsigned p0 = (a0 & 0xffffu) | (b0 << 16), p1 = (a0 >> 16) | (b0 & 0xffff0000u);
                        const unsigned p2 = (a1 & 0xffffu) | (b1 << 16), p3 = (a1 >> 16) | (b1 & 0xffff0000u);
                        const int ch0 = cw + (odd ? 4 : 0), se = s & ~1;
                        bf16_t* dst;
                        if (tn < 28) dst = vT + VS_VD + ((size_t)(((b * 4 + (tn - 24)) * 32 + (se >> 6)) * 128 + ch0)) * 64 + (se & 63);
                        else dst = vT + VS_VN + ((size_t)(((b * 8 + (tn - 28) * 2 + (ch0 >> 6)) * 32 + (se >> 6)) * 64 + (ch0 & 63))) * 64 + (se & 63);
                        *(unsigned*)(dst) = p0; *(unsigned*)(dst + 64) = p1; *(unsigned*)(dst + 128) = p2; *(unsigned*)(dst + 192) = p3;
                    }
                }
            }
    }
};
template <bool WRITE_XB> struct EpiRes {
    static constexpr bool PERM = true, AFTER_DRAIN = false;
    const float* xin; float* xf; bf16_t* xb; float* rss;
    __device__ __forceinline__ void operator()(const f32x4 (&acc)[2][2][4][2], const Unit& u, int wr, int wc, int fr, int fq) const {
#pragma unroll
        for (int ai = 0; ai < 2; ++ai) {
            f32x4 res[4][2][2];
#pragma unroll
            for (int m = 0; m < 4; ++m)
#pragma unroll
                for (int bj = 0; bj < 2; ++bj) {
                    const size_t off = (size_t)(u.pm * BM + ai * HALF + wr * 64 + m * 16 + fr) * 1024 + u.pn * BM + bj * HALF + 32 * wc + 8 * fq;
                    res[m][bj][0] = *(const f32x4*)(xin + off); res[m][bj][1] = *(const f32x4*)(xin + off + 4);
                }
            __builtin_amdgcn_sched_barrier(0);
#pragma unroll
            for (int m = 0; m < 4; ++m) {
                const int row = u.pm * BM + ai * HALF + wr * 64 + m * 16 + fr;
                float ss = 0.f;
#pragma unroll
                for (int bj = 0; bj < 2; ++bj) {
                    const size_t off = (size_t)row * 1024 + u.pn * BM + bj * HALF + 32 * wc + 8 * fq;
                    const f32x4 v0 = res[m][bj][0] + acc[ai][bj][m][0], v1 = res[m][bj][1] + acc[ai][bj][m][1];
                    *(f32x4*)(xf + off) = v0; *(f32x4*)(xf + off + 4) = v1;
                    if (WRITE_XB) { u32x4 w; w.x = ::cvt_pk_bf16(v0[0], v0[1]); w.y = ::cvt_pk_bf16(v0[2], v0[3]); w.z = ::cvt_pk_bf16(v1[0], v1[1]); w.w = ::cvt_pk_bf16(v1[2], v1[3]); *(u32x4*)(xb + off) = w; }
                    ss += (v0[0] * v0[0] + v0[1] * v0[1]) + (v0[2] * v0[2] + v0[3] * v0[3]) + (v1[0] * v1[0] + v1[1] * v1[1]) + (v1[2] * v1[2] + v1[3] * v1[3]);
                }
                ss += __shfl_xor(ss, 16); ss += __shfl_xor(ss, 32);
                if (fq == 0) rss[(size_t)row * 16 + u.pn * 4 + wc] = ss;
            }
            __builtin_amdgcn_sched_barrier(0);
        }
    }
};
struct EpiFinal {
    static constexpr bool PERM = true, AFTER_DRAIN = true;
    const float* xin; float* out; const float* fg; float* rss; unsigned* cnt;
    __device__ __forceinline__ void fused(f32x4 (&acc)[2][2][4][2], const Unit& u, int wr, int wc, int fr, int fq, PG8_LAS unsigned char* lds, int wid, int lane) const {
        float ssv[2][4];
#pragma unroll
        for (int ai = 0; ai < 2; ++ai) {
            f32x4 res[4][2][2];
#pragma unroll
            for (int m = 0; m < 4; ++m)
#pragma unroll
                for (int bj = 0; bj < 2; ++bj) {
                    const size_t off = (size_t)(u.pm * BM + ai * HALF + wr * 64 + m * 16 + fr) * 1024 + u.pn * BM + bj * HALF + 32 * wc + 8 * fq;
                    res[m][bj][0] = *(const f32x4*)(xin + off); res[m][bj][1] = *(const f32x4*)(xin + off + 4);
                }
#pragma unroll
            for (int m = 0; m < 4; ++m) {
                float ss = 0.f;
#pragma unroll
                for (int bj = 0; bj < 2; ++bj) {
                    const f32x4 v0 = res[m][bj][0] + acc[ai][bj][m][0], v1 = res[m][bj][1] + acc[ai][bj][m][1];
                    acc[ai][bj][m][0] = v0; acc[ai][bj][m][1] = v1;
                    ss += (v0[0] * v0[0] + v0[1] * v0[1]) + (v0[2] * v0[2] + v0[3] * v0[3]) + (v1[0] * v1[0] + v1[1] * v1[1]) + (v1[2] * v1[2] + v1[3] * v1[3]);
                }
                ss += __shfl_xor(ss, 16); ss += __shfl_xor(ss, 32);
                ssv[ai][m] = ss;
            }
        }
        if (fq == 0) {
#pragma unroll
            for (int ai = 0; ai < 2; ++ai)
#pragma unroll
                for (int m = 0; m < 4; ++m)
                    __hip_atomic_store((unsigned*)rss + (size_t)(u.pm * BM + ai * HALF + wr * 64 + m * 16 + fr) * 16 + u.pn * 4 + wc, __float_as_uint(ssv[ai][m]), __ATOMIC_RELAXED, __HIP_MEMORY_SCOPE_AGENT);
        }
        asm volatile("s_waitcnt vmcnt(0)" ::: "memory");
        if (lane == 0) __hip_atomic_fetch_add(cnt + 64 * u.pm, 1u, __ATOMIC_RELAXED, __HIP_MEMORY_SCOPE_AGENT);
        if (wid == 0) {
            unsigned spins = 0;
            while ((unsigned)__builtin_amdgcn_readfirstlane(__hip_atomic_load(cnt + 64 * u.pm, __ATOMIC_RELAXED, __HIP_MEMORY_SCOPE_AGENT)) < 32u) {
                __builtin_amdgcn_s_sleep(2);
                if (++spins > (1u << 22)) break;
            }
            __builtin_amdgcn_fence(__ATOMIC_ACQUIRE, "agent");
        }
        asm volatile("s_waitcnt vmcnt(0) lgkmcnt(0)" ::: "memory"); __builtin_amdgcn_s_barrier(); asm volatile("" ::: "memory");
        float rstdv[2][4];
#pragma unroll
        for (int ai = 0; ai < 2; ++ai)
#pragma unroll
            for (int m = 0; m < 4; ++m) {
                const unsigned* rp = (const unsigned*)rss + (size_t)(u.pm * BM + ai * HALF + wr * 64 + m * 16 + fr) * 16 + 4 * fq;
                float s = 0.f;
#pragma unroll
                for (int k = 0; k < 4; ++k) s += __uint_as_float(__hip_atomic_load(rp + k, __ATOMIC_RELAXED, __HIP_MEMORY_SCOPE_AGENT));
                s += __shfl_xor(s, 16); s += __shfl_xor(s, 32);
                rstdv[ai][m] = rsqrtf(s * (1.0f / 1024.0f) + RMS_EPS);
            }
        f32x4 gv[2][2];
#pragma unroll
        for (int bj = 0; bj < 2; ++bj) { const int c0 = u.pn * BM + bj * HALF + 32 * wc + 8 * fq; gv[bj][0] = *(const f32x4*)(fg + c0); gv[bj][1] = *(const f32x4*)(fg + c0 + 4); }
#pragma unroll
        for (int ai = 0; ai < 2; ++ai)
#pragma unroll
            for (int m = 0; m < 4; ++m)
#pragma unroll
                for (int bj = 0; bj < 2; ++bj) {
                    const size_t off = (size_t)(u.pm * BM + ai * HALF + wr * 64 + m * 16 + fr) * 1024 + u.pn * BM + bj * HALF + 32 * wc + 8 * fq;
                    *(f32x4*)(out + off) = acc[ai][bj][m][0] * rstdv[ai][m] * gv[bj][0];
                    *(f32x4*)(out + off + 4) = acc[ai][bj][m][1] * rstdv[ai][m] * gv[bj][1];
                }
    }
};
}
constexpr int LDS_PHASE_BYTES = 143360;
constexpr int LDS_RPB_OFF = LDS_PHASE_BYTES + 16 + 128, LDS_RPB_BYTES = 8 * 465 * 4 + 128;

constexpr int DA_KP = 272, DA_VP = 144;
constexpr int DA_KBYTES = 128 * DA_KP, DA_VSUB = 128 * DA_VP, DA_VBYTES = 2 * DA_VSUB, DA_STAGE = DA_KBYTES + DA_VBYTES;

__device__ __forceinline__ float silu_f(float x) { return x / (1.0f + __expf(-x)); }

__device__ void da_unit(char* lds, const Params& p, int layer, int unit) {
    int tid_ = threadIdx.x; asm volatile("" : "+v"(tid_)); const int tid = tid_, lane = tid & 63, wid = __builtin_amdgcn_readfirstlane(tid >> 6), r = lane & 31, h2 = lane >> 5;
    const int c = wid & 1, qg = wid >> 1;
    const int g8 = unit >> 3, bh = (unit & 7) * 4 + (g8 >> 4), qb = g8 & 15, b = bh >> 2, h = bh & 3;
    const float slope2 = exp2f(-2.0f * (float)(h + 1)) * LOG2E;
    const float qscale = 0.125f * LOG2E;
    float lam;
    {
        const float v1 = p.lq1[layer * 64 + lane] * p.lk1[layer * 64 + lane], v2 = p.lq2[layer * 64 + lane] * p.lk2[layer * 64 + lane];
        float s1 = v1, s2 = v2;
#pragma unroll
        for (int s = 32; s >= 1; s >>= 1) { s1 += __shfl_xor(s1, s); s2 += __shfl_xor(s2, s); }
        lam = __expf(s1) - __expf(s2) + p.lam_init[layer];
    }
    const int q0 = qb * 128 + qg * 32;
    const size_t tokq = (size_t)b * SEQ + q0 + r;
    bf16x8 qf[4];
#pragma unroll
    for (int t = 0; t < 4; ++t) {
        const u32x4 w = *(const u32x4*)(p.z + ZS_QD + ((size_t)(bh * 2048 + q0 + r)) * 128 + c * 64 + t * 16 + h2 * 8);
        u32x4 o;
        o.x = cvt_pk_bf16(bflo(w.x) * qscale, bfhi(w.x) * qscale); o.y = cvt_pk_bf16(bflo(w.y) * qscale, bfhi(w.y) * qscale);
        o.z = cvt_pk_bf16(bflo(w.z) * qscale, bfhi(w.z) * qscale); o.w = cvt_pk_bf16(bflo(w.w) * qscale, bfhi(w.w) * qscale);
        qf[t] = __builtin_bit_cast(bf16x8, o);
    }
    f32x16 O[4], Bs;
#pragma unroll
    for (int k = 0; k < 4; ++k)
#pragma unroll
        for (int e = 0; e < 16; ++e) O[k][e] = 0.f;
#pragma unroll
    for (int e = 0; e < 16; ++e) Bs[e] = -slope2 * (float)(16 * (e >> 3) + (e & 7));
    float mrow = -1e30f, lrow = 0.f;
    const float qrel = (float)(8 * h2) - (float)(q0 + r);
    const bf16_t* Kg = p.z + ZS_KD + ((size_t)bh * 2048) * 128 + tid * 8;
    const bf16_t* Vg = p.vT + VS_VD + ((size_t)bh * 32) * 8192 + tid * 8;
    const int kr_ = tid >> 4, kc_ = tid & 15, vr_ = tid >> 3, vc_ = tid & 7;
    constexpr int NT = SEQ / 128;
    auto tile_of = [&](int i) { return (i < NT - qb) ? (qb + i) : (NT - 1 - i); };
    u32x4 rk[4], rv[4];
    {
        const int t0 = tile_of(0);
#pragma unroll
        for (int j = 0; j < 4; ++j) { rk[j] = *(const u32x4*)(Kg + (size_t)t0 * 16384 + j * 4096); rv[j] = *(const u32x4*)(Vg + (size_t)t0 * 16384 + j * 4096); }
    }
    __syncthreads();
#pragma unroll
    for (int j = 0; j < 4; ++j) {
        *(u32x4*)(lds + (kr_ + 32 * j) * DA_KP + kc_ * 16) = rk[j];
        *(u32x4*)(lds + DA_KBYTES + (j >> 1) * DA_VSUB + (vr_ + 64 * (j & 1)) * DA_VP + vc_ * 16) = rv[j];
    }
    __syncthreads();
    const int pr = (r & 0x13) | ((r & 4) << 1) | ((r & 8) >> 1);
    if (wid >= 4) __builtin_amdgcn_s_setprio(1);
    {
        const int it = 0; const int kt = qb;
        const char* cK = lds + (it & 1) * DA_STAGE;
        const char* cV = cK + DA_KBYTES;
        char* nK = lds + ((it + 1) & 1) * DA_STAGE;
        if (it + 1 < NT) {
            const int tn = tile_of(it + 1);
#pragma unroll
            for (int j = 0; j < 4; ++j) { rk[j] = *(const u32x4*)(Kg + (size_t)tn * 16384 + j * 4096); rv[j] = *(const u32x4*)(Vg + (size_t)tn * 16384 + j * 4096); }
        }
#pragma unroll
        for (int kb = 0; kb < 4; ++kb) {
            const int k0 = kt * 128 + kb * 32;
            f32x16 s; const float A = 0.f;
            const float kq = (float)k0 + qrel;
#pragma unroll
            for (int e = 0; e < 16; ++e) s[e] = 0.f;
#pragma unroll
            for (int t = 0; t < 4; ++t) {
                const bf16x8 kf = *(const bf16x8*)(cK + (kb * 32 + pr) * DA_KP + c * 128 + t * 32 + h2 * 16);
                s = __builtin_amdgcn_mfma_f32_32x32x16_bf16(kf, qf[t], s, 0, 0, 0);
            }
#pragma unroll
            for (int e = 0; e < 16; ++e) s[e] = fmaf(fabsf(kq + (float)(16 * (e >> 3) + (e & 7))), -slope2, s[e]);
            float mx = s[0];
#pragma unroll
            for (int e = 1; e < 16; ++e) mx = fmaxf(mx, s[e]);
            mx += A;
            mx = fmaxf(mx, __shfl_xor(mx, 32));
            if (!__all(mx <= mrow + 8.0f)) {
                const float mnew = fmaxf(mrow, mx);
                const float alpha = fast_exp2(mrow - mnew);
#pragma unroll
                for (int k = 0; k < 4; ++k) O[k] = O[k] * alpha;
                lrow *= alpha; mrow = mnew;
            }
            const float mm = mrow - A;
            float ps = 0.f;
#pragma unroll
            for (int e = 0; e < 16; ++e) { s[e] = fast_exp2(s[e] - mm); ps += s[e]; }
            lrow += ps;
            bf16x8 pb[2];
#pragma unroll
            for (int sp = 0; sp < 2; ++sp) {
                u32x4 w;
                w.x = cvt_pk_bf16(s[8 * sp + 0], s[8 * sp + 1]); w.y = cvt_pk_bf16(s[8 * sp + 2], s[8 * sp + 3]);
                w.z = cvt_pk_bf16(s[8 * sp + 4], s[8 * sp + 5]); w.w = cvt_pk_bf16(s[8 * sp + 6], s[8 * sp + 7]);
                pb[sp] = __builtin_bit_cast(bf16x8, w);
            }
#pragma unroll
            for (int sp = 0; sp < 2; ++sp)
#pragma unroll
                for (int k = 0; k < 4; ++k) {
                    const bf16x8 vf = *(const bf16x8*)(cV + (kb >> 1) * DA_VSUB + (32 * k + r) * DA_VP + (32 * (kb & 1) + 16 * sp + 8 * h2) * 2);
                    O[k] = __builtin_amdgcn_mfma_f32_32x32x16_bf16(vf, pb[sp], O[k], 0, 0, 0);
                }
        }

        if (it + 1 < NT) {
#pragma unroll
            for (int j = 0; j < 4; ++j) {
                *(u32x4*)(nK + (kr_ + 32 * j) * DA_KP + kc_ * 16) = rk[j];
                *(u32x4*)(nK + DA_KBYTES + (j >> 1) * DA_VSUB + (vr_ + 64 * (j & 1)) * DA_VP + vc_ * 16) = rv[j];
            }
        }
        __syncthreads();
    }
    for (int it = 1; it < NT - qb; ++it) {
        const int kt = tile_of(it);
        const char* cK = lds + (it & 1) * DA_STAGE;
        const char* cV = cK + DA_KBYTES;
        char* nK = lds + ((it + 1) & 1) * DA_STAGE;
        const int tn = tile_of(it + 1 < NT ? it + 1 : it);
        if (it + 1 < NT) {
#pragma unroll
            for (int j = 0; j < 4; ++j) rk[j] = *(const u32x4*)(Kg + (size_t)tn * 16384 + j * 4096);
        }
#define DA_FAST_HALF(BSEL, SGN, hf) \
            { \
                f32x16 s0, s1; \
                { const bf16x8 kf0 = *(const bf16x8*)(cK + (hf * 64 + pr) * DA_KP + c * 128 + h2 * 16); \
                  const bf16x8 kf1 = *(const bf16x8*)(cK + (hf * 64 + 32 + pr) * DA_KP + c * 128 + h2 * 16); \
                  s0 = __builtin_amdgcn_mfma_f32_32x32x16_bf16(kf0, qf[0], BSEL, 0, 0, 0); \
                  s1 = __builtin_amdgcn_mfma_f32_32x32x16_bf16(kf1, qf[0], BSEL, 0, 0, 0); } \
                _Pragma("unroll") \
                for (int t = 1; t < 4; ++t) { \
                    const bf16x8 kf0 = *(const bf16x8*)(cK + (hf * 64 + pr) * DA_KP + c * 128 + t * 32 + h2 * 16); \
                    const bf16x8 kf1 = *(const bf16x8*)(cK + (hf * 64 + 32 + pr) * DA_KP + c * 128 + t * 32 + h2 * 16); \
                    s0 = __builtin_amdgcn_mfma_f32_32x32x16_bf16(kf0, qf[t], s0, 0, 0, 0); \
                    s1 = __builtin_amdgcn_mfma_f32_32x32x16_bf16(kf1, qf[t], s1, 0, 0, 0); \
                } \
                const float A0 = (SGN) * ((float)(kt * 128 + hf * 64) + qrel), A1 = A0 + (SGN) * 32.0f; \
                const float mm0 = mrow - A0, mm1 = mrow - A1; \
                float ps0 = 0.f, ps1 = 0.f; \
                _Pragma("unroll") \
                for (int e = 0; e < 16; ++e) { s0[e] = fast_exp2(s0[e] - mm0); ps0 += s0[e]; } \
                bf16x8 pb0[2], pb1[2]; \
                _Pragma("unroll") \
                for (int sp = 0; sp < 2; ++sp) { \
                    u32x4 w; \
                    w.x = cvt_pk_bf16(s0[8 * sp + 0], s0[8 * sp + 1]); w.y = cvt_pk_bf16(s0[8 * sp + 2], s0[8 * sp + 3]); \
                    w.z = cvt_pk_bf16(s0[8 * sp + 4], s0[8 * sp + 5]); w.w = cvt_pk_bf16(s0[8 * sp + 6], s0[8 * sp + 7]); \
                    pb0[sp] = __builtin_bit_cast(bf16x8, w); \
                } \
                _Pragma("unroll") \
                for (int sp = 0; sp < 2; ++sp) \
                    _Pragma("unroll") \
                    for (int k = 0; k < 4; ++k) { \
                        const bf16x8 vf0 = *(const bf16x8*)(cV + hf * DA_VSUB + (32 * k + r) * DA_VP + (16 * sp + 8 * h2) * 2); \
                        O[k] = __builtin_amdgcn_mfma_f32_32x32x16_bf16(vf0, pb0[sp], O[k], 0, 0, 0); \
                    } \
                _Pragma("unroll") \
                for (int e = 0; e < 16; ++e) { s1[e] = fast_exp2(s1[e] - mm1); ps1 += s1[e]; } \
                lrow += ps0 + ps1; \
                _Pragma("unroll") \
                for (int sp = 0; sp < 2; ++sp) { \
                    u32x4 w; \
                    w.x = cvt_pk_bf16(s1[8 * sp + 0], s1[8 * sp + 1]); w.y = cvt_pk_bf16(s1[8 * sp + 2], s1[8 * sp + 3]); \
                    w.z = cvt_pk_bf16(s1[8 * sp + 4], s1[8 * sp + 5]); w.w = cvt_pk_bf16(s1[8 * sp + 6], s1[8 * sp + 7]); \
                    pb1[sp] = __builtin_bit_cast(bf16x8, w); \
                } \
                _Pragma("unroll") \
                for (int sp = 0; sp < 2; ++sp) \
                    _Pragma("unroll") \
                    for (int k = 0; k < 4; ++k) { \
                        const bf16x8 vf1 = *(const bf16x8*)(cV + hf * DA_VSUB + (32 * k + r) * DA_VP + (32 + 16 * sp + 8 * h2) * 2); \
                        O[k] = __builtin_amdgcn_mfma_f32_32x32x16_bf16(vf1, pb1[sp], O[k], 0, 0, 0); \
                    } \
            }
        DA_FAST_HALF(Bs, -slope2, 0)
        if (it + 1 < NT) {
#pragma unroll
            for (int j = 0; j < 4; ++j) *(u32x4*)(nK + (kr_ + 32 * j) * DA_KP + kc_ * 16) = rk[j];
#pragma unroll
            for (int j = 0; j < 4; ++j) rk[j] = *(const u32x4*)(Vg + (size_t)tn * 16384 + j * 4096);
        }
        DA_FAST_HALF(Bs, -slope2, 1)
#undef DA_FAST_HALF
        if (it + 1 < NT) {
#pragma unroll
            for (int j = 0; j < 4; ++j) *(u32x4*)(nK + DA_KBYTES + (j >> 1) * DA_VSUB + (vr_ + 64 * (j & 1)) * DA_VP + vc_ * 16) = rk[j];
        }
        __syncthreads();
    }
#pragma unroll
    for (int e = 0; e < 16; ++e) Bs[e] = -Bs[e];
    for (int it = NT - qb; it < NT; ++it) {
        const int kt = tile_of(it);
        const char* cK = lds + (it & 1) * DA_STAGE;
        const char* cV = cK + DA_KBYTES;
        char* nK = lds + ((it + 1) & 1) * DA_STAGE;
        const int tn = tile_of(it + 1 < NT ? it + 1 : it);
        if (it + 1 < NT) {
#pragma unroll
            for (int j = 0; j < 4; ++j) rk[j] = *(const u32x4*)(Kg + (size_t)tn * 16384 + j * 4096);
        }
#define DA_FAST_HALF(BSEL, SGN, hf) \
            { \
                f32x16 s0, s1; \
                { const bf16x8 kf0 = *(const bf16x8*)(cK + (hf * 64 + pr) * DA_KP + c * 128 + h2 * 16); \
                  const bf16x8 kf1 = *(const bf16x8*)(cK + (hf * 64 + 32 + pr) * DA_KP + c * 128 + h2 * 16); \
                  s0 = __builtin_amdgcn_mfma_f32_32x32x16_bf16(kf0, qf[0], BSEL, 0, 0, 0); \
                  s1 = __builtin_amdgcn_mfma_f32_32x32x16_bf16(kf1, qf[0], BSEL, 0, 0, 0); } \
                _Pragma("unroll") \
                for (int t = 1; t < 4; ++t) { \
                    const bf16x8 kf0 = *(const bf16x8*)(cK + (hf * 64 + pr) * DA_KP + c * 128 + t * 32 + h2 * 16); \
                    const bf16x8 kf1 = *(const bf16x8*)(cK + (hf * 64 + 32 + pr) * DA_KP + c * 128 + t * 32 + h2 * 16); \
                    s0 = __builtin_amdgcn_mfma_f32_32x32x16_bf16(kf0, qf[t], s0, 0, 0, 0); \
                    s1 = __builtin_amdgcn_mfma_f32_32x32x16_bf16(kf1, qf[t], s1, 0, 0, 0); \
                } \
                const float A0 = (SGN) * ((float)(kt * 128 + hf * 64) + qrel), A1 = A0 + (SGN) * 32.0f; \
                const float mm0 = mrow - A0, mm1 = mrow - A1; \
                float ps0 = 0.f, ps1 = 0.f; \
                _Pragma("unroll") \
                for (int e = 0; e < 16; ++e) { s0[e] = fast_exp2(s0[e] - mm0); ps0 += s0[e]; } \
                bf16x8 pb0[2], pb1[2]; \
                _Pragma("unroll") \
                for (int sp = 0; sp < 2; ++sp) { \
                    u32x4 w; \
                    w.x = cvt_pk_bf16(s0[8 * sp + 0], s0[8 * sp + 1]); w.y = cvt_pk_bf16(s0[8 * sp + 2], s0[8 * sp + 3]); \
                    w.z = cvt_pk_bf16(s0[8 * sp + 4], s0[8 * sp + 5]); w.w = cvt_pk_bf16(s0[8 * sp + 6], s0[8 * sp + 7]); \
                    pb0[sp] = __builtin_bit_cast(bf16x8, w); \
                } \
                _Pragma("unroll") \
                for (int sp = 0; sp < 2; ++sp) \
                    _Pragma("unroll") \
                    for (int k = 0; k < 4; ++k) { \
                        const bf16x8 vf0 = *(const bf16x8*)(cV + hf * DA_VSUB + (32 * k + r) * DA_VP + (16 * sp + 8 * h2) * 2); \
                        O[k] = __builtin_amdgcn_mfma_f32_32x32x16_bf16(vf0, pb0[sp], O[k], 0, 0, 0); \
                    } \
                _Pragma("unroll") \
                for (int e = 0; e < 16; ++e) { s1[e] = fast_exp2(s1[e] - mm1); ps1 += s1[e]; } \
                lrow += ps0 + ps1; \
                _Pragma("unroll") \
                for (int sp = 0; sp < 2; ++sp) { \
                    u32x4 w; \
                    w.x = cvt_pk_bf16(s1[8 * sp + 0], s1[8 * sp + 1]); w.y = cvt_pk_bf16(s1[8 * sp + 2], s1[8 * sp + 3]); \
                    w.z = cvt_pk_bf16(s1[8 * sp + 4], s1[8 * sp + 5]); w.w = cvt_pk_bf16(s1[8 * sp + 6], s1[8 * sp + 7]); \
                    pb1[sp] = __builtin_bit_cast(bf16x8, w); \
                } \
                _Pragma("unroll") \
                for (int sp = 0; sp < 2; ++sp) \
                    _Pragma("unroll") \
                    for (int k = 0; k < 4; ++k) { \
                        const bf16x8 vf1 = *(const bf16x8*)(cV + hf * DA_VSUB + (32 * k + r) * DA_VP + (32 + 16 * sp + 8 * h2) * 2); \
                        O[k] = __builtin_amdgcn_mfma_f32_32x32x16_bf16(vf1, pb1[sp], O[k], 0, 0, 0); \
                    } \
            }
        DA_FAST_HALF(Bs, slope2, 0)
        if (it + 1 < NT) {
#pragma unroll
            for (int j = 0; j < 4; ++j) *(u32x4*)(nK + (kr_ + 32 * j) * DA_KP + kc_ * 16) = rk[j];
#pragma unroll
            for (int j = 0; j < 4; ++j) rk[j] = *(const u32x4*)(Vg + (size_t)tn * 16384 + j * 4096);
        }
        DA_FAST_HALF(Bs, slope2, 1)
#undef DA_FAST_HALF
        if (it + 1 < NT) {
#pragma unroll
            for (int j = 0; j < 4; ++j) *(u32x4*)(nK + DA_KBYTES + (j >> 1) * DA_VSUB + (vr_ + 64 * (j & 1)) * DA_VP + vc_ * 16) = rk[j];
        }
        __syncthreads();
    }
    __builtin_amdgcn_s_setprio(0);
    {
        const float lchk = lrow + __shfl_xor(lrow, 32);
        const int bad = !(lchk < 1e30f);
        volatile unsigned* bflag = (volatile unsigned*)(lds + LDS_PHASE_BYTES + 8);
        if (tid == 0) *bflag = 0u;
        __syncthreads();
        if (__any(bad) && lane == 0) *bflag = 1u;
        __syncthreads();
        if (*bflag != 0u) {
#pragma unroll
            for (int k = 0; k < 4; ++k)
#pragma unroll
                for (int e = 0; e < 16; ++e) O[k][e] = 0.f;
            mrow = -1e30f; lrow = 0.f;
            {
                const int t0 = tile_of(0);
#pragma unroll
                for (int j = 0; j < 4; ++j) { rk[j] = *(const u32x4*)(Kg + (size_t)t0 * 16384 + j * 4096); rv[j] = *(const u32x4*)(Vg + (size_t)t0 * 16384 + j * 4096); }
            }
#pragma unroll
            for (int j = 0; j < 4; ++j) {
                *(u32x4*)(lds + (kr_ + 32 * j) * DA_KP + kc_ * 16) = rk[j];
                *(u32x4*)(lds + DA_KBYTES + (j >> 1) * DA_VSUB + (vr_ + 64 * (j & 1)) * DA_VP + vc_ * 16) = rv[j];
            }
            __syncthreads();
        for (int it = 0; it < NT; ++it) {
            const int kt = tile_of(it);
        const char* cK = lds + (it & 1) * DA_STAGE;
        const char* cV = cK + DA_KBYTES;
        char* nK = lds + ((it + 1) & 1) * DA_STAGE;
        if (it + 1 < NT) {
            const int tn = tile_of(it + 1);
#pragma unroll
            for (int j = 0; j < 4; ++j) { rk[j] = *(const u32x4*)(Kg + (size_t)tn * 16384 + j * 4096); rv[j] = *(const u32x4*)(Vg + (size_t)tn * 16384 + j * 4096); }
        }
#pragma unroll
        for (int kb = 0; kb < 4; ++kb) {
            const int k0 = kt * 128 + kb * 32;
            f32x16 s; const float A = 0.f;
            const float kq = (float)k0 + qrel;
#pragma unroll
            for (int e = 0; e < 16; ++e) s[e] = 0.f;
#pragma unroll
            for (int t = 0; t < 4; ++t) {
                const bf16x8 kf = *(const bf16x8*)(cK + (kb * 32 + pr) * DA_KP + c * 128 + t * 32 + h2 * 16);
                s = __builtin_amdgcn_mfma_f32_32x32x16_bf16(kf, qf[t], s, 0, 0, 0);
            }
#pragma unroll
            for (int e = 0; e < 16; ++e) s[e] = fmaf(fabsf(kq + (float)(16 * (e >> 3) + (e & 7))), -slope2, s[e]);
            float mx = s[0];
#pragma unroll
            for (int e = 1; e < 16; ++e) mx = fmaxf(mx, s[e]);
            mx += A;
            mx = fmaxf(mx, __shfl_xor(mx, 32));
            if (!__all(mx <= mrow + 8.0f)) {
                const float mnew = fmaxf(mrow, mx);
                const float alpha = fast_exp2(mrow - mnew);
#pragma unroll
                for (int k = 0; k < 4; ++k) O[k] = O[k] * alpha;
                lrow *= alpha; mrow = mnew;
            }
            const float mm = mrow - A;
            float ps = 0.f;
#pragma unroll
            for (int e = 0; e < 16; ++e) { s[e] = fast_exp2(s[e] - mm); ps += s[e]; }
            lrow += ps;
            bf16x8 pb[2];
#pragma unroll
            for (int sp = 0; sp < 2; ++sp) {
                u32x4 w;
                w.x = cvt_pk_bf16(s[8 * sp + 0], s[8 * sp + 1]); w.y = cvt_pk_bf16(s[8 * sp + 2], s[8 * sp + 3]);
                w.z = cvt_pk_bf16(s[8 * sp + 4], s[8 * sp + 5]); w.w = cvt_pk_bf16(s[8 * sp + 6], s[8 * sp + 7]);
                pb[sp] = __builtin_bit_cast(bf16x8, w);
            }
#pragma unroll
            for (int sp = 0; sp < 2; ++sp)
#pragma unroll
                for (int k = 0; k < 4; ++k) {
                    const bf16x8 vf = *(const bf16x8*)(cV + (kb >> 1) * DA_VSUB + (32 * k + r) * DA_VP + (32 * (kb & 1) + 16 * sp + 8 * h2) * 2);
                    O[k] = __builtin_amdgcn_mfma_f32_32x32x16_bf16(vf, pb[sp], O[k], 0, 0, 0);
                }
        }

        if (it + 1 < NT) {
#pragma unroll
            for (int j = 0; j < 4; ++j) {
                *(u32x4*)(nK + (kr_ + 32 * j) * DA_KP + kc_ * 16) = rk[j];
                *(u32x4*)(nK + DA_KBYTES + (j >> 1) * DA_VSUB + (vr_ + 64 * (j & 1)) * DA_VP + vc_ * 16) = rv[j];
            }
        }
        __syncthreads();
    }
        }
    }
    const float lsum = lrow + __shfl_xor(lrow, 32);
    float* xch = (float*)lds + qg * 4096;
    if (c == 1) {
        const float i1 = lam / lsum;
#pragma unroll
        for (int k = 0; k < 4; ++k)
#pragma unroll
            for (int e = 0; e < 16; ++e) xch[(k * 16 + e) * 64 + lane] = O[k][e] * i1;
    }
    __syncthreads();
    if (c == 0) {
        const float i0 = 1.0f / lsum;
        float ss = 0.f;
#pragma unroll
        for (int k = 0; k < 4; ++k)
#pragma unroll
            for (int e = 0; e < 16; ++e) { const float a = O[k][e] * i0 - xch[(k * 16 + e) * 64 + lane]; O[k][e] = a; ss += a * a; }
        ss += __shfl_xor(ss, 32);
        const float rstd = rsqrtf(ss * (1.0f / 128.0f) + RMS_EPS) * (1.0f - p.lam_init[layer]);
        const float* sg = p.subln_g + layer * 128;
        u32x2 gwv[16]; f32x4 ggv[16];
#pragma unroll
        for (int k = 0; k < 4; ++k)
#pragma unroll
            for (int g = 0; g < 4; ++g) {
                const int d0 = 32 * k + 8 * g + 4 * h2;
                ggv[k * 4 + g] = *(const f32x4*)(sg + d0);
                gwv[k * 4 + g] = *(const u32x2*)(p.z + ZS_GATE + tokq * 1024 + h * 128 + d0);
            }
        __builtin_amdgcn_sched_barrier(0);
#pragma unroll
        for (int k = 0; k < 4; ++k)
#pragma unroll
            for (int g = 0; g < 4; ++g) {
                const int d0 = 32 * k + 8 * g + 4 * h2;
                const f32x4 gg = ggv[k * 4 + g];
                const u32x2 gw = gwv[k * 4 + g];
                const float o0 = O[k][4 * g + 0] * rstd * gg[0] * silu_f(bflo(gw.x));
                const float o1 = O[k][4 * g + 1] * rstd * gg[1] * silu_f(bfhi(gw.x));
                const float o2 = O[k][4 * g + 2] * rstd * gg[2] * silu_f(bflo(gw.y));
                const float o3 = O[k][4 * g + 3] * rstd * gg[3] * silu_f(bfhi(gw.y));
                u32x2 w; w.x = cvt_pk_bf16(o0, o1); w.y = cvt_pk_bf16(o2, o3);
                *(u32x2*)(p.o + tokq * 1024 + h * 128 + d0) = w;
            }
    }
}

__device__ void na_unit(char* lds, const Params& p, int layer, int unit) {
    int tid_ = threadIdx.x; asm volatile("" : "+v"(tid_)); const int tid = tid_, lane = tid & 63, wid = __builtin_amdgcn_readfirstlane(tid >> 6), fr = lane & 15, fq = lane >> 4;
    const int hp = unit & 3, rr0 = (unit >> 2) & 31, b = unit >> 7;
    const int h = 2 * hp + (wid >> 2), n = wid & 3;
    const float* rph = (const float*)(lds + LDS_RPB_OFF) + h * 465;
    const int r = rr0;
    const int rs = min(max(r - 4, 0), 24);
    const int kcstart = min(max(16 * n - 8, 0), 32);
    const int qcol = 16 * n + fr;
    const int qcstart = min(max(qcol - 8, 0), 48);
    const size_t tokq = (size_t)b * SEQ + r * 64 + qcol;
    bf16x8 qf[2];
#pragma unroll
    for (int t = 0; t < 2; ++t) qf[t] = *(const bf16x8*)(p.z + ZS_QN + ((size_t)((b * 8 + h) * 2048 + r * 64 + qcol)) * 64 + t * 32 + fq * 8);
    bf16x8 kfr[8][4];
    {
        const int kc = kcstart + 8 * (fr >> 2) + (fr & 3);
        const bf16_t* kg0 = p.z + ZS_KN + ((size_t)((b * 8 + h) * 2048 + rs * 64 + kc)) * 64 + fq * 8;
#pragma unroll
        for (int rr = 0; rr < 8; ++rr)
#pragma unroll
            for (int T = 0; T < 2; ++T) {
                const bf16_t* kg = kg0 + (size_t)(rr * 64 + 4 * T) * 64;
                kfr[rr][2 * T] = *(const bf16x8*)(kg); kfr[rr][2 * T + 1] = *(const bf16x8*)(kg + 32);
            }
    }
    __builtin_amdgcn_sched_barrier(0);
    const float c1 = 0.125f * LOG2E;
    float sc[8][8];
    float mx = -1e30f;
#pragma unroll
    for (int rr = 0; rr < 8; ++rr) {
#pragma unroll
        for (int T = 0; T < 2; ++T) {
            f32x4 s = (f32x4){0.f, 0.f, 0.f, 0.f};
            s = __builtin_amdgcn_mfma_f32_16x16x32_bf16(kfr[rr][2 * T], qf[0], s, 0, 0, 0);
            s = __builtin_amdgcn_mfma_f32_16x16x32_bf16(kfr[rr][2 * T + 1], qf[1], s, 0, 0, 0);
            const int dr = rs + rr - r + 7;
#pragma unroll
            for (int e = 0; e < 4; ++e) {
                const int kcol = kcstart + 8 * fq + e + 4 * T;
                const bool valid = (kcol >= qcstart) && (kcol < qcstart + 16);
                const int dc = min(max(kcol - qcol, -15), 15) + 15;
                const float bias = rph[dr * 31 + dc];
                const float v = valid ? fmaf(s[e], c1, bias) : -1e30f;
                sc[rr][4 * T + e] = v;
                mx = fmaxf(mx, v);
            }
        }
    }
    __builtin_amdgcn_sched_barrier(0);
    bf16x8 vfr[4][8];
    {
        const bf16_t* vg0 = p.vT + VS_VN + ((size_t)(((b * 8 + h) * 32 + rs) * 64 + fr)) * 64 + kcstart + 8 * fq;
#pragma unroll
        for (int dt = 0; dt < 4; ++dt)
#pragma unroll
            for (int rr = 0; rr < 8; ++rr) vfr[dt][rr] = *(const bf16x8*)(vg0 + (size_t)(rr * 64 + 16 * dt) * 64);
    }
    mx = fmaxf(mx, __shfl_xor(mx, 16)); mx = fmaxf(mx, __shfl_xor(mx, 32));
    float l = 0.f;
    bf16x8 pb[8];
#pragma unroll
    for (int rr = 0; rr < 8; ++rr) {
#pragma unroll
        for (int e = 0; e < 8; ++e) { sc[rr][e] = fast_exp2(sc[rr][e] - mx); l += sc[rr][e]; }
        u32x4 w;
        w.x = cvt_pk_bf16(sc[rr][0], sc[rr][1]); w.y = cvt_pk_bf16(sc[rr][2], sc[rr][3]);
        w.z = cvt_pk_bf16(sc[rr][4], sc[rr][5]); w.w = cvt_pk_bf16(sc[rr][6], sc[rr][7]);
        pb[rr] = __builtin_bit_cast(bf16x8, w);
    }
    l += __shfl_xor(l, 16); l += __shfl_xor(l, 32);
    const float il = 1.0f / l;
    f32x4 O[4];
#pragma unroll
    for (int dt = 0; dt < 4; ++dt) {
        O[dt] = (f32x4){0.f, 0.f, 0.f, 0.f};
#pragma unroll
        for (int rr = 0; rr < 8; ++rr) O[dt] = __builtin_amdgcn_mfma_f32_16x16x32_bf16(vfr[dt][rr], pb[rr], O[dt], 0, 0, 0);
    }
#pragma unroll
    for (int dt = 0; dt < 4; ++dt) {
        const int d0 = 16 * dt + 4 * fq;
        const u32x2 gw = *(const u32x2*)(p.z + ZS_GATE + tokq * 1024 + 512 + h * 64 + d0);
        const float o0 = O[dt][0] * il * silu_f(bflo(gw.x)), o1 = O[dt][1] * il * silu_f(bfhi(gw.x));
        const float o2 = O[dt][2] * il * silu_f(bflo(gw.y)), o3 = O[dt][3] * il * silu_f(bfhi(gw.y));
        u32x2 w; w.x = cvt_pk_bf16(o0, o1); w.y = cvt_pk_bf16(o2, o3);
        *(u32x2*)(p.o + tokq * 1024 + 512 + h * 64 + d0) = w;
    }
}


constexpr int NA_P = 144, NA_KBYTES = 128 * NA_P, NA_STAGE = 2 * NA_KBYTES;

__device__ void na_super_online(char* lds, const Params& p, int layer, int su) {
    int tid_ = threadIdx.x; asm volatile("" : "+v"(tid_)); const int tid = tid_, lane = tid & 63, wid = __builtin_amdgcn_readfirstlane(tid >> 6), fr = lane & 15, fq = lane >> 4;
    const int bh = (su & 7) * 8 + (su >> 5), g = (su >> 3) & 3, b = bh >> 3, h = bh & 7;
    const float* rph = (const float*)(lds + LDS_RPB_OFF) + h * 465;
    const float c1 = 0.125f * LOG2E;
    const int rq = 8 * g + wid, rsw = min(max(rq - 4, 0), 24);
    bf16x8 qf[4][2];
    f32x4 O[4][4];
    float mrow[4], lrow[4];
#pragma unroll
    for (int n = 0; n < 4; ++n) {
#pragma unroll
        for (int t = 0; t < 2; ++t) qf[n][t] = *(const bf16x8*)(p.z + ZS_QN + ((size_t)(bh * 2048 + rq * 64 + 16 * n + fr)) * 64 + t * 32 + fq * 8);
#pragma unroll
        for (int dt = 0; dt < 4; ++dt) O[n][dt] = (f32x4){0.f, 0.f, 0.f, 0.f};
        mrow[n] = -1e30f; lrow[n] = 0.f;
    }
    const int klo = min(max(8 * g - 4, 0), 24);
    const int nsteps = (g == 0 || g == 3) ? 6 : 8;
    const bf16_t* Kg = p.z + ZS_KN + ((size_t)(bh * 2048 + klo * 64)) * 64 + tid * 8;
    const bf16_t* Vg = p.vT + VS_VN + ((size_t)((bh * 32 + klo) * 64)) * 64 + tid * 8;
    const int lw = (tid >> 3) * NA_P + (tid & 7) * 16;
    u32x4 rk[2], rv[2];
    rk[0] = *(const u32x4*)(Kg); rk[1] = *(const u32x4*)(Kg + 4096);
    rv[0] = *(const u32x4*)(Vg); rv[1] = *(const u32x4*)(Vg + 4096);
    __syncthreads();
    *(u32x4*)(lds + lw) = rk[0]; *(u32x4*)(lds + lw + 64 * NA_P) = rk[1];
    *(u32x4*)(lds + NA_KBYTES + lw) = rv[0]; *(u32x4*)(lds + NA_KBYTES + lw + 64 * NA_P) = rv[1];
    __syncthreads();
    const int krow_off = (8 * (fr >> 2) + (fr & 3)) * NA_P + fq * 16;
    const int vrow_off = fr * NA_P + (8 * fq) * 2;
    for (int st = 0; st < nsteps; ++st) {
        const char* cur = lds + (st & 1) * NA_STAGE;
        char* nxt = lds + ((st + 1) & 1) * NA_STAGE;
        if (st + 1 < nsteps) {
            const bf16_t* kg = Kg + (size_t)(st + 1) * 8192; const bf16_t* vg = Vg + (size_t)(st + 1) * 8192;
            rk[0] = *(const u32x4*)(kg); rk[1] = *(const u32x4*)(kg + 4096);
            rv[0] = *(const u32x4*)(vg); rv[1] = *(const u32x4*)(vg + 4096);
        }
#pragma unroll 1
        for (int slot = 0; slot < 2; ++slot) {
            const int kr = klo + 2 * st + slot;
            if (kr >= rsw && kr <= rsw + 7) {
                const char* cK = cur + slot * 64 * NA_P + krow_off;
                const char* cV = cur + NA_KBYTES + slot * 64 * NA_P + vrow_off;
                const float* rpr = rph + (kr - rq + 7) * 31;
                float v[4][8], mx[4];
#pragma unroll
                for (int n = 0; n < 4; ++n) {
                    const int kcstart = n == 0 ? 0 : (n == 1 ? 8 : (n == 2 ? 24 : 32));
                    const int qcol = 16 * n + fr;
                    const int qcstart = min(max(qcol - 8, 0), 48);
                    float bias[8];
#pragma unroll
                    for (int e = 0; e < 8; ++e) bias[e] = rpr[min(max(kcstart + 8 * fq + e - qcol, -15), 15) + 15];
#pragma unroll
                    for (int e = 0; e < 8; ++e) asm volatile("" : "+v"(bias[e]));
#pragma unroll
                    for (int T = 0; T < 2; ++T) {
                        const bf16x8 k0 = *(const bf16x8*)(cK + (kcstart + T * 4) * NA_P), k1 = *(const bf16x8*)(cK + (kcstart + T * 4) * NA_P + 64);
                        f32x4 s = (f32x4){0.f, 0.f, 0.f, 0.f};
                        s = __builtin_amdgcn_mfma_f32_16x16x32_bf16(k0, qf[n][0], s, 0, 0, 0);
                        s = __builtin_amdgcn_mfma_f32_16x16x32_bf16(k1, qf[n][1], s, 0, 0, 0);
#pragma unroll
                        for (int e = 0; e < 4; ++e) {
                            const int kcol = kcstart + 8 * fq + e + 4 * T;
                            const bool valid = (kcol >= qcstart) && (kcol < qcstart + 16);
                            v[n][4 * T + e] = valid ? fmaf(s[e], c1, bias[4 * T + e]) : -1e30f;
                        }
                    }
                    mx[n] = fmaxf(fmaxf(fmaxf(v[n][0], v[n][1]), fmaxf(v[n][2], v[n][3])), fmaxf(fmaxf(v[n][4], v[n][5]), fmaxf(v[n][6], v[n][7])));
                }
#pragma unroll
                for (int n = 0; n < 4; ++n) mx[n] = fmaxf(mx[n], __shfl_xor(mx[n], 16));
#pragma unroll
                for (int n = 0; n < 4; ++n) mx[n] = fmaxf(mx[n], __shfl_xor(mx[n], 32));
#pragma unroll
                for (int n = 0; n < 4; ++n) {
                    const int kcstart = n == 0 ? 0 : (n == 1 ? 8 : (n == 2 ? 24 : 32));
                    const float mnew = fmaxf(mrow[n], mx[n]);
                    const float alpha = fast_exp2(mrow[n] - mnew);
                    mrow[n] = mnew;
                    float ps = 0.f;
#pragma unroll
                    for (int e = 0; e < 8; ++e) { v[n][e] = fast_exp2(v[n][e] - mnew); ps += v[n][e]; }
                    lrow[n] = lrow[n] * alpha + ps;
                    u32x4 w;
                    w.x = cvt_pk_bf16(v[n][0], v[n][1]); w.y = cvt_pk_bf16(v[n][2], v[n][3]); w.z = cvt_pk_bf16(v[n][4], v[n][5]); w.w = cvt_pk_bf16(v[n][6], v[n][7]);
                    const bf16x8 pb = __builtin_bit_cast(bf16x8, w);
#pragma unroll
                    for (int dt = 0; dt < 4; ++dt) {
                        const bf16x8 vf = *(const bf16x8*)(cV + dt * 16 * NA_P + kcstart * 2);
                        O[n][dt] = __builtin_amdgcn_mfma_f32_16x16x32_bf16(vf, pb, O[n][dt] * alpha, 0, 0, 0);
                    }
                }
            }
        }
        if (st + 1 < nsteps) {
            *(u32x4*)(nxt + lw) = rk[0]; *(u32x4*)(nxt + lw + 64 * NA_P) = rk[1];
            *(u32x4*)(nxt + NA_KBYTES + lw) = rv[0]; *(u32x4*)(nxt + NA_KBYTES + lw + 64 * NA_P) = rv[1];
        }
        __syncthreads();
    }
    u32x2 gwv[4][4];
#pragma unroll
    for (int n = 0; n < 4; ++n)
#pragma unroll
        for (int dt = 0; dt < 4; ++dt) gwv[n][dt] = *(const u32x2*)(p.z + ZS_GATE + ((size_t)b * SEQ + rq * 64 + 16 * n + fr) * 1024 + 512 + h * 64 + 16 * dt + 4 * fq);
    __builtin_amdgcn_sched_barrier(0);
#pragma unroll
    for (int n = 0; n < 4; ++n) {
        float l = lrow[n];
        l += __shfl_xor(l, 16); l += __shfl_xor(l, 32);
        const float il = 1.0f / l;
        const size_t tokq = (size_t)b * SEQ + rq * 64 + 16 * n + fr;
#pragma unroll
        for (int dt = 0; dt < 4; ++dt) {
            const int d0 = 16 * dt + 4 * fq;
            const u32x2 gw = gwv[n][dt];
            const float o0 = O[n][dt][0] * il * silu_f(bflo(gw.x)), o1 = O[n][dt][1] * il * silu_f(bfhi(gw.x));
            const float o2 = O[n][dt][2] * il * silu_f(bflo(gw.y)), o3 = O[n][dt][3] * il * silu_f(bfhi(gw.y));
            u32x2 w; w.x = cvt_pk_bf16(o0, o1); w.y = cvt_pk_bf16(o2, o3);
            *(u32x2*)(p.o + tokq * 1024 + 512 + h * 64 + d0) = w;
        }
    }
}

__device__ void na_super(char* lds, const Params& p, int layer, int su) {
    int tid_ = threadIdx.x; asm volatile("" : "+v"(tid_)); const int tid = tid_, lane = tid & 63, wid = __builtin_amdgcn_readfirstlane(tid >> 6), fr = lane & 15, fq = lane >> 4;
    const int bh = (su & 7) * 8 + (su >> 5), g = (su >> 3) & 3, b = bh >> 3, h = bh & 7;
    const float* rph = (const float*)(lds + LDS_RPB_OFF) + h * 465;
    const float c1 = 0.125f * LOG2E;
    const int rq = 8 * g + wid, rsw = min(max(rq - 4, 0), 24);
    bf16x8 qf[4][2];
    f32x4 O[4][4];
    float mrow[4], lrow[4];
#pragma unroll
    for (int n = 0; n < 4; ++n) {
#pragma unroll
        for (int t = 0; t < 2; ++t) qf[n][t] = *(const bf16x8*)(p.z + ZS_QN + ((size_t)(bh * 2048 + rq * 64 + 16 * n + fr)) * 64 + t * 32 + fq * 8);
#pragma unroll
        for (int dt = 0; dt < 4; ++dt) O[n][dt] = (f32x4){0.f, 0.f, 0.f, 0.f};
        lrow[n] = 0.f;
        {
            const u32x4 k0 = *(const u32x4*)(p.z + ZS_KN + ((size_t)(bh * 2048 + rq * 64 + 16 * n + fr)) * 64 + fq * 8);
            const u32x4 k1 = *(const u32x4*)(p.z + ZS_KN + ((size_t)(bh * 2048 + rq * 64 + 16 * n + fr)) * 64 + 32 + fq * 8);
            const u32x4 q0 = __builtin_bit_cast(u32x4, qf[n][0]), q1 = __builtin_bit_cast(u32x4, qf[n][1]);
            float d = 0.f;
#pragma unroll
            for (int w = 0; w < 4; ++w) { d += bflo(q0[w]) * bflo(k0[w]) + bfhi(q0[w]) * bfhi(k0[w]); d += bflo(q1[w]) * bflo(k1[w]) + bfhi(q1[w]) * bfhi(k1[w]); }
            d += __shfl_xor(d, 16); d += __shfl_xor(d, 32);
            mrow[n] = -d;
        }
    }
    const int klo = min(max(8 * g - 4, 0), 24);
    const int nsteps = (g == 0 || g == 3) ? 6 : 8;
    const bf16_t* Kg = p.z + ZS_KN + ((size_t)(bh * 2048 + klo * 64)) * 64 + tid * 8;
    const bf16_t* Vg = p.vT + VS_VN + ((size_t)((bh * 32 + klo) * 64)) * 64 + tid * 8;
    const int lw = (tid >> 3) * NA_P + (tid & 7) * 16;
    u32x4 rk[2], rv[2];
    rk[0] = *(const u32x4*)(Kg); rk[1] = *(const u32x4*)(Kg + 4096);
    rv[0] = *(const u32x4*)(Vg); rv[1] = *(const u32x4*)(Vg + 4096);
    __syncthreads();
    *(u32x4*)(lds + lw) = rk[0]; *(u32x4*)(lds + lw + 64 * NA_P) = rk[1];
    *(u32x4*)(lds + NA_KBYTES + lw) = rv[0]; *(u32x4*)(lds + NA_KBYTES + lw + 64 * NA_P) = rv[1];
    __syncthreads();
    const int krow_off = (8 * (fr >> 2) + (fr & 3)) * NA_P + fq * 16;
    const int vrow_off = fr * NA_P + (8 * fq) * 2;
    for (int st = 0; st < nsteps; ++st) {
        const char* cur = lds + (st & 1) * NA_STAGE;
        char* nxt = lds + ((st + 1) & 1) * NA_STAGE;
        if (st + 1 < nsteps) {
            const bf16_t* kg = Kg + (size_t)(st + 1) * 8192; const bf16_t* vg = Vg + (size_t)(st + 1) * 8192;
            rk[0] = *(const u32x4*)(kg); rk[1] = *(const u32x4*)(kg + 4096);
            rv[0] = *(const u32x4*)(vg); rv[1] = *(const u32x4*)(vg + 4096);
        }
#pragma unroll 1
        for (int slot = 0; slot < 2; ++slot) {
            const int kr = klo + 2 * st + slot;
            if (kr >= rsw && kr <= rsw + 7) {
                const char* cK = cur + slot * 64 * NA_P + krow_off;
                const char* cV = cur + NA_KBYTES + slot * 64 * NA_P + vrow_off;
                const float* rpr = rph + (kr - rq + 7) * 31;
                float v[4][8];
#pragma unroll
                for (int n = 0; n < 4; ++n) {
                    const int kcstart = n == 0 ? 0 : (n == 1 ? 8 : (n == 2 ? 24 : 32));
                    const int qcol = 16 * n + fr;
                    const float* bp = rpr + (kcstart + 8 * fq - qcol + 15);
#pragma unroll
                    for (int e = 0; e < 8; ++e) v[n][e] = bp[e];
                }
#pragma unroll
                for (int n = 0; n < 4; ++n)
#pragma unroll
                    for (int e = 0; e < 8; ++e) asm volatile("" : "+v"(v[n][e]));
#pragma unroll
                for (int np = 0; np < 2; ++np) {
                    bf16x8 kfr[2][4];
#pragma unroll
                    for (int q = 0; q < 2; ++q) {
                        const int n = 2 * np + q;
                        const int kcstart = n == 0 ? 0 : (n == 1 ? 8 : (n == 2 ? 24 : 32));
#pragma unroll
                        for (int T = 0; T < 2; ++T) { kfr[q][2 * T] = *(const bf16x8*)(cK + (kcstart + T * 4) * NA_P); kfr[q][2 * T + 1] = *(const bf16x8*)(cK + (kcstart + T * 4) * NA_P + 64); }
                    }
#pragma unroll
                    for (int q = 0; q < 2; ++q) {
                        const int n = 2 * np + q;
                        const int kcstart = n == 0 ? 0 : (n == 1 ? 8 : (n == 2 ? 24 : 32));
                        const int qcol = 16 * n + fr;
                        const int qcstart = min(max(qcol - 8, 0), 48);
#pragma unroll
                        for (int T = 0; T < 2; ++T) {
                            f32x4 s = (f32x4){mrow[n], mrow[n], mrow[n], mrow[n]};
                            s = __builtin_amdgcn_mfma_f32_16x16x32_bf16(kfr[q][2 * T], qf[n][0], s, 0, 0, 0);
                            s = __builtin_amdgcn_mfma_f32_16x16x32_bf16(kfr[q][2 * T + 1], qf[n][1], s, 0, 0, 0);
#pragma unroll
                            for (int e = 0; e < 4; ++e) {
                                const int kcol = kcstart + 8 * fq + e + 4 * T;
                                const bool valid = (kcol >= qcstart) && (kcol < qcstart + 16);
                                v[n][4 * T + e] = valid ? fmaf(s[e], c1, v[n][4 * T + e]) : -1e30f;
                            }
                        }
                    }
                }
#pragma unroll
                for (int n = 0; n < 4; ++n) {
                    const int kcstart = n == 0 ? 0 : (n == 1 ? 8 : (n == 2 ? 24 : 32));
                    float ps = 0.f;
#pragma unroll
                    for (int e = 0; e < 8; ++e) { v[n][e] = fast_exp2(v[n][e]); ps += v[n][e]; }
                    lrow[n] += ps;
                    u32x4 w;
                    w.x = cvt_pk_bf16(v[n][0], v[n][1]); w.y = cvt_pk_bf16(v[n][2], v[n][3]); w.z = cvt_pk_bf16(v[n][4], v[n][5]); w.w = cvt_pk_bf16(v[n][6], v[n][7]);
                    const bf16x8 pb = __builtin_bit_cast(bf16x8, w);
#pragma unroll
                    for (int dt = 0; dt < 4; ++dt) {
                        const bf16x8 vf = *(const bf16x8*)(cV + dt * 16 * NA_P + kcstart * 2);
                        O[n][dt] = __builtin_amdgcn_mfma_f32_16x16x32_bf16(vf, pb, O[n][dt], 0, 0, 0);
                    }
                }
            }
        }
        if (st + 1 < nsteps) {
            *(u32x4*)(nxt + lw) = rk[0]; *(u32x4*)(nxt + lw + 64 * NA_P) = rk[1];
            *(u32x4*)(nxt + NA_KBYTES + lw) = rv[0]; *(u32x4*)(nxt + NA_KBYTES + lw + 64 * NA_P) = rv[1];
        }
        __syncthreads();
    }
    int bad = 0;
#pragma unroll
    for (int n = 0; n < 4; ++n) { lrow[n] += __shfl_xor(lrow[n], 16); lrow[n] += __shfl_xor(lrow[n], 32); bad |= !(lrow[n] < 1e30f); }
    {
        volatile unsigned* bflag = (volatile unsigned*)(lds + LDS_PHASE_BYTES + 8);
        if (tid == 0) *bflag = 0u;
        __syncthreads();
        if (__any(bad) && lane == 0) *bflag = 1u;
        __syncthreads();
        if (*bflag != 0u) { if (tid == 0) *(volatile unsigned*)(lds + LDS_PHASE_BYTES + 12) = 1u; return; }
    }
    u32x2 gwv[4][4];
#pragma unroll
    for (int n = 0; n < 4; ++n)
#pragma unroll
        for (int dt = 0; dt < 4; ++dt) gwv[n][dt] = *(const u32x2*)(p.z + ZS_GATE + ((size_t)b * SEQ + rq * 64 + 16 * n + fr) * 1024 + 512 + h * 64 + 16 * dt + 4 * fq);
    __builtin_amdgcn_sched_barrier(0);
#pragma unroll
    for (int n = 0; n < 4; ++n) {
        const float l = lrow[n];
        const float il = 1.0f / l;
        const size_t tokq = (size_t)b * SEQ + rq * 64 + 16 * n + fr;
#pragma unroll
        for (int dt = 0; dt < 4; ++dt) {
            const int d0 = 16 * dt + 4 * fq;
            const u32x2 gw = gwv[n][dt];
            const float o0 = O[n][dt][0] * il * silu_f(bflo(gw.x)), o1 = O[n][dt][1] * il * silu_f(bfhi(gw.x));
            const float o2 = O[n][dt][2] * il * silu_f(bflo(gw.y)), o3 = O[n][dt][3] * il * silu_f(bfhi(gw.y));
            u32x2 w; w.x = cvt_pk_bf16(o0, o1); w.y = cvt_pk_bf16(o2, o3);
            *(u32x2*)(p.o + tokq * 1024 + 512 + h * 64 + d0) = w;
        }
    }
}

__global__ void __launch_bounds__(NTHREADS) fwd_megakernel(Params p) {
    extern __shared__ __attribute__((aligned(16))) char lds[];
    if (p.never) cg::this_grid().sync();
    volatile LAS unsigned* st = (volatile LAS unsigned*)(lds + LDS_PHASE_BYTES);
    if (threadIdx.x < 4) st[threadIdx.x] = 0u;
    __syncthreads();
    const XcdBarrier gb = xcd_barrier_post(p.bar, st);
    prologue_phase(lds, p);
    xcd_barrier(gb);
    for (int layer = 0; layer < DEPTH; ++layer) {
        for (int rep = 0; rep < REP_GEMM0; ++rep) {
        { pg8::Gemm g{p.xb, p.wi_t + (size_t)layer * 4096 * 1024, NTOK, IN_W, 1024}; pg8::StaticOrder S; S.init(NTOK, IN_W, (int)gridDim.x, (int)blockIdx.x);
          pg8::EpiZ E{p.z, p.vT, p.rss};
          pg8::gemm_phase<pg8::EpiZ, pg8::StaticOrder, true, true>((PG8_LAS unsigned char*)lds, g, S, E); }
        xcd_barrier(gb);
        }
        { int t0_ = threadIdx.x; asm volatile("" : "+v"(t0_));
          for (int i = t0_; i < 8 * 465; i += NTHREADS) ((float*)(lds + LDS_RPB_OFF))[i] = p.rpb[(size_t)layer * 8 * 465 + i] * LOG2E;
          if (t0_ == 0) *(volatile unsigned*)(lds + LDS_PHASE_BYTES + 12) = 0u; }
        __syncthreads();
        for (int rep = 0; rep < REP_ATT; ++rep) {
        for (int u = blockIdx.x; u < 512 + 256; u += gridDim.x) {
            if (u < 512) { if (rep < REP_DA) da_unit(lds, p, layer, u); } else { if (rep < REP_NA) na_super(lds, p, layer, u - 512); }
        }
        __syncthreads();
        if (*(volatile unsigned*)(lds + LDS_PHASE_BYTES + 12) != 0u) {
            for (int u = blockIdx.x; u < 512 + 256; u += gridDim.x) if (u >= 512) na_super_online(lds, p, layer, u - 512);
        }
        xcd_barrier(gb);
        }
        { pg8::Gemm g{p.o, p.wo_t + (size_t)layer * 1024 * 1024, NTOK, 1024, 1024}; pg8::StaticOrder S; S.init(NTOK, 1024, (int)gridDim.x, (int)blockIdx.x);
          if (layer + 1 < DEPTH) { pg8::EpiRes<true> E{layer == 0 ? p.x : p.xf, p.xf, p.xb, p.rss};
            pg8::gemm_phase<pg8::EpiRes<true>, pg8::StaticOrder, true, true>((PG8_LAS unsigned char*)lds, g, S, E); }
          else if (gridDim.x == 256) { pg8::EpiFinal E{p.xf, p.xf, p.final_g, p.rss, p.bar + XCD_BAR_WORDS};
            pg8::gemm_phase<pg8::EpiFinal, pg8::StaticOrder, false, true>((PG8_LAS unsigned char*)lds, g, S, E); return; }
          else { pg8::EpiRes<false> E{p.xf, p.xf, p.xb, p.rss};
            pg8::gemm_phase<pg8::EpiRes<false>, pg8::StaticOrder, true, true>((PG8_LAS unsigned char*)lds, g, S, E); } }
        xcd_barrier(gb);
    }
    final_phase(p);
}

constexpr size_t LDS_BYTES = LDS_RPB_OFF + LDS_RPB_BYTES;

extern "C" void kernel_launch(void* const* d_in, const int* in_sizes, int n_in, void* d_out, int out_size, void* d_ws, size_t ws_size, hipStream_t stream) {
    static int grid_blocks = 0;
    if (!grid_blocks) {
        int dev = 0, cus = 0, per_cu = 0;
        hipGetDevice(&dev);
        hipDeviceGetAttribute(&cus, hipDeviceAttributeMultiprocessorCount, dev);
        hipFuncSetAttribute((const void*)fwd_megakernel, hipFuncAttributeMaxDynamicSharedMemorySize, (int)LDS_BYTES);
        hipOccupancyMaxActiveBlocksPerMultiprocessor(&per_cu, fwd_megakernel, NTHREADS, LDS_BYTES);
        if (per_cu < 1) per_cu = 1;
        if (per_cu > 1) per_cu = 1;
        grid_blocks = cus * per_cu;
    }
    Params p{};
    p.x = (const float*)d_in[0]; p.norm_g = (const float*)d_in[1]; p.w_in = (const float*)d_in[2]; p.w_out = (const float*)d_in[3];
    p.lq1 = (const float*)d_in[4]; p.lk1 = (const float*)d_in[5]; p.lq2 = (const float*)d_in[6]; p.lk2 = (const float*)d_in[7];
    p.subln_g = (const float*)d_in[8]; p.rpb = (const float*)d_in[9]; p.final_g = (const float*)d_in[10];
    p.xf = (float*)d_out;
    char* w = (char*)d_ws; size_t off = 0;
    auto take = [&](size_t bytes) { char* r = w + off; off += (bytes + 255) & ~(size_t)255; return r; };
    p.wi_t = (bf16_t*)take((size_t)DEPTH * 4096 * 1024 * 2);
    p.wo_t = (bf16_t*)take((size_t)DEPTH * 1024 * 1024 * 2);
    p.xb = (bf16_t*)take((size_t)NTOK * 1024 * 2);
    p.rss = (float*)take((size_t)NTOK * 16 * 4);
    p.z = (bf16_t*)take((size_t)NTOK * ZP * 2);
    p.vT = (bf16_t*)take((size_t)BATCH * 1024 * SEQ * 2);
    p.o = (bf16_t*)take((size_t)NTOK * 1024 * 2);
    p.bar = (unsigned*)take((size_t)(XCD_BAR_WORDS + 64 * 64) * 4);
    (void)hipMemsetAsync(p.bar, 0, (size_t)(XCD_BAR_WORDS + 64 * 64) * 4, stream);
    for (int l = 0; l < DEPTH; ++l) p.lam_init[l] = (float)(0.8 - 0.6 * exp(-0.3 * (double)l));
    void* args[] = {&p};
    hipError_t e = hipLaunchCooperativeKernel((const void*)fwd_megakernel, dim3(grid_blocks), dim3(NTHREADS), args, LDS_BYTES, stream);
    if (e != hipSuccess) fprintf(stderr, "cooperative launch failed: %s (grid %d)\n", hipGetErrorString(e), grid_blocks);
}
```

```cpp
#include <hip/hip_runtime.h>
#include <hip/hip_cooperative_groups.h>
#include <cstdio>
#include <cstdint>
namespace cg = cooperative_groups;

typedef unsigned short bf16_t;
typedef short bf16x8 __attribute__((ext_vector_type(8)));
typedef float f32x4 __attribute__((ext_vector_type(4)));
typedef float f32x16 __attribute__((ext_vector_type(16)));
typedef unsigned u32x4 __attribute__((ext_vector_type(4)));
typedef unsigned u32x2 __attribute__((ext_vector_type(2)));

constexpr int D_MODEL = 1024, BATCH = 8, SEQ = 2048, DEPTH = 4, NTOK = BATCH * SEQ;
constexpr int IN_W = 4096;
constexpr size_t ZS_QD = 0, ZS_KD = (size_t)NTOK * 512, ZS_QN = (size_t)NTOK * 1024, ZS_KN = (size_t)NTOK * 1536, ZS_GATE = (size_t)NTOK * 2048;
constexpr size_t VS_VD = 0, VS_VN = (size_t)NTOK * 512;
constexpr int ZP = 3072;
constexpr float RMS_EPS = 1e-6f;
constexpr float LOG2E = 1.4426950408889634f;
constexpr int NTHREADS = 512;
#ifndef REP_GEMM0
#define REP_GEMM0 1
#endif
#ifndef REP_DA
#define REP_DA 1
#endif
#ifndef REP_NA
#define REP_NA 1
#endif
#define REP_ATT (REP_DA > REP_NA ? REP_DA : REP_NA)

struct Params {
    const float* x; const float* norm_g; const float* w_in; const float* w_out;
    const float* lq1; const float* lk1; const float* lq2; const float* lk2;
    const float* subln_g; const float* rpb; const float* final_g;
    float* xf;
    bf16_t* wi_t;
    bf16_t* wo_t;
    bf16_t* xb;
    float* rss;
    bf16_t* z;
    bf16_t* vT;
    bf16_t* o;
    unsigned* bar;
    float lam_init[DEPTH];
    int never;
    int pad_;
};

typedef __bf16 bf16x2_t __attribute__((ext_vector_type(2)));
typedef float f32x2_t __attribute__((ext_vector_type(2)));
__device__ __forceinline__ unsigned cvt_pk_bf16(float lo, float hi) {
    const f32x2_t v = {lo, hi};
    return __builtin_bit_cast(unsigned, __builtin_convertvector(v, bf16x2_t));
}
__device__ __forceinline__ float bf2f(unsigned short b) { return __uint_as_float(((unsigned)b) << 16); }
__device__ __forceinline__ float bflo(unsigned w) { return __uint_as_float(w << 16); }
__device__ __forceinline__ float bfhi(unsigned w) { return __uint_as_float(w & 0xffff0000u); }
__device__ __forceinline__ float fast_exp2(float x) { return __builtin_amdgcn_exp2f(x); }


#define XB_TMO      128
#define XB_XCNT(j)  (256  + 64 * (j))
#define XB_XSUB(j)  (1280 + 64 * (j))
#define XB_XGEN(j)  (2304 + 64 * (j))
#define XB_TOP      3328
#define XB_TOPGEN   3392
#define XCD_BAR_WORDS 3456
#define XB_SPIN_CAP (1u << 20)
#define LAS __attribute__((address_space(3)))
__device__ __forceinline__ unsigned xb_ld(unsigned* p)              { return __hip_atomic_load(p, __ATOMIC_RELAXED, __HIP_MEMORY_SCOPE_AGENT); }
__device__ __forceinline__ unsigned xb_add(unsigned* p, unsigned v) { return __hip_atomic_fetch_add(p, v, __ATOMIC_RELAXED, __HIP_MEMORY_SCOPE_AGENT); }
__device__ __forceinline__ unsigned xb_xcc_id() { return (unsigned)__builtin_amdgcn_s_getreg((3 << 11) | 20) & 0xFu; }
#define XB_SPIN(cond, bar) do { unsigned _sp = 0; while (cond) { __builtin_amdgcn_s_sleep(1); \
    if ((++_sp & 255u) == 0u) { if (xb_ld(&(bar)[XB_TMO])) break; if (_sp > XB_SPIN_CAP) { atomicAdd(&(bar)[XB_TMO], 1u); break; } } } } while (0)
struct XcdBarrier { unsigned* bar; unsigned x; volatile LAS unsigned* st; };
__device__ __forceinline__ XcdBarrier xcd_barrier_post(unsigned* bar, volatile LAS unsigned* st) {
    XcdBarrier b; b.bar = bar; b.x = xb_xcc_id(); b.st = st;
    if (threadIdx.x == 0) (void)xb_add(&bar[XB_XCNT(b.x)], 1u);
    return b;
}
__device__ __forceinline__ void xcd_barrier_complete(unsigned* bar, unsigned x, unsigned& nloc, unsigned& nx) {
    const unsigned G = gridDim.x * gridDim.y * gridDim.z;
    unsigned sum, cnt, mine, sp = 0u;
    for (;;) {
        sum = 0u; cnt = 0u; mine = 0u;
#pragma unroll
        for (unsigned j = 0; j < 16; ++j) { const unsigned c = xb_ld(&bar[XB_XCNT(j)]); sum += c; cnt += (c > 0u) ? 1u : 0u; mine = (j == x) ? c : mine; }
        if (sum == G) break;
        __builtin_amdgcn_s_sleep(1);
        if ((++sp & 255u) == 0u) { if (xb_ld(&bar[XB_TMO])) break; if (sp > XB_SPIN_CAP) { atomicAdd(&bar[XB_TMO], 1u); break; } }
    }
    nloc = mine > 0u ? mine : 1u; nx = cnt > 0u ? cnt : 1u;
}
__device__ __forceinline__ void xcd_barrier(const XcdBarrier& b) {
    asm volatile("s_waitcnt vmcnt(0)" ::: "memory");
    __syncthreads();
    if (threadIdx.x == 0) {
        unsigned* bar = b.bar;
        unsigned bx = b.x; asm volatile("" : "+s"(bx));
        __builtin_amdgcn_s_waitcnt(0);
        unsigned nloc = b.st[0], nx = b.st[1];
        if (nloc == 0u) { xcd_barrier_complete(bar, bx, nloc, nx); b.st[0] = nloc; b.st[1] = nx; }
        const unsigned old = xb_add(&bar[XB_XSUB(bx)], 1u);
        const unsigned gen = old / nloc;
        if (old + 1u == (gen + 1u) * nloc) {
            __builtin_amdgcn_fence(__ATOMIC_RELEASE, "agent");
            asm volatile("s_waitcnt vmcnt(0)" ::: "memory");
            const unsigned og = xb_add(&bar[XB_TOP], 1u);
            const unsigned tg = og / nx;
            if (og + 1u == (tg + 1u) * nx) xb_add(&bar[XB_TOPGEN], 1u);
            else XB_SPIN(xb_ld(&bar[XB_TOPGEN]) == tg, bar);
            __builtin_amdgcn_fence(__ATOMIC_ACQUIRE, "agent");
            xb_add(&bar[XB_XGEN(bx)], 1u);
            asm volatile("s_waitcnt vmcnt(0)" ::: "memory");
        } else {
            XB_SPIN(xb_ld(&bar[XB_XGEN(bx)]) == gen, bar);
            __builtin_amdgcn_fence(__ATOMIC_ACQUIRE, "agent");
            asm volatile("s_waitcnt vmcnt(0)" ::: "memory");
        }
    }
    __syncthreads();
}

__device__ __forceinline__ int perm_col(int n) {
    if (n < 1024) return n;
    if (n < 2048) return n + 512;
    if (n < 3072) return n + 1024;
    if (n < 3584) return n - 2048;
    return n - 1024;
}

__device__ void prologue_phase(char* lds, const Params& p) {
    int tid_ = threadIdx.x; asm volatile("" : "+v"(tid_)); const int tid = tid_, lane = tid & 63, wid = tid >> 6;
    float* tile = (float*)lds;
    const int nt_in = DEPTH * 16 * 64, nt_out = DEPTH * 16 * 16;
    for (int t = blockIdx.x; t < nt_in + nt_out; t += gridDim.x) {
        const float* W; bf16_t* Wt; const float* g; int N, k0, n0, no0;
        if (t < nt_in) {
            const int l = t >> 10, rem = t & 1023; k0 = (rem >> 6) * 64; n0 = (rem & 63) * 64;
            W = p.w_in + (size_t)l * 1024 * 4096; N = 4096; Wt = p.wi_t + (size_t)l * 4096 * 1024; g = p.norm_g + l * 1024; no0 = perm_col(n0);
        } else {
            const int t2 = t - nt_in; const int l = t2 >> 8, rem = t2 & 255; k0 = (rem >> 4) * 64; n0 = (rem & 15) * 64;
            W = p.w_out + (size_t)l * 1024 * 1024; N = 1024; Wt = p.wo_t + (size_t)l * 1024 * 1024; g = nullptr; no0 = n0;
        }
        {
            const int i = tid >> 4, j4 = tid & 15;
#pragma unroll
            for (int ps = 0; ps < 2; ++ps) {
                const int kk = i + 32 * ps;
                const f32x4 v = *(const f32x4*)(W + (size_t)(k0 + kk) * N + no0 + 4 * j4);
                const float gg = g ? g[k0 + kk] : 1.0f;
                tile[kk * 65 + 4 * j4 + 0] = v[0] * gg; tile[kk * 65 + 4 * j4 + 1] = v[1] * gg;
                tile[kk * 65 + 4 * j4 + 2] = v[2] * gg; tile[kk * 65 + 4 * j4 + 3] = v[3] * gg;
            }
        }
        __syncthreads();
        {
            const int j = tid >> 3, i8 = tid & 7;
            float v[8];
#pragma unroll
            for (int e = 0; e < 8; ++e) v[e] = tile[(8 * i8 + e) * 65 + j];
            u32x4 w; w.x = cvt_pk_bf16(v[0], v[1]); w.y = cvt_pk_bf16(v[2], v[3]); w.z = cvt_pk_bf16(v[4], v[5]); w.w = cvt_pk_bf16(v[6], v[7]);
            *(u32x4*)(Wt + (size_t)(n0 + j) * 1024 + k0 + 8 * i8) = w;
        }
        __syncthreads();
    }
    for (int row = blockIdx.x * 8 + wid; row < NTOK; row += gridDim.x * 8) {
        float ss = 0.f;
#pragma unroll
        for (int i = 0; i < 4; ++i) {
            const int c = 4 * lane + 256 * i;
            const f32x4 v = *(const f32x4*)(p.x + (size_t)row * 1024 + c);
            ss += v[0] * v[0] + v[1] * v[1] + v[2] * v[2] + v[3] * v[3];
            u32x2 w; w.x = cvt_pk_bf16(v[0], v[1]); w.y = cvt_pk_bf16(v[2], v[3]);
            *(u32x2*)(p.xb + (size_t)row * 1024 + c) = w;
        }
#pragma unroll
        for (int s = 32; s >= 1; s >>= 1) ss += __shfl_xor(ss, s);
        if (lane < 16) p.rss[(size_t)row * 16 + lane] = lane == 0 ? ss : 0.f;
    }
}

__device__ void final_phase(const Params& p) {
    int tid_ = threadIdx.x; asm volatile("" : "+v"(tid_)); const int tid = tid_, lane = tid & 63, wid = tid >> 6;
    for (int row = blockIdx.x * 8 + wid; row < NTOK; row += gridDim.x * 8) {
        float ss = 0.f;
        if (lane < 16) ss = p.rss[(size_t)row * 16 + lane];
#pragma unroll
        for (int s = 8; s >= 1; s >>= 1) ss += __shfl_xor(ss, s);
        ss = __shfl(ss, 0);
        const float rstd = rsqrtf(ss * (1.0f / 1024.0f) + RMS_EPS);
#pragma unroll
        for (int i = 0; i < 4; ++i) {
            const int c = 4 * lane + 256 * i;
            f32x4 v = *(const f32x4*)(p.xf + (size_t)row * 1024 + c);
            const f32x4 g = *(const f32x4*)(p.final_g + c);
            v = v * rstd * g;
            *(f32x4*)(p.xf + (size_t)row * 1024 + c) = v;
        }
    }
}

namespace pg8 {
#define PG8_LAS __attribute__((address_space(3)))
typedef unsigned short bf16_t;
typedef short bf16x8 __attribute__((ext_vector_type(8)));
typedef float f32x4 __attribute__((ext_vector_type(4)));
typedef unsigned u32x4 __attribute__((ext_vector_type(4)));
constexpr int BM = 256, BK = 64, HALF = 128, HTB = HALF * BK * 2  , STAGE_BYTES = 8 * HTB, NXCD = 8, WGM = 8;

__host__ __device__ __forceinline__ int lds_byte(int r, int c) { const int st = (r >> 4) * 2 + (c >> 5), rr = r & 15, cc = c & 31, ob = rr * 64 + cc * 2; return st * 1024 + (ob ^ (((ob >> 9) & 1) << 5)); }
__host__ __device__ __forceinline__ void stage_rc(int b, int& R, int& C) { const int st = b / 1024, sb = b % 1024, swz = sb ^ (((sb >> 9) & 1) << 5); R = (st >> 1) * 16 + swz / 64; C = (st & 1) * 32 + (swz % 64) / 2; }
__host__ __device__ __forceinline__ int perm32(int rho) { const int n = rho >> 4, i = rho & 15; return 8 * (i >> 2) + 4 * n + (i & 3); }

struct Unit { int pm, pn; };
struct Gemm { const bf16_t* A; const bf16_t* Bt; int M, N, K; };

struct StaticOrder {
    int nM, nN, nwg, G, c;
    __host__ __device__ void init(int M, int N, int G_, int c_) { nM = M / BM; nN = N / BM; nwg = nM * nN; G = G_; c = c_; }
    __host__ __device__ bool next(int i, Unit& u) const {
        const long L = (long)i * G + c; if (L >= nwg) return false;
        int wgid = (int)L; { const int q = nwg / NXCD, r = nwg % NXCD, xcd = wgid % NXCD, off = wgid / NXCD; wgid = (xcd < r ? xcd * (q + 1) : r * (q + 1) + (xcd - r) * q) + off; }
        const int nig = WGM * nN, gid = wgid / nig, fm = gid * WGM, gsz = (nM - fm) < WGM ? (nM - fm) : WGM;
        u.pm = fm + ((wgid % nig) % gsz); u.pn = (wgid % nig) / gsz; return true;
    }
    __device__ __forceinline__ void a_ready(const Unit&) const {}
    __device__ __forceinline__ void done(const Unit&) const {}
};


template <class Epi, class Sched, bool ALIGN_EPI = false, bool SP2 = false>
__device__ __forceinline__ void gemm_phase(PG8_LAS unsigned char* lds, const Gemm g, const Sched& S, const Epi& E) {
    int tid_ = threadIdx.x; asm volatile("" : "+v"(tid_));
    const int tid = tid_, wid = __builtin_amdgcn_readfirstlane(tid >> 6), lane = tid & 63, wr = wid >> 2, wc = wid & 3, fr = lane & 15, fq = lane >> 4;
    const int K = g.K, nt = K / BK;
    unsigned voffA[2], voffB[2];
#pragma unroll
    for (int i = 0; i < 2; ++i) { int R, C; stage_rc(tid * 16 + i * 8192, R, C); const int Rb = Epi::PERM ? ((R & ~31) + perm32(R & 31)) : R;
        voffA[i] = (unsigned)(R * K + C) * 2u; voffB[i] = (unsigned)(Rb * K + C) * 2u; }
    const size_t kstep = (size_t)(BK * 2);
    const size_t hstep = (size_t)HALF * K * 2;
    const size_t tstep = 2 * hstep;
    const unsigned ldsw = (unsigned)wid * 1024u;
    const int aoff = lds_byte(wr * 64 + fr, fq * 8), boff = lds_byte(wc * 32 + fr, fq * 8);
#define PG8_SA(b, h) (((b) * 2 + (h)) * HTB)
#define PG8_SB(b, h) ((4 + (b) * 2 + (h)) * HTB)
#define PG8_STAGE(bufoff, gbase, voff) do { _Pragma("unroll") for (int _i = 0; _i < 2; ++_i) \
        __builtin_amdgcn_global_load_lds((const unsigned*)((const char*)(gbase) + (voff)[_i]), (PG8_LAS unsigned*)(lds + (bufoff) + ldsw + _i * 8192), 16, 0, 0); } while (0)
#define PG8_LDA(dst, b, h) do { _Pragma("unroll") for (int m = 0; m < 4; ++m) _Pragma("unroll") for (int k = 0; k < 2; ++k) dst[m][k] = *(const PG8_LAS bf16x8*)(lds + PG8_SA(b, h) + aoff + m * 2048 + k * 1024); } while (0)
#define PG8_LDB(dst, b, h) do { _Pragma("unroll") for (int n = 0; n < 2; ++n) _Pragma("unroll") for (int k = 0; k < 2; ++k) dst[n][k] = *(const PG8_LAS bf16x8*)(lds + PG8_SB(b, h) + boff + n * 2048 + k * 1024); } while (0)
#define PG8_MMA(ai, bj, At, Bt) do { __builtin_amdgcn_s_setprio(1); _Pragma("unroll") for (int m = 0; m < 4; ++m) _Pragma("unroll") for (int n = 0; n < 2; ++n) _Pragma("unroll") for (int k = 0; k < 2; ++k) \
        acc[ai][bj][m][n] = __builtin_amdgcn_mfma_f32_16x16x32_bf16(Bt[n][k], At[m][k], acc[ai][bj][m][n], 0, 0, 0); __builtin_amdgcn_s_setprio(0); } while (0)
#define PG8_WAIT_V(n) asm volatile("s_waitcnt vmcnt(" #n ")" ::: "memory")
#define PG8_WAIT_L(n) asm volatile("s_waitcnt lgkmcnt(" #n ")" ::: "memory")
#define PG8_BAR __builtin_amdgcn_s_barrier()
#define PG8_SCHED __builtin_amdgcn_sched_barrier(0)
    Unit cur, nxt; int ui = 0;
    if (!S.next(0, cur)) return;
    f32x4 acc[2][2][4][2];
#pragma unroll
    for (int a = 0; a < 2; ++a)
#pragma unroll
        for (int b = 0; b < 2; ++b)
#pragma unroll
            for (int m = 0; m < 4; ++m)
#pragma unroll
                for (int n = 0; n < 2; ++n) acc[a][b][m][n] = (f32x4){0.f, 0.f, 0.f, 0.f};
    bf16x8 At[4][2], B0[2][2], B1[2][2];
    const char* cA = (const char*)g.A + (size_t)cur.pm * tstep; const char* cB = (const char*)g.Bt + (size_t)cur.pn * tstep;
    S.a_ready(cur);
    if constexpr (SP2) {
        PG8_STAGE(PG8_SB(0, 0), cB, voffB); PG8_STAGE(PG8_SB(0, 1), cB + hstep, voffB); PG8_STAGE(PG8_SA(0, 0), cA, voffA); PG8_STAGE(PG8_SA(0, 1), cA + hstep, voffA);
        if (wr == 1) PG8_BAR;
        PG8_WAIT_V(2); PG8_BAR;
        PG8_STAGE(PG8_SB(1, 0), cB + kstep, voffB); PG8_STAGE(PG8_SA(1, 0), cA + kstep, voffA); PG8_STAGE(PG8_SB(1, 1), cB + hstep + kstep, voffB);
        PG8_WAIT_V(6); PG8_BAR;
    } else {
        PG8_STAGE(PG8_SB(0, 0), cB, voffB); PG8_STAGE(PG8_SA(0, 0), cA, voffA); PG8_STAGE(PG8_SB(0, 1), cB + hstep, voffB); PG8_STAGE(PG8_SA(0, 1), cA + hstep, voffA);
        if (wr == 1) PG8_BAR;
        PG8_WAIT_V(4); PG8_BAR;
        PG8_STAGE(PG8_SB(1, 0), cB + kstep, voffB); PG8_STAGE(PG8_SA(1, 0), cA + kstep, voffA); PG8_STAGE(PG8_SB(1, 1), cB + hstep + kstep, voffB);
        PG8_WAIT_V(6); PG8_BAR;
    }
    for (;;) {
        const bool has_next = S.next(ui + 1, nxt);
        const char* nA = has_next ? (const char*)g.A + (size_t)nxt.pm * tstep : cA; const char* nB = has_next ? (const char*)g.Bt + (size_t)nxt.pn * tstep : cB;
        for (int t = 0; t < nt; t += 2) {
            const bool last = (t == nt - 2);
            const char* a1 = cA + (size_t)(t + 1) * kstep;
            const char* a2 = last ? nA : cA + (size_t)(t + 2) * kstep; const char* b2 = last ? nB : cB + (size_t)(t + 2) * kstep;
            const char* a3 = a2 + kstep; const char* b3 = b2 + kstep;
            if (last && has_next) S.a_ready(nxt);
            if constexpr (SP2) {
            PG8_LDB(B0, 0, 0); PG8_LDB(B1, 0, 1); PG8_SCHED; PG8_LDA(At, 0, 0); PG8_STAGE(PG8_SA(1, 1), a1 + hstep, voffA);
            PG8_WAIT_V(8); PG8_WAIT_L(0); PG8_BAR; PG8_MMA(0, 0, At, B0); PG8_MMA(0, 1, At, B1); PG8_BAR; PG8_SCHED;
            PG8_LDA(At, 0, 1); PG8_STAGE(PG8_SB(0, 0), b2, voffB); PG8_STAGE(PG8_SB(0, 1), b2 + hstep, voffB); PG8_STAGE(PG8_SA(0, 0), a2, voffA);
            PG8_WAIT_V(8); PG8_WAIT_L(0); PG8_BAR; PG8_MMA(1, 0, At, B0); PG8_MMA(1, 1, At, B1); PG8_BAR; PG8_SCHED;
            PG8_LDB(B0, 1, 0); PG8_LDB(B1, 1, 1); PG8_SCHED; PG8_LDA(At, 1, 0); PG8_STAGE(PG8_SA(0, 1), a2 + hstep, voffA);
            PG8_WAIT_V(8); PG8_WAIT_L(0); PG8_BAR; PG8_MMA(0, 0, At, B0); PG8_MMA(0, 1, At, B1); PG8_BAR; PG8_SCHED;
            PG8_LDA(At, 1, 1); PG8_STAGE(PG8_SB(1, 0), b3, voffB); PG8_STAGE(PG8_SB(1, 1), b3 + hstep, voffB); PG8_STAGE(PG8_SA(1, 0), a3, voffA);
            PG8_WAIT_V(8); PG8_WAIT_L(0); PG8_BAR; PG8_MMA(1, 0, At, B0); PG8_MMA(1, 1, At, B1); PG8_BAR; PG8_SCHED;
            } else {
            PG8_LDB(B0, 0, 0); PG8_SCHED; PG8_LDA(At, 0, 0); PG8_STAGE(PG8_SA(1, 1), a1 + hstep, voffA);
            PG8_WAIT_L(8); PG8_BAR; PG8_WAIT_L(0); PG8_MMA(0, 0, At, B0); PG8_BAR; PG8_SCHED;
            PG8_LDB(B1, 0, 1); PG8_STAGE(PG8_SB(0, 0), b2, voffB);
            PG8_BAR; PG8_WAIT_L(0); PG8_MMA(0, 1, At, B1); PG8_BAR;
            PG8_LDA(At, 0, 1); PG8_STAGE(PG8_SA(0, 0), a2, voffA);
            PG8_BAR; PG8_WAIT_L(0); PG8_MMA(1, 0, At, B0); PG8_BAR; PG8_SCHED;
            PG8_STAGE(PG8_SB(0, 1), b2 + hstep, voffB);
            PG8_WAIT_V(6); PG8_BAR; PG8_MMA(1, 1, At, B1); PG8_BAR;
            PG8_LDB(B0, 1, 0); PG8_SCHED; PG8_LDA(At, 1, 0); PG8_STAGE(PG8_SA(0, 1), a2 + hstep, voffA);
            PG8_WAIT_L(8); PG8_BAR; PG8_WAIT_L(0); PG8_MMA(0, 0, At, B0); PG8_BAR; PG8_SCHED;
            PG8_LDB(B1, 1, 1); PG8_STAGE(PG8_SB(1, 0), b3, voffB);
            PG8_BAR; PG8_WAIT_L(0); PG8_MMA(0, 1, At, B1); PG8_BAR;
            PG8_LDA(At, 1, 1); PG8_STAGE(PG8_SA(1, 0), a3, voffA);
            PG8_BAR; PG8_WAIT_L(0); PG8_MMA(1, 0, At, B0); PG8_BAR; PG8_SCHED;
            PG8_STAGE(PG8_SB(1, 1), b3 + hstep, voffB);
            PG8_WAIT_V(6); PG8_BAR; PG8_MMA(1, 1, At, B1); PG8_BAR;
            }
        }
        if constexpr (ALIGN_EPI) { if (wr == 0) PG8_BAR; }
        if constexpr (!Epi::AFTER_DRAIN) { E(acc, cur, wr, wc, fr, fq); S.done(cur); }
        if (!has_next) break;
#pragma unroll
        for (int a = 0; a < 2; ++a)
#pragma unroll
            for (int b = 0; b < 2; ++b)
#pragma unroll
                for (int m = 0; m < 4; ++m)
#pragma unroll
                    for (int n = 0; n < 2; ++n) acc[a][b][m][n] = (f32x4){0.f, 0.f, 0.f, 0.f};
        cur = nxt; cA = nA; cB = nB; ++ui;
        if constexpr (ALIGN_EPI) { if (wr == 1) PG8_BAR; }
    }
    PG8_WAIT_V(0);
    if constexpr (!ALIGN_EPI) { if (wr == 0) PG8_BAR; }
    PG8_BAR;
    if constexpr (Epi::AFTER_DRAIN) { E.fused(acc, cur, wr, wc, fr, fq, lds, wid, lane); S.done(cur); }
#undef PG8_SA
#undef PG8_SB
#undef PG8_STAGE
#undef PG8_LDA
#undef PG8_LDB
#undef PG8_MMA
#undef PG8_WAIT_V
#undef PG8_WAIT_L
#undef PG8_BAR
#undef PG8_SCHED
}
}


namespace pg8 {
struct EpiZ {
    static constexpr bool PERM = true, AFTER_DRAIN = false;
    bf16_t* z; bf16_t* vT; const float* rss;
    __device__ __forceinline__ void operator()(const f32x4 (&acc)[2][2][4][2], const Unit& u, int wr, int wc, int fr, int fq) const {
        f32x4 part[2][4];
#pragma unroll
        for (int ai = 0; ai < 2; ++ai)
#pragma unroll
            for (int m = 0; m < 4; ++m) part[ai][m] = *(const f32x4*)(rss + (size_t)(u.pm * BM + ai * HALF + wr * 64 + m * 16 + fr) * 16 + 4 * fq);
        float rstdv[2][4];
#pragma unroll
        for (int ai = 0; ai < 2; ++ai)
#pragma unroll
            for (int m = 0; m < 4; ++m) {
                float s = (part[ai][m][0] + part[ai][m][1]) + (part[ai][m][2] + part[ai][m][3]);
                s += __shfl_xor(s, 16); s += __shfl_xor(s, 32);
                rstdv[ai][m] = rsqrtf(s * (1.0f / 1024.0f) + RMS_EPS);
            }
#pragma unroll
        for (int ai = 0; ai < 2; ++ai)
#pragma unroll
            for (int m = 0; m < 4; ++m) {
                const int row = u.pm * BM + ai * HALF + wr * 64 + m * 16 + fr;
                const float rstd = rstdv[ai][m];
                const int b = row >> 11, s = row & 2047;
#pragma unroll
                for (int bj = 0; bj < 2; ++bj) {
                    const int tn = 2 * u.pn + bj;
                    const int cw = 32 * wc + 8 * fq;
                    const f32x4 v0 = acc[ai][bj][m][0] * rstd, v1 = acc[ai][bj][m][1] * rstd;
                    u32x4 w; w.x = ::cvt_pk_bf16(v0[0], v0[1]); w.y = ::cvt_pk_bf16(v0[2], v0[3]); w.z = ::cvt_pk_bf16(v1[0], v1[1]); w.w = ::cvt_pk_bf16(v1[2], v1[3]);
                    if (tn < 24) {
                        bf16_t* dst;
                        if (tn < 8) dst = z + (size_t)(tn >> 2) * ZS_KD + ((size_t)((b * 4 + (tn & 3)) * 2048 + s)) * 128 + cw;
                        else if (tn < 16) dst = z + ZS_QN + (size_t)((tn - 8) >> 2) * (ZS_KN - ZS_QN) + ((size_t)((b * 8 + ((tn - 8) & 3) * 2 + (cw >> 6)) * 2048 + s)) * 64 + (cw & 63);
                        else dst = z + ZS_GATE + (size_t)row * 1024 + (tn - 16) * 128 + cw;
                        *(u32x4*)dst = w;
                    } else {
                        const unsigned ox = __shfl_xor(w.x, 1), oy = __shfl_xor(w.y, 1), oz = __shfl_xor(w.z, 1), ow = __shfl_xor(w.w, 1);
                        const bool odd = fr & 1;
                        const unsigned a0 = odd ? oz : w.x, a1 = odd ? ow : w.y;
                        const unsigned b0 = odd ? w.z : ox, b1 = odd ? w.w : oy;
                        const unsigned p0 = (a0 & 0xffffu) | (b0 << 16), p1 = (a0 >> 16) | (b0 & 0xffff0000u);
                        const unsigned p2 = (a1 & 0xffffu) | (b1 << 16), p3 = (a1 >> 16) | (b1 & 0xffff0000u);
                        const int ch0 = cw + (odd ? 4 : 0), se = s & ~1;
                        bf16_t* dst;
                        if (tn < 28) dst = vT + VS_VD + ((size_t)(((b * 4 + (tn - 24)) * 32 + (se >> 6)) * 128 + ch0)) * 64 + (se & 63);
                        else dst = vT + VS_VN + ((size_t)(((b * 8 + (tn - 28) * 2 + (ch0 >> 6)) * 32 + (se >> 6)) * 64 + (ch0 & 63))) * 64 + (se & 63);
                        *(unsigned*)(dst) = p0; *(unsigned*)(dst + 64) = p1; *(unsigned*)(dst + 128) = p2; *(unsigned*)(dst + 192) = p3;
                    }
                }
            }
    }
};
template <int XIN, int OUT> struct EpiRes2 {
    static constexpr bool PERM = true, AFTER_DRAIN = false, TOUCH = false;
    const float* xin32; const bf16_t* xinb; bf16_t* xb; float* xf; float* rss;
    __device__ __forceinline__ void operator()(const f32x4 (&acc)[2][2][4][2], const Unit& u, int wr, int wc, int fr, int fq) const {
#pragma unroll
        for (int ai = 0; ai < 2; ++ai) {
            f32x4 res[XIN == 0 ? 4 : 1][2][2]; u32x4 rb[XIN == 0 ? 1 : 4][2];
#pragma unroll
            for (int m = 0; m < 4; ++m)
#pragma unroll
                for (int bj = 0; bj < 2; ++bj) {
                    const size_t off = (size_t)(u.pm * BM + ai * HALF + wr * 64 + m * 16 + fr) * 1024 + u.pn * BM + bj * HALF + 32 * wc + 8 * fq;
                    if (XIN == 0) { res[m][bj][0] = *(const f32x4*)(xin32 + off); res[m][bj][1] = *(const f32x4*)(xin32 + off + 4); }
                    else rb[m][bj] = *(const u32x4*)(xinb + off);
                }
            __builtin_amdgcn_sched_barrier(0);
#pragma unroll
            for (int m = 0; m < 4; ++m) {
                const int row = u.pm * BM + ai * HALF + wr * 64 + m * 16 + fr;
                float ss = 0.f;
#pragma unroll
                for (int bj = 0; bj < 2; ++bj) {
                    const size_t off = (size_t)row * 1024 + u.pn * BM + bj * HALF + 32 * wc + 8 * fq;
                    f32x4 r0, r1;
                    if (XIN == 0) { r0 = res[m][bj][0]; r1 = res[m][bj][1]; }
                    else { const u32x4 w = rb[m][bj]; r0 = (f32x4){bflo(w.x), bfhi(w.x), bflo(w.y), bfhi(w.y)}; r1 = (f32x4){bflo(w.z), bfhi(w.z), bflo(w.w), bfhi(w.w)}; }
                    const f32x4 v0 = r0 + acc[ai][bj][m][0], v1 = r1 + acc[ai][bj][m][1];
                    if (OUT == 0) { u32x4 w; w.x = ::cvt_pk_bf16(v0[0], v0[1]); w.y = ::cvt_pk_bf16(v0[2], v0[3]); w.z = ::cvt_pk_bf16(v1[0], v1[1]); w.w = ::cvt_pk_bf16(v1[2], v1[3]); *(u32x4*)(xb + off) = w; }
                    else { *(f32x4*)(xf + off) = v0; *(f32x4*)(xf + off + 4) = v1; }
                    ss += (v0[0] * v0[0] + v0[1] * v0[1]) + (v0[2] * v0[2] + v0[3] * v0[3]) + (v1[0] * v1[0] + v1[1] * v1[1]) + (v1[2] * v1[2] + v1[3] * v1[3]);
                }
                ss += __shfl_xor(ss, 16); ss += __shfl_xor(ss, 32);
                if (fq == 0) rss[(size_t)row * 16 + u.pn * 4 + wc] = ss;
            }
            __builtin_amdgcn_sched_barrier(0);
        }
    }
};
struct EpiFinal {
    static constexpr bool PERM = true, AFTER_DRAIN = true;
    const bf16_t* xinb; float* out; const float* fg; float* rss; unsigned* cnt;
    __device__ __forceinline__ void fused(f32x4 (&acc)[2][2][4][2], const Unit& u, int wr, int wc, int fr, int fq, PG8_LAS unsigned char* lds, int wid, int lane) const {
        float ssv[2][4];
#pragma unroll
        for (int ai = 0; ai < 2; ++ai) {
            u32x4 rb[4][2];
#pragma unroll
            for (int m = 0; m < 4; ++m)
#pragma unroll
                for (int bj = 0; bj < 2; ++bj) {
                    const size_t off = (size_t)(u.pm * BM + ai * HALF + wr * 64 + m * 16 + fr) * 1024 + u.pn * BM + bj * HALF + 32 * wc + 8 * fq;
                    rb[m][bj] = *(const u32x4*)(xinb + off);
                }
#pragma unroll
            for (int m = 0; m < 4; ++m) {
                float ss = 0.f;
#pragma unroll
                for (int bj = 0; bj < 2; ++bj) {
                    const u32x4 w = rb[m][bj];
                    const f32x4 v0 = (f32x4){bflo(w.x), bfhi(w.x), bflo(w.y), bfhi(w.y)} + acc[ai][bj][m][0], v1 = (f32x4){bflo(w.z), bfhi(w.z), bflo(w.w), bfhi(w.w)} + acc[ai][bj][m][1];
                    acc[ai][bj][m][0] = v0; acc[ai][bj][m][1] = v1;
                    ss += (v0[0] * v0[0] + v0[1] * v0[1]) + (v0[2] * v0[2] + v0[3] * v0[3]) + (v1[0] * v1[0] + v1[1] * v1[1]) + (v1[2] * v1[2] + v1[3] * v1[3]);
                }
                ss += __shfl_xor(ss, 16); ss += __shfl_xor(ss, 32);
                ssv[ai][m] = ss;
            }
        }
        if (fq == 0) {
#pragma unroll
            for (int ai = 0; ai < 2; ++ai)
#pragma unroll
                for (int m = 0; m < 4; ++m)
                    __hip_atomic_store((unsigned*)rss + (size_t)(u.pm * BM + ai * HALF + wr * 64 + m * 16 + fr) * 16 + u.pn * 4 + wc, __float_as_uint(ssv[ai][m]), __ATOMIC_RELAXED, __HIP_MEMORY_SCOPE_AGENT);
        }
        asm volatile("s_waitcnt vmcnt(0)" ::: "memory");
        if (lane == 0) __hip_atomic_fetch_add(cnt + 64 * u.pm, 1u, __ATOMIC_RELAXED, __HIP_MEMORY_SCOPE_AGENT);
        if (wid == 0) {
            unsigned spins = 0;
            while ((unsigned)__builtin_amdgcn_readfirstlane(__hip_atomic_load(cnt + 64 * u.pm, __ATOMIC_RELAXED, __HIP_MEMORY_SCOPE_AGENT)) < 32u) {
                __builtin_amdgcn_s_sleep(2);
                if (++spins > (1u << 22)) break;
            }
            __builtin_amdgcn_fence(__ATOMIC_ACQUIRE, "agent");
        }
        asm volatile("s_waitcnt vmcnt(0) lgkmcnt(0)" ::: "memory"); __builtin_amdgcn_s_barrier(); asm volatile("" ::: "memory");
        float rstdv[2][4];
#pragma unroll
        for (int ai = 0; ai < 2; ++ai)
#pragma unroll
            for (int m = 0; m < 4; ++m) {
                const unsigned* rp = (const unsigned*)rss + (size_t)(u.pm * BM + ai * HALF + wr * 64 + m * 16 + fr) * 16 + 4 * fq;
                float s = 0.f;
#pragma unroll
                for (int k = 0; k < 4; ++k) s += __uint_as_float(__hip_atomic_load(rp + k, __ATOMIC_RELAXED, __HIP_MEMORY_SCOPE_AGENT));
                s += __shfl_xor(s, 16); s += __shfl_xor(s, 32);
                rstdv[ai][m] = rsqrtf(s * (1.0f / 1024.0f) + RMS_EPS);
            }
        f32x4 gv[2][2];
#pragma unroll
        for (int bj = 0; bj < 2; ++bj) { const int c0 = u.pn * BM + bj * HALF + 32 * wc + 8 * fq; gv[bj][0] = *(const f32x4*)(fg + c0); gv[bj][1] = *(const f32x4*)(fg + c0 + 4); }
#pragma unroll
        for (int ai = 0; ai < 2; ++ai)
#pragma unroll
            for (int m = 0; m < 4; ++m)
#pragma unroll
                for (int bj = 0; bj < 2; ++bj) {
                    const size_t off = (size_t)(u.pm * BM + ai * HALF + wr * 64 + m * 16 + fr) * 1024 + u.pn * BM + bj * HALF + 32 * wc + 8 * fq;
                    *(f32x4*)(out + off) = acc[ai][bj][m][0] * rstdv[ai][m] * gv[bj][0];
                    *(f32x4*)(out + off + 4) = acc[ai][bj][m][1] * rstdv[ai][m] * gv[bj][1];
                }
    }
};
}
constexpr int LDS_PHASE_BYTES = 143360;
constexpr int LDS_RPB_OFF = LDS_PHASE_BYTES + 16 + 128, LDS_SG_OFF = LDS_RPB_OFF + 8 * 465 * 4 + 128, LDS_RPB_BYTES = 8 * 465 * 4 + 128 + 512;

constexpr int DA_KP = 272, DA_VP = 144;
constexpr int DA_KBYTES = 128 * DA_KP, DA_VSUB = 128 * DA_VP, DA_VBYTES = 2 * DA_VSUB, DA_STAGE = DA_KBYTES + DA_VBYTES;

__device__ __forceinline__ float silu_f(float x) { return x / (1.0f + __expf(-x)); }

__device__ void da_unit(char* lds, const Params& p, int layer, int unit) {
    int tid_ = threadIdx.x; asm volatile("" : "+v"(tid_)); const int tid = tid_, lane = tid & 63, wid = __builtin_amdgcn_readfirstlane(tid >> 6), r = lane & 31, h2 = lane >> 5;
    const int c = wid & 1, qg = wid >> 1;
    const int g8 = unit >> 3, bh = (unit & 7) * 4 + (g8 >> 4), qb = g8 & 15, b = bh >> 2, h = bh & 3;
    const float slope2 = exp2f(-2.0f * (float)(h + 1)) * LOG2E;
    const float qscale = 0.125f * LOG2E;
    float lam;
    {
        const float v1 = p.lq1[layer * 64 + lane] * p.lk1[layer * 64 + lane], v2 = p.lq2[layer * 64 + lane] * p.lk2[layer * 64 + lane];
        float s1 = v1, s2 = v2;
#pragma unroll
        for (int s = 32; s >= 1; s >>= 1) { s1 += __shfl_xor(s1, s); s2 += __shfl_xor(s2, s); }
        lam = __expf(s1) - __expf(s2) + p.lam_init[layer];
    }
    const int q0 = qb * 128 + qg * 32;
    const size_t tokq = (size_t)b * SEQ + q0 + r;
    bf16x8 qf[4];
#pragma unroll
    for (int t = 0; t < 4; ++t) {
        const u32x4 w = *(const u32x4*)(p.z + ZS_QD + ((size_t)(bh * 2048 + q0 + r)) * 128 + c * 64 + t * 16 + h2 * 8);
        u32x4 o;
        o.x = cvt_pk_bf16(bflo(w.x) * qscale, bfhi(w.x) * qscale); o.y = cvt_pk_bf16(bflo(w.y) * qscale, bfhi(w.y) * qscale);
        o.z = cvt_pk_bf16(bflo(w.z) * qscale, bfhi(w.z) * qscale); o.w = cvt_pk_bf16(bflo(w.w) * qscale, bfhi(w.w) * qscale);
        qf[t] = __builtin_bit_cast(bf16x8, o);
    }
    f32x16 O[4], Bs;
#pragma unroll
    for (int k = 0; k < 4; ++k)
#pragma unroll
        for (int e = 0; e < 16; ++e) O[k][e] = 0.f;
#pragma unroll
    for (int e = 0; e < 16; ++e) Bs[e] = -slope2 * (float)(16 * (e >> 3) + (e & 7));
    float mrow = -1e30f, lrow = 0.f;
    const float qrel = (float)(8 * h2) - (float)(q0 + r);
    const bf16_t* Kg = p.z + ZS_KD + ((size_t)bh * 2048) * 128 + tid * 8;
    const bf16_t* Vg = p.vT + VS_VD + ((size_t)bh * 32) * 8192 + tid * 8;
    const int kr_ = tid >> 4, kc_ = tid & 15, vr_ = tid >> 3, vc_ = tid & 7;
    constexpr int NT = SEQ / 128;
    auto tile_of = [&](int i) { return (i < NT - qb) ? (qb + i) : (NT - 1 - i); };
    u32x4 rk[4], rv[4];
    {
        const int t0 = tile_of(0);
#pragma unroll
        for (int j = 0; j < 4; ++j) { rk[j] = *(const u32x4*)(Kg + (size_t)t0 * 16384 + j * 4096); rv[j] = *(const u32x4*)(Vg + (size_t)t0 * 16384 + j * 4096); }
    }
    __syncthreads();
#pragma unroll
    for (int j = 0; j < 4; ++j) {
        *(u32x4*)(lds + (kr_ + 32 * j) * DA_KP + kc_ * 16) = rk[j];
        *(u32x4*)(lds + DA_KBYTES + (j >> 1) * DA_VSUB + (vr_ + 64 * (j & 1)) * DA_VP + vc_ * 16) = rv[j];
    }
    __syncthreads();
    const int pr = (r & 0x13) | ((r & 4) << 1) | ((r & 8) >> 1);
    if (wid >= 4) __builtin_amdgcn_s_setprio(1);
    {
        const int it = 0; const int kt = qb;
        const char* cK = lds + (it & 1) * DA_STAGE;
        const char* cV = cK + DA_KBYTES;
        char* nK = lds + ((it + 1) & 1) * DA_STAGE;
        if (it + 1 < NT) {
            const int tn = tile_of(it + 1);
#pragma unroll
            for (int j = 0; j < 4; ++j) { rk[j] = *(const u32x4*)(Kg + (size_t)tn * 16384 + j * 4096); rv[j] = *(const u32x4*)(Vg + (size_t)tn * 16384 + j * 4096); }
        }
#pragma unroll
        for (int kb = 0; kb < 4; ++kb) {
            const int k0 = kt * 128 + kb * 32;
            f32x16 s; const float A = 0.f;
            const float kq = (float)k0 + qrel;
#pragma unroll
            for (int e = 0; e < 16; ++e) s[e] = 0.f;
#pragma unroll
            for (int t = 0; t < 4; ++t) {
                const bf16x8 kf = *(const bf16x8*)(cK + (kb * 32 + pr) * DA_KP + c * 128 + t * 32 + h2 * 16);
                s = __builtin_amdgcn_mfma_f32_32x32x16_bf16(kf, qf[t], s, 0, 0, 0);
            }
#pragma unroll
            for (int e = 0; e < 16; ++e) s[e] = fmaf(fabsf(kq + (float)(16 * (e >> 3) + (e & 7))), -slope2, s[e]);
            float mx = s[0];
#pragma unroll
            for (int e = 1; e < 16; ++e) mx = fmaxf(mx, s[e]);
            mx += A;
            mx = fmaxf(mx, __shfl_xor(mx, 32));
            if (!__all(mx <= mrow + 8.0f)) {
                const float mnew = fmaxf(mrow, mx);
                const float alpha = fast_exp2(mrow - mnew);
#pragma unroll
                for (int k = 0; k < 4; ++k) O[k] = O[k] * alpha;
                lrow *= alpha; mrow = mnew;
            }
            const float mm = mrow - A;
            float ps = 0.f;
#pragma unroll
            for (int e = 0; e < 16; ++e) { s[e] = fast_exp2(s[e] - mm); ps += s[e]; }
            lrow += ps;
            bf16x8 pb[2];
#pragma unroll
            for (int sp = 0; sp < 2; ++sp) {
                u32x4 w;
                w.x = cvt_pk_bf16(s[8 * sp + 0], s[8 * sp + 1]); w.y = cvt_pk_bf16(s[8 * sp + 2], s[8 * sp + 3]);
                w.z = cvt_pk_bf16(s[8 * sp + 4], s[8 * sp + 5]); w.w = cvt_pk_bf16(s[8 * sp + 6], s[8 * sp + 7]);
                pb[sp] = __builtin_bit_cast(bf16x8, w);
            }
#pragma unroll
            for (int sp = 0; sp < 2; ++sp)
#pragma unroll
                for (int k = 0; k < 4; ++k) {
                    const bf16x8 vf = *(const bf16x8*)(cV + (kb >> 1) * DA_VSUB + (32 * k + r) * DA_VP + (32 * (kb & 1) + 16 * sp + 8 * h2) * 2);
                    O[k] = __builtin_amdgcn_mfma_f32_32x32x16_bf16(vf, pb[sp], O[k], 0, 0, 0);
                }
        }

        if (it + 1 < NT) {
#pragma unroll
            for (int j = 0; j < 4; ++j) {
                *(u32x4*)(nK + (kr_ + 32 * j) * DA_KP + kc_ * 16) = rk[j];
                *(u32x4*)(nK + DA_KBYTES + (j >> 1) * DA_VSUB + (vr_ + 64 * (j & 1)) * DA_VP + vc_ * 16) = rv[j];
            }
        }
        __syncthreads();
    }
    for (int it = 1; it < NT - qb; ++it) {
        const int kt = tile_of(it);
        const char* cK = lds + (it & 1) * DA_STAGE;
        const char* cV = cK + DA_KBYTES;
        char* nK = lds + ((it + 1) & 1) * DA_STAGE;
        const int tn = tile_of(it + 1 < NT ? it + 1 : it);
        if (it + 1 < NT) {
#pragma unroll
            for (int j = 0; j < 4; ++j) rk[j] = *(const u32x4*)(Kg + (size_t)tn * 16384 + j * 4096);
        }
#define DA_FAST_HALF(BSEL, SGN, hf) \
            { \
                f32x16 s0, s1; \
                { const bf16x8 kf0 = *(const bf16x8*)(cK + (hf * 64 + pr) * DA_KP + c * 128 + h2 * 16); \
                  const bf16x8 kf1 = *(const bf16x8*)(cK + (hf * 64 + 32 + pr) * DA_KP + c * 128 + h2 * 16); \
                  s0 = __builtin_amdgcn_mfma_f32_32x32x16_bf16(kf0, qf[0], BSEL, 0, 0, 0); \
                  s1 = __builtin_amdgcn_mfma_f32_32x32x16_bf16(kf1, qf[0], BSEL, 0, 0, 0); } \
                _Pragma("unroll") \
                for (int t = 1; t < 4; ++t) { \
                    const bf16x8 kf0 = *(const bf16x8*)(cK + (hf * 64 + pr) * DA_KP + c * 128 + t * 32 + h2 * 16); \
                    const bf16x8 kf1 = *(const bf16x8*)(cK + (hf * 64 + 32 + pr) * DA_KP + c * 128 + t * 32 + h2 * 16); \
                    s0 = __builtin_amdgcn_mfma_f32_32x32x16_bf16(kf0, qf[t], s0, 0, 0, 0); \
                    s1 = __builtin_amdgcn_mfma_f32_32x32x16_bf16(kf1, qf[t], s1, 0, 0, 0); \
                } \
                const float A0 = (SGN) * ((float)(kt * 128 + hf * 64) + qrel), A1 = A0 + (SGN) * 32.0f; \
                const float mm0 = mrow - A0, mm1 = mrow - A1; \
                float ps0 = 0.f, ps1 = 0.f; \
                _Pragma("unroll") \
                for (int e = 0; e < 16; ++e) { s0[e] = fast_exp2(s0[e] - mm0); ps0 += s0[e]; } \
                bf16x8 pb0[2], pb1[2]; \
                _Pragma("unroll") \
                for (int sp = 0; sp < 2; ++sp) { \
                    u32x4 w; \
                    w.x = cvt_pk_bf16(s0[8 * sp + 0], s0[8 * sp + 1]); w.y = cvt_pk_bf16(s0[8 * sp + 2], s0[8 * sp + 3]); \
                    w.z = cvt_pk_bf16(s0[8 * sp + 4], s0[8 * sp + 5]); w.w = cvt_pk_bf16(s0[8 * sp + 6], s0[8 * sp + 7]); \
                    pb0[sp] = __builtin_bit_cast(bf16x8, w); \
                } \
                _Pragma("unroll") \
                for (int sp = 0; sp < 2; ++sp) \
                    _Pragma("unroll") \
                    for (int k = 0; k < 4; ++k) { \
                        const bf16x8 vf0 = *(const bf16x8*)(cV + hf * DA_VSUB + (32 * k + r) * DA_VP + (16 * sp + 8 * h2) * 2); \
                        O[k] = __builtin_amdgcn_mfma_f32_32x32x16_bf16(vf0, pb0[sp], O[k], 0, 0, 0); \
                    } \
                _Pragma("unroll") \
                for (int e = 0; e < 16; ++e) { s1[e] = fast_exp2(s1[e] - mm1); ps1 += s1[e]; } \
                lrow += ps0 + ps1; \
                _Pragma("unroll") \
                for (int sp = 0; sp < 2; ++sp) { \
                    u32x4 w; \
                    w.x = cvt_pk_bf16(s1[8 * sp + 0], s1[8 * sp + 1]); w.y = cvt_pk_bf16(s1[8 * sp + 2], s1[8 * sp + 3]); \
                    w.z = cvt_pk_bf16(s1[8 * sp + 4], s1[8 * sp + 5]); w.w = cvt_pk_bf16(s1[8 * sp + 6], s1[8 * sp + 7]); \
                    pb1[sp] = __builtin_bit_cast(bf16x8, w); \
                } \
                _Pragma("unroll") \
                for (int sp = 0; sp < 2; ++sp) \
                    _Pragma("unroll") \
                    for (int k = 0; k < 4; ++k) { \
                        const bf16x8 vf1 = *(const bf16x8*)(cV + hf * DA_VSUB + (32 * k + r) * DA_VP + (32 + 16 * sp + 8 * h2) * 2); \
                        O[k] = __builtin_amdgcn_mfma_f32_32x32x16_bf16(vf1, pb1[sp], O[k], 0, 0, 0); \
                    } \
            }
        DA_FAST_HALF(Bs, -slope2, 0)
        if (it + 1 < NT) {
#pragma unroll
            for (int j = 0; j < 4; ++j) *(u32x4*)(nK + (kr_ + 32 * j) * DA_KP + kc_ * 16) = rk[j];
#pragma unroll
            for (int j = 0; j < 4; ++j) rk[j] = *(const u32x4*)(Vg + (size_t)tn * 16384 + j * 4096);
        }
        DA_FAST_HALF(Bs, -slope2, 1)
#undef DA_FAST_HALF
        if (it + 1 < NT) {
#pragma unroll
            for (int j = 0; j < 4; ++j) *(u32x4*)(nK + DA_KBYTES + (j >> 1) * DA_VSUB + (vr_ + 64 * (j & 1)) * DA_VP + vc_ * 16) = rk[j];
        }
        __syncthreads();
    }
#pragma unroll
    for (int e = 0; e < 16; ++e) Bs[e] = -Bs[e];
    for (int it = NT - qb; it < NT; ++it) {
        const int kt = tile_of(it);
        const char* cK = lds + (it & 1) * DA_STAGE;
        const char* cV = cK + DA_KBYTES;
        char* nK = lds + ((it + 1) & 1) * DA_STAGE;
        const int tn = tile_of(it + 1 < NT ? it + 1 : it);
        if (it + 1 < NT) {
#pragma unroll
            for (int j = 0; j < 4; ++j) rk[j] = *(const u32x4*)(Kg + (size_t)tn * 16384 + j * 4096);
        }
#define DA_FAST_HALF(BSEL, SGN, hf) \
            { \
                f32x16 s0, s1; \
                { const bf16x8 kf0 = *(const bf16x8*)(cK + (hf * 64 + pr) * DA_KP + c * 128 + h2 * 16); \
                  const bf16x8 kf1 = *(const bf16x8*)(cK + (hf * 64 + 32 + pr) * DA_KP + c * 128 + h2 * 16); \
                  s0 = __builtin_amdgcn_mfma_f32_32x32x16_bf16(kf0, qf[0], BSEL, 0, 0, 0); \
                  s1 = __builtin_amdgcn_mfma_f32_32x32x16_bf16(kf1, qf[0], BSEL, 0, 0, 0); } \
                _Pragma("unroll") \
                for (int t = 1; t < 4; ++t) { \
                    const bf16x8 kf0 = *(const bf16x8*)(cK + (hf * 64 + pr) * DA_KP + c * 128 + t * 32 + h2 * 16); \
                    const bf16x8 kf1 = *(const bf16x8*)(cK + (hf * 64 + 32 + pr) * DA_KP + c * 128 + t * 32 + h2 * 16); \
                    s0 = __builtin_amdgcn_mfma_f32_32x32x16_bf16(kf0, qf[t], s0, 0, 0, 0); \
                    s1 = __builtin_amdgcn_mfma_f32_32x32x16_bf16(kf1, qf[t], s1, 0, 0, 0); \
                } \
                const float A0 = (SGN) * ((float)(kt * 128 + hf * 64) + qrel), A1 = A0 + (SGN) * 32.0f; \
                const float mm0 = mrow - A0, mm1 = mrow - A1; \
                float ps0 = 0.f, ps1 = 0.f; \
                _Pragma("unroll") \
                for (int e = 0; e < 16; ++e) { s0[e] = fast_exp2(s0[e] - mm0); ps0 += s0[e]; } \
                bf16x8 pb0[2], pb1[2]; \
                _Pragma("unroll") \
                for (int sp = 0; sp < 2; ++sp) { \
                    u32x4 w; \
                    w.x = cvt_pk_bf16(s0[8 * sp + 0], s0[8 * sp + 1]); w.y = cvt_pk_bf16(s0[8 * sp + 2], s0[8 * sp + 3]); \
                    w.z = cvt_pk_bf16(s0[8 * sp + 4], s0[8 * sp + 5]); w.w = cvt_pk_bf16(s0[8 * sp + 6], s0[8 * sp + 7]); \
                    pb0[sp] = __builtin_bit_cast(bf16x8, w); \
                } \
                _Pragma("unroll") \
                for (int sp = 0; sp < 2; ++sp) \
                    _Pragma("unroll") \
                    for (int k = 0; k < 4; ++k) { \
                        const bf16x8 vf0 = *(const bf16x8*)(cV + hf * DA_VSUB + (32 * k + r) * DA_VP + (16 * sp + 8 * h2) * 2); \
                        O[k] = __builtin_amdgcn_mfma_f32_32x32x16_bf16(vf0, pb0[sp], O[k], 0, 0, 0); \
                    } \
                _Pragma("unroll") \
                for (int e = 0; e < 16; ++e) { s1[e] = fast_exp2(s1[e] - mm1); ps1 += s1[e]; } \
                lrow += ps0 + ps1; \
                _Pragma("unroll") \
                for (int sp = 0; sp < 2; ++sp) { \
                    u32x4 w; \
                    w.x = cvt_pk_bf16(s1[8 * sp + 0], s1[8 * sp + 1]); w.y = cvt_pk_bf16(s1[8 * sp + 2], s1[8 * sp + 3]); \
                    w.z = cvt_pk_bf16(s1[8 * sp + 4], s1[8 * sp + 5]); w.w = cvt_pk_bf16(s1[8 * sp + 6], s1[8 * sp + 7]); \
                    pb1[sp] = __builtin_bit_cast(bf16x8, w); \
                } \
                _Pragma("unroll") \
                for (int sp = 0; sp < 2; ++sp) \
                    _Pragma("unroll") \
                    for (int k = 0; k < 4; ++k) { \
                        const bf16x8 vf1 = *(const bf16x8*)(cV + hf * DA_VSUB + (32 * k + r) * DA_VP + (32 + 16 * sp + 8 * h2) * 2); \
                        O[k] = __builtin_amdgcn_mfma_f32_32x32x16_bf16(vf1, pb1[sp], O[k], 0, 0, 0); \
                    } \
            }
        DA_FAST_HALF(Bs, slope2, 0)
        if (it + 1 < NT) {
#pragma unroll
            for (int j = 0; j < 4; ++j) *(u32x4*)(nK + (kr_ + 32 * j) * DA_KP + kc_ * 16) = rk[j];
#pragma unroll
            for (int j = 0; j < 4; ++j) rk[j] = *(const u32x4*)(Vg + (size_t)tn * 16384 + j * 4096);
        }
        DA_FAST_HALF(Bs, slope2, 1)
#undef DA_FAST_HALF
        if (it + 1 < NT) {
#pragma unroll
            for (int j = 0; j < 4; ++j) *(u32x4*)(nK + DA_KBYTES + (j >> 1) * DA_VSUB + (vr_ + 64 * (j & 1)) * DA_VP + vc_ * 16) = rk[j];
        }
        __syncthreads();
    }
    __builtin_amdgcn_s_setprio(0);
    {
        const float lchk = lrow + __shfl_xor(lrow, 32);
        const int bad = !(lchk < 1e30f);
        volatile unsigned* bflag = (volatile unsigned*)(lds + LDS_PHASE_BYTES + 8);
        if (tid == 0) *bflag = 0u;
        __syncthreads();
        if (__any(bad) && lane == 0) *bflag = 1u;
        __syncthreads();
        if (*bflag != 0u) {
#pragma unroll
            for (int k = 0; k < 4; ++k)
#pragma unroll
                for (int e = 0; e < 16; ++e) O[k][e] = 0.f;
            mrow = -1e30f; lrow = 0.f;
            {
                const int t0 = tile_of(0);
#pragma unroll
                for (int j = 0; j < 4; ++j) { rk[j] = *(const u32x4*)(Kg + (size_t)t0 * 16384 + j * 4096); rv[j] = *(const u32x4*)(Vg + (size_t)t0 * 16384 + j * 4096); }
            }
#pragma unroll
            for (int j = 0; j < 4; ++j) {
                *(u32x4*)(lds + (kr_ + 32 * j) * DA_KP + kc_ * 16) = rk[j];
                *(u32x4*)(lds + DA_KBYTES + (j >> 1) * DA_VSUB + (vr_ + 64 * (j & 1)) * DA_VP + vc_ * 16) = rv[j];
            }
            __syncthreads();
        for (int it = 0; it < NT; ++it) {
            const int kt = tile_of(it);
        const char* cK = lds + (it & 1) * DA_STAGE;
        const char* cV = cK + DA_KBYTES;
        char* nK = lds + ((it + 1) & 1) * DA_STAGE;
        if (it + 1 < NT) {
            const int tn = tile_of(it + 1);
#pragma unroll
            for (int j = 0; j < 4; ++j) { rk[j] = *(const u32x4*)(Kg + (size_t)tn * 16384 + j * 4096); rv[j] = *(const u32x4*)(Vg + (size_t)tn * 16384 + j * 4096); }
        }
#pragma unroll
        for (int kb = 0; kb < 4; ++kb) {
            const int k0 = kt * 128 + kb * 32;
            f32x16 s; const float A = 0.f;
            const float kq = (float)k0 + qrel;
#pragma unroll
            for (int e = 0; e < 16; ++e) s[e] = 0.f;
#pragma unroll
            for (int t = 0; t < 4; ++t) {
                const bf16x8 kf = *(const bf16x8*)(cK + (kb * 32 + pr) * DA_KP + c * 128 + t * 32 + h2 * 16);
                s = __builtin_amdgcn_mfma_f32_32x32x16_bf16(kf, qf[t], s, 0, 0, 0);
            }
#pragma unroll
            for (int e = 0; e < 16; ++e) s[e] = fmaf(fabsf(kq + (float)(16 * (e >> 3) + (e & 7))), -slope2, s[e]);
            float mx = s[0];
#pragma unroll
            for (int e = 1; e < 16; ++e) mx = fmaxf(mx, s[e]);
            mx += A;
            mx = fmaxf(mx, __shfl_xor(mx, 32));
            if (!__all(mx <= mrow + 8.0f)) {
                const float mnew = fmaxf(mrow, mx);
                const float alpha = fast_exp2(mrow - mnew);
#pragma unroll
                for (int k = 0; k < 4; ++k) O[k] = O[k] * alpha;
                lrow *= alpha; mrow = mnew;
            }
            const float mm = mrow - A;
            float ps = 0.f;
#pragma unroll
            for (int e = 0; e < 16; ++e) { s[e] = fast_exp2(s[e] - mm); ps += s[e]; }
            lrow += ps;
            bf16x8 pb[2];
#pragma unroll
            for (int sp = 0; sp < 2; ++sp) {
                u32x4 w;
                w.x = cvt_pk_bf16(s[8 * sp + 0], s[8 * sp + 1]); w.y = cvt_pk_bf16(s[8 * sp + 2], s[8 * sp + 3]);
                w.z = cvt_pk_bf16(s[8 * sp + 4], s[8 * sp + 5]); w.w = cvt_pk_bf16(s[8 * sp + 6], s[8 * sp + 7]);
                pb[sp] = __builtin_bit_cast(bf16x8, w);
            }
#pragma unroll
            for (int sp = 0; sp < 2; ++sp)
#pragma unroll
                for (int k = 0; k < 4; ++k) {
                    const bf16x8 vf = *(const bf16x8*)(cV + (kb >> 1) * DA_VSUB + (32 * k + r) * DA_VP + (32 * (kb & 1) + 16 * sp + 8 * h2) * 2);
                    O[k] = __builtin_amdgcn_mfma_f32_32x32x16_bf16(vf, pb[sp], O[k], 0, 0, 0);
                }
        }

        if (it + 1 < NT) {
#pragma unroll
            for (int j = 0; j < 4; ++j) {
                *(u32x4*)(nK + (kr_ + 32 * j) * DA_KP + kc_ * 16) = rk[j];
                *(u32x4*)(nK + DA_KBYTES + (j >> 1) * DA_VSUB + (vr_ + 64 * (j & 1)) * DA_VP + vc_ * 16) = rv[j];
            }
        }
        __syncthreads();
    }
        }
    }
    const float lsum = lrow + __shfl_xor(lrow, 32);
    float* xch = (float*)lds + qg * 4096;
    if (c == 1) {
        const float i1 = lam / lsum;
#pragma unroll
        for (int k = 0; k < 4; ++k)
#pragma unroll
            for (int e = 0; e < 16; ++e) xch[(k * 16 + e) * 64 + lane] = O[k][e] * i1;
    }
    __syncthreads();
    if (c == 0) {
        const float i0 = 1.0f / lsum;
        float ss = 0.f;
#pragma unroll
        for (int k = 0; k < 4; ++k)
#pragma unroll
            for (int e = 0; e < 16; ++e) { const float a = O[k][e] * i0 - xch[(k * 16 + e) * 64 + lane]; O[k][e] = a; ss += a * a; }
        ss += __shfl_xor(ss, 32);
        const float rstd = rsqrtf(ss * (1.0f / 128.0f) + RMS_EPS) * (1.0f - p.lam_init[layer]);
        const float* sg = (const float*)(lds + LDS_SG_OFF);
        u32x2 gwv[16];
#pragma unroll
        for (int k = 0; k < 4; ++k)
#pragma unroll
            for (int g = 0; g < 4; ++g) {
                const int d0 = 32 * k + 8 * g + 4 * h2;
                gwv[k * 4 + g] = *(const u32x2*)(p.z + ZS_GATE + tokq * 1024 + h * 128 + d0);
            }
        __builtin_amdgcn_sched_barrier(0);
#pragma unroll
        for (int k = 0; k < 4; ++k)
#pragma unroll
            for (int g = 0; g < 4; ++g) {
                const int d0 = 32 * k + 8 * g + 4 * h2;
                const f32x4 gg = *(const f32x4*)(sg + d0);
                const u32x2 gw = gwv[k * 4 + g];
                const float o0 = O[k][4 * g + 0] * rstd * gg[0] * silu_f(bflo(gw.x));
                const float o1 = O[k][4 * g + 1] * rstd * gg[1] * silu_f(bfhi(gw.x));
                const float o2 = O[k][4 * g + 2] * rstd * gg[2] * silu_f(bflo(gw.y));
                const float o3 = O[k][4 * g + 3] * rstd * gg[3] * silu_f(bfhi(gw.y));
                u32x2 w; w.x = cvt_pk_bf16(o0, o1); w.y = cvt_pk_bf16(o2, o3);
                *(u32x2*)(p.o + tokq * 1024 + h * 128 + d0) = w;
            }
    }
}

__device__ void na_unit(char* lds, const Params& p, int layer, int unit) {
    int tid_ = threadIdx.x; asm volatile("" : "+v"(tid_)); const int tid = tid_, lane = tid & 63, wid = __builtin_amdgcn_readfirstlane(tid >> 6), fr = lane & 15, fq = lane >> 4;
    const int hp = unit & 3, rr0 = (unit >> 2) & 31, b = unit >> 7;
    const int h = 2 * hp + (wid >> 2), n = wid & 3;
    const float* rph = (const float*)(lds + LDS_RPB_OFF) + h * 465;
    const int r = rr0;
    const int rs = min(max(r - 4, 0), 24);
    const int kcstart = min(max(16 * n - 8, 0), 32);
    const int qcol = 16 * n + fr;
    const int qcstart = min(max(qcol - 8, 0), 48);
    const size_t tokq = (size_t)b * SEQ + r * 64 + qcol;
    bf16x8 qf[2];
#pragma unroll
    for (int t = 0; t < 2; ++t) qf[t] = *(const bf16x8*)(p.z + ZS_QN + ((size_t)((b * 8 + h) * 2048 + r * 64 + qcol)) * 64 + t * 32 + fq * 8);
    bf16x8 kfr[8][4];
    {
        const int kc = kcstart + 8 * (fr >> 2) + (fr & 3);
        const bf16_t* kg0 = p.z + ZS_KN + ((size_t)((b * 8 + h) * 2048 + rs * 64 + kc)) * 64 + fq * 8;
#pragma unroll
        for (int rr = 0; rr < 8; ++rr)
#pragma unroll
            for (int T = 0; T < 2; ++T) {
                const bf16_t* kg = kg0 + (size_t)(rr * 64 + 4 * T) * 64;
                kfr[rr][2 * T] = *(const bf16x8*)(kg); kfr[rr][2 * T + 1] = *(const bf16x8*)(kg + 32);
            }
    }
    __builtin_amdgcn_sched_barrier(0);
    const float c1 = 0.125f * LOG2E;
    float sc[8][8];
    float mx = -1e30f;
#pragma unroll
    for (int rr = 0; rr < 8; ++rr) {
#pragma unroll
        for (int T = 0; T < 2; ++T) {
            f32x4 s = (f32x4){0.f, 0.f, 0.f, 0.f};
            s = __builtin_amdgcn_mfma_f32_16x16x32_bf16(kfr[rr][2 * T], qf[0], s, 0, 0, 0);
            s = __builtin_amdgcn_mfma_f32_16x16x32_bf16(kfr[rr][2 * T + 1], qf[1], s, 0, 0, 0);
            const int dr = rs + rr - r + 7;
#pragma unroll
            for (int e = 0; e < 4; ++e) {
                const int kcol = kcstart + 8 * fq + e + 4 * T;
                const bool valid = (kcol >= qcstart) && (kcol < qcstart + 16);
                const int dc = min(max(kcol - qcol, -15), 15) + 15;
                const float bias = rph[dr * 31 + dc];
                const float v = valid ? fmaf(s[e], c1, bias) : -1e30f;
                sc[rr][4 * T + e] = v;
                mx = fmaxf(mx, v);
            }
        }
    }
    __builtin_amdgcn_sched_barrier(0);
    bf16x8 vfr[4][8];
    {
        const bf16_t* vg0 = p.vT + VS_VN + ((size_t)(((b * 8 + h) * 32 + rs) * 64 + fr)) * 64 + kcstart + 8 * fq;
#pragma unroll
        for (int dt = 0; dt < 4; ++dt)
#pragma unroll
            for (int rr = 0; rr < 8; ++rr) vfr[dt][rr] = *(const bf16x8*)(vg0 + (size_t)(rr * 64 + 16 * dt) * 64);
    }
    mx = fmaxf(mx, __shfl_xor(mx, 16)); mx = fmaxf(mx, __shfl_xor(mx, 32));
    float l = 0.f;
    bf16x8 pb[8];
#pragma unroll
    for (int rr = 0; rr < 8; ++rr) {
#pragma unroll
        for (int e = 0; e < 8; ++e) { sc[rr][e] = fast_exp2(sc[rr][e] - mx); l += sc[rr][e]; }
        u32x4 w;
        w.x = cvt_pk_bf16(sc[rr][0], sc[rr][1]); w.y = cvt_pk_bf16(sc[rr][2], sc[rr][3]);
        w.z = cvt_pk_bf16(sc[rr][4], sc[rr][5]); w.w = cvt_pk_bf16(sc[rr][6], sc[rr][7]);
        pb[rr] = __builtin_bit_cast(bf16x8, w);
    }
    l += __shfl_xor(l, 16); l += __shfl_xor(l, 32);
    const float il = 1.0f / l;
    f32x4 O[4];
#pragma unroll
    for (int dt = 0; dt < 4; ++dt) {
        O[dt] = (f32x4){0.f, 0.f, 0.f, 0.f};
#pragma unroll
        for (int rr = 0; rr < 8; ++rr) O[dt] = __builtin_amdgcn_mfma_f32_16x16x32_bf16(vfr[dt][rr], pb[rr], O[dt], 0, 0, 0);
    }
#pragma unroll
    for (int dt = 0; dt < 4; ++dt) {
        const int d0 = 16 * dt + 4 * fq;
        const u32x2 gw = *(const u32x2*)(p.z + ZS_GATE + tokq * 1024 + 512 + h * 64 + d0);
        const float o0 = O[dt][0] * il * silu_f(bflo(gw.x)), o1 = O[dt][1] * il * silu_f(bfhi(gw.x));
        const float o2 = O[dt][2] * il * silu_f(bflo(gw.y)), o3 = O[dt][3] * il * silu_f(bfhi(gw.y));
        u32x2 w; w.x = cvt_pk_bf16(o0, o1); w.y = cvt_pk_bf16(o2, o3);
        *(u32x2*)(p.o + tokq * 1024 + 512 + h * 64 + d0) = w;
    }
}


constexpr int NA_P = 144, NA_KBYTES = 128 * NA_P, NA_STAGE = 2 * NA_KBYTES;

__device__ void na_super_online(char* lds, const Params& p, int layer, int su) {
    int tid_ = threadIdx.x; asm volatile("" : "+v"(tid_)); const int tid = tid_, lane = tid & 63, wid = __builtin_amdgcn_readfirstlane(tid >> 6), fr = lane & 15, fq = lane >> 4;
    const int bh = (su & 7) * 8 + (su >> 5), g = (su >> 3) & 3, b = bh >> 3, h = bh & 7;
    const float* rph = (const float*)(lds + LDS_RPB_OFF) + h * 465;
    const float c1 = 0.125f * LOG2E;
    const int rq = 8 * g + wid, rsw = min(max(rq - 4, 0), 24);
    bf16x8 qf[4][2];
    f32x4 O[4][4];
    float mrow[4], lrow[4];
#pragma unroll
    for (int n = 0; n < 4; ++n) {
#pragma unroll
        for (int t = 0; t < 2; ++t) qf[n][t] = *(const bf16x8*)(p.z + ZS_QN + ((size_t)(bh * 2048 + rq * 64 + 16 * n + fr)) * 64 + t * 32 + fq * 8);
#pragma unroll
        for (int dt = 0; dt < 4; ++dt) O[n][dt] = (f32x4){0.f, 0.f, 0.f, 0.f};
        mrow[n] = -1e30f; lrow[n] = 0.f;
    }
    const int klo = min(max(8 * g - 4, 0), 24);
    const int nsteps = (g == 0 || g == 3) ? 6 : 8;
    const bf16_t* Kg = p.z + ZS_KN + ((size_t)(bh * 2048 + klo * 64)) * 64 + tid * 8;
    const bf16_t* Vg = p.vT + VS_VN + ((size_t)((bh * 32 + klo) * 64)) * 64 + tid * 8;
    const int lw = (tid >> 3) * NA_P + (tid & 7) * 16;
    u32x4 rk[2], rv[2];
    rk[0] = *(const u32x4*)(Kg); rk[1] = *(const u32x4*)(Kg + 4096);
    rv[0] = *(const u32x4*)(Vg); rv[1] = *(const u32x4*)(Vg + 4096);
    __syncthreads();
    *(u32x4*)(lds + lw) = rk[0]; *(u32x4*)(lds + lw + 64 * NA_P) = rk[1];
    *(u32x4*)(lds + NA_KBYTES + lw) = rv[0]; *(u32x4*)(lds + NA_KBYTES + lw + 64 * NA_P) = rv[1];
    __syncthreads();
    const int krow_off = (8 * (fr >> 2) + (fr & 3)) * NA_P + fq * 16;
    const int vrow_off = fr * NA_P + (8 * fq) * 2;
    for (int st = 0; st < nsteps; ++st) {
        const char* cur = lds + (st & 1) * NA_STAGE;
        char* nxt = lds + ((st + 1) & 1) * NA_STAGE;
        if (st + 1 < nsteps) {
            const bf16_t* kg = Kg + (size_t)(st + 1) * 8192; const bf16_t* vg = Vg + (size_t)(st + 1) * 8192;
            rk[0] = *(const u32x4*)(kg); rk[1] = *(const u32x4*)(kg + 4096);
            rv[0] = *(const u32x4*)(vg); rv[1] = *(const u32x4*)(vg + 4096);
        }
#pragma unroll 1
        for (int slot = 0; slot < 2; ++slot) {
            const int kr = klo + 2 * st + slot;
            if (kr >= rsw && kr <= rsw + 7) {
                const char* cK = cur + slot * 64 * NA_P + krow_off;
                const char* cV = cur + NA_KBYTES + slot * 64 * NA_P + vrow_off;
                const float* rpr = rph + (kr - rq + 7) * 31;
                float v[4][8], mx[4];
#pragma unroll
                for (int n = 0; n < 4; ++n) {
                    const int kcstart = n == 0 ? 0 : (n == 1 ? 8 : (n == 2 ? 24 : 32));
                    const int qcol = 16 * n + fr;
                    const int qcstart = min(max(qcol - 8, 0), 48);
                    float bias[8];
#pragma unroll
                    for (int e = 0; e < 8; ++e) bias[e] = rpr[min(max(kcstart + 8 * fq + e - qcol, -15), 15) + 15];
#pragma unroll
                    for (int e = 0; e < 8; ++e) asm volatile("" : "+v"(bias[e]));
#pragma unroll
                    for (int T = 0; T < 2; ++T) {
                        const bf16x8 k0 = *(const bf16x8*)(cK + (kcstart + T * 4) * NA_P), k1 = *(const bf16x8*)(cK + (kcstart + T * 4) * NA_P + 64);
                        f32x4 s = (f32x4){0.f, 0.f, 0.f, 0.f};
                        s = __builtin_amdgcn_mfma_f32_16x16x32_bf16(k0, qf[n][0], s, 0, 0, 0);
                        s = __builtin_amdgcn_mfma_f32_16x16x32_bf16(k1, qf[n][1], s, 0, 0, 0);
#pragma unroll
                        for (int e = 0; e < 4; ++e) {
                            const int kcol = kcstart + 8 * fq + e + 4 * T;
                            const bool valid = (kcol >= qcstart) && (kcol < qcstart + 16);
                            v[n][4 * T + e] = valid ? fmaf(s[e], c1, bias[4 * T + e]) : -1e30f;
                        }
                    }
                    mx[n] = fmaxf(fmaxf(fmaxf(v[n][0], v[n][1]), fmaxf(v[n][2], v[n][3])), fmaxf(fmaxf(v[n][4], v[n][5]), fmaxf(v[n][6], v[n][7])));
                }
#pragma unroll
                for (int n = 0; n < 4; ++n) mx[n] = fmaxf(mx[n], __shfl_xor(mx[n], 16));
#pragma unroll
                for (int n = 0; n < 4; ++n) mx[n] = fmaxf(mx[n], __shfl_xor(mx[n], 32));
#pragma unroll
                for (int n = 0; n < 4; ++n) {
                    const int kcstart = n == 0 ? 0 : (n == 1 ? 8 : (n == 2 ? 24 : 32));
                    const float mnew = fmaxf(mrow[n], mx[n]);
                    const float alpha = fast_exp2(mrow[n] - mnew);
                    mrow[n] = mnew;
                    float ps = 0.f;
#pragma unroll
                    for (int e = 0; e < 8; ++e) { v[n][e] = fast_exp2(v[n][e] - mnew); ps += v[n][e]; }
                    lrow[n] = lrow[n] * alpha + ps;
                    u32x4 w;
                    w.x = cvt_pk_bf16(v[n][0], v[n][1]); w.y = cvt_pk_bf16(v[n][2], v[n][3]); w.z = cvt_pk_bf16(v[n][4], v[n][5]); w.w = cvt_pk_bf16(v[n][6], v[n][7]);
                    const bf16x8 pb = __builtin_bit_cast(bf16x8, w);
#pragma unroll
                    for (int dt = 0; dt < 4; ++dt) {
                        const bf16x8 vf = *(const bf16x8*)(cV + dt * 16 * NA_P + kcstart * 2);
                        O[n][dt] = __builtin_amdgcn_mfma_f32_16x16x32_bf16(vf, pb, O[n][dt] * alpha, 0, 0, 0);
                    }
                }
            }
        }
        if (st + 1 < nsteps) {
            *(u32x4*)(nxt + lw) = rk[0]; *(u32x4*)(nxt + lw + 64 * NA_P) = rk[1];
            *(u32x4*)(nxt + NA_KBYTES + lw) = rv[0]; *(u32x4*)(nxt + NA_KBYTES + lw + 64 * NA_P) = rv[1];
        }
        __syncthreads();
    }
    u32x2 gwv[4][4];
#pragma unroll
    for (int n = 0; n < 4; ++n)
#pragma unroll
        for (int dt = 0; dt < 4; ++dt) gwv[n][dt] = *(const u32x2*)(p.z + ZS_GATE + ((size_t)b * SEQ + rq * 64 + 16 * n + fr) * 1024 + 512 + h * 64 + 16 * dt + 4 * fq);
    __builtin_amdgcn_sched_barrier(0);
#pragma unroll
    for (int n = 0; n < 4; ++n) {
        float l = lrow[n];
        l += __shfl_xor(l, 16); l += __shfl_xor(l, 32);
        const float il = 1.0f / l;
        const size_t tokq = (size_t)b * SEQ + rq * 64 + 16 * n + fr;
#pragma unroll
        for (int dt = 0; dt < 4; ++dt) {
            const int d0 = 16 * dt + 4 * fq;
            const u32x2 gw = gwv[n][dt];
            const float o0 = O[n][dt][0] * il * silu_f(bflo(gw.x)), o1 = O[n][dt][1] * il * silu_f(bfhi(gw.x));
            const float o2 = O[n][dt][2] * il * silu_f(bflo(gw.y)), o3 = O[n][dt][3] * il * silu_f(bfhi(gw.y));
            u32x2 w; w.x = cvt_pk_bf16(o0, o1); w.y = cvt_pk_bf16(o2, o3);
            *(u32x2*)(p.o + tokq * 1024 + 512 + h * 64 + d0) = w;
        }
    }
}

__device__ void na_super(char* lds, const Params& p, int layer, int su) {
    int tid_ = threadIdx.x; asm volatile("" : "+v"(tid_)); const int tid = tid_, lane = tid & 63, wid = __builtin_amdgcn_readfirstlane(tid >> 6), fr = lane & 15, fq = lane >> 4;
    const int bh = (su & 7) * 8 + (su >> 5), g = (su >> 3) & 3, b = bh >> 3, h = bh & 7;
    const float* rph = (const float*)(lds + LDS_RPB_OFF) + h * 465;
    const float c1 = 0.125f * LOG2E;
    const int rq = 8 * g + wid, rsw = min(max(rq - 4, 0), 24);
    bf16x8 qf[4][2];
    f32x4 O[4][4];
    float mrow[4], lrow[4];
#pragma unroll
    for (int n = 0; n < 4; ++n) {
#pragma unroll
        for (int t = 0; t < 2; ++t) qf[n][t] = *(const bf16x8*)(p.z + ZS_QN + ((size_t)(bh * 2048 + rq * 64 + 16 * n + fr)) * 64 + t * 32 + fq * 8);
#pragma unroll
        for (int dt = 0; dt < 4; ++dt) O[n][dt] = (f32x4){0.f, 0.f, 0.f, 0.f};
        lrow[n] = 0.f;
        {
            const u32x4 k0 = *(const u32x4*)(p.z + ZS_KN + ((size_t)(bh * 2048 + rq * 64 + 16 * n + fr)) * 64 + fq * 8);
            const u32x4 k1 = *(const u32x4*)(p.z + ZS_KN + ((size_t)(bh * 2048 + rq * 64 + 16 * n + fr)) * 64 + 32 + fq * 8);
            const u32x4 q0 = __builtin_bit_cast(u32x4, qf[n][0]), q1 = __builtin_bit_cast(u32x4, qf[n][1]);
            float d = 0.f;
#pragma unroll
            for (int w = 0; w < 4; ++w) { d += bflo(q0[w]) * bflo(k0[w]) + bfhi(q0[w]) * bfhi(k0[w]); d += bflo(q1[w]) * bflo(k1[w]) + bfhi(q1[w]) * bfhi(k1[w]); }
            d += __shfl_xor(d, 16); d += __shfl_xor(d, 32);
            mrow[n] = -d;
        }
    }
    const int klo = min(max(8 * g - 4, 0), 24);
    const int nsteps = (g == 0 || g == 3) ? 6 : 8;
    const bf16_t* Kg = p.z + ZS_KN + ((size_t)(bh * 2048 + klo * 64)) * 64 + tid * 8;
    const bf16_t* Vg = p.vT + VS_VN + ((size_t)((bh * 32 + klo) * 64)) * 64 + tid * 8;
    const int lw = (tid >> 3) * NA_P + (tid & 7) * 16;
    u32x4 rk[2], rv[2];
    rk[0] = *(const u32x4*)(Kg); rk[1] = *(const u32x4*)(Kg + 4096);
    rv[0] = *(const u32x4*)(Vg); rv[1] = *(const u32x4*)(Vg + 4096);
    __syncthreads();
    *(u32x4*)(lds + lw) = rk[0]; *(u32x4*)(lds + lw + 64 * NA_P) = rk[1];
    *(u32x4*)(lds + NA_KBYTES + lw) = rv[0]; *(u32x4*)(lds + NA_KBYTES + lw + 64 * NA_P) = rv[1];
    __syncthreads();
    const int krow_off = (8 * (fr >> 2) + (fr & 3)) * NA_P + fq * 16;
    const int vrow_off = fr * NA_P + (8 * fq) * 2;
    for (int st = 0; st < nsteps; ++st) {
        const char* cur = lds + (st & 1) * NA_STAGE;
        char* nxt = lds + ((st + 1) & 1) * NA_STAGE;
        if (st + 1 < nsteps) {
            const bf16_t* kg = Kg + (size_t)(st + 1) * 8192; const bf16_t* vg = Vg + (size_t)(st + 1) * 8192;
            rk[0] = *(const u32x4*)(kg); rk[1] = *(const u32x4*)(kg + 4096);
            rv[0] = *(const u32x4*)(vg); rv[1] = *(const u32x4*)(vg + 4096);
        }
#pragma unroll 1
        for (int slot = 0; slot < 2; ++slot) {
            const int kr = klo + 2 * st + slot;
            if (kr >= rsw && kr <= rsw + 7) {
                const char* cK = cur + slot * 64 * NA_P + krow_off;
                const char* cV = cur + NA_KBYTES + slot * 64 * NA_P + vrow_off;
                const float* rpr = rph + (kr - rq + 7) * 31;
                float v[4][8];
#pragma unroll
                for (int n = 0; n < 4; ++n) {
                    const int kcstart = n == 0 ? 0 : (n == 1 ? 8 : (n == 2 ? 24 : 32));
                    const int qcol = 16 * n + fr;
                    const float* bp = rpr + (kcstart + 8 * fq - qcol + 15);
#pragma unroll
                    for (int e = 0; e < 8; ++e) v[n][e] = bp[e];
                }
#pragma unroll
                for (int n = 0; n < 4; ++n)
#pragma unroll
                    for (int e = 0; e < 8; ++e) asm volatile("" : "+v"(v[n][e]));
#pragma unroll
                for (int np = 0; np < 2; ++np) {
                    bf16x8 kfr[2][4];
#pragma unroll
                    for (int q = 0; q < 2; ++q) {
                        const int n = 2 * np + q;
                        const int kcstart = n == 0 ? 0 : (n == 1 ? 8 : (n == 2 ? 24 : 32));
#pragma unroll
                        for (int T = 0; T < 2; ++T) { kfr[q][2 * T] = *(const bf16x8*)(cK + (kcstart + T * 4) * NA_P); kfr[q][2 * T + 1] = *(const bf16x8*)(cK + (kcstart + T * 4) * NA_P + 64); }
                    }
#pragma unroll
                    for (int q = 0; q < 2; ++q) {
                        const int n = 2 * np + q;
                        const int kcstart = n == 0 ? 0 : (n == 1 ? 8 : (n == 2 ? 24 : 32));
                        const int qcol = 16 * n + fr;
                        const int qcstart = min(max(qcol - 8, 0), 48);
#pragma unroll
                        for (int T = 0; T < 2; ++T) {
                            f32x4 s = (f32x4){mrow[n], mrow[n], mrow[n], mrow[n]};
                            s = __builtin_amdgcn_mfma_f32_16x16x32_bf16(kfr[q][2 * T], qf[n][0], s, 0, 0, 0);
                            s = __builtin_amdgcn_mfma_f32_16x16x32_bf16(kfr[q][2 * T + 1], qf[n][1], s, 0, 0, 0);
#pragma unroll
                            for (int e = 0; e < 4; ++e) {
                                const int kcol = kcstart + 8 * fq + e + 4 * T;
                                const bool valid = (kcol >= qcstart) && (kcol < qcstart + 16);
                                v[n][4 * T + e] = valid ? fmaf(s[e], c1, v[n][4 * T + e]) : -1e30f;
                            }
                        }
                    }
                }
#pragma unroll
                for (int n = 0; n < 4; ++n) {
                    const int kcstart = n == 0 ? 0 : (n == 1 ? 8 : (n == 2 ? 24 : 32));
                    float ps = 0.f;
#pragma unroll
                    for (int e = 0; e < 8; ++e) { v[n][e] = fast_exp2(v[n][e]); ps += v[n][e]; }
                    lrow[n] += ps;
                    u32x4 w;
                    w.x = cvt_pk_bf16(v[n][0], v[n][1]); w.y = cvt_pk_bf16(v[n][2], v[n][3]); w.z = cvt_pk_bf16(v[n][4], v[n][5]); w.w = cvt_pk_bf16(v[n][6], v[n][7]);
                    const bf16x8 pb = __builtin_bit_cast(bf16x8, w);
#pragma unroll
                    for (int dt = 0; dt < 4; ++dt) {
                        const bf16x8 vf = *(const bf16x8*)(cV + dt * 16 * NA_P + kcstart * 2);
                        O[n][dt] = __builtin_amdgcn_mfma_f32_16x16x32_bf16(vf, pb, O[n][dt], 0, 0, 0);
                    }
                }
            }
        }
        if (st + 1 < nsteps) {
            *(u32x4*)(nxt + lw) = rk[0]; *(u32x4*)(nxt + lw + 64 * NA_P) = rk[1];
            *(u32x4*)(nxt + NA_KBYTES + lw) = rv[0]; *(u32x4*)(nxt + NA_KBYTES + lw + 64 * NA_P) = rv[1];
        }
        __syncthreads();
    }
    int bad = 0;
#pragma unroll
    for (int n = 0; n < 4; ++n) { lrow[n] += __shfl_xor(lrow[n], 16); lrow[n] += __shfl_xor(lrow[n], 32); bad |= !(lrow[n] < 1e30f); }
    {
        volatile unsigned* bflag = (volatile unsigned*)(lds + LDS_PHASE_BYTES + 8);
        if (tid == 0) *bflag = 0u;
        __syncthreads();
        if (__any(bad) && lane == 0) *bflag = 1u;
        __syncthreads();
        if (*bflag != 0u) { if (tid == 0) *(volatile unsigned*)(lds + LDS_PHASE_BYTES + 12) = 1u; return; }
    }
    u32x2 gwv[4][4];
#pragma unroll
    for (int n = 0; n < 4; ++n)
#pragma unroll
        for (int dt = 0; dt < 4; ++dt) gwv[n][dt] = *(const u32x2*)(p.z + ZS_GATE + ((size_t)b * SEQ + rq * 64 + 16 * n + fr) * 1024 + 512 + h * 64 + 16 * dt + 4 * fq);
    __builtin_amdgcn_sched_barrier(0);
#pragma unroll
    for (int n = 0; n < 4; ++n) {
        const float l = lrow[n];
        const float il = 1.0f / l;
        const size_t tokq = (size_t)b * SEQ + rq * 64 + 16 * n + fr;
#pragma unroll
        for (int dt = 0; dt < 4; ++dt) {
            const int d0 = 16 * dt + 4 * fq;
            const u32x2 gw = gwv[n][dt];
            const float o0 = O[n][dt][0] * il * silu_f(bflo(gw.x)), o1 = O[n][dt][1] * il * silu_f(bfhi(gw.x));
            const float o2 = O[n][dt][2] * il * silu_f(bflo(gw.y)), o3 = O[n][dt][3] * il * silu_f(bfhi(gw.y));
            u32x2 w; w.x = cvt_pk_bf16(o0, o1); w.y = cvt_pk_bf16(o2, o3);
            *(u32x2*)(p.o + tokq * 1024 + 512 + h * 64 + d0) = w;
        }
    }
}

__global__ void __launch_bounds__(NTHREADS) fwd_megakernel(Params p) {
    extern __shared__ __attribute__((aligned(16))) char lds[];
    if (p.never) cg::this_grid().sync();
    volatile LAS unsigned* st = (volatile LAS unsigned*)(lds + LDS_PHASE_BYTES);
    if (threadIdx.x < 4) st[threadIdx.x] = 0u;
    __syncthreads();
    const XcdBarrier gb = xcd_barrier_post(p.bar, st);
    prologue_phase(lds, p);
    xcd_barrier(gb);
    for (int layer = 0; layer < DEPTH; ++layer) {
        for (int rep = 0; rep < REP_GEMM0; ++rep) {
        { pg8::Gemm g{p.xb, p.wi_t + (size_t)layer * 4096 * 1024, NTOK, IN_W, 1024}; pg8::StaticOrder S; S.init(NTOK, IN_W, (int)gridDim.x, (int)blockIdx.x);
          pg8::EpiZ E{p.z, p.vT, p.rss};
          pg8::gemm_phase<pg8::EpiZ, pg8::StaticOrder, true, true>((PG8_LAS unsigned char*)lds, g, S, E); }
        xcd_barrier(gb);
        }
        { int t0_ = threadIdx.x; asm volatile("" : "+v"(t0_));
          for (int i = t0_; i < 8 * 465; i += NTHREADS) ((float*)(lds + LDS_RPB_OFF))[i] = p.rpb[(size_t)layer * 8 * 465 + i] * LOG2E;
          if (t0_ < 128) ((float*)(lds + LDS_SG_OFF))[t0_] = p.subln_g[layer * 128 + t0_];
          if (t0_ == 0) *(volatile unsigned*)(lds + LDS_PHASE_BYTES + 12) = 0u; }
        __syncthreads();
        for (int rep = 0; rep < REP_ATT; ++rep) {
        for (int u = blockIdx.x; u < 512 + 256; u += gridDim.x) {
            if (u < 512) { if (rep < REP_DA) da_unit(lds, p, layer, u); } else { if (rep < REP_NA) na_super(lds, p, layer, u - 512); }
        }
        __syncthreads();
        if (*(volatile unsigned*)(lds + LDS_PHASE_BYTES + 12) != 0u) {
            for (int u = blockIdx.x; u < 512 + 256; u += gridDim.x) if (u >= 512) na_super_online(lds, p, layer, u - 512);
        }
        xcd_barrier(gb);
        }
        { pg8::Gemm g{p.o, p.wo_t + (size_t)layer * 1024 * 1024, NTOK, 1024, 1024}; pg8::StaticOrder S; S.init(NTOK, 1024, (int)gridDim.x, (int)blockIdx.x);
          if (layer == 0) { pg8::EpiRes2<0, 0> E{p.x, p.xb, p.xb, p.xf, p.rss};
            pg8::gemm_phase<pg8::EpiRes2<0, 0>, pg8::StaticOrder, true, true>((PG8_LAS unsigned char*)lds, g, S, E); }
          else if (layer + 1 < DEPTH) { pg8::EpiRes2<1, 0> E{p.x, p.xb, p.xb, p.xf, p.rss};
            pg8::gemm_phase<pg8::EpiRes2<1, 0>, pg8::StaticOrder, true, true>((PG8_LAS unsigned char*)lds, g, S, E); }
          else if (gridDim.x == 256) { pg8::EpiFinal E{p.xb, p.xf, p.final_g, p.rss, p.bar + XCD_BAR_WORDS};
            pg8::gemm_phase<pg8::EpiFinal, pg8::StaticOrder, false, true>((PG8_LAS unsigned char*)lds, g, S, E); return; }
          else { pg8::EpiRes2<1, 1> E{p.x, p.xb, p.xb, p.xf, p.rss};
            pg8::gemm_phase<pg8::EpiRes2<1, 1>, pg8::StaticOrder, true, true>((PG8_LAS unsigned char*)lds, g, S, E); } }
        xcd_barrier(gb);
    }
    final_phase(p);
}

constexpr size_t LDS_BYTES = LDS_RPB_OFF + LDS_RPB_BYTES;

extern "C" void kernel_launch(void* const* d_in, const int* in_sizes, int n_in, void* d_out, int out_size, void* d_ws, size_t ws_size, hipStream_t stream) {
    static int grid_blocks = 0;
    if (!grid_blocks) {
        int dev = 0, cus = 0, per_cu = 0;
        hipGetDevice(&dev);
        hipDeviceGetAttribute(&cus, hipDeviceAttributeMultiprocessorCount, dev);
        hipFuncSetAttribute((const void*)fwd_megakernel, hipFuncAttributeMaxDynamicSharedMemorySize, (int)LDS_BYTES);
        hipOccupancyMaxActiveBlocksPerMultiprocessor(&per_cu, fwd_megakernel, NTHREADS, LDS_BYTES);
        if (per_cu < 1) per_cu = 1;
        if (per_cu > 1) per_cu = 1;
        grid_blocks = cus * per_cu;
    }
    Params p{};
    p.x = (const float*)d_in[0]; p.norm_g = (const float*)d_in[1]; p.w_in = (const float*)d_in[2]; p.w_out = (const float*)d_in[3];
    p.lq1 = (const float*)d_in[4]; p.lk1 = (const float*)d_in[5]; p.lq2 = (const float*)d_in[6]; p.lk2 = (const float*)d_in[7];
    p.subln_g = (const float*)d_in[8]; p.rpb = (const float*)d_in[9]; p.final_g = (const float*)d_in[10];
    p.xf = (float*)d_out;
    char* w = (char*)d_ws; size_t off = 0;
    auto take = [&](size_t bytes) { char* r = w + off; off += (bytes + 255) & ~(size_t)255; return r; };
    p.wi_t = (bf16_t*)take((size_t)DEPTH * 4096 * 1024 * 2);
    p.wo_t = (bf16_t*)take((size_t)DEPTH * 1024 * 1024 * 2);
    p.xb = (bf16_t*)take((size_t)NTOK * 1024 * 2);
    p.rss = (float*)take((size_t)NTOK * 16 * 4);
    p.z = (bf16_t*)take((size_t)NTOK * ZP * 2);
    p.vT = (bf16_t*)take((size_t)BATCH * 1024 * SEQ * 2);
    p.o = (bf16_t*)take((size_t)NTOK * 1024 * 2);
    p.bar = (unsigned*)take((size_t)(XCD_BAR_WORDS + 64 * 64) * 4);
    (void)hipMemsetAsync(p.bar, 0, (size_t)(XCD_BAR_WORDS + 64 * 64) * 4, stream);
    for (int l = 0; l < DEPTH; ++l) p.lam_init[l] = (float)(0.8 - 0.6 * exp(-0.3 * (double)l));
    void* args[] = {&p};
    hipError_t e = hipLaunchCooperativeKernel((const void*)fwd_megakernel, dim3(grid_blocks), dim3(NTHREADS), args, LDS_BYTES, stream);
    if (e != hipSuccess) fprintf(stderr, "cooperative launch failed: %s (grid %d)\n", hipGetErrorString(e), grid_blocks);
}
```

```cpp
#include <hip/hip_runtime.h>
#include <hip/hip_cooperative_groups.h>
#include <cstdio>
#include <cstdint>
namespace cg = cooperative_groups;

typedef unsigned short bf16_t;
typedef short bf16x8 __attribute__((ext_vector_type(8)));
typedef float f32x4 __attribute__((ext_vector_type(4)));
typedef float f32x16 __attribute__((ext_vector_type(16)));
typedef unsigned u32x4 __attribute__((ext_vector_type(4)));
typedef unsigned u32x2 __attribute__((ext_vector_type(2)));

constexpr int D_MODEL = 1024, BATCH = 8, SEQ = 2048, DEPTH = 4, NTOK = BATCH * SEQ;
constexpr int IN_W = 4096;
constexpr size_t ZS_QD = 0, ZS_KD = (size_t)NTOK * 512, ZS_QN = (size_t)NTOK * 1024, ZS_KN = (size_t)NTOK * 1536, ZS_GATE = (size_t)NTOK * 2048;
constexpr size_t VS_VD = 0, VS_VN = (size_t)NTOK * 512;
constexpr int ZP = 3072;
constexpr float RMS_EPS = 1e-6f;
constexpr float LOG2E = 1.4426950408889634f;
constexpr int NTHREADS = 512;
#ifndef REP_GEMM0
#define REP_GEMM0 1
#endif
#ifndef REP_DA
#define REP_DA 1
#endif
#ifndef REP_NA
#define REP_NA 1
#endif
#define REP_ATT (REP_DA > REP_NA ? REP_DA : REP_NA)

struct Params {
    const float* x; const float* norm_g; const float* w_in; const float* w_out;
    const float* lq1; const float* lk1; const float* lq2; const float* lk2;
    const float* subln_g; const float* rpb; const float* final_g;
    float* xf;
    bf16_t* wi_t;
    bf16_t* wo_t;
    bf16_t* xb;
    float* rss;
    bf16_t* z;
    bf16_t* vT;
    bf16_t* o;
    unsigned* bar;
    float lam_init[DEPTH];
    int never;
    int pad_;
};

typedef __bf16 bf16x2_t __attribute__((ext_vector_type(2)));
typedef float f32x2_t __attribute__((ext_vector_type(2)));
__device__ __forceinline__ unsigned cvt_pk_bf16(float lo, float hi) {
    const f32x2_t v = {lo, hi};
    return __builtin_bit_cast(unsigned, __builtin_convertvector(v, bf16x2_t));
}
__device__ __forceinline__ float bf2f(unsigned short b) { return __uint_as_float(((unsigned)b) << 16); }
__device__ __forceinline__ float bflo(unsigned w) { return __uint_as_float(w << 16); }
__device__ __forceinline__ float bfhi(unsigned w) { return __uint_as_float(w & 0xffff0000u); }
__device__ __forceinline__ float fast_exp2(float x) { return __builtin_amdgcn_exp2f(x); }


#define XB_TMO      128
#define XB_XCNT(j)  (256  + 64 * (j))
#define XB_XSUB(j)  (1280 + 64 * (j))
#define XB_XGEN(j)  (2304 + 64 * (j))
#define XB_TOP      3328
#define XB_TOPGEN   3392
#define XCD_BAR_WORDS 3456
#define XB_SPIN_CAP (1u << 20)
#define LAS __attribute__((address_space(3)))
__device__ __forceinline__ unsigned xb_ld(unsigned* p)              { return __hip_atomic_load(p, __ATOMIC_RELAXED, __HIP_MEMORY_SCOPE_AGENT); }
__device__ __forceinline__ unsigned xb_add(unsigned* p, unsigned v) { return __hip_atomic_fetch_add(p, v, __ATOMIC_RELAXED, __HIP_MEMORY_SCOPE_AGENT); }
__device__ __forceinline__ unsigned xb_xcc_id() { return (unsigned)__builtin_amdgcn_s_getreg((3 << 11) | 20) & 0xFu; }
#define XB_SPIN(cond, bar) do { unsigned _sp = 0; while (cond) { __builtin_amdgcn_s_sleep(1); \
    if ((++_sp & 255u) == 0u) { if (xb_ld(&(bar)[XB_TMO])) break; if (_sp > XB_SPIN_CAP) { atomicAdd(&(bar)[XB_TMO], 1u); break; } } } } while (0)
struct XcdBarrier { unsigned* bar; unsigned x; volatile LAS unsigned* st; };
__device__ __forceinline__ XcdBarrier xcd_barrier_post(unsigned* bar, volatile LAS unsigned* st) {
    XcdBarrier b; b.bar = bar; b.x = xb_xcc_id(); b.st = st;
    if (threadIdx.x == 0) (void)xb_add(&bar[XB_XCNT(b.x)], 1u);
    return b;
}
__device__ __forceinline__ void xcd_barrier_complete(unsigned* bar, unsigned x, unsigned& nloc, unsigned& nx) {
    const unsigned G = gridDim.x * gridDim.y * gridDim.z;
    unsigned sum, cnt, mine, sp = 0u;
    for (;;) {
        sum = 0u; cnt = 0u; mine = 0u;
#pragma unroll
        for (unsigned j = 0; j < 16; ++j) { const unsigned c = xb_ld(&bar[XB_XCNT(j)]); sum += c; cnt += (c > 0u) ? 1u : 0u; mine = (j == x) ? c : mine; }
        if (sum == G) break;
        __builtin_amdgcn_s_sleep(1);
        if ((++sp & 255u) == 0u) { if (xb_ld(&bar[XB_TMO])) break; if (sp > XB_SPIN_CAP) { atomicAdd(&bar[XB_TMO], 1u); break; } }
    }
    nloc = mine > 0u ? mine : 1u; nx = cnt > 0u ? cnt : 1u;
}
__device__ __forceinline__ void xcd_barrier(const XcdBarrier& b) {
    asm volatile("s_waitcnt vmcnt(0)" ::: "memory");
    __syncthreads();
    if (threadIdx.x == 0) {
        unsigned* bar = b.bar;
        unsigned bx = b.x; asm volatile("" : "+s"(bx));
        __builtin_amdgcn_s_waitcnt(0);
        unsigned nloc = b.st[0], nx = b.st[1];
        if (nloc == 0u) { xcd_barrier_complete(bar, bx, nloc, nx); b.st[0] = nloc; b.st[1] = nx; }
        const unsigned old = xb_add(&bar[XB_XSUB(bx)], 1u);
        const unsigned gen = old / nloc;
        if (old + 1u == (gen + 1u) * nloc) {
            __builtin_amdgcn_fence(__ATOMIC_RELEASE, "agent");
            asm volatile("s_waitcnt vmcnt(0)" ::: "memory");
            const unsigned og = xb_add(&bar[XB_TOP], 1u);
            const unsigned tg = og / nx;
            if (og + 1u == (tg + 1u) * nx) xb_add(&bar[XB_TOPGEN], 1u);
            else XB_SPIN(xb_ld(&bar[XB_TOPGEN]) == tg, bar);
            __builtin_amdgcn_fence(__ATOMIC_ACQUIRE, "agent");
            xb_add(&bar[XB_XGEN(bx)], 1u);
            asm volatile("s_waitcnt vmcnt(0)" ::: "memory");
        } else {
            XB_SPIN(xb_ld(&bar[XB_XGEN(bx)]) == gen, bar);
            __builtin_amdgcn_fence(__ATOMIC_ACQUIRE, "agent");
            asm volatile("s_waitcnt vmcnt(0)" ::: "memory");
        }
    }
    __syncthreads();
}

__device__ __forceinline__ int perm_col(int n) {
    if (n < 1024) return n;
    if (n < 2048) return n + 512;
    if (n < 3072) return n + 1024;
    if (n < 3584) return n - 2048;
    return n - 1024;
}

__device__ void prologue_phase(char* lds, const Params& p) {
    int tid_ = threadIdx.x; asm volatile("" : "+v"(tid_)); const int tid = tid_, lane = tid & 63, wid = tid >> 6;
    float* tile = (float*)lds;
    const int nt_in = DEPTH * 16 * 64, nt_out = DEPTH * 16 * 16;
    for (int t = blockIdx.x; t < nt_in + nt_out; t += gridDim.x) {
        const float* W; bf16_t* Wt; const float* g; int N, k0, n0, no0;
        if (t < nt_in) {
            const int l = t >> 10, rem = t & 1023; k0 = (rem >> 6) * 64; n0 = (rem & 63) * 64;
            W = p.w_in + (size_t)l * 1024 * 4096; N = 4096; Wt = p.wi_t + (size_t)l * 4096 * 1024; g = p.norm_g + l * 1024; no0 = perm_col(n0);
        } else {
            const int t2 = t - nt_in; const int l = t2 >> 8, rem = t2 & 255; k0 = (rem >> 4) * 64; n0 = (rem & 15) * 64;
            W = p.w_out + (size_t)l * 1024 * 1024; N = 1024; Wt = p.wo_t + (size_t)l * 1024 * 1024; g = nullptr; no0 = n0;
        }
        {
            const int i = tid >> 4, j4 = tid & 15;
#pragma unroll
            for (int ps = 0; ps < 2; ++ps) {
                const int kk = i + 32 * ps;
                const f32x4 v = *(const f32x4*)(W + (size_t)(k0 + kk) * N + no0 + 4 * j4);
                const float gg = g ? g[k0 + kk] : 1.0f;
                tile[kk * 65 + 4 * j4 + 0] = v[0] * gg; tile[kk * 65 + 4 * j4 + 1] = v[1] * gg;
                tile[kk * 65 + 4 * j4 + 2] = v[2] * gg; tile[kk * 65 + 4 * j4 + 3] = v[3] * gg;
            }
        }
        __syncthreads();
        {
            const int j = tid >> 3, i8 = tid & 7;
            float v[8];
#pragma unroll
            for (int e = 0; e < 8; ++e) v[e] = tile[(8 * i8 + e) * 65 + j];
            u32x4 w; w.x = cvt_pk_bf16(v[0], v[1]); w.y = cvt_pk_bf16(v[2], v[3]); w.z = cvt_pk_bf16(v[4], v[5]); w.w = cvt_pk_bf16(v[6], v[7]);
            *(u32x4*)(Wt + (size_t)(n0 + j) * 1024 + k0 + 8 * i8) = w;
        }
        __syncthreads();
    }
    for (int row = blockIdx.x * 8 + wid; row < NTOK; row += gridDim.x * 8) {
        float ss = 0.f;
#pragma unroll
        for (int i = 0; i < 4; ++i) {
            const int c = 4 * lane + 256 * i;
            const f32x4 v = *(const f32x4*)(p.x + (size_t)row * 1024 + c);
            ss += v[0] * v[0] + v[1] * v[1] + v[2] * v[2] + v[3] * v[3];
            u32x2 w; w.x = cvt_pk_bf16(v[0], v[1]); w.y = cvt_pk_bf16(v[2], v[3]);
            *(u32x2*)(p.xb + (size_t)row * 1024 + c) = w;
        }
#pragma unroll
        for (int s = 32; s >= 1; s >>= 1) ss += __shfl_xor(ss, s);
        if (lane < 16) p.rss[(size_t)row * 16 + lane] = lane == 0 ? ss : 0.f;
    }
}

__device__ void final_phase(const Params& p) {
    int tid_ = threadIdx.x; asm volatile("" : "+v"(tid_)); const int tid = tid_, lane = tid & 63, wid = tid >> 6;
    for (int row = blockIdx.x * 8 + wid; row < NTOK; row += gridDim.x * 8) {
        float ss = 0.f;
        if (lane < 16) ss = p.rss[(size_t)row * 16 + lane];
#pragma unroll
        for (int s = 8; s >= 1; s >>= 1) ss += __shfl_xor(ss, s);
        ss = __shfl(ss, 0);
        const float rstd = rsqrtf(ss * (1.0f / 1024.0f) + RMS_EPS);
#pragma unroll
        for (int i = 0; i < 4; ++i) {
            const int c = 4 * lane + 256 * i;
            f32x4 v = *(const f32x4*)(p.xf + (size_t)row * 1024 + c);
            const f32x4 g = *(const f32x4*)(p.final_g + c);
            v = v * rstd * g;
            *(f32x4*)(p.xf + (size_t)row * 1024 + c) = v;
        }
    }
}

namespace pg8 {
#define PG8_LAS __attribute__((address_space(3)))
typedef unsigned short bf16_t;
typedef short bf16x8 __attribute__((ext_vector_type(8)));
typedef float f32x4 __attribute__((ext_vector_type(4)));
typedef unsigned u32x4 __attribute__((ext_vector_type(4)));
constexpr int BM = 256, BK = 64, HALF = 128, HTB = HALF * BK * 2  , STAGE_BYTES = 8 * HTB, NXCD = 8, WGM = 8;

__host__ __device__ __forceinline__ int lds_byte(int r, int c) { const int st = (r >> 4) * 2 + (c >> 5), rr = r & 15, cc = c & 31, ob = rr * 64 + cc * 2; return st * 1024 + (ob ^ (((ob >> 9) & 1) << 5)); }
__host__ __device__ __forceinline__ void stage_rc(int b, int& R, int& C) { const int st = b / 1024, sb = b % 1024, swz = sb ^ (((sb >> 9) & 1) << 5); R = (st >> 1) * 16 + swz / 64; C = (st & 1) * 32 + (swz % 64) / 2; }
__host__ __device__ __forceinline__ int perm32(int rho) { const int n = rho >> 4, i = rho & 15; return 8 * (i >> 2) + 4 * n + (i & 3); }

struct Unit { int pm, pn; };
struct Gemm { const bf16_t* A; const bf16_t* Bt; int M, N, K; };

struct StaticOrder {
    int nM, nN, nwg, G, c;
    __host__ __device__ void init(int M, int N, int G_, int c_) { nM = M / BM; nN = N / BM; nwg = nM * nN; G = G_; c = c_; }
    __host__ __device__ bool next(int i, Unit& u) const {
        const long L = (long)i * G + c; if (L >= nwg) return false;
        int wgid = (int)L; { const int q = nwg / NXCD, r = nwg % NXCD, xcd = wgid % NXCD, off = wgid / NXCD; wgid = (xcd < r ? xcd * (q + 1) : r * (q + 1) + (xcd - r) * q) + off; }
        const int nig = WGM * nN, gid = wgid / nig, fm = gid * WGM, gsz = (nM - fm) < WGM ? (nM - fm) : WGM;
        u.pm = fm + ((wgid % nig) % gsz); u.pn = (wgid % nig) / gsz; return true;
    }
    __device__ __forceinline__ void a_ready(const Unit&) const {}
    __device__ __forceinline__ void done(const Unit&) const {}
};


template <class Epi, class Sched, bool ALIGN_EPI = false, bool SP2 = false>
__device__ __forceinline__ void gemm_phase(PG8_LAS unsigned char* lds, const Gemm g, const Sched& S, const Epi& E) {
    int tid_ = threadIdx.x; asm volatile("" : "+v"(tid_));
    const int tid = tid_, wid = __builtin_amdgcn_readfirstlane(tid >> 6), lane = tid & 63, wr = wid >> 2, wc = wid & 3, fr = lane & 15, fq = lane >> 4;
    const int K = g.K, nt = K / BK;
    unsigned voffA[2], voffB[2];
#pragma unroll
    for (int i = 0; i < 2; ++i) { int R, C; stage_rc(tid * 16 + i * 8192, R, C); const int Rb = Epi::PERM ? ((R & ~31) + perm32(R & 31)) : R;
        voffA[i] = (unsigned)(R * K + C) * 2u; voffB[i] = (unsigned)(Rb * K + C) * 2u; }
    const size_t kstep = (size_t)(BK * 2);
    const size_t hstep = (size_t)HALF * K * 2;
    const size_t tstep = 2 * hstep;
    const unsigned ldsw = (unsigned)wid * 1024u;
    const int aoff = lds_byte(wr * 64 + fr, fq * 8), boff = lds_byte(wc * 32 + fr, fq * 8);
#define PG8_SA(b, h) (((b) * 2 + (h)) * HTB)
#define PG8_SB(b, h) ((4 + (b) * 2 + (h)) * HTB)
#define PG8_STAGE(bufoff, gbase, voff) do { _Pragma("unroll") for (int _i = 0; _i < 2; ++_i) \
        __builtin_amdgcn_global_load_lds((const unsigned*)((const char*)(gbase) + (voff)[_i]), (PG8_LAS unsigned*)(lds + (bufoff) + ldsw + _i * 8192), 16, 0, 0); } while (0)
#define PG8_LDA(dst, b, h) do { _Pragma("unroll") for (int m = 0; m < 4; ++m) _Pragma("unroll") for (int k = 0; k < 2; ++k) dst[m][k] = *(const PG8_LAS bf16x8*)(lds + PG8_SA(b, h) + aoff + m * 2048 + k * 1024); } while (0)
#define PG8_LDB(dst, b, h) do { _Pragma("unroll") for (int n = 0; n < 2; ++n) _Pragma("unroll") for (int k = 0; k < 2; ++k) dst[n][k] = *(const PG8_LAS bf16x8*)(lds + PG8_SB(b, h) + boff + n * 2048 + k * 1024); } while (0)
#define PG8_MMA(ai, bj, At, Bt) do { __builtin_amdgcn_s_setprio(1); _Pragma("unroll") for (int m = 0; m < 4; ++m) _Pragma("unroll") for (int n = 0; n < 2; ++n) _Pragma("unroll") for (int k = 0; k < 2; ++k) \
        acc[ai][bj][m][n] = __builtin_amdgcn_mfma_f32_16x16x32_bf16(Bt[n][k], At[m][k], acc[ai][bj][m][n], 0, 0, 0); __builtin_amdgcn_s_setprio(0); } while (0)
#define PG8_WAIT_V(n) asm volatile("s_waitcnt vmcnt(" #n ")" ::: "memory")
#define PG8_WAIT_L(n) asm volatile("s_waitcnt lgkmcnt(" #n ")" ::: "memory")
#define PG8_BAR __builtin_amdgcn_s_barrier()
#define PG8_SCHED __builtin_amdgcn_sched_barrier(0)
    Unit cur, nxt; int ui = 0;
    if (!S.next(0, cur)) return;
    f32x4 acc[2][2][4][2];
#pragma unroll
    for (int a = 0; a < 2; ++a)
#pragma unroll
        for (int b = 0; b < 2; ++b)
#pragma unroll
            for (int m = 0; m < 4; ++m)
#pragma unroll
                for (int n = 0; n < 2; ++n) acc[a][b][m][n] = (f32x4){0.f, 0.f, 0.f, 0.f};
    bf16x8 At[4][2], B0[2][2], B1[2][2];
    const char* cA = (const char*)g.A + (size_t)cur.pm * tstep; const char* cB = (const char*)g.Bt + (size_t)cur.pn * tstep;
    S.a_ready(cur);
    if constexpr (SP2) {
        PG8_STAGE(PG8_SB(0, 0), cB, voffB); PG8_STAGE(PG8_SB(0, 1), cB + hstep, voffB); PG8_STAGE(PG8_SA(0, 0), cA, voffA); PG8_STAGE(PG8_SA(0, 1), cA + hstep, voffA);
        if (wr == 1) PG8_BAR;
        PG8_WAIT_V(2); PG8_BAR;
        PG8_STAGE(PG8_SB(1, 0), cB + kstep, voffB); PG8_STAGE(PG8_SA(1, 0), cA + kstep, voffA); PG8_STAGE(PG8_SB(1, 1), cB + hstep + kstep, voffB);
        PG8_WAIT_V(6); PG8_BAR;
    } else {
        PG8_STAGE(PG8_SB(0, 0), cB, voffB); PG8_STAGE(PG8_SA(0, 0), cA, voffA); PG8_STAGE(PG8_SB(0, 1), cB + hstep, voffB); PG8_STAGE(PG8_SA(0, 1), cA + hstep, voffA);
        if (wr == 1) PG8_BAR;
        PG8_WAIT_V(4); PG8_BAR;
        PG8_STAGE(PG8_SB(1, 0), cB + kstep, voffB); PG8_STAGE(PG8_SA(1, 0), cA + kstep, voffA); PG8_STAGE(PG8_SB(1, 1), cB + hstep + kstep, voffB);
        PG8_WAIT_V(6); PG8_BAR;
    }
    for (;;) {
        const bool has_next = S.next(ui + 1, nxt);
        const char* nA = has_next ? (const char*)g.A + (size_t)nxt.pm * tstep : cA; const char* nB = has_next ? (const char*)g.Bt + (size_t)nxt.pn * tstep : cB;
        for (int t = 0; t < nt; t += 2) {
            const bool last = (t == nt - 2);
            const char* a1 = cA + (size_t)(t + 1) * kstep;
            const char* a2 = last ? nA : cA + (size_t)(t + 2) * kstep; const char* b2 = last ? nB : cB + (size_t)(t + 2) * kstep;
            const char* a3 = a2 + kstep; const char* b3 = b2 + kstep;
            if (last && has_next) S.a_ready(nxt);
            if constexpr (SP2) {
            PG8_LDB(B0, 0, 0); PG8_LDB(B1, 0, 1); PG8_SCHED; PG8_LDA(At, 0, 0); PG8_STAGE(PG8_SA(1, 1), a1 + hstep, voffA);
            PG8_WAIT_V(8); PG8_WAIT_L(0); PG8_BAR; PG8_MMA(0, 0, At, B0); PG8_MMA(0, 1, At, B1); PG8_BAR; PG8_SCHED;
            PG8_LDA(At, 0, 1); PG8_STAGE(PG8_SB(0, 0), b2, voffB); PG8_STAGE(PG8_SB(0, 1), b2 + hstep, voffB); PG8_STAGE(PG8_SA(0, 0), a2, voffA);
            PG8_WAIT_V(8); PG8_WAIT_L(0); PG8_BAR; PG8_MMA(1, 0, At, B0); PG8_MMA(1, 1, At, B1); PG8_BAR; PG8_SCHED;
            PG8_LDB(B0, 1, 0); PG8_LDB(B1, 1, 1); PG8_SCHED; PG8_LDA(At, 1, 0); PG8_STAGE(PG8_SA(0, 1), a2 + hstep, voffA);
            PG8_WAIT_V(8); PG8_WAIT_L(0); PG8_BAR; PG8_MMA(0, 0, At, B0); PG8_MMA(0, 1, At, B1); PG8_BAR; PG8_SCHED;
            PG8_LDA(At, 1, 1); PG8_STAGE(PG8_SB(1, 0), b3, voffB); PG8_STAGE(PG8_SB(1, 1), b3 + hstep, voffB); PG8_STAGE(PG8_SA(1, 0), a3, voffA);
            PG8_WAIT_V(8); PG8_WAIT_L(0); PG8_BAR; PG8_MMA(1, 0, At, B0); PG8_MMA(1, 1, At, B1); PG8_BAR; PG8_SCHED;
            } else {
            PG8_LDB(B0, 0, 0); PG8_SCHED; PG8_LDA(At, 0, 0); PG8_STAGE(PG8_SA(1, 1), a1 + hstep, voffA);
            PG8_WAIT_L(8); PG8_BAR; PG8_WAIT_L(0); PG8_MMA(0, 0, At, B0); PG8_BAR; PG8_SCHED;
            PG8_LDB(B1, 0, 1); PG8_STAGE(PG8_SB(0, 0), b2, voffB);
            PG8_BAR; PG8_WAIT_L(0); PG8_MMA(0, 1, At, B1); PG8_BAR;
            PG8_LDA(At, 0, 1); PG8_STAGE(PG8_SA(0, 0), a2, voffA);
            PG8_BAR; PG8_WAIT_L(0); PG8_MMA(1, 0, At, B0); PG8_BAR; PG8_SCHED;
            PG8_STAGE(PG8_SB(0, 1), b2 + hstep, voffB);
            PG8_WAIT_V(6); PG8_BAR; PG8_MMA(1, 1, At, B1); PG8_BAR;
            PG8_LDB(B0, 1, 0); PG8_SCHED; PG8_LDA(At, 1, 0); PG8_STAGE(PG8_SA(0, 1), a2 + hstep, voffA);
            PG8_WAIT_L(8); PG8_BAR; PG8_WAIT_L(0); PG8_MMA(0, 0, At, B0); PG8_BAR; PG8_SCHED;
            PG8_LDB(B1, 1, 1); PG8_STAGE(PG8_SB(1, 0), b3, voffB);
            PG8_BAR; PG8_WAIT_L(0); PG8_MMA(0, 1, At, B1); PG8_BAR;
            PG8_LDA(At, 1, 1); PG8_STAGE(PG8_SA(1, 0), a3, voffA);
            PG8_BAR; PG8_WAIT_L(0); PG8_MMA(1, 0, At, B0); PG8_BAR; PG8_SCHED;
            PG8_STAGE(PG8_SB(1, 1), b3 + hstep, voffB);
            PG8_WAIT_V(6); PG8_BAR; PG8_MMA(1, 1, At, B1); PG8_BAR;
            }
        }
        if constexpr (ALIGN_EPI) { if (wr == 0) PG8_BAR; }
        if constexpr (!Epi::AFTER_DRAIN) { E(acc, cur, wr, wc, fr, fq); S.done(cur); }
        if (!has_next) break;
#pragma unroll
        for (int a = 0; a < 2; ++a)
#pragma unroll
            for (int b = 0; b < 2; ++b)
#pragma unroll
                for (int m = 0; m < 4; ++m)
#pragma unroll
                    for (int n = 0; n < 2; ++n) acc[a][b][m][n] = (f32x4){0.f, 0.f, 0.f, 0.f};
        cur = nxt; cA = nA; cB = nB; ++ui;
        if constexpr (ALIGN_EPI) { if (wr == 1) PG8_BAR; }
    }
    PG8_WAIT_V(0);
    if constexpr (!ALIGN_EPI) { if (wr == 0) PG8_BAR; }
    PG8_BAR;
    if constexpr (Epi::AFTER_DRAIN) { E.fused(acc, cur, wr, wc, fr, fq, lds, wid, lane); S.done(cur); }
#undef PG8_SA
#undef PG8_SB
#undef PG8_STAGE
#undef PG8_LDA
#undef PG8_LDB
#undef PG8_MMA
#undef PG8_WAIT_V
#undef PG8_WAIT_L
#undef PG8_BAR
#undef PG8_SCHED
}
}


namespace pg8 {
struct EpiZ {
    static constexpr bool PERM = true, AFTER_DRAIN = false;
    bf16_t* z; bf16_t* vT; const float* rss;
    __device__ __forceinline__ void operator()(const f32x4 (&acc)[2][2][4][2], const Unit& u, int wr, int wc, int fr, int fq) const {
        f32x4 part[2][4];
#pragma unroll
        for (int ai = 0; ai < 2; ++ai)
#pragma unroll
            for (int m = 0; m < 4; ++m) part[ai][m] = *(const f32x4*)(rss + (size_t)(u.pm * BM + ai * HALF + wr * 64 + m * 16 + fr) * 16 + 4 * fq);
        float rstdv[2][4];
#pragma unroll
        for (int ai = 0; ai < 2; ++ai)
#pragma unroll
            for (int m = 0; m < 4; ++m) {
                float s = (part[ai][m][0] + part[ai][m][1]) + (part[ai][m][2] + part[ai][m][3]);
                s += __shfl_xor(s, 16); s += __shfl_xor(s, 32);
                rstdv[ai][m] = rsqrtf(s * (1.0f / 1024.0f) + RMS_EPS);
            }
#pragma unroll
        for (int ai = 0; ai < 2; ++ai)
#pragma unroll
            for (int m = 0; m < 4; ++m) {
                const int row = u.pm * BM + ai * HALF + wr * 64 + m * 16 + fr;
                const float rstd = rstdv[ai][m];
                const int b = row >> 11, s = row & 2047;
#pragma unroll
                for (int bj = 0; bj < 2; ++bj) {
                    const int tn = 2 * u.pn + bj;
                    const int cw = 32 * wc + 8 * fq;
                    const f32x4 v0 = acc[ai][bj][m][0] * rstd, v1 = acc[ai][bj][m][1] * rstd;
                    u32x4 w; w.x = ::cvt_pk_bf16(v0[0], v0[1]); w.y = ::cvt_pk_bf16(v0[2], v0[3]); w.z = ::cvt_pk_bf16(v1[0], v1[1]); w.w = ::cvt_pk_bf16(v1[2], v1[3]);
                    if (tn < 24) {
                        bf16_t* dst;
                        if (tn < 8) dst = z + (size_t)(tn >> 2) * ZS_KD + ((size_t)((b * 4 + (tn & 3)) * 2048 + s)) * 128 + cw;
                        else if (tn < 16) dst = z + ZS_QN + (size_t)((tn - 8) >> 2) * (ZS_KN - ZS_QN) + ((size_t)((b * 8 + ((tn - 8) & 3) * 2 + (cw >> 6)) * 2048 + s)) * 64 + (cw & 63);
                        else dst = z + ZS_GATE + (size_t)row * 1024 + (tn - 16) * 128 + cw;
                        *(u32x4*)dst = w;
                    } else {
                        const unsigned ox = __shfl_xor(w.x, 1), oy = __shfl_xor(w.y, 1), oz = __shfl_xor(w.z, 1), ow = __shfl_xor(w.w, 1);
                        const bool odd = fr & 1;
                        const unsigned a0 = odd ? oz : w.x, a1 = odd ? ow : w.y;
                        const unsigned b0 = odd ? w.z : ox, b1 = odd ? w.w : oy;
                        const unsigned p0 = (a0 & 0xffffu) | (b0 << 16), p1 = (a0 >> 16) | (b0 & 0xffff0000u);
                        const unsigned p2 = (a1 & 0xffffu) | (b1 << 16), p3 = (a1 >> 16) | (b1 & 0xffff0000u);
                        const int ch0 = cw + (odd ? 4 : 0), se = s & ~1;
                        bf16_t* dst;
                        if (tn < 28) dst = vT + VS_VD + ((size_t)(((b * 4 + (tn - 24)) * 32 + (se >> 6)) * 128 + ch0)) * 64 + (se & 63);
                        else dst = vT + VS_VN + ((size_t)(((b * 8 + (tn - 28) * 2 + (ch0 >> 6)) * 32 + (se >> 6)) * 64 + (ch0 & 63))) * 64 + (se & 63);
                        *(unsigned*)(dst) = p0; *(unsigned*)(dst + 64) = p1; *(unsigned*)(dst + 128) = p2; *(unsigned*)(dst + 192) = p3;
                    }
                }
            }
    }
};
template <int XIN, int OUT> struct EpiRes2 {
    static constexpr bool PERM = true, AFTER_DRAIN = false, TOUCH = false;
    const float* xin32; const bf16_t* xinb; bf16_t* xb; float* xf; float* rss;
    __device__ __forceinline__ void operator()(const f32x4 (&acc)[2][2][4][2], const Unit& u, int wr, int wc, int fr, int fq) const {
#pragma unroll
        for (int ai = 0; ai < 2; ++ai) {
            f32x4 res[XIN == 0 ? 4 : 1][2][2]; u32x4 rb[XIN == 0 ? 1 : 4][2];
#pragma unroll
            for (int m = 0; m < 4; ++m)
#pragma unroll
                for (int bj = 0; bj < 2; ++bj) {
                    const size_t off = (size_t)(u.pm * BM + ai * HALF + wr * 64 + m * 16 + fr) * 1024 + u.pn * BM + bj * HALF + 32 * wc + 8 * fq;
                    if (XIN == 0) { res[m][bj][0] = *(const f32x4*)(xin32 + off); res[m][bj][1] = *(const f32x4*)(xin32 + off + 4); }
                    else rb[m][bj] = *(const u32x4*)(xinb + off);
                }
            __builtin_amdgcn_sched_barrier(0);
#pragma unroll
            for (int m = 0; m < 4; ++m) {
                const int row = u.pm * BM + ai * HALF + wr * 64 + m * 16 + fr;
                float ss = 0.f;
#pragma unroll
                for (int bj = 0; bj < 2; ++bj) {
                    const size_t off = (size_t)row * 1024 + u.pn * BM + bj * HALF + 32 * wc + 8 * fq;
                    f32x4 r0, r1;
                    if (XIN == 0) { r0 = res[m][bj][0]; r1 = res[m][bj][1]; }
                    else { const u32x4 w = rb[m][bj]; r0 = (f32x4){bflo(w.x), bfhi(w.x), bflo(w.y), bfhi(w.y)}; r1 = (f32x4){bflo(w.z), bfhi(w.z), bflo(w.w), bfhi(w.w)}; }
                    const f32x4 v0 = r0 + acc[ai][bj][m][0], v1 = r1 + acc[ai][bj][m][1];
                    if (OUT == 0) { u32x4 w; w.x = ::cvt_pk_bf16(v0[0], v0[1]); w.y = ::cvt_pk_bf16(v0[2], v0[3]); w.z = ::cvt_pk_bf16(v1[0], v1[1]); w.w = ::cvt_pk_bf16(v1[2], v1[3]); *(u32x4*)(xb + off) = w; }
                    else { *(f32x4*)(xf + off) = v0; *(f32x4*)(xf + off + 4) = v1; }
                    ss += (v0[0] * v0[0] + v0[1] * v0[1]) + (v0[2] * v0[2] + v0[3] * v0[3]) + (v1[0] * v1[0] + v1[1] * v1[1]) + (v1[2] * v1[2] + v1[3] * v1[3]);
                }
                ss += __shfl_xor(ss, 16); ss += __shfl_xor(ss, 32);
                if (fq == 0) rss[(size_t)row * 16 + u.pn * 4 + wc] = ss;
            }
            __builtin_amdgcn_sched_barrier(0);
        }
    }
};
struct EpiFinal {
    static constexpr bool PERM = true, AFTER_DRAIN = true;
    const bf16_t* xinb; float* out; const float* fg; float* rss; unsigned* cnt;
    __device__ __forceinline__ void fused(f32x4 (&acc)[2][2][4][2], const Unit& u, int wr, int wc, int fr, int fq, PG8_LAS unsigned char* lds, int wid, int lane) const {
        float ssv[2][4];
#pragma unroll
        for (int ai = 0; ai < 2; ++ai) {
            u32x4 rb[4][2];
#pragma unroll
            for (int m = 0; m < 4; ++m)
#pragma unroll
                for (int bj = 0; bj < 2; ++bj) {
                    const size_t off = (size_t)(u.pm * BM + ai * HALF + wr * 64 + m * 16 + fr) * 1024 + u.pn * BM + bj * HALF + 32 * wc + 8 * fq;
                    rb[m][bj] = *(const u32x4*)(xinb + off);
                }
#pragma unroll
            for (int m = 0; m < 4; ++m) {
                float ss = 0.f;
#pragma unroll
                for (int bj = 0; bj < 2; ++bj) {
                    const u32x4 w = rb[m][bj];
                    const f32x4 v0 = (f32x4){bflo(w.x), bfhi(w.x), bflo(w.y), bfhi(w.y)} + acc[ai][bj][m][0], v1 = (f32x4){bflo(w.z), bfhi(w.z), bflo(w.w), bfhi(w.w)} + acc[ai][bj][m][1];
                    acc[ai][bj][m][0] = v0; acc[ai][bj][m][1] = v1;
                    ss += (v0[0] * v0[0] + v0[1] * v0[1]) + (v0[2] * v0[2] + v0[3] * v0[3]) + (v1[0] * v1[0] + v1[1] * v1[1]) + (v1[2] * v1[2] + v1[3] * v1[3]);
                }
                ss += __shfl_xor(ss, 16); ss += __shfl_xor(ss, 32);
                ssv[ai][m] = ss;
            }
        }
        if (fq == 0) {
#pragma unroll
            for (int ai = 0; ai < 2; ++ai)
#pragma unroll
                for (int m = 0; m < 4; ++m)
                    __hip_atomic_store((unsigned*)rss + (size_t)(u.pm * BM + ai * HALF + wr * 64 + m * 16 + fr) * 16 + u.pn * 4 + wc, __float_as_uint(ssv[ai][m]), __ATOMIC_RELAXED, __HIP_MEMORY_SCOPE_AGENT);
        }
        asm volatile("s_waitcnt vmcnt(0)" ::: "memory");
        if (lane == 0) __hip_atomic_fetch_add(cnt + 64 * u.pm, 1u, __ATOMIC_RELAXED, __HIP_MEMORY_SCOPE_AGENT);
        if (wid == 0) {
            unsigned spins = 0;
            while ((unsigned)__builtin_amdgcn_readfirstlane(__hip_atomic_load(cnt + 64 * u.pm, __ATOMIC_RELAXED, __HIP_MEMORY_SCOPE_AGENT)) < 32u) {
                __builtin_amdgcn_s_sleep(2);
                if (++spins > (1u << 22)) break;
            }
            __builtin_amdgcn_fence(__ATOMIC_ACQUIRE, "agent");
        }
        asm volatile("s_waitcnt vmcnt(0) lgkmcnt(0)" ::: "memory"); __builtin_amdgcn_s_barrier(); asm volatile("" ::: "memory");
        float rstdv[2][4];
#pragma unroll
        for (int ai = 0; ai < 2; ++ai)
#pragma unroll
            for (int m = 0; m < 4; ++m) {
                const unsigned* rp = (const unsigned*)rss + (size_t)(u.pm * BM + ai * HALF + wr * 64 + m * 16 + fr) * 16 + 4 * fq;
                float s = 0.f;
#pragma unroll
                for (int k = 0; k < 4; ++k) s += __uint_as_float(__hip_atomic_load(rp + k, __ATOMIC_RELAXED, __HIP_MEMORY_SCOPE_AGENT));
                s += __shfl_xor(s, 16); s += __shfl_xor(s, 32);
                rstdv[ai][m] = rsqrtf(s * (1.0f / 1024.0f) + RMS_EPS);
            }
        f32x4 gv[2][2];
#pragma unroll
        for (int bj = 0; bj < 2; ++bj) { const int c0 = u.pn * BM + bj * HALF + 32 * wc + 8 * fq; gv[bj][0] = *(const f32x4*)(fg + c0); gv[bj][1] = *(const f32x4*)(fg + c0 + 4); }
#pragma unroll
        for (int ai = 0; ai < 2; ++ai)
#pragma unroll
            for (int m = 0; m < 4; ++m)
#pragma unroll
                for (int bj = 0; bj < 2; ++bj) {
                    const size_t off = (size_t)(u.pm * BM + ai * HALF + wr * 64 + m * 16 + fr) * 1024 + u.pn * BM + bj * HALF + 32 * wc + 8 * fq;
                    *(f32x4*)(out + off) = acc[ai][bj][m][0] * rstdv[ai][m] * gv[bj][0];
                    *(f32x4*)(out + off + 4) = acc[ai][bj][m][1] * rstdv[ai][m] * gv[bj][1];
                }
    }
};
}
constexpr int LDS_PHASE_BYTES = 143360;
constexpr int LDS_RPB_OFF = LDS_PHASE_BYTES + 16 + 128, LDS_SG_OFF = LDS_RPB_OFF + 8 * 465 * 4 + 128, LDS_RPB_BYTES = 8 * 465 * 4 + 128 + 512;

constexpr int DA_KP = 272, DA_VP = 144;
constexpr int DA_KBYTES = 128 * DA_KP, DA_VSUB = 128 * DA_VP, DA_VBYTES = 2 * DA_VSUB, DA_STAGE = DA_KBYTES + DA_VBYTES;

__device__ __forceinline__ float silu_f(float x) { return x / (1.0f + __expf(-x)); }

__device__ void da_unit(char* lds, const Params& p, int layer, int unit) {
    int tid_ = threadIdx.x; asm volatile("" : "+v"(tid_)); const int tid = tid_, lane = tid & 63, wid = __builtin_amdgcn_readfirstlane(tid >> 6), r = lane & 31, h2 = lane >> 5;
    const int c = wid & 1, qg = wid >> 1;
    const int g8 = unit >> 3, bh = (unit & 7) * 4 + (g8 >> 4), qb = g8 & 15, b = bh >> 2, h = bh & 3;
    const float slope2 = exp2f(-2.0f * (float)(h + 1)) * LOG2E;
    const float qscale = 0.125f * LOG2E;
    float lam;
    {
        const float v1 = p.lq1[layer * 64 + lane] * p.lk1[layer * 64 + lane], v2 = p.lq2[layer * 64 + lane] * p.lk2[layer * 64 + lane];
        float s1 = v1, s2 = v2;
#pragma unroll
        for (int s = 32; s >= 1; s >>= 1) { s1 += __shfl_xor(s1, s); s2 += __shfl_xor(s2, s); }
        lam = __expf(s1) - __expf(s2) + p.lam_init[layer];
    }
    const int q0 = qb * 128 + qg * 32;
    const size_t tokq = (size_t)b * SEQ + q0 + r;
    bf16x8 qf[4];
#pragma unroll
    for (int t = 0; t < 4; ++t) {
        const u32x4 w = *(const u32x4*)(p.z + ZS_QD + ((size_t)(bh * 2048 + q0 + r)) * 128 + c * 64 + t * 16 + h2 * 8);
        u32x4 o;
        o.x = cvt_pk_bf16(bflo(w.x) * qscale, bfhi(w.x) * qscale); o.y = cvt_pk_bf16(bflo(w.y) * qscale, bfhi(w.y) * qscale);
        o.z = cvt_pk_bf16(bflo(w.z) * qscale, bfhi(w.z) * qscale); o.w = cvt_pk_bf16(bflo(w.w) * qscale, bfhi(w.w) * qscale);
        qf[t] = __builtin_bit_cast(bf16x8, o);
    }
    f32x16 O[4], Bs;
#pragma unroll
    for (int k = 0; k < 4; ++k)
#pragma unroll
        for (int e = 0; e < 16; ++e) O[k][e] = 0.f;
#pragma unroll
    for (int e = 0; e < 16; ++e) Bs[e] = -slope2 * (float)(16 * (e >> 3) + (e & 7));
    float mrow = -1e30f, lrow = 0.f;
    const float qrel = (float)(8 * h2) - (float)(q0 + r);
    const bf16_t* Kg = p.z + ZS_KD + ((size_t)bh * 2048) * 128 + tid * 8;
    const bf16_t* Vg = p.vT + VS_VD + ((size_t)bh * 32) * 8192 + tid * 8;
    const int kr_ = tid >> 4, kc_ = tid & 15, vr_ = tid >> 3, vc_ = tid & 7;
    constexpr int NT = SEQ / 128;
    auto tile_of = [&](int i) { return (i < NT - qb) ? (qb + i) : (NT - 1 - i); };
    u32x4 rk[4], rv[4];
    {
        const int t0 = tile_of(0);
#pragma unroll
        for (int j = 0; j < 4; ++j) { rk[j] = *(const u32x4*)(Kg + (size_t)t0 * 16384 + j * 4096); rv[j] = *(const u32x4*)(Vg + (size_t)t0 * 16384 + j * 4096); }
    }
    __syncthreads();
#pragma unroll
    for (int j = 0; j < 4; ++j) {
        *(u32x4*)(lds + (kr_ + 32 * j) * DA_KP + kc_ * 16) = rk[j];
        *(u32x4*)(lds + DA_KBYTES + (j >> 1) * DA_VSUB + (vr_ + 64 * (j & 1)) * DA_VP + vc_ * 16) = rv[j];
    }
    __syncthreads();
    const int pr = (r & 0x13) | ((r & 4) << 1) | ((r & 8) >> 1);
    if (wid >= 4) __builtin_amdgcn_s_setprio(1);
    {
        const int it = 0; const int kt = qb;
        const char* cK = lds + (it & 1) * DA_STAGE;
        const char* cV = cK + DA_KBYTES;
        char* nK = lds + ((it + 1) & 1) * DA_STAGE;
        if (it + 1 < NT) {
            const int tn = tile_of(it + 1);
#pragma unroll
            for (int j = 0; j < 4; ++j) { rk[j] = *(const u32x4*)(Kg + (size_t)tn * 16384 + j * 4096); rv[j] = *(const u32x4*)(Vg + (size_t)tn * 16384 + j * 4096); }
        }
#pragma unroll
        for (int kb = 0; kb < 4; ++kb) {
            const int k0 = kt * 128 + kb * 32;
            f32x16 s; const float A = 0.f;
            const float kq = (float)k0 + qrel;
#pragma unroll
            for (int e = 0; e < 16; ++e) s[e] = 0.f;
#pragma unroll
            for (int t = 0; t < 4; ++t) {
                const bf16x8 kf = *(const bf16x8*)(cK + (kb * 32 + pr) * DA_KP + c * 128 + t * 32 + h2 * 16);
                s = __builtin_amdgcn_mfma_f32_32x32x16_bf16(kf, qf[t], s, 0, 0, 0);
            }
#pragma unroll
            for (int e = 0; e < 16; ++e) s[e] = fmaf(fabsf(kq + (float)(16 * (e >> 3) + (e & 7))), -slope2, s[e]);
            float mx = s[0];
#pragma unroll
            for (int e = 1; e < 16; ++e) mx = fmaxf(mx, s[e]);
            mx += A;
            mx = fmaxf(mx, __shfl_xor(mx, 32));
            if (!__all(mx <= mrow + 8.0f)) {
                const float mnew = fmaxf(mrow, mx);
                const float alpha = fast_exp2(mrow - mnew);
#pragma unroll
                for (int k = 0; k < 4; ++k) O[k] = O[k] * alpha;
                lrow *= alpha; mrow = mnew;
            }
            const float mm = mrow - A;
            float ps = 0.f;
#pragma unroll
            for (int e = 0; e < 16; ++e) { s[e] = fast_exp2(s[e] - mm); ps += s[e]; }
            lrow += ps;
            bf16x8 pb[2];
#pragma unroll
            for (int sp = 0; sp < 2; ++sp) {
                u32x4 w;
                w.x = cvt_pk_bf16(s[8 * sp + 0], s[8 * sp + 1]); w.y = cvt_pk_bf16(s[8 * sp + 2], s[8 * sp + 3]);
                w.z = cvt_pk_bf16(s[8 * sp + 4], s[8 * sp + 5]); w.w = cvt_pk_bf16(s[8 * sp + 6], s[8 * sp + 7]);
                pb[sp] = __builtin_bit_cast(bf16x8, w);
            }
#pragma unroll
            for (int sp = 0; sp < 2; ++sp)
#pragma unroll
                for (int k = 0; k < 4; ++k) {
                    const bf16x8 vf = *(const bf16x8*)(cV + (kb >> 1) * DA_VSUB + (32 * k + r) * DA_VP + (32 * (kb & 1) + 16 * sp + 8 * h2) * 2);
                    O[k] = __builtin_amdgcn_mfma_f32_32x32x16_bf16(vf, pb[sp], O[k], 0, 0, 0);
                }
        }

        if (it + 1 < NT) {
#pragma unroll
            for (int j = 0; j < 4; ++j) {
                *(u32x4*)(nK + (kr_ + 32 * j) * DA_KP + kc_ * 16) = rk[j];
                *(u32x4*)(nK + DA_KBYTES + (j >> 1) * DA_VSUB + (vr_ + 64 * (j & 1)) * DA_VP + vc_ * 16) = rv[j];
            }
        }
        __syncthreads();
    }
    for (int it = 1; it < NT - qb; ++it) {
        const int kt = tile_of(it);
        const char* cK = lds + (it & 1) * DA_STAGE;
        const char* cV = cK + DA_KBYTES;
        char* nK = lds + ((it + 1) & 1) * DA_STAGE;
        const int tn = tile_of(it + 1 < NT ? it + 1 : it);
        if (it + 1 < NT) {
#pragma unroll
            for (int j = 0; j < 4; ++j) rk[j] = *(const u32x4*)(Kg + (size_t)tn * 16384 + j * 4096);
        }
#define DA_FAST_HALF(BSEL, SGN, hf) \
            { \
                f32x16 s0, s1; \
                { const bf16x8 kf0 = *(const bf16x8*)(cK + (hf * 64 + pr) * DA_KP + c * 128 + h2 * 16); \
                  const bf16x8 kf1 = *(const bf16x8*)(cK + (hf * 64 + 32 + pr) * DA_KP + c * 128 + h2 * 16); \
                  s0 = __builtin_amdgcn_mfma_f32_32x32x16_bf16(kf0, qf[0], BSEL, 0, 0, 0); \
                  s1 = __builtin_amdgcn_mfma_f32_32x32x16_bf16(kf1, qf[0], BSEL, 0, 0, 0); } \
                _Pragma("unroll") \
                for (int t = 1; t < 4; ++t) { \
                    const bf16x8 kf0 = *(const bf16x8*)(cK + (hf * 64 + pr) * DA_KP + c * 128 + t * 32 + h2 * 16); \
                    const bf16x8 kf1 = *(const bf16x8*)(cK + (hf * 64 + 32 + pr) * DA_KP + c * 128 + t * 32 + h2 * 16); \
                    s0 = __builtin_amdgcn_mfma_f32_32x32x16_bf16(kf0, qf[t], s0, 0, 0, 0); \
                    s1 = __builtin_amdgcn_mfma_f32_32x32x16_bf16(kf1, qf[t], s1, 0, 0, 0); \
                } \
                const float A0 = (SGN) * ((float)(kt * 128 + hf * 64) + qrel), A1 = A0 + (SGN) * 32.0f; \
                const float mm0 = mrow - A0, mm1 = mrow - A1; \
                float ps0 = 0.f, ps1 = 0.f; \
                _Pragma("unroll") \
                for (int e = 0; e < 16; ++e) { s0[e] = fast_exp2(s0[e] - mm0); ps0 += s0[e]; } \
                bf16x8 pb0[2], pb1[2]; \
                _Pragma("unroll") \
                for (int sp = 0; sp < 2; ++sp) { \
                    u32x4 w; \
                    w.x = cvt_pk_bf16(s0[8 * sp + 0], s0[8 * sp + 1]); w.y = cvt_pk_bf16(s0[8 * sp + 2], s0[8 * sp + 3]); \
                    w.z = cvt_pk_bf16(s0[8 * sp + 4], s0[8 * sp + 5]); w.w = cvt_pk_bf16(s0[8 * sp + 6], s0[8 * sp + 7]); \
                    pb0[sp] = __builtin_bit_cast(bf16x8, w); \
                } \
                _Pragma("unroll") \
                for (int sp = 0; sp < 2; ++sp) \
                    _Pragma("unroll") \
                    for (int k = 0; k < 4; ++k) { \
                        const bf16x8 vf0 = *(const bf16x8*)(cV + hf * DA_VSUB + (32 * k + r) * DA_VP + (16 * sp + 8 * h2) * 2); \
                        O[k] = __builtin_amdgcn_mfma_f32_32x32x16_bf16(vf0, pb0[sp], O[k], 0, 0, 0); \
                    } \
                _Pragma("unroll") \
                for (int e = 0; e < 16; ++e) { s1[e] = fast_exp2(s1[e] - mm1); ps1 += s1[e]; } \
                lrow += ps0 + ps1; \
                _Pragma("unroll") \
                for (int sp = 0; sp < 2; ++sp) { \
                    u32x4 w; \
                    w.x = cvt_pk_bf16(s1[8 * sp + 0], s1[8 * sp + 1]); w.y = cvt_pk_bf16(s1[8 * sp + 2], s1[8 * sp + 3]); \
                    w.z = cvt_pk_bf16(s1[8 * sp + 4], s1[8 * sp + 5]); w.w = cvt_pk_bf16(s1[8 * sp + 6], s1[8 * sp + 7]); \
                    pb1[sp] = __builtin_bit_cast(bf16x8, w); \
                } \
                _Pragma("unroll") \
                for (int sp = 0; sp < 2; ++sp) \
                    _Pragma("unroll") \
                    for (int k = 0; k < 4; ++k) { \
                        const bf16x8 vf1 = *(const bf16x8*)(cV + hf * DA_VSUB + (32 * k + r) * DA_VP + (32 + 16 * sp + 8 * h2) * 2); \
                        O[k] = __builtin_amdgcn_mfma_f32_32x32x16_bf16(vf1, pb1[sp], O[k], 0, 0, 0); \
                    } \
            }
        DA_FAST_HALF(Bs, -slope2, 0)
        if (it + 1 < NT) {
#pragma unroll
            for (int j = 0; j < 4; ++j) *(u32x4*)(nK + (kr_ + 32 * j) * DA_KP + kc_ * 16) = rk[j];
#pragma unroll
            for (int j = 0; j < 4; ++j) rk[j] = *(const u32x4*)(Vg + (size_t)tn * 16384 + j * 4096);
        }
        DA_FAST_HALF(Bs, -slope2, 1)
#undef DA_FAST_HALF
        if (it + 1 < NT) {
#pragma unroll
            for (int j = 0; j < 4; ++j) *(u32x4*)(nK + DA_KBYTES + (j >> 1) * DA_VSUB + (vr_ + 64 * (j & 1)) * DA_VP + vc_ * 16) = rk[j];
        }
        __syncthreads();
    }
#pragma unroll
    for (int e = 0; e < 16; ++e) Bs[e] = -Bs[e];
    for (int it = NT - qb; it < NT; ++it) {
        const int kt = tile_of(it);
        const char* cK = lds + (it & 1) * DA_STAGE;
        const char* cV = cK + DA_KBYTES;
        char* nK = lds + ((it + 1) & 1) * DA_STAGE;
        const int tn = tile_of(it + 1 < NT ? it + 1 : it);
        if (it + 1 < NT) {
#pragma unroll
            for (int j = 0; j < 4; ++j) rk[j] = *(const u32x4*)(Kg + (size_t)tn * 16384 + j * 4096);
        }
#define DA_FAST_HALF(BSEL, SGN, hf) \
            { \
                f32x16 s0, s1; \
                { const bf16x8 kf0 = *(const bf16x8*)(cK + (hf * 64 + pr) * DA_KP + c * 128 + h2 * 16); \
                  const bf16x8 kf1 = *(const bf16x8*)(cK + (hf * 64 + 32 + pr) * DA_KP + c * 128 + h2 * 16); \
                  s0 = __builtin_amdgcn_mfma_f32_32x32x16_bf16(kf0, qf[0], BSEL, 0, 0, 0); \
                  s1 = __builtin_amdgcn_mfma_f32_32x32x16_bf16(kf1, qf[0], BSEL, 0, 0, 0); } \
                _Pragma("unroll") \
                for (int t = 1; t < 4; ++t) { \
                    const bf16x8 kf0 = *(const bf16x8*)(cK + (hf * 64 + pr) * DA_KP + c * 128 + t * 32 + h2 * 16); \
                    const bf16x8 kf1 = *(const bf16x8*)(cK + (hf * 64 + 32 + pr) * DA_KP + c * 128 + t * 32 + h2 * 16); \
                    s0 = __builtin_amdgcn_mfma_f32_32x32x16_bf16(kf0, qf[t], s0, 0, 0, 0); \
                    s1 = __builtin_amdgcn_mfma_f32_32x32x16_bf16(kf1, qf[t], s1, 0, 0, 0); \
                } \
                const float A0 = (SGN) * ((float)(kt * 128 + hf * 64) + qrel), A1 = A0 + (SGN) * 32.0f; \
                const float mm0 = mrow - A0, mm1 = mrow - A1; \
                float ps0 = 0.f, ps1 = 0.f; \
                _Pragma("unroll") \
                for (int e = 0; e < 16; ++e) { s0[e] = fast_exp2(s0[e] - mm0); ps0 += s0[e]; } \
                bf16x8 pb0[2], pb1[2]; \
                _Pragma("unroll") \
                for (int sp = 0; sp < 2; ++sp) { \
                    u32x4 w; \
                    w.x = cvt_pk_bf16(s0[8 * sp + 0], s0[8 * sp + 1]); w.y = cvt_pk_bf16(s0[8 * sp + 2], s0[8 * sp + 3]); \
                    w.z = cvt_pk_bf16(s0[8 * sp + 4], s0[8 * sp + 5]); w.w = cvt_pk_bf16(s0[8 * sp + 6], s0[8 * sp + 7]); \
                    pb0[sp] = __builtin_bit_cast(bf16x8, w); \
                } \
                _Pragma("unroll") \
                for (int sp = 0; sp < 2; ++sp) \
                    _Pragma("unroll") \
                    for (int k = 0; k < 4; ++k) { \
                        const bf16x8 vf0 = *(const bf16x8*)(cV + hf * DA_VSUB + (32 * k + r) * DA_VP + (16 * sp + 8 * h2) * 2); \
                        O[k] = __builtin_amdgcn_mfma_f32_32x32x16_bf16(vf0, pb0[sp], O[k], 0, 0, 0); \
                    } \
                _Pragma("unroll") \
                for (int e = 0; e < 16; ++e) { s1[e] = fast_exp2(s1[e] - mm1); ps1 += s1[e]; } \
                lrow += ps0 + ps1; \
                _Pragma("unroll") \
                for (int sp = 0; sp < 2; ++sp) { \
                    u32x4 w; \
                    w.x = cvt_pk_bf16(s1[8 * sp + 0], s1[8 * sp + 1]); w.y = cvt_pk_bf16(s1[8 * sp + 2], s1[8 * sp + 3]); \
                    w.z = cvt_pk_bf16(s1[8 * sp + 4], s1[8 * sp + 5]); w.w = cvt_pk_bf16(s1[8 * sp + 6], s1[8 * sp + 7]); \
                    pb1[sp] = __builtin_bit_cast(bf16x8, w); \
                } \
                _Pragma("unroll") \
                for (int sp = 0; sp < 2; ++sp) \
                    _Pragma("unroll") \
                    for (int k = 0; k < 4; ++k) { \
                        const bf16x8 vf1 = *(const bf16x8*)(cV + hf * DA_VSUB + (32 * k + r) * DA_VP + (32 + 16 * sp + 8 * h2) * 2); \
                        O[k] = __builtin_amdgcn_mfma_f32_32x32x16_bf16(vf1, pb1[sp], O[k], 0, 0, 0); \
                    } \
            }
        DA_FAST_HALF(Bs, slope2, 0)
        if (it + 1 < NT) {
#pragma unroll
            for (int j = 0; j < 4; ++j) *(u32x4*)(nK + (kr_ + 32 * j) * DA_KP + kc_ * 16) = rk[j];
#pragma unroll
            for (int j = 0; j < 4; ++j) rk[j] = *(const u32x4*)(Vg + (size_t)tn * 16384 + j * 4096);
        }
        DA_FAST_HALF(Bs, slope2, 1)
#undef DA_FAST_HALF
        if (it + 1 < NT) {
#pragma unroll
            for (int j = 0; j < 4; ++j) *(u32x4*)(nK + DA_KBYTES + (j >> 1) * DA_VSUB + (vr_ + 64 * (j & 1)) * DA_VP + vc_ * 16) = rk[j];
        }
        __syncthreads();
    }
    __builtin_amdgcn_s_setprio(0);
    {
        const float lchk = lrow + __shfl_xor(lrow, 32);
        const int bad = !(lchk < 1e30f);
        volatile unsigned* bflag = (volatile unsigned*)(lds + LDS_PHASE_BYTES + 8);
        if (tid == 0) *bflag = 0u;
        __syncthreads();
        if (__any(bad) && lane == 0) *bflag = 1u;
        __syncthreads();
        if (*bflag != 0u) {
#pragma unroll
            for (int k = 0; k < 4; ++k)
#pragma unroll
                for (int e = 0; e < 16; ++e) O[k][e] = 0.f;
            mrow = -1e30f; lrow = 0.f;
            {
                const int t0 = tile_of(0);
#pragma unroll
                for (int j = 0; j < 4; ++j) { rk[j] = *(const u32x4*)(Kg + (size_t)t0 * 16384 + j * 4096); rv[j] = *(const u32x4*)(Vg + (size_t)t0 * 16384 + j * 4096); }
            }
#pragma unroll
            for (int j = 0; j < 4; ++j) {
                *(u32x4*)(lds + (kr_ + 32 * j) * DA_KP + kc_ * 16) = rk[j];
                *(u32x4*)(lds + DA_KBYTES + (j >> 1) * DA_VSUB + (vr_ + 64 * (j & 1)) * DA_VP + vc_ * 16) = rv[j];
            }
            __syncthreads();
        for (int it = 0; it < NT; ++it) {
            const int kt = tile_of(it);
        const char* cK = lds + (it & 1) * DA_STAGE;
        const char* cV = cK + DA_KBYTES;
        char* nK = lds + ((it + 1) & 1) * DA_STAGE;
        if (it + 1 < NT) {
            const int tn = tile_of(it + 1);
#pragma unroll
            for (int j = 0; j < 4; ++j) { rk[j] = *(const u32x4*)(Kg + (size_t)tn * 16384 + j * 4096); rv[j] = *(const u32x4*)(Vg + (size_t)tn * 16384 + j * 4096); }
        }
#pragma unroll
        for (int kb = 0; kb < 4; ++kb) {
            const int k0 = kt * 128 + kb * 32;
            f32x16 s; const float A = 0.f;
            const float kq = (float)k0 + qrel;
#pragma unroll
            for (int e = 0; e < 16; ++e) s[e] = 0.f;
#pragma unroll
            for (int t = 0; t < 4; ++t) {
                const bf16x8 kf = *(const bf16x8*)(cK + (kb * 32 + pr) * DA_KP + c * 128 + t * 32 + h2 * 16);
                s = __builtin_amdgcn_mfma_f32_32x32x16_bf16(kf, qf[t], s, 0, 0, 0);
            }
#pragma unroll
            for (int e = 0; e < 16; ++e) s[e] = fmaf(fabsf(kq + (float)(16 * (e >> 3) + (e & 7))), -slope2, s[e]);
            float mx = s[0];
#pragma unroll
            for (int e = 1; e < 16; ++e) mx = fmaxf(mx, s[e]);
            mx += A;
            mx = fmaxf(mx, __shfl_xor(mx, 32));
            if (!__all(mx <= mrow + 8.0f)) {
                const float mnew = fmaxf(mrow, mx);
                const float alpha = fast_exp2(mrow - mnew);
#pragma unroll
                for (int k = 0; k < 4; ++k) O[k] = O[k] * alpha;
                lrow *= alpha; mrow = mnew;
            }
            const float mm = mrow - A;
            float ps = 0.f;
#pragma unroll
            for (int e = 0; e < 16; ++e) { s[e] = fast_exp2(s[e] - mm); ps += s[e]; }
            lrow += ps;
            bf16x8 pb[2];
#pragma unroll
            for (int sp = 0; sp < 2; ++sp) {
                u32x4 w;
                w.x = cvt_pk_bf16(s[8 * sp + 0], s[8 * sp + 1]); w.y = cvt_pk_bf16(s[8 * sp + 2], s[8 * sp + 3]);
                w.z = cvt_pk_bf16(s[8 * sp + 4], s[8 * sp + 5]); w.w = cvt_pk_bf16(s[8 * sp + 6], s[8 * sp + 7]);
                pb[sp] = __builtin_bit_cast(bf16x8, w);
            }
#pragma unroll
            for (int sp = 0; sp < 2; ++sp)
#pragma unroll
                for (int k = 0; k < 4; ++k) {
                    const bf16x8 vf = *(const bf16x8*)(cV + (kb >> 1) * DA_VSUB + (32 * k + r) * DA_VP + (32 * (kb & 1) + 16 * sp + 8 * h2) * 2);
                    O[k] = __builtin_amdgcn_mfma_f32_32x32x16_bf16(vf, pb[sp], O[k], 0, 0, 0);
                }
        }

        if (it + 1 < NT) {
#pragma unroll
            for (int j = 0; j < 4; ++j) {
                *(u32x4*)(nK + (kr_ + 32 * j) * DA_KP + kc_ * 16) = rk[j];
                *(u32x4*)(nK + DA_KBYTES + (j >> 1) * DA_VSUB + (vr_ + 64 * (j & 1)) * DA_VP + vc_ * 16) = rv[j];
            }
        }
        __syncthreads();
    }
        }
    }
    u32x2 gwv[16];
    if (c == 0) {
#pragma unroll
        for (int k = 0; k < 4; ++k)
#pragma unroll
            for (int g = 0; g < 4; ++g) gwv[k * 4 + g] = *(const u32x2*)(p.z + ZS_GATE + tokq * 1024 + h * 128 + 32 * k + 8 * g + 4 * h2);
    }
    const float lsum = lrow + __shfl_xor(lrow, 32);
    float* xch = (float*)lds + qg * 4096;
    if (c == 1) {
        const float i1 = lam / lsum;
#pragma unroll
        for (int k = 0; k < 4; ++k)
#pragma unroll
            for (int e = 0; e < 16; ++e) xch[(k * 16 + e) * 64 + lane] = O[k][e] * i1;
    }
    __syncthreads();
    if (c == 0) {
        const float i0 = 1.0f / lsum;
        float ss = 0.f;
#pragma unroll
        for (int k = 0; k < 4; ++k)
#pragma unroll
            for (int e = 0; e < 16; ++e) { const float a = O[k][e] * i0 - xch[(k * 16 + e) * 64 + lane]; O[k][e] = a; ss += a * a; }
        ss += __shfl_xor(ss, 32);
        const float rstd = rsqrtf(ss * (1.0f / 128.0f) + RMS_EPS) * (1.0f - p.lam_init[layer]);
        const float* sg = (const float*)(lds + LDS_SG_OFF);
        __builtin_amdgcn_sched_barrier(0);
#pragma unroll
        for (int k = 0; k < 4; ++k)
#pragma unroll
            for (int g = 0; g < 4; ++g) {
                const int d0 = 32 * k + 8 * g + 4 * h2;
                const f32x4 gg = *(const f32x4*)(sg + d0);
                const u32x2 gw = gwv[k * 4 + g];
                const float o0 = O[k][4 * g + 0] * rstd * gg[0] * silu_f(bflo(gw.x));
                const float o1 = O[k][4 * g + 1] * rstd * gg[1] * silu_f(bfhi(gw.x));
                const float o2 = O[k][4 * g + 2] * rstd * gg[2] * silu_f(bflo(gw.y));
                const float o3 = O[k][4 * g + 3] * rstd * gg[3] * silu_f(bfhi(gw.y));
                u32x2 w; w.x = cvt_pk_bf16(o0, o1); w.y = cvt_pk_bf16(o2, o3);
                *(u32x2*)(p.o + tokq * 1024 + h * 128 + d0) = w;
            }
    }
}

__device__ void na_unit(char* lds, const Params& p, int layer, int unit) {
    int tid_ = threadIdx.x; asm volatile("" : "+v"(tid_)); const int tid = tid_, lane = tid & 63, wid = __builtin_amdgcn_readfirstlane(tid >> 6), fr = lane & 15, fq = lane >> 4;
    const int hp = unit & 3, rr0 = (unit >> 2) & 31, b = unit >> 7;
    const int h = 2 * hp + (wid >> 2), n = wid & 3;
    const float* rph = (const float*)(lds + LDS_RPB_OFF) + h * 465;
    const int r = rr0;
    const int rs = min(max(r - 4, 0), 24);
    const int kcstart = min(max(16 * n - 8, 0), 32);
    const int qcol = 16 * n + fr;
    const int qcstart = min(max(qcol - 8, 0), 48);
    const size_t tokq = (size_t)b * SEQ + r * 64 + qcol;
    bf16x8 qf[2];
#pragma unroll
    for (int t = 0; t < 2; ++t) qf[t] = *(const bf16x8*)(p.z + ZS_QN + ((size_t)((b * 8 + h) * 2048 + r * 64 + qcol)) * 64 + t * 32 + fq * 8);
    bf16x8 kfr[8][4];
    {
        const int kc = kcstart + 8 * (fr >> 2) + (fr & 3);
        const bf16_t* kg0 = p.z + ZS_KN + ((size_t)((b * 8 + h) * 2048 + rs * 64 + kc)) * 64 + fq * 8;
#pragma unroll
        for (int rr = 0; rr < 8; ++rr)
#pragma unroll
            for (int T = 0; T < 2; ++T) {
                const bf16_t* kg = kg0 + (size_t)(rr * 64 + 4 * T) * 64;
                kfr[rr][2 * T] = *(const bf16x8*)(kg); kfr[rr][2 * T + 1] = *(const bf16x8*)(kg + 32);
            }
    }
    __builtin_amdgcn_sched_barrier(0);
    const float c1 = 0.125f * LOG2E;
    float sc[8][8];
    float mx = -1e30f;
#pragma unroll
    for (int rr = 0; rr < 8; ++rr) {
#pragma unroll
        for (int T = 0; T < 2; ++T) {
            f32x4 s = (f32x4){0.f, 0.f, 0.f, 0.f};
            s = __builtin_amdgcn_mfma_f32_16x16x32_bf16(kfr[rr][2 * T], qf[0], s, 0, 0, 0);
            s = __builtin_amdgcn_mfma_f32_16x16x32_bf16(kfr[rr][2 * T + 1], qf[1], s, 0, 0, 0);
            const int dr = rs + rr - r + 7;
#pragma unroll
            for (int e = 0; e < 4; ++e) {
                const int kcol = kcstart + 8 * fq + e + 4 * T;
                const bool valid = (kcol >= qcstart) && (kcol < qcstart + 16);
                const int dc = min(max(kcol - qcol, -15), 15) + 15;
                const float bias = rph[dr * 31 + dc];
                const float v = valid ? fmaf(s[e], c1, bias) : -1e30f;
                sc[rr][4 * T + e] = v;
                mx = fmaxf(mx, v);
            }
        }
    }
    __builtin_amdgcn_sched_barrier(0);
    bf16x8 vfr[4][8];
    {
        const bf16_t* vg0 = p.vT + VS_VN + ((size_t)(((b * 8 + h) * 32 + rs) * 64 + fr)) * 64 + kcstart + 8 * fq;
#pragma unroll
        for (int dt = 0; dt < 4; ++dt)
#pragma unroll
            for (int rr = 0; rr < 8; ++rr) vfr[dt][rr] = *(const bf16x8*)(vg0 + (size_t)(rr * 64 + 16 * dt) * 64);
    }
    mx = fmaxf(mx, __shfl_xor(mx, 16)); mx = fmaxf(mx, __shfl_xor(mx, 32));
    float l = 0.f;
    bf16x8 pb[8];
#pragma unroll
    for (int rr = 0; rr < 8; ++rr) {
#pragma unroll
        for (int e = 0; e < 8; ++e) { sc[rr][e] = fast_exp2(sc[rr][e] - mx); l += sc[rr][e]; }
        u32x4 w;
        w.x = cvt_pk_bf16(sc[rr][0], sc[rr][1]); w.y = cvt_pk_bf16(sc[rr][2], sc[rr][3]);
        w.z = cvt_pk_bf16(sc[rr][4], sc[rr][5]); w.w = cvt_pk_bf16(sc[rr][6], sc[rr][7]);
        pb[rr] = __builtin_bit_cast(bf16x8, w);
    }
    l += __shfl_xor(l, 16); l += __shfl_xor(l, 32);
    const float il = 1.0f / l;
    f32x4 O[4];
#pragma unroll
    for (int dt = 0; dt < 4; ++dt) {
        O[dt] = (f32x4){0.f, 0.f, 0.f, 0.f};
#pragma unroll
        for (int rr = 0; rr < 8; ++rr) O[dt] = __builtin_amdgcn_mfma_f32_16x16x32_bf16(vfr[dt][rr], pb[rr], O[dt], 0, 0, 0);
    }
#pragma unroll
    for (int dt = 0; dt < 4; ++dt) {
        const int d0 = 16 * dt + 4 * fq;
        const u32x2 gw = *(const u32x2*)(p.z + ZS_GATE + tokq * 1024 + 512 + h * 64 + d0);
        const float o0 = O[dt][0] * il * silu_f(bflo(gw.x)), o1 = O[dt][1] * il * silu_f(bfhi(gw.x));
        const float o2 = O[dt][2] * il * silu_f(bflo(gw.y)), o3 = O[dt][3] * il * silu_f(bfhi(gw.y));
        u32x2 w; w.x = cvt_pk_bf16(o0, o1); w.y = cvt_pk_bf16(o2, o3);
        *(u32x2*)(p.o + tokq * 1024 + 512 + h * 64 + d0) = w;
    }
}


constexpr int NA_P = 144, NA_KBYTES = 128 * NA_P, NA_STAGE = 2 * NA_KBYTES;

__device__ void na_super_online(char* lds, const Params& p, int layer, int su) {
    int tid_ = threadIdx.x; asm volatile("" : "+v"(tid_)); const int tid = tid_, lane = tid & 63, wid = __builtin_amdgcn_readfirstlane(tid >> 6), fr = lane & 15, fq = lane >> 4;
    const int bh = (su & 7) * 8 + (su >> 5), g = (su >> 3) & 3, b = bh >> 3, h = bh & 7;
    const float* rph = (const float*)(lds + LDS_RPB_OFF) + h * 465;
    const float c1 = 0.125f * LOG2E;
    const int rq = 8 * g + wid, rsw = min(max(rq - 4, 0), 24);
    bf16x8 qf[4][2];
    f32x4 O[4][4];
    float mrow[4], lrow[4];
#pragma unroll
    for (int n = 0; n < 4; ++n) {
#pragma unroll
        for (int t = 0; t < 2; ++t) qf[n][t] = *(const bf16x8*)(p.z + ZS_QN + ((size_t)(bh * 2048 + rq * 64 + 16 * n + fr)) * 64 + t * 32 + fq * 8);
#pragma unroll
        for (int dt = 0; dt < 4; ++dt) O[n][dt] = (f32x4){0.f, 0.f, 0.f, 0.f};
        mrow[n] = -1e30f; lrow[n] = 0.f;
    }
    const int klo = min(max(8 * g - 4, 0), 24);
    const int nsteps = (g == 0 || g == 3) ? 6 : 8;
    const bf16_t* Kg = p.z + ZS_KN + ((size_t)(bh * 2048 + klo * 64)) * 64 + tid * 8;
    const bf16_t* Vg = p.vT + VS_VN + ((size_t)((bh * 32 + klo) * 64)) * 64 + tid * 8;
    const int lw = (tid >> 3) * NA_P + (tid & 7) * 16;
    u32x4 rk[2], rv[2];
    rk[0] = *(const u32x4*)(Kg); rk[1] = *(const u32x4*)(Kg + 4096);
    rv[0] = *(const u32x4*)(Vg); rv[1] = *(const u32x4*)(Vg + 4096);
    __syncthreads();
    *(u32x4*)(lds + lw) = rk[0]; *(u32x4*)(lds + lw + 64 * NA_P) = rk[1];
    *(u32x4*)(lds + NA_KBYTES + lw) = rv[0]; *(u32x4*)(lds + NA_KBYTES + lw + 64 * NA_P) = rv[1];
    __syncthreads();
    const int krow_off = (8 * (fr >> 2) + (fr & 3)) * NA_P + fq * 16;
    const int vrow_off = fr * NA_P + (8 * fq) * 2;
    for (int st = 0; st < nsteps; ++st) {
        const char* cur = lds + (st & 1) * NA_STAGE;
        char* nxt = lds + ((st + 1) & 1) * NA_STAGE;
        if (st + 1 < nsteps) {
            const bf16_t* kg = Kg + (size_t)(st + 1) * 8192; const bf16_t* vg = Vg + (size_t)(st + 1) * 8192;
            rk[0] = *(const u32x4*)(kg); rk[1] = *(const u32x4*)(kg + 4096);
            rv[0] = *(const u32x4*)(vg); rv[1] = *(const u32x4*)(vg + 4096);
        }
#pragma unroll 1
        for (int slot = 0; slot < 2; ++slot) {
            const int kr = klo + 2 * st + slot;
            if (kr >= rsw && kr <= rsw + 7) {
                const char* cK = cur + slot * 64 * NA_P + krow_off;
                const char* cV = cur + NA_KBYTES + slot * 64 * NA_P + vrow_off;
                const float* rpr = rph + (kr - rq + 7) * 31;
                float v[4][8], mx[4];
#pragma unroll
                for (int n = 0; n < 4; ++n) {
                    const int kcstart = n == 0 ? 0 : (n == 1 ? 8 : (n == 2 ? 24 : 32));
                    const int qcol = 16 * n + fr;
                    const int qcstart = min(max(qcol - 8, 0), 48);
                    float bias[8];
#pragma unroll
                    for (int e = 0; e < 8; ++e) bias[e] = rpr[min(max(kcstart + 8 * fq + e - qcol, -15), 15) + 15];
#pragma unroll
                    for (int e = 0; e < 8; ++e) asm volatile("" : "+v"(bias[e]));
#pragma unroll
                    for (int T = 0; T < 2; ++T) {
                        const bf16x8 k0 = *(const bf16x8*)(cK + (kcstart + T * 4) * NA_P), k1 = *(const bf16x8*)(cK + (kcstart + T * 4) * NA_P + 64);
                        f32x4 s = (f32x4){0.f, 0.f, 0.f, 0.f};
                        s = __builtin_amdgcn_mfma_f32_16x16x32_bf16(k0, qf[n][0], s, 0, 0, 0);
                        s = __builtin_amdgcn_mfma_f32_16x16x32_bf16(k1, qf[n][1], s, 0, 0, 0);
#pragma unroll
                        for (int e = 0; e < 4; ++e) {
                            const int kcol = kcstart + 8 * fq + e + 4 * T;
                            const bool valid = (kcol >= qcstart) && (kcol < qcstart + 16);
                            v[n][4 * T + e] = valid ? fmaf(s[e], c1, bias[4 * T + e]) : -1e30f;
                        }
                    }
                    mx[n] = fmaxf(fmaxf(fmaxf(v[n][0], v[n][1]), fmaxf(v[n][2], v[n][3])), fmaxf(fmaxf(v[n][4], v[n][5]), fmaxf(v[n][6], v[n][7])));
                }
#pragma unroll
                for (int n = 0; n < 4; ++n) mx[n] = fmaxf(mx[n], __shfl_xor(mx[n], 16));
#pragma unroll
                for (int n = 0; n < 4; ++n) mx[n] = fmaxf(mx[n], __shfl_xor(mx[n], 32));
#pragma unroll
                for (int n = 0; n < 4; ++n) {
                    const int kcstart = n == 0 ? 0 : (n == 1 ? 8 : (n == 2 ? 24 : 32));
                    const float mnew = fmaxf(mrow[n], mx[n]);
                    const float alpha = fast_exp2(mrow[n] - mnew);
                    mrow[n] = mnew;
                    float ps = 0.f;
#pragma unroll
                    for (int e = 0; e < 8; ++e) { v[n][e] = fast_exp2(v[n][e] - mnew); ps += v[n][e]; }
                    lrow[n] = lrow[n] * alpha + ps;
                    u32x4 w;
                    w.x = cvt_pk_bf16(v[n][0], v[n][1]); w.y = cvt_pk_bf16(v[n][2], v[n][3]); w.z = cvt_pk_bf16(v[n][4], v[n][5]); w.w = cvt_pk_bf16(v[n][6], v[n][7]);
                    const bf16x8 pb = __builtin_bit_cast(bf16x8, w);
#pragma unroll
                    for (int dt = 0; dt < 4; ++dt) {
                        const bf16x8 vf = *(const bf16x8*)(cV + dt * 16 * NA_P + kcstart * 2);
                        O[n][dt] = __builtin_amdgcn_mfma_f32_16x16x32_bf16(vf, pb, O[n][dt] * alpha, 0, 0, 0);
                    }
                }
            }
        }
        if (st + 1 < nsteps) {
            *(u32x4*)(nxt + lw) = rk[0]; *(u32x4*)(nxt + lw + 64 * NA_P) = rk[1];
            *(u32x4*)(nxt + NA_KBYTES + lw) = rv[0]; *(u32x4*)(nxt + NA_KBYTES + lw + 64 * NA_P) = rv[1];
        }
        __syncthreads();
    }
    u32x2 gwv[4][4];
#pragma unroll
    for (int n = 0; n < 4; ++n)
#pragma unroll
        for (int dt = 0; dt < 4; ++dt) gwv[n][dt] = *(const u32x2*)(p.z + ZS_GATE + ((size_t)b * SEQ + rq * 64 + 16 * n + fr) * 1024 + 512 + h * 64 + 16 * dt + 4 * fq);
    __builtin_amdgcn_sched_barrier(0);
#pragma unroll
    for (int n = 0; n < 4; ++n) {
        float l = lrow[n];
        l += __shfl_xor(l, 16); l += __shfl_xor(l, 32);
        const float il = 1.0f / l;
        const size_t tokq = (size_t)b * SEQ + rq * 64 + 16 * n + fr;
#pragma unroll
        for (int dt = 0; dt < 4; ++dt) {
            const int d0 = 16 * dt + 4 * fq;
            const u32x2 gw = gwv[n][dt];
            const float o0 = O[n][dt][0] * il * silu_f(bflo(gw.x)), o1 = O[n][dt][1] * il * silu_f(bfhi(gw.x));
            const float o2 = O[n][dt][2] * il * silu_f(bflo(gw.y)), o3 = O[n][dt][3] * il * silu_f(bfhi(gw.y));
            u32x2 w; w.x = cvt_pk_bf16(o0, o1); w.y = cvt_pk_bf16(o2, o3);
            *(u32x2*)(p.o + tokq * 1024 + 512 + h * 64 + d0) = w;
        }
    }
}

__device__ void na_super(char* lds, const Params& p, int layer, int su) {
    int tid_ = threadIdx.x; asm volatile("" : "+v"(tid_)); const int tid = tid_, lane = tid & 63, wid = __builtin_amdgcn_readfirstlane(tid >> 6), fr = lane & 15, fq = lane >> 4;
    const int bh = (su & 7) * 8 + (su >> 5), g = (su >> 3) & 3, b = bh >> 3, h = bh & 7;
    const float* rph = (const float*)(lds + LDS_RPB_OFF) + h * 465;
    const float c1 = 0.125f * LOG2E;
    const int rq = 8 * g + wid, rsw = min(max(rq - 4, 0), 24);
    bf16x8 qf[4][2];
    f32x4 O[4][4];
    float mrow[4], lrow[4];
#pragma unroll
    for (int n = 0; n < 4; ++n) {
#pragma unroll
        for (int t = 0; t < 2; ++t) qf[n][t] = *(const bf16x8*)(p.z + ZS_QN + ((size_t)(bh * 2048 + rq * 64 + 16 * n + fr)) * 64 + t * 32 + fq * 8);
#pragma unroll
        for (int dt = 0; dt < 4; ++dt) O[n][dt] = (f32x4){0.f, 0.f, 0.f, 0.f};
        lrow[n] = 0.f;
        {
            const u32x4 k0 = *(const u32x4*)(p.z + ZS_KN + ((size_t)(bh * 2048 + rq * 64 + 16 * n + fr)) * 64 + fq * 8);
            const u32x4 k1 = *(const u32x4*)(p.z + ZS_KN + ((size_t)(bh * 2048 + rq * 64 + 16 * n + fr)) * 64 + 32 + fq * 8);
            const u32x4 q0 = __builtin_bit_cast(u32x4, qf[n][0]), q1 = __builtin_bit_cast(u32x4, qf[n][1]);
            float d = 0.f;
#pragma unroll
            for (int w = 0; w < 4; ++w) { d += bflo(q0[w]) * bflo(k0[w]) + bfhi(q0[w]) * bfhi(k0[w]); d += bflo(q1[w]) * bflo(k1[w]) + bfhi(q1[w]) * bfhi(k1[w]); }
            d += __shfl_xor(d, 16); d += __shfl_xor(d, 32);
            mrow[n] = -d;
        }
    }
    const int klo = min(max(8 * g - 4, 0), 24);
    const int nsteps = (g == 0 || g == 3) ? 6 : 8;
    const bf16_t* Kg = p.z + ZS_KN + ((size_t)(bh * 2048 + klo * 64)) * 64 + tid * 8;
    const bf16_t* Vg = p.vT + VS_VN + ((size_t)((bh * 32 + klo) * 64)) * 64 + tid * 8;
    const int lw = (tid >> 3) * NA_P + (tid & 7) * 16;
    u32x4 rk[2], rv[2];
    rk[0] = *(const u32x4*)(Kg); rk[1] = *(const u32x4*)(Kg + 4096);
    rv[0] = *(const u32x4*)(Vg); rv[1] = *(const u32x4*)(Vg + 4096);
    __syncthreads();
    *(u32x4*)(lds + lw) = rk[0]; *(u32x4*)(lds + lw + 64 * NA_P) = rk[1];
    *(u32x4*)(lds + NA_KBYTES + lw) = rv[0]; *(u32x4*)(lds + NA_KBYTES + lw + 64 * NA_P) = rv[1];
    __syncthreads();
    const int krow_off = (8 * (fr >> 2) + (fr & 3)) * NA_P + fq * 16;
    const int vrow_off = fr * NA_P + (8 * fq) * 2;
    for (int st = 0; st < nsteps; ++st) {
        const char* cur = lds + (st & 1) * NA_STAGE;
        char* nxt = lds + ((st + 1) & 1) * NA_STAGE;
        if (st + 1 < nsteps) {
            const bf16_t* kg = Kg + (size_t)(st + 1) * 8192; const bf16_t* vg = Vg + (size_t)(st + 1) * 8192;
            rk[0] = *(const u32x4*)(kg); rk[1] = *(const u32x4*)(kg + 4096);
            rv[0] = *(const u32x4*)(vg); rv[1] = *(const u32x4*)(vg + 4096);
        }
#pragma unroll 1
        for (int slot = 0; slot < 2; ++slot) {
            const int kr = klo + 2 * st + slot;
            if (kr >= rsw && kr <= rsw + 7) {
                const char* cK = cur + slot * 64 * NA_P + krow_off;
                const char* cV = cur + NA_KBYTES + slot * 64 * NA_P + vrow_off;
                const float* rpr = rph + (kr - rq + 7) * 31;
                float v[4][8];
#pragma unroll
                for (int n = 0; n < 4; ++n) {
                    const int kcstart = n == 0 ? 0 : (n == 1 ? 8 : (n == 2 ? 24 : 32));
                    const int qcol = 16 * n + fr;
                    const float* bp = rpr + (kcstart + 8 * fq - qcol + 15);
#pragma unroll
                    for (int e = 0; e < 8; ++e) v[n][e] = bp[e];
                }
#pragma unroll
                for (int n = 0; n < 4; ++n)
#pragma unroll
                    for (int e = 0; e < 8; ++e) asm volatile("" : "+v"(v[n][e]));
#pragma unroll
                for (int np = 0; np < 2; ++np) {
                    bf16x8 kfr[2][4];
#pragma unroll
                    for (int q = 0; q < 2; ++q) {
                        const int n = 2 * np + q;
                        const int kcstart = n == 0 ? 0 : (n == 1 ? 8 : (n == 2 ? 24 : 32));
#pragma unroll
                        for (int T = 0; T < 2; ++T) { kfr[q][2 * T] = *(const bf16x8*)(cK + (kcstart + T * 4) * NA_P); kfr[q][2 * T + 1] = *(const bf16x8*)(cK + (kcstart + T * 4) * NA_P + 64); }
                    }
#pragma unroll
                    for (int q = 0; q < 2; ++q) {
                        const int n = 2 * np + q;
                        const int kcstart = n == 0 ? 0 : (n == 1 ? 8 : (n == 2 ? 24 : 32));
                        const int qcol = 16 * n + fr;
                        const int qcstart = min(max(qcol - 8, 0), 48);
#pragma unroll
                        for (int T = 0; T < 2; ++T) {
                            f32x4 s = (f32x4){mrow[n], mrow[n], mrow[n], mrow[n]};
                            s = __builtin_amdgcn_mfma_f32_16x16x32_bf16(kfr[q][2 * T], qf[n][0], s, 0, 0, 0);
                            s = __builtin_amdgcn_mfma_f32_16x16x32_bf16(kfr[q][2 * T + 1], qf[n][1], s, 0, 0, 0);
#pragma unroll
                            for (int e = 0; e < 4; ++e) {
                                const int kcol = kcstart + 8 * fq + e + 4 * T;
                                const bool valid = (kcol >= qcstart) && (kcol < qcstart + 16);
                                v[n][4 * T + e] = valid ? fmaf(s[e], c1, v[n][4 * T + e]) : -1e30f;
                            }
                        }
                    }
                }
#pragma unroll
                for (int n = 0; n < 4; ++n) {
                    const int kcstart = n == 0 ? 0 : (n == 1 ? 8 : (n == 2 ? 24 : 32));
                    float ps = 0.f;
#pragma unroll
                    for (int e = 0; e < 8; ++e) { v[n][e] = fast_exp2(v[n][e]); ps += v[n][e]; }
                    lrow[n] += ps;
                    u32x4 w;
                    w.x = cvt_pk_bf16(v[n][0], v[n][1]); w.y = cvt_pk_bf16(v[n][2], v[n][3]); w.z = cvt_pk_bf16(v[n][4], v[n][5]); w.w = cvt_pk_bf16(v[n][6], v[n][7]);
                    const bf16x8 pb = __builtin_bit_cast(bf16x8, w);
#pragma unroll
                    for (int dt = 0; dt < 4; ++dt) {
                        const bf16x8 vf = *(const bf16x8*)(cV + dt * 16 * NA_P + kcstart * 2);
                        O[n][dt] = __builtin_amdgcn_mfma_f32_16x16x32_bf16(vf, pb, O[n][dt], 0, 0, 0);
                    }
                }
            }
        }
        if (st + 1 < nsteps) {
            *(u32x4*)(nxt + lw) = rk[0]; *(u32x4*)(nxt + lw + 64 * NA_P) = rk[1];
            *(u32x4*)(nxt + NA_KBYTES + lw) = rv[0]; *(u32x4*)(nxt + NA_KBYTES + lw + 64 * NA_P) = rv[1];
        }
        __syncthreads();
    }
    u32x2 gwv[4][4];
#pragma unroll
    for (int n = 0; n < 4; ++n)
#pragma unroll
        for (int dt = 0; dt < 4; ++dt) gwv[n][dt] = *(const u32x2*)(p.z + ZS_GATE + ((size_t)b * SEQ + rq * 64 + 16 * n + fr) * 1024 + 512 + h * 64 + 16 * dt + 4 * fq);
    __builtin_amdgcn_sched_barrier(0);
    int bad = 0;
#pragma unroll
    for (int n = 0; n < 4; ++n) { lrow[n] += __shfl_xor(lrow[n], 16); lrow[n] += __shfl_xor(lrow[n], 32); bad |= !(lrow[n] < 1e30f); }
    {
        volatile unsigned* bflag = (volatile unsigned*)(lds + LDS_PHASE_BYTES + 8);
        if (tid == 0) *bflag = 0u;
        __syncthreads();
        if (__any(bad) && lane == 0) *bflag = 1u;
        __syncthreads();
        if (*bflag != 0u) { if (tid == 0) *(volatile unsigned*)(lds + LDS_PHASE_BYTES + 12) = 1u; return; }
    }
#pragma unroll
    for (int n = 0; n < 4; ++n) {
        const float l = lrow[n];
        const float il = 1.0f / l;
        const size_t tokq = (size_t)b * SEQ + rq * 64 + 16 * n + fr;
#pragma unroll
        for (int dt = 0; dt < 4; ++dt) {
            const int d0 = 16 * dt + 4 * fq;
            const u32x2 gw = gwv[n][dt];
            const float o0 = O[n][dt][0] * il * silu_f(bflo(gw.x)), o1 = O[n][dt][1] * il * silu_f(bfhi(gw.x));
            const float o2 = O[n][dt][2] * il * silu_f(bflo(gw.y)), o3 = O[n][dt][3] * il * silu_f(bfhi(gw.y));
            u32x2 w; w.x = cvt_pk_bf16(o0, o1); w.y = cvt_pk_bf16(o2, o3);
            *(u32x2*)(p.o + tokq * 1024 + 512 + h * 64 + d0) = w;
        }
    }
}

__global__ void __launch_bounds__(NTHREADS) fwd_megakernel(Params p) {
    extern __shared__ __attribute__((aligned(16))) char lds[];
    if (p.never) cg::this_grid().sync();
    volatile LAS unsigned* st = (volatile LAS unsigned*)(lds + LDS_PHASE_BYTES);
    if (threadIdx.x < 4) st[threadIdx.x] = 0u;
    __syncthreads();
    const XcdBarrier gb = xcd_barrier_post(p.bar, st);
    prologue_phase(lds, p);
    xcd_barrier(gb);
    for (int layer = 0; layer < DEPTH; ++layer) {
        for (int rep = 0; rep < REP_GEMM0; ++rep) {
        { pg8::Gemm g{p.xb, p.wi_t + (size_t)layer * 4096 * 1024, NTOK, IN_W, 1024}; pg8::StaticOrder S; S.init(NTOK, IN_W, (int)gridDim.x, (int)blockIdx.x);
          pg8::EpiZ E{p.z, p.vT, p.rss};
          pg8::gemm_phase<pg8::EpiZ, pg8::StaticOrder, true, true>((PG8_LAS unsigned char*)lds, g, S, E); }
        xcd_barrier(gb);
        }
        { int t0_ = threadIdx.x; asm volatile("" : "+v"(t0_));
          for (int i = t0_; i < 8 * 465; i += NTHREADS) ((float*)(lds + LDS_RPB_OFF))[i] = p.rpb[(size_t)layer * 8 * 465 + i] * LOG2E;
          if (t0_ < 128) ((float*)(lds + LDS_SG_OFF))[t0_] = p.subln_g[layer * 128 + t0_];
          if (t0_ == 0) *(volatile unsigned*)(lds + LDS_PHASE_BYTES + 12) = 0u; }
        __syncthreads();
        for (int rep = 0; rep < REP_ATT; ++rep) {
        for (int u = blockIdx.x; u < 512 + 256; u += gridDim.x) {
            if (u < 512) { if (rep < REP_DA) da_unit(lds, p, layer, u); } else { if (rep < REP_NA) na_super(lds, p, layer, u - 512); }
        }
        __syncthreads();
        if (*(volatile unsigned*)(lds + LDS_PHASE_BYTES + 12) != 0u) {
            for (int u = blockIdx.x; u < 512 + 256; u += gridDim.x) if (u >= 512) na_super_online(lds, p, layer, u - 512);
        }
        xcd_barrier(gb);
        }
        { pg8::Gemm g{p.o, p.wo_t + (size_t)layer * 1024 * 1024, NTOK, 1024, 1024}; pg8::StaticOrder S; S.init(NTOK, 1024, (int)gridDim.x, (int)blockIdx.x);
          if (layer == 0) { pg8::EpiRes2<0, 0> E{p.x, p.xb, p.xb, p.xf, p.rss};
            pg8::gemm_phase<pg8::EpiRes2<0, 0>, pg8::StaticOrder, true, true>((PG8_LAS unsigned char*)lds, g, S, E); }
          else if (layer + 1 < DEPTH) { pg8::EpiRes2<1, 0> E{p.x, p.xb, p.xb, p.xf, p.rss};
            pg8::gemm_phase<pg8::EpiRes2<1, 0>, pg8::StaticOrder, true, true>((PG8_LAS unsigned char*)lds, g, S, E); }
          else if (gridDim.x == 256) { pg8::EpiFinal E{p.xb, p.xf, p.final_g, p.rss, p.bar + XCD_BAR_WORDS};
            pg8::gemm_phase<pg8::EpiFinal, pg8::StaticOrder, false, true>((PG8_LAS unsigned char*)lds, g, S, E); return; }
          else { pg8::EpiRes2<1, 1> E{p.x, p.xb, p.xb, p.xf, p.rss};
            pg8::gemm_phase<pg8::EpiRes2<1, 1>, pg8::StaticOrder, true, true>((PG8_LAS unsigned char*)lds, g, S, E); } }
        xcd_barrier(gb);
    }
    final_phase(p);
}

constexpr size_t LDS_BYTES = LDS_RPB_OFF + LDS_RPB_BYTES;

extern "C" void kernel_launch(void* const* d_in, const int* in_sizes, int n_in, void* d_out, int out_size, void* d_ws, size_t ws_size, hipStream_t stream) {
    static int grid_blocks = 0;
    if (!grid_blocks) {
        int dev = 0, cus = 0, per_cu = 0;
        hipGetDevice(&dev);
        hipDeviceGetAttribute(&cus, hipDeviceAttributeMultiprocessorCount, dev);
        hipFuncSetAttribute((const void*)fwd_megakernel, hipFuncAttributeMaxDynamicSharedMemorySize, (int)LDS_BYTES);
        hipOccupancyMaxActiveBlocksPerMultiprocessor(&per_cu, fwd_megakernel, NTHREADS, LDS_BYTES);
        if (per_cu < 1) per_cu = 1;
        if (per_cu > 1) per_cu = 1;
        grid_blocks = cus * per_cu;
    }
    Params p{};
    p.x = (const float*)d_in[0]; p.norm_g = (const float*)d_in[1]; p.w_in = (const float*)d_in[2]; p.w_out = (const float*)d_in[3];
    p.lq1 = (const float*)d_in[4]; p.lk1 = (const float*)d_in[5]; p.lq2 = (const float*)d_in[6]; p.lk2 = (const float*)d_in[7];
    p.subln_g = (const float*)d_in[8]; p.rpb = (const float*)d_in[9]; p.final_g = (const float*)d_in[10];
    p.xf = (float*)d_out;
    char* w = (char*)d_ws; size_t off = 0;
    auto take = [&](size_t bytes) { char* r = w + off; off += (bytes + 255) & ~(size_t)255; return r; };
    p.wi_t = (bf16_t*)take((size_t)DEPTH * 4096 * 1024 * 2);
    p.wo_t = (bf16_t*)take((size_t)DEPTH * 1024 * 1024 * 2);
    p.xb = (bf16_t*)take((size_t)NTOK * 1024 * 2);
    p.rss = (float*)take((size_t)NTOK * 16 * 4);
    p.z = (bf16_t*)take((size_t)NTOK * ZP * 2);
    p.vT = (bf16_t*)take((size_t)BATCH * 1024 * SEQ * 2);
    p.o = (bf16_t*)take((size_t)NTOK * 1024 * 2);
    p.bar = (unsigned*)take((size_t)(XCD_BAR_WORDS + 64 * 64) * 4);
    (void)hipMemsetAsync(p.bar, 0, (size_t)(XCD_BAR_WORDS + 64 * 64) * 4, stream);
    for (int l = 0; l < DEPTH; ++l) p.lam_init[l] = (float)(0.8 - 0.6 * exp(-0.3 * (double)l));
    void* args[] = {&p};
    hipError_t e = hipLaunchCooperativeKernel((const void*)fwd_megakernel, dim3(grid_blocks), dim3(NTHREADS), args, LDS_BYTES, stream);
    if (e != hipSuccess) fprintf(stderr, "cooperative launch failed: %s (grid %d)\n", hipGetErrorString(e), grid_blocks);
}
```

```cpp
#include <hip/hip_runtime.h>
#include <hip/hip_cooperative_groups.h>
#include <cstdio>
#include <cstdint>
namespace cg = cooperative_groups;

typedef unsigned short bf16_t;
typedef short bf16x8 __attribute__((ext_vector_type(8)));
typedef float f32x4 __attribute__((ext_vector_type(4)));
typedef float f32x16 __attribute__((ext_vector_type(16)));
typedef unsigned u32x4 __attribute__((ext_vector_type(4)));
typedef unsigned u32x2 __attribute__((ext_vector_type(2)));

constexpr int D_MODEL = 1024, BATCH = 8, SEQ = 2048, DEPTH = 4, NTOK = BATCH * SEQ;
constexpr int IN_W = 4096;
constexpr size_t ZS_QD = 0, ZS_KD = (size_t)NTOK * 512, ZS_QN = (size_t)NTOK * 1024, ZS_KN = (size_t)NTOK * 1536, ZS_GATE = (size_t)NTOK * 2048;
constexpr size_t VS_VD = 0, VS_VN = (size_t)NTOK * 512;
constexpr int ZP = 3072;
constexpr float RMS_EPS = 1e-6f;
constexpr float LOG2E = 1.4426950408889634f;
constexpr int NTHREADS = 512;
#ifndef REP_GEMM0
#define REP_GEMM0 1
#endif
#ifndef REP_DA
#define REP_DA 1
#endif
#ifndef REP_NA
#define REP_NA 1
#endif
#define REP_ATT (REP_DA > REP_NA ? REP_DA : REP_NA)

struct Params {
    const float* x; const float* norm_g; const float* w_in; const float* w_out;
    const float* lq1; const float* lk1; const float* lq2; const float* lk2;
    const float* subln_g; const float* rpb; const float* final_g;
    float* xf;
    bf16_t* wi_t;
    bf16_t* wo_t;
    bf16_t* xb;
    float* rss;
    bf16_t* z;
    bf16_t* vT;
    bf16_t* o;
    unsigned* bar;
    float lam_init[DEPTH];
    int never;
    int pad_;
};

typedef __bf16 bf16x2_t __attribute__((ext_vector_type(2)));
typedef float f32x2_t __attribute__((ext_vector_type(2)));
__device__ __forceinline__ unsigned cvt_pk_bf16(float lo, float hi) {
    const f32x2_t v = {lo, hi};
    return __builtin_bit_cast(unsigned, __builtin_convertvector(v, bf16x2_t));
}
__device__ __forceinline__ float bf2f(unsigned short b) { return __uint_as_float(((unsigned)b) << 16); }
__device__ __forceinline__ float bflo(unsigned w) { return __uint_as_float(w << 16); }
__device__ __forceinline__ float bfhi(unsigned w) { return __uint_as_float(w & 0xffff0000u); }
__device__ __forceinline__ float fast_exp2(float x) { return __builtin_amdgcn_exp2f(x); }


#define XB_TMO      128
#define XB_XCNT(j)  (256  + 64 * (j))
#define XB_XSUB(j)  (1280 + 64 * (j))
#define XB_XGEN(j)  (2304 + 64 * (j))
#define XB_TOP      3328
#define XB_TOPGEN   3392
#define XCD_BAR_WORDS 3456
#define XB_SPIN_CAP (1u << 20)
#define LAS __attribute__((address_space(3)))
__device__ __forceinline__ unsigned xb_ld(unsigned* p)              { return __hip_atomic_load(p, __ATOMIC_RELAXED, __HIP_MEMORY_SCOPE_AGENT); }
__device__ __forceinline__ unsigned xb_add(unsigned* p, unsigned v) { return __hip_atomic_fetch_add(p, v, __ATOMIC_RELAXED, __HIP_MEMORY_SCOPE_AGENT); }
__device__ __forceinline__ unsigned xb_xcc_id() { return (unsigned)__builtin_amdgcn_s_getreg((3 << 11) | 20) & 0xFu; }
#define XB_SPIN(cond, bar) do { unsigned _sp = 0; while (cond) { __builtin_amdgcn_s_sleep(1); \
    if ((++_sp & 255u) == 0u) { if (xb_ld(&(bar)[XB_TMO])) break; if (_sp > XB_SPIN_CAP) { atomicAdd(&(bar)[XB_TMO], 1u); break; } } } } while (0)
struct XcdBarrier { unsigned* bar; unsigned x; volatile LAS unsigned* st; };
__device__ __forceinline__ XcdBarrier xcd_barrier_post(unsigned* bar, volatile LAS unsigned* st) {
    XcdBarrier b; b.bar = bar; b.x = xb_xcc_id(); b.st = st;
    if (threadIdx.x == 0) (void)xb_add(&bar[XB_XCNT(b.x)], 1u);
    return b;
}
__device__ __forceinline__ void xcd_barrier_complete(unsigned* bar, unsigned x, unsigned& nloc, unsigned& nx) {
    const unsigned G = gridDim.x * gridDim.y * gridDim.z;
    unsigned sum, cnt, mine, sp = 0u;
    for (;;) {
        sum = 0u; cnt = 0u; mine = 0u;
#pragma unroll
        for (unsigned j = 0; j < 16; ++j) { const unsigned c = xb_ld(&bar[XB_XCNT(j)]); sum += c; cnt += (c > 0u) ? 1u : 0u; mine = (j == x) ? c : mine; }
        if (sum == G) break;
        __builtin_amdgcn_s_sleep(1);
        if ((++sp & 255u) == 0u) { if (xb_ld(&bar[XB_TMO])) break; if (sp > XB_SPIN_CAP) { atomicAdd(&bar[XB_TMO], 1u); break; } }
    }
    nloc = mine > 0u ? mine : 1u; nx = cnt > 0u ? cnt : 1u;
}
__device__ __forceinline__ void xcd_barrier(const XcdBarrier& b) {
    asm volatile("s_waitcnt vmcnt(0)" ::: "memory");
    __syncthreads();
    if (threadIdx.x == 0) {
        unsigned* bar = b.bar;
        unsigned bx = b.x; asm volatile("" : "+s"(bx));
        __builtin_amdgcn_s_waitcnt(0);
        unsigned nloc = b.st[0], nx = b.st[1];
        if (nloc == 0u) { xcd_barrier_complete(bar, bx, nloc, nx); b.st[0] = nloc; b.st[1] = nx; }
        const unsigned old = xb_add(&bar[XB_XSUB(bx)], 1u);
        const unsigned gen = old / nloc;
        if (old + 1u == (gen + 1u) * nloc) {
            __builtin_amdgcn_fence(__ATOMIC_RELEASE, "agent");
            asm volatile("s_waitcnt vmcnt(0)" ::: "memory");
            const unsigned og = xb_add(&bar[XB_TOP], 1u);
            const unsigned tg = og / nx;
            if (og + 1u == (tg + 1u) * nx) xb_add(&bar[XB_TOPGEN], 1u);
            else XB_SPIN(xb_ld(&bar[XB_TOPGEN]) == tg, bar);
            __builtin_amdgcn_fence(__ATOMIC_ACQUIRE, "agent");
            xb_add(&bar[XB_XGEN(bx)], 1u);
            asm volatile("s_waitcnt vmcnt(0)" ::: "memory");
        } else {
            XB_SPIN(xb_ld(&bar[XB_XGEN(bx)]) == gen, bar);
            __builtin_amdgcn_fence(__ATOMIC_ACQUIRE, "agent");
            asm volatile("s_waitcnt vmcnt(0)" ::: "memory");
        }
    }
    __syncthreads();
}

__device__ __forceinline__ int perm_col(int n) {
    if (n < 1024) return n;
    if (n < 2048) return n + 512;
    if (n < 3072) return n + 1024;
    if (n < 3584) return n - 2048;
    return n - 1024;
}

__device__ void prologue_phase(char* lds, const Params& p) {
    int tid_ = threadIdx.x; asm volatile("" : "+v"(tid_)); const int tid = tid_, lane = tid & 63, wid = tid >> 6;
    float* tile = (float*)lds;
    const int nt_in = DEPTH * 16 * 64, nt_out = DEPTH * 16 * 16;
    for (int t = blockIdx.x; t < nt_in + nt_out; t += gridDim.x) {
        const float* W; bf16_t* Wt; const float* g; int N, k0, n0, no0;
        if (t < nt_in) {
            const int l = t >> 10, rem = t & 1023; k0 = (rem >> 6) * 64; n0 = (rem & 63) * 64;
            W = p.w_in + (size_t)l * 1024 * 4096; N = 4096; Wt = p.wi_t + (size_t)l * 4096 * 1024; g = p.norm_g + l * 1024; no0 = perm_col(n0);
        } else {
            const int t2 = t - nt_in; const int l = t2 >> 8, rem = t2 & 255; k0 = (rem >> 4) * 64; n0 = (rem & 15) * 64;
            W = p.w_out + (size_t)l * 1024 * 1024; N = 1024; Wt = p.wo_t + (size_t)l * 1024 * 1024; g = nullptr; no0 = n0;
        }
        {
            const int i = tid >> 4, j4 = tid & 15;
#pragma unroll
            for (int ps = 0; ps < 2; ++ps) {
                const int kk = i + 32 * ps;
                const f32x4 v = *(const f32x4*)(W + (size_t)(k0 + kk) * N + no0 + 4 * j4);
                const float gg = g ? g[k0 + kk] : 1.0f;
                tile[kk * 65 + 4 * j4 + 0] = v[0] * gg; tile[kk * 65 + 4 * j4 + 1] = v[1] * gg;
                tile[kk * 65 + 4 * j4 + 2] = v[2] * gg; tile[kk * 65 + 4 * j4 + 3] = v[3] * gg;
            }
        }
        __syncthreads();
        {
            const int j = tid >> 3, i8 = tid & 7;
            float v[8];
#pragma unroll
            for (int e = 0; e < 8; ++e) v[e] = tile[(8 * i8 + e) * 65 + j];
            u32x4 w; w.x = cvt_pk_bf16(v[0], v[1]); w.y = cvt_pk_bf16(v[2], v[3]); w.z = cvt_pk_bf16(v[4], v[5]); w.w = cvt_pk_bf16(v[6], v[7]);
            *(u32x4*)(Wt + (size_t)(n0 + j) * 1024 + k0 + 8 * i8) = w;
        }
        __syncthreads();
    }
    for (int row = blockIdx.x * 8 + wid; row < NTOK; row += gridDim.x * 8) {
        float ss = 0.f;
#pragma unroll
        for (int i = 0; i < 4; ++i) {
            const int c = 4 * lane + 256 * i;
            const f32x4 v = *(const f32x4*)(p.x + (size_t)row * 1024 + c);
            ss += v[0] * v[0] + v[1] * v[1] + v[2] * v[2] + v[3] * v[3];
            u32x2 w; w.x = cvt_pk_bf16(v[0], v[1]); w.y = cvt_pk_bf16(v[2], v[3]);
            *(u32x2*)(p.xb + (size_t)row * 1024 + c) = w;
        }
#pragma unroll
        for (int s = 32; s >= 1; s >>= 1) ss += __shfl_xor(ss, s);
        if (lane < 16) p.rss[(size_t)row * 16 + lane] = lane == 0 ? ss : 0.f;
    }
}

__device__ void final_phase(const Params& p) {
    int tid_ = threadIdx.x; asm volatile("" : "+v"(tid_)); const int tid = tid_, lane = tid & 63, wid = tid >> 6;
    for (int row = blockIdx.x * 8 + wid; row < NTOK; row += gridDim.x * 8) {
        float ss = 0.f;
        if (lane < 16) ss = p.rss[(size_t)row * 16 + lane];
#pragma unroll
        for (int s = 8; s >= 1; s >>= 1) ss += __shfl_xor(ss, s);
        ss = __shfl(ss, 0);
        const float rstd = rsqrtf(ss * (1.0f / 1024.0f) + RMS_EPS);
#pragma unroll
        for (int i = 0; i < 4; ++i) {
            const int c = 4 * lane + 256 * i;
            f32x4 v = *(const f32x4*)(p.xf + (size_t)row * 1024 + c);
            const f32x4 g = *(const f32x4*)(p.final_g + c);
            v = v * rstd * g;
            *(f32x4*)(p.xf + (size_t)row * 1024 + c) = v;
        }
    }
}

namespace pg8 {
#define PG8_LAS __attribute__((address_space(3)))
typedef unsigned short bf16_t;
typedef short bf16x8 __attribute__((ext_vector_type(8)));
typedef float f32x4 __attribute__((ext_vector_type(4)));
typedef unsigned u32x4 __attribute__((ext_vector_type(4)));
constexpr int BM = 256, BK = 64, HALF = 128, HTB = HALF * BK * 2  , STAGE_BYTES = 8 * HTB, NXCD = 8, WGM = 8;

__host__ __device__ __forceinline__ int lds_byte(int r, int c) { const int st = (r >> 4) * 2 + (c >> 5), rr = r & 15, cc = c & 31, ob = rr * 64 + cc * 2; return st * 1024 + (ob ^ (((ob >> 9) & 1) << 5)); }
__host__ __device__ __forceinline__ void stage_rc(int b, int& R, int& C) { const int st = b / 1024, sb = b % 1024, swz = sb ^ (((sb >> 9) & 1) << 5); R = (st >> 1) * 16 + swz / 64; C = (st & 1) * 32 + (swz % 64) / 2; }
__host__ __device__ __forceinline__ int perm32(int rho) { const int n = rho >> 4, i = rho & 15; return 8 * (i >> 2) + 4 * n + (i & 3); }

struct Unit { int pm, pn; };
struct Gemm { const bf16_t* A; const bf16_t* Bt; int M, N, K; };

struct StaticOrder {
    int nM, nN, nwg, G, c;
    __host__ __device__ void init(int M, int N, int G_, int c_) { nM = M / BM; nN = N / BM; nwg = nM * nN; G = G_; c = c_; }
    __host__ __device__ bool next(int i, Unit& u) const {
        const long L = (long)i * G + c; if (L >= nwg) return false;
        int wgid = (int)L; { const int q = nwg / NXCD, r = nwg % NXCD, xcd = wgid % NXCD, off = wgid / NXCD; wgid = (xcd < r ? xcd * (q + 1) : r * (q + 1) + (xcd - r) * q) + off; }
        const int nig = WGM * nN, gid = wgid / nig, fm = gid * WGM, gsz = (nM - fm) < WGM ? (nM - fm) : WGM;
        u.pm = fm + ((wgid % nig) % gsz); u.pn = (wgid % nig) / gsz; return true;
    }
    __device__ __forceinline__ void a_ready(const Unit&) const {}
    __device__ __forceinline__ void done(const Unit&) const {}
};


template <class Epi, class Sched, bool ALIGN_EPI = false, bool SP2 = false>
__device__ __forceinline__ void gemm_phase(PG8_LAS unsigned char* lds, const Gemm g, const Sched& S, const Epi& E) {
    int tid_ = threadIdx.x; asm volatile("" : "+v"(tid_));
    const int tid = tid_, wid = __builtin_amdgcn_readfirstlane(tid >> 6), lane = tid & 63, wr = wid >> 2, wc = wid & 3, fr = lane & 15, fq = lane >> 4;
    const int K = g.K, nt = K / BK;
    unsigned voffA[2], voffB[2];
#pragma unroll
    for (int i = 0; i < 2; ++i) { int R, C; stage_rc(tid * 16 + i * 8192, R, C); const int Rb = Epi::PERM ? ((R & ~31) + perm32(R & 31)) : R;
        voffA[i] = (unsigned)(R * K + C) * 2u; voffB[i] = (unsigned)(Rb * K + C) * 2u; }
    const size_t kstep = (size_t)(BK * 2);
    const size_t hstep = (size_t)HALF * K * 2;
    const size_t tstep = 2 * hstep;
    const unsigned ldsw = (unsigned)wid * 1024u;
    const int aoff = lds_byte(wr * 64 + fr, fq * 8), boff = lds_byte(wc * 32 + fr, fq * 8);
#define PG8_SA(b, h) (((b) * 2 + (h)) * HTB)
#define PG8_SB(b, h) ((4 + (b) * 2 + (h)) * HTB)
#define PG8_STAGE(bufoff, gbase, voff) do { _Pragma("unroll") for (int _i = 0; _i < 2; ++_i) \
        __builtin_amdgcn_global_load_lds((const unsigned*)((const char*)(gbase) + (voff)[_i]), (PG8_LAS unsigned*)(lds + (bufoff) + ldsw + _i * 8192), 16, 0, 0); } while (0)
#define PG8_LDA(dst, b, h) do { _Pragma("unroll") for (int m = 0; m < 4; ++m) _Pragma("unroll") for (int k = 0; k < 2; ++k) dst[m][k] = *(const PG8_LAS bf16x8*)(lds + PG8_SA(b, h) + aoff + m * 2048 + k * 1024); } while (0)
#define PG8_LDB(dst, b, h) do { _Pragma("unroll") for (int n = 0; n < 2; ++n) _Pragma("unroll") for (int k = 0; k < 2; ++k) dst[n][k] = *(const PG8_LAS bf16x8*)(lds + PG8_SB(b, h) + boff + n * 2048 + k * 1024); } while (0)
#define PG8_MMA(ai, bj, At, Bt) do { __builtin_amdgcn_s_setprio(1); _Pragma("unroll") for (int m = 0; m < 4; ++m) _Pragma("unroll") for (int n = 0; n < 2; ++n) _Pragma("unroll") for (int k = 0; k < 2; ++k) \
        acc[ai][bj][m][n] = __builtin_amdgcn_mfma_f32_16x16x32_bf16(Bt[n][k], At[m][k], acc[ai][bj][m][n], 0, 0, 0); __builtin_amdgcn_s_setprio(0); } while (0)
#define PG8_WAIT_V(n) asm volatile("s_waitcnt vmcnt(" #n ")" ::: "memory")
#define PG8_WAIT_L(n) asm volatile("s_waitcnt lgkmcnt(" #n ")" ::: "memory")
#define PG8_BAR __builtin_amdgcn_s_barrier()
#define PG8_SCHED __builtin_amdgcn_sched_barrier(0)
    Unit cur, nxt; int ui = 0;
    if (!S.next(0, cur)) return;
    f32x4 acc[2][2][4][2];
#pragma unroll
    for (int a = 0; a < 2; ++a)
#pragma unroll
        for (int b = 0; b < 2; ++b)
#pragma unroll
            for (int m = 0; m < 4; ++m)
#pragma unroll
                for (int n = 0; n < 2; ++n) acc[a][b][m][n] = (f32x4){0.f, 0.f, 0.f, 0.f};
    bf16x8 At[4][2], B0[2][2], B1[2][2];
    const char* cA = (const char*)g.A + (size_t)cur.pm * tstep; const char* cB = (const char*)g.Bt + (size_t)cur.pn * tstep;
    S.a_ready(cur);
    if constexpr (SP2) {
        PG8_STAGE(PG8_SB(0, 0), cB, voffB); PG8_STAGE(PG8_SB(0, 1), cB + hstep, voffB); PG8_STAGE(PG8_SA(0, 0), cA, voffA); PG8_STAGE(PG8_SA(0, 1), cA + hstep, voffA);
        if (wr == 1) PG8_BAR;
        PG8_WAIT_V(2); PG8_BAR;
        PG8_STAGE(PG8_SB(1, 0), cB + kstep, voffB); PG8_STAGE(PG8_SA(1, 0), cA + kstep, voffA); PG8_STAGE(PG8_SB(1, 1), cB + hstep + kstep, voffB);
        PG8_WAIT_V(6); PG8_BAR;
    } else {
        PG8_STAGE(PG8_SB(0, 0), cB, voffB); PG8_STAGE(PG8_SA(0, 0), cA, voffA); PG8_STAGE(PG8_SB(0, 1), cB + hstep, voffB); PG8_STAGE(PG8_SA(0, 1), cA + hstep, voffA);
        if (wr == 1) PG8_BAR;
        PG8_WAIT_V(4); PG8_BAR;
        PG8_STAGE(PG8_SB(1, 0), cB + kstep, voffB); PG8_STAGE(PG8_SA(1, 0), cA + kstep, voffA); PG8_STAGE(PG8_SB(1, 1), cB + hstep + kstep, voffB);
        PG8_WAIT_V(6); PG8_BAR;
    }
    for (;;) {
        const bool has_next = S.next(ui + 1, nxt);
        const char* nA = has_next ? (const char*)g.A + (size_t)nxt.pm * tstep : cA; const char* nB = has_next ? (const char*)g.Bt + (size_t)nxt.pn * tstep : cB;
        for (int t = 0; t < nt; t += 2) {
            const bool last = (t == nt - 2);
            const char* a1 = cA + (size_t)(t + 1) * kstep;
            const char* a2 = last ? nA : cA + (size_t)(t + 2) * kstep; const char* b2 = last ? nB : cB + (size_t)(t + 2) * kstep;
            const char* a3 = a2 + kstep; const char* b3 = b2 + kstep;
            if (last && has_next) S.a_ready(nxt);
            if constexpr (SP2) {
            PG8_LDB(B0, 0, 0); PG8_LDB(B1, 0, 1); PG8_SCHED; PG8_LDA(At, 0, 0); PG8_STAGE(PG8_SA(1, 1), a1 + hstep, voffA);
            PG8_WAIT_V(8); PG8_WAIT_L(0); PG8_BAR; PG8_MMA(0, 0, At, B0); PG8_MMA(0, 1, At, B1); PG8_BAR; PG8_SCHED;
            PG8_LDA(At, 0, 1); PG8_STAGE(PG8_SB(0, 0), b2, voffB); PG8_STAGE(PG8_SB(0, 1), b2 + hstep, voffB); PG8_STAGE(PG8_SA(0, 0), a2, voffA);
            PG8_WAIT_V(8); PG8_WAIT_L(0); PG8_BAR; PG8_MMA(1, 0, At, B0); PG8_MMA(1, 1, At, B1); PG8_BAR; PG8_SCHED;
            PG8_LDB(B0, 1, 0); PG8_LDB(B1, 1, 1); PG8_SCHED; PG8_LDA(At, 1, 0); PG8_STAGE(PG8_SA(0, 1), a2 + hstep, voffA);
            PG8_WAIT_V(8); PG8_WAIT_L(0); PG8_BAR; PG8_MMA(0, 0, At, B0); PG8_MMA(0, 1, At, B1); PG8_BAR; PG8_SCHED;
            PG8_LDA(At, 1, 1); PG8_STAGE(PG8_SB(1, 0), b3, voffB); PG8_STAGE(PG8_SB(1, 1), b3 + hstep, voffB); PG8_STAGE(PG8_SA(1, 0), a3, voffA);
            PG8_WAIT_V(8); PG8_WAIT_L(0); PG8_BAR; PG8_MMA(1, 0, At, B0); PG8_MMA(1, 1, At, B1); PG8_BAR; PG8_SCHED;
            } else {
            PG8_LDB(B0, 0, 0); PG8_SCHED; PG8_LDA(At, 0, 0); PG8_STAGE(PG8_SA(1, 1), a1 + hstep, voffA);
            PG8_WAIT_L(8); PG8_BAR; PG8_WAIT_L(0); PG8_MMA(0, 0, At, B0); PG8_BAR; PG8_SCHED;
            PG8_LDB(B1, 0, 1); PG8_STAGE(PG8_SB(0, 0), b2, voffB);
            PG8_BAR; PG8_WAIT_L(0); PG8_MMA(0, 1, At, B1); PG8_BAR;
            PG8_LDA(At, 0, 1); PG8_STAGE(PG8_SA(0, 0), a2, voffA);
            PG8_BAR; PG8_WAIT_L(0); PG8_MMA(1, 0, At, B0); PG8_BAR; PG8_SCHED;
            PG8_STAGE(PG8_SB(0, 1), b2 + hstep, voffB);
            PG8_WAIT_V(6); PG8_BAR; PG8_MMA(1, 1, At, B1); PG8_BAR;
            PG8_LDB(B0, 1, 0); PG8_SCHED; PG8_LDA(At, 1, 0); PG8_STAGE(PG8_SA(0, 1), a2 + hstep, voffA);
            PG8_WAIT_L(8); PG8_BAR; PG8_WAIT_L(0); PG8_MMA(0, 0, At, B0); PG8_BAR; PG8_SCHED;
            PG8_LDB(B1, 1, 1); PG8_STAGE(PG8_SB(1, 0), b3, voffB);
            PG8_BAR; PG8_WAIT_L(0); PG8_MMA(0, 1, At, B1); PG8_BAR;
            PG8_LDA(At, 1, 1); PG8_STAGE(PG8_SA(1, 0), a3, voffA);
            PG8_BAR; PG8_WAIT_L(0); PG8_MMA(1, 0, At, B0); PG8_BAR; PG8_SCHED;
            PG8_STAGE(PG8_SB(1, 1), b3 + hstep, voffB);
            PG8_WAIT_V(6); PG8_BAR; PG8_MMA(1, 1, At, B1); PG8_BAR;
            }
        }
        if constexpr (ALIGN_EPI) { if (wr == 0) PG8_BAR; }
        if constexpr (!Epi::AFTER_DRAIN) { E(acc, cur, wr, wc, fr, fq); S.done(cur); }
        if (!has_next) break;
#pragma unroll
        for (int a = 0; a < 2; ++a)
#pragma unroll
            for (int b = 0; b < 2; ++b)
#pragma unroll
                for (int m = 0; m < 4; ++m)
#pragma unroll
                    for (int n = 0; n < 2; ++n) acc[a][b][m][n] = (f32x4){0.f, 0.f, 0.f, 0.f};
        cur = nxt; cA = nA; cB = nB; ++ui;
        if constexpr (ALIGN_EPI) { if (wr == 1) PG8_BAR; }
    }
    PG8_WAIT_V(0);
    if constexpr (!ALIGN_EPI) { if (wr == 0) PG8_BAR; }
    PG8_BAR;
    if constexpr (Epi::AFTER_DRAIN) { E.fused(acc, cur, wr, wc, fr, fq, lds, wid, lane); S.done(cur); }
#undef PG8_SA
#undef PG8_SB
#undef PG8_STAGE
#undef PG8_LDA
#undef PG8_LDB
#undef PG8_MMA
#undef PG8_WAIT_V
#undef PG8_WAIT_L
#undef PG8_BAR
#undef PG8_SCHED
}
}


namespace pg8 {
struct EpiZ {
    static constexpr bool PERM = true, AFTER_DRAIN = false;
    bf16_t* z; bf16_t* vT; const float* rss;
    __device__ __forceinline__ void operator()(const f32x4 (&acc)[2][2][4][2], const Unit& u, int wr, int wc, int fr, int fq) const {
        f32x4 part[2][4];
#pragma unroll
        for (int ai = 0; ai < 2; ++ai)
#pragma unroll
            for (int m = 0; m < 4; ++m) part[ai][m] = *(const f32x4*)(rss + (size_t)(u.pm * BM + ai * HALF + wr * 64 + m * 16 + fr) * 16 + 4 * fq);
        float rstdv[2][4];
#pragma unroll
        for (int ai = 0; ai < 2; ++ai)
#pragma unroll
            for (int m = 0; m < 4; ++m) {
                float s = (part[ai][m][0] + part[ai][m][1]) + (part[ai][m][2] + part[ai][m][3]);
                s += __shfl_xor(s, 16); s += __shfl_xor(s, 32);
                rstdv[ai][m] = rsqrtf(s * (1.0f / 1024.0f) + RMS_EPS);
            }
#pragma unroll
        for (int ai = 0; ai < 2; ++ai)
#pragma unroll
            for (int m = 0; m < 4; ++m) {
                const int row = u.pm * BM + ai * HALF + wr * 64 + m * 16 + fr;
                const float rstd = rstdv[ai][m];
                const int b = row >> 11, s = row & 2047;
#pragma unroll
                for (int bj = 0; bj < 2; ++bj) {
                    const int tn = 2 * u.pn + bj;
                    const int cw = 32 * wc + 8 * fq;
                    const f32x4 v0 = acc[ai][bj][m][0] * rstd, v1 = acc[ai][bj][m][1] * rstd;
                    u32x4 w; w.x = ::cvt_pk_bf16(v0[0], v0[1]); w.y = ::cvt_pk_bf16(v0[2], v0[3]); w.z = ::cvt_pk_bf16(v1[0], v1[1]); w.w = ::cvt_pk_bf16(v1[2], v1[3]);
                    if (tn < 24) {
                        bf16_t* dst;
                        if (tn < 8) dst = z + (size_t)(tn >> 2) * ZS_KD + ((size_t)((b * 4 + (tn & 3)) * 2048 + s)) * 128 + cw;
                        else if (tn < 16) dst = z + ZS_QN + (size_t)((tn - 8) >> 2) * (ZS_KN - ZS_QN) + ((size_t)((b * 8 + ((tn - 8) & 3) * 2 + (cw >> 6)) * 2048 + s)) * 64 + (cw & 63);
                        else dst = z + ZS_GATE + (size_t)row * 1024 + (tn - 16) * 128 + cw;
                        *(u32x4*)dst = w;
                    } else {
                        const unsigned ox = __shfl_xor(w.x, 1), oy = __shfl_xor(w.y, 1), oz = __shfl_xor(w.z, 1), ow = __shfl_xor(w.w, 1);
                        const bool odd = fr & 1;
                        const unsigned a0 = odd ? oz : w.x, a1 = odd ? ow : w.y;
                        const unsigned b0 = odd ? w.z : ox, b1 = odd ? w.w : oy;
                        const unsigned p0 = (a0 & 0xffffu) | (b0 << 16), p1 = (a0 >> 16) | (b0 & 0xffff0000u);
                        const unsigned p2 = (a1 & 0xffffu) | (b1 << 16), p3 = (a1 >> 16) | (b1 & 0xffff0000u);
                        const int ch0 = cw + (odd ? 4 : 0), se = s & ~1;
                        bf16_t* dst;
                        if (tn < 28) dst = vT + VS_VD + ((size_t)(((b * 4 + (tn - 24)) * 32 + (se >> 6)) * 128 + ch0)) * 64 + (se & 63);
                        else dst = vT + VS_VN + ((size_t)(((b * 8 + (tn - 28) * 2 + (ch0 >> 6)) * 32 + (se >> 6)) * 64 + (ch0 & 63))) * 64 + (se & 63);
                        *(unsigned*)(dst) = p0; *(unsigned*)(dst + 64) = p1; *(unsigned*)(dst + 128) = p2; *(unsigned*)(dst + 192) = p3;
                    }
                }
            }
    }
};
template <int XIN, int OUT> struct EpiRes2 {
    static constexpr bool PERM = true, AFTER_DRAIN = false, TOUCH = false;
    const float* xin32; const bf16_t* xinb; bf16_t* xb; float* xf; float* rss;
    __device__ __forceinline__ void operator()(const f32x4 (&acc)[2][2][4][2], const Unit& u, int wr, int wc, int fr, int fq) const {
#pragma unroll
        for (int ai = 0; ai < 2; ++ai) {
            f32x4 res[XIN == 0 ? 4 : 1][2][2]; u32x4 rb[XIN == 0 ? 1 : 4][2];
#pragma unroll
            for (int m = 0; m < 4; ++m)
#pragma unroll
                for (int bj = 0; bj < 2; ++bj) {
                    const size_t off = (size_t)(u.pm * BM + ai * HALF + wr * 64 + m * 16 + fr) * 1024 + u.pn * BM + bj * HALF + 32 * wc + 8 * fq;
                    if (XIN == 0) { res[m][bj][0] = *(const f32x4*)(xin32 + off); res[m][bj][1] = *(const f32x4*)(xin32 + off + 4); }
                    else rb[m][bj] = *(const u32x4*)(xinb + off);
                }
            __builtin_amdgcn_sched_barrier(0);
#pragma unroll
            for (int m = 0; m < 4; ++m) {
                const int row = u.pm * BM + ai * HALF + wr * 64 + m * 16 + fr;
                float ss = 0.f;
#pragma unroll
                for (int bj = 0; bj < 2; ++bj) {
                    const size_t off = (size_t)row * 1024 + u.pn * BM + bj * HALF + 32 * wc + 8 * fq;
                    f32x4 r0, r1;
                    if (XIN == 0) { r0 = res[m][bj][0]; r1 = res[m][bj][1]; }
                    else { const u32x4 w = rb[m][bj]; r0 = (f32x4){bflo(w.x), bfhi(w.x), bflo(w.y), bfhi(w.y)}; r1 = (f32x4){bflo(w.z), bfhi(w.z), bflo(w.w), bfhi(w.w)}; }
                    const f32x4 v0 = r0 + acc[ai][bj][m][0], v1 = r1 + acc[ai][bj][m][1];
                    if (OUT == 0) { u32x4 w; w.x = ::cvt_pk_bf16(v0[0], v0[1]); w.y = ::cvt_pk_bf16(v0[2], v0[3]); w.z = ::cvt_pk_bf16(v1[0], v1[1]); w.w = ::cvt_pk_bf16(v1[2], v1[3]); *(u32x4*)(xb + off) = w; }
                    else { *(f32x4*)(xf + off) = v0; *(f32x4*)(xf + off + 4) = v1; }
                    ss += (v0[0] * v0[0] + v0[1] * v0[1]) + (v0[2] * v0[2] + v0[3] * v0[3]) + (v1[0] * v1[0] + v1[1] * v1[1]) + (v1[2] * v1[2] + v1[3] * v1[3]);
                }
                ss += __shfl_xor(ss, 16); ss += __shfl_xor(ss, 32);
                if (fq == 0) rss[(size_t)row * 16 + u.pn * 4 + wc] = ss;
            }
            __builtin_amdgcn_sched_barrier(0);
        }
    }
};
struct EpiFinal {
    static constexpr bool PERM = true, AFTER_DRAIN = true;
    const bf16_t* xinb; float* out; const float* fg; float* rss; unsigned* cnt;
    __device__ __forceinline__ void fused(f32x4 (&acc)[2][2][4][2], const Unit& u, int wr, int wc, int fr, int fq, PG8_LAS unsigned char* lds, int wid, int lane) const {
        float ssv[2][4];
#pragma unroll
        for (int ai = 0; ai < 2; ++ai) {
            u32x4 rb[4][2];
#pragma unroll
            for (int m = 0; m < 4; ++m)
#pragma unroll
                for (int bj = 0; bj < 2; ++bj) {
                    const size_t off = (size_t)(u.pm * BM + ai * HALF + wr * 64 + m * 16 + fr) * 1024 + u.pn * BM + bj * HALF + 32 * wc + 8 * fq;
                    rb[m][bj] = *(const u32x4*)(xinb + off);
                }
#pragma unroll
            for (int m = 0; m < 4; ++m) {
                float ss = 0.f;
#pragma unroll
                for (int bj = 0; bj < 2; ++bj) {
                    const u32x4 w = rb[m][bj];
                    const f32x4 v0 = (f32x4){bflo(w.x), bfhi(w.x), bflo(w.y), bfhi(w.y)} + acc[ai][bj][m][0], v1 = (f32x4){bflo(w.z), bfhi(w.z), bflo(w.w), bfhi(w.w)} + acc[ai][bj][m][1];
                    acc[ai][bj][m][0] = v0; acc[ai][bj][m][1] = v1;
                    ss += (v0[0] * v0[0] + v0[1] * v0[1]) + (v0[2] * v0[2] + v0[3] * v0[3]) + (v1[0] * v1[0] + v1[1] * v1[1]) + (v1[2] * v1[2] + v1[3] * v1[3]);
                }
                ss += __shfl_xor(ss, 16); ss += __shfl_xor(ss, 32);
                ssv[ai][m] = ss;
            }
        }
        if (fq == 0) {
#pragma unroll
            for (int ai = 0; ai < 2; ++ai)
#pragma unroll
                for (int m = 0; m < 4; ++m)
                    __hip_atomic_store((unsigned*)rss + (size_t)(u.pm * BM + ai * HALF + wr * 64 + m * 16 + fr) * 16 + u.pn * 4 + wc, __float_as_uint(ssv[ai][m]), __ATOMIC_RELAXED, __HIP_MEMORY_SCOPE_AGENT);
        }
        asm volatile("s_waitcnt vmcnt(0)" ::: "memory");
        if (lane == 0) __hip_atomic_fetch_add(cnt + 64 * u.pm, 1u, __ATOMIC_RELAXED, __HIP_MEMORY_SCOPE_AGENT);
        if (wid == 0) {
            unsigned spins = 0;
            while ((unsigned)__builtin_amdgcn_readfirstlane(__hip_atomic_load(cnt + 64 * u.pm, __ATOMIC_RELAXED, __HIP_MEMORY_SCOPE_AGENT)) < 32u) {
                __builtin_amdgcn_s_sleep(2);
                if (++spins > (1u << 22)) break;
            }
            __builtin_amdgcn_fence(__ATOMIC_ACQUIRE, "agent");
        }
        asm volatile("s_waitcnt vmcnt(0) lgkmcnt(0)" ::: "memory"); __builtin_amdgcn_s_barrier(); asm volatile("" ::: "memory");
        float rstdv[2][4];
#pragma unroll
        for (int ai = 0; ai < 2; ++ai)
#pragma unroll
            for (int m = 0; m < 4; ++m) {
                const unsigned* rp = (const unsigned*)rss + (size_t)(u.pm * BM + ai * HALF + wr * 64 + m * 16 + fr) * 16 + 4 * fq;
                float s = 0.f;
#pragma unroll
                for (int k = 0; k < 4; ++k) s += __uint_as_float(__hip_atomic_load(rp + k, __ATOMIC_RELAXED, __HIP_MEMORY_SCOPE_AGENT));
                s += __shfl_xor(s, 16); s += __shfl_xor(s, 32);
                rstdv[ai][m] = rsqrtf(s * (1.0f / 1024.0f) + RMS_EPS);
            }
        f32x4 gv[2][2];
#pragma unroll
        for (int bj = 0; bj < 2; ++bj) { const int c0 = u.pn * BM + bj * HALF + 32 * wc + 8 * fq; gv[bj][0] = *(const f32x4*)(fg + c0); gv[bj][1] = *(const f32x4*)(fg + c0 + 4); }
#pragma unroll
        for (int ai = 0; ai < 2; ++ai)
#pragma unroll
            for (int m = 0; m < 4; ++m)
#pragma unroll
                for (int bj = 0; bj < 2; ++bj) {
                    const size_t off = (size_t)(u.pm * BM + ai * HALF + wr * 64 + m * 16 + fr) * 1024 + u.pn * BM + bj * HALF + 32 * wc + 8 * fq;
                    *(f32x4*)(out + off) = acc[ai][bj][m][0] * rstdv[ai][m] * gv[bj][0];
                    *(f32x4*)(out + off + 4) = acc[ai][bj][m][1] * rstdv[ai][m] * gv[bj][1];
                }
    }
};
}
constexpr int LDS_PHASE_BYTES = 143360;
constexpr int LDS_RPB_OFF = LDS_PHASE_BYTES + 16 + 128, LDS_SG_OFF = LDS_RPB_OFF + 8 * 465 * 4 + 128, LDS_RPB_BYTES = 8 * 465 * 4 + 128 + 512;

constexpr int DA_KP = 272, DA_VP = 144;
constexpr int DA_KBYTES = 128 * DA_KP, DA_VSUB = 128 * DA_VP, DA_VBYTES = 2 * DA_VSUB, DA_STAGE = DA_KBYTES + DA_VBYTES;

__device__ __forceinline__ float silu_f(float x) { return x / (1.0f + __expf(-x)); }

__device__ void da_unit(char* lds, const Params& p, int layer, int unit) {
    int tid_ = threadIdx.x; asm volatile("" : "+v"(tid_)); const int tid = tid_, lane = tid & 63, wid = __builtin_amdgcn_readfirstlane(tid >> 6), r = lane & 31, h2 = lane >> 5;
    const int c = wid & 1, qg = wid >> 1;
    const int g8 = unit >> 3, bh = (unit & 7) * 4 + (g8 >> 4), qb = g8 & 15, b = bh >> 2, h = bh & 3;
    const float slope2 = exp2f(-2.0f * (float)(h + 1)) * LOG2E;
    const float qscale = 0.125f * LOG2E;
    float lam;
    {
        const float v1 = p.lq1[layer * 64 + lane] * p.lk1[layer * 64 + lane], v2 = p.lq2[layer * 64 + lane] * p.lk2[layer * 64 + lane];
        float s1 = v1, s2 = v2;
#pragma unroll
        for (int s = 32; s >= 1; s >>= 1) { s1 += __shfl_xor(s1, s); s2 += __shfl_xor(s2, s); }
        lam = __expf(s1) - __expf(s2) + p.lam_init[layer];
    }
    const int q0 = qb * 128 + qg * 32;
    const size_t tokq = (size_t)b * SEQ + q0 + r;
    bf16x8 qf[4];
#pragma unroll
    for (int t = 0; t < 4; ++t) {
        const u32x4 w = *(const u32x4*)(p.z + ZS_QD + ((size_t)(bh * 2048 + q0 + r)) * 128 + c * 64 + t * 16 + h2 * 8);
        u32x4 o;
        o.x = cvt_pk_bf16(bflo(w.x) * qscale, bfhi(w.x) * qscale); o.y = cvt_pk_bf16(bflo(w.y) * qscale, bfhi(w.y) * qscale);
        o.z = cvt_pk_bf16(bflo(w.z) * qscale, bfhi(w.z) * qscale); o.w = cvt_pk_bf16(bflo(w.w) * qscale, bfhi(w.w) * qscale);
        qf[t] = __builtin_bit_cast(bf16x8, o);
    }
    f32x16 O[4], Bs;
#pragma unroll
    for (int k = 0; k < 4; ++k)
#pragma unroll
        for (int e = 0; e < 16; ++e) O[k][e] = 0.f;
#pragma unroll
    for (int e = 0; e < 16; ++e) Bs[e] = -slope2 * (float)(16 * (e >> 3) + (e & 7));
    float mrow = -1e30f, lrow = 0.f;
    const float qrel = (float)(8 * h2) - (float)(q0 + r);
    const bf16_t* Kg = p.z + ZS_KD + ((size_t)bh * 2048) * 128 + tid * 8;
    const bf16_t* Vg = p.vT + VS_VD + ((size_t)bh * 32) * 8192 + tid * 8;
    const int kr_ = tid >> 4, kc_ = tid & 15, vr_ = tid >> 3, vc_ = tid & 7;
    constexpr int NT = SEQ / 128;
    auto tile_of = [&](int i) { return (i < NT - qb) ? (qb + i) : (NT - 1 - i); };
    u32x4 rk[4], rv[4];
    {
        const int t0 = tile_of(0);
#pragma unroll
        for (int j = 0; j < 4; ++j) { rk[j] = *(const u32x4*)(Kg + (size_t)t0 * 16384 + j * 4096); rv[j] = *(const u32x4*)(Vg + (size_t)t0 * 16384 + j * 4096); }
    }
    __syncthreads();
#pragma unroll
    for (int j = 0; j < 4; ++j) {
        *(u32x4*)(lds + (kr_ + 32 * j) * DA_KP + kc_ * 16) = rk[j];
        *(u32x4*)(lds + DA_KBYTES + (j >> 1) * DA_VSUB + (vr_ + 64 * (j & 1)) * DA_VP + vc_ * 16) = rv[j];
    }
    __syncthreads();
    const int pr = (r & 0x13) | ((r & 4) << 1) | ((r & 8) >> 1);
    if (wid >= 4) __builtin_amdgcn_s_setprio(1);
    {
        const int it = 0; const int kt = qb;
        const char* cK = lds + (it & 1) * DA_STAGE;
        const char* cV = cK + DA_KBYTES;
        char* nK = lds + ((it + 1) & 1) * DA_STAGE;
        if (it + 1 < NT) {
            const int tn = tile_of(it + 1);
#pragma unroll
            for (int j = 0; j < 4; ++j) { rk[j] = *(const u32x4*)(Kg + (size_t)tn * 16384 + j * 4096); rv[j] = *(const u32x4*)(Vg + (size_t)tn * 16384 + j * 4096); }
        }
#pragma unroll
        for (int kb = 0; kb < 4; ++kb) {
            const int k0 = kt * 128 + kb * 32;
            f32x16 s; const float A = 0.f;
            const float kq = (float)k0 + qrel;
#pragma unroll
            for (int e = 0; e < 16; ++e) s[e] = 0.f;
#pragma unroll
            for (int t = 0; t < 4; ++t) {
                const bf16x8 kf = *(const bf16x8*)(cK + (kb * 32 + pr) * DA_KP + c * 128 + t * 32 + h2 * 16);
                s = __builtin_amdgcn_mfma_f32_32x32x16_bf16(kf, qf[t], s, 0, 0, 0);
            }
#pragma unroll
            for (int e = 0; e < 16; ++e) s[e] = fmaf(fabsf(kq + (float)(16 * (e >> 3) + (e & 7))), -slope2, s[e]);
            float mx = s[0];
#pragma unroll
            for (int e = 1; e < 16; ++e) mx = fmaxf(mx, s[e]);
            mx += A;
            mx = fmaxf(mx, __shfl_xor(mx, 32));
            if (!__all(mx <= mrow + 8.0f)) {
                const float mnew = fmaxf(mrow, mx);
                const float alpha = fast_exp2(mrow - mnew);
#pragma unroll
                for (int k = 0; k < 4; ++k) O[k] = O[k] * alpha;
                lrow *= alpha; mrow = mnew;
            }
            const float mm = mrow - A;
            float ps = 0.f;
#pragma unroll
            for (int e = 0; e < 16; ++e) { s[e] = fast_exp2(s[e] - mm); ps += s[e]; }
            lrow += ps;
            bf16x8 pb[2];
#pragma unroll
            for (int sp = 0; sp < 2; ++sp) {
                u32x4 w;
                w.x = cvt_pk_bf16(s[8 * sp + 0], s[8 * sp + 1]); w.y = cvt_pk_bf16(s[8 * sp + 2], s[8 * sp + 3]);
                w.z = cvt_pk_bf16(s[8 * sp + 4], s[8 * sp + 5]); w.w = cvt_pk_bf16(s[8 * sp + 6], s[8 * sp + 7]);
                pb[sp] = __builtin_bit_cast(bf16x8, w);
            }
#pragma unroll
            for (int sp = 0; sp < 2; ++sp)
#pragma unroll
                for (int k = 0; k < 4; ++k) {
                    const bf16x8 vf = *(const bf16x8*)(cV + (kb >> 1) * DA_VSUB + (32 * k + r) * DA_VP + (32 * (kb & 1) + 16 * sp + 8 * h2) * 2);
                    O[k] = __builtin_amdgcn_mfma_f32_32x32x16_bf16(vf, pb[sp], O[k], 0, 0, 0);
                }
        }

        if (it + 1 < NT) {
#pragma unroll
            for (int j = 0; j < 4; ++j) {
                *(u32x4*)(nK + (kr_ + 32 * j) * DA_KP + kc_ * 16) = rk[j];
                *(u32x4*)(nK + DA_KBYTES + (j >> 1) * DA_VSUB + (vr_ + 64 * (j & 1)) * DA_VP + vc_ * 16) = rv[j];
            }
        }
        __syncthreads();
    }
    for (int it = 1; it < NT - qb; ++it) {
        const int kt = tile_of(it);
        const char* cK = lds + (it & 1) * DA_STAGE;
        const char* cV = cK + DA_KBYTES;
        char* nK = lds + ((it + 1) & 1) * DA_STAGE;
        const int tn = tile_of(it + 1 < NT ? it + 1 : it);
        if (it + 1 < NT) {
#pragma unroll
            for (int j = 0; j < 4; ++j) rk[j] = *(const u32x4*)(Kg + (size_t)tn * 16384 + j * 4096);
        }
#define DA_FAST_HALF(BSEL, SGN, hf) \
            { \
                f32x16 s0, s1; \
                { const bf16x8 kf0 = *(const bf16x8*)(cK + (hf * 64 + pr) * DA_KP + c * 128 + h2 * 16); \
                  const bf16x8 kf1 = *(const bf16x8*)(cK + (hf * 64 + 32 + pr) * DA_KP + c * 128 + h2 * 16); \
                  s0 = __builtin_amdgcn_mfma_f32_32x32x16_bf16(kf0, qf[0], BSEL, 0, 0, 0); \
                  s1 = __builtin_amdgcn_mfma_f32_32x32x16_bf16(kf1, qf[0], BSEL, 0, 0, 0); } \
                _Pragma("unroll") \
                for (int t = 1; t < 4; ++t) { \
                    const bf16x8 kf0 = *(const bf16x8*)(cK + (hf * 64 + pr) * DA_KP + c * 128 + t * 32 + h2 * 16); \
                    const bf16x8 kf1 = *(const bf16x8*)(cK + (hf * 64 + 32 + pr) * DA_KP + c * 128 + t * 32 + h2 * 16); \
                    s0 = __builtin_amdgcn_mfma_f32_32x32x16_bf16(kf0, qf[t], s0, 0, 0, 0); \
                    s1 = __builtin_amdgcn_mfma_f32_32x32x16_bf16(kf1, qf[t], s1, 0, 0, 0); \
                } \
                const float A0 = (SGN) * ((float)(kt * 128 + hf * 64) + qrel), A1 = A0 + (SGN) * 32.0f; \
                const float mm0 = mrow - A0, mm1 = mrow - A1; \
                float ps0 = 0.f, ps1 = 0.f; \
                _Pragma("unroll") \
                for (int e = 0; e < 16; ++e) { s0[e] = fast_exp2(s0[e] - mm0); ps0 += s0[e]; } \
                bf16x8 pb0[2], pb1[2]; \
                _Pragma("unroll") \
                for (int sp = 0; sp < 2; ++sp) { \
                    u32x4 w; \
                    w.x = cvt_pk_bf16(s0[8 * sp + 0], s0[8 * sp + 1]); w.y = cvt_pk_bf16(s0[8 * sp + 2], s0[8 * sp + 3]); \
                    w.z = cvt_pk_bf16(s0[8 * sp + 4], s0[8 * sp + 5]); w.w = cvt_pk_bf16(s0[8 * sp + 6], s0[8 * sp + 7]); \
                    pb0[sp] = __builtin_bit_cast(bf16x8, w); \
                } \
                _Pragma("unroll") \
                for (int sp = 0; sp < 2; ++sp) \
                    _Pragma("unroll") \
                    for (int k = 0; k < 4; ++k) { \
                        const bf16x8 vf0 = *(const bf16x8*)(cV + hf * DA_VSUB + (32 * k + r) * DA_VP + (16 * sp + 8 * h2) * 2); \
                        O[k] = __builtin_amdgcn_mfma_f32_32x32x16_bf16(vf0, pb0[sp], O[k], 0, 0, 0); \
                    } \
                _Pragma("unroll") \
                for (int e = 0; e < 16; ++e) { s1[e] = fast_exp2(s1[e] - mm1); ps1 += s1[e]; } \
                lrow += ps0 + ps1; \
                _Pragma("unroll") \
                for (int sp = 0; sp < 2; ++sp) { \
                    u32x4 w; \
                    w.x = cvt_pk_bf16(s1[8 * sp + 0], s1[8 * sp + 1]); w.y = cvt_pk_bf16(s1[8 * sp + 2], s1[8 * sp + 3]); \
                    w.z = cvt_pk_bf16(s1[8 * sp + 4], s1[8 * sp + 5]); w.w = cvt_pk_bf16(s1[8 * sp + 6], s1[8 * sp + 7]); \
                    pb1[sp] = __builtin_bit_cast(bf16x8, w); \
                } \
                _Pragma("unroll") \
                for (int sp = 0; sp < 2; ++sp) \
                    _Pragma("unroll") \
                    for (int k = 0; k < 4; ++k) { \
                        const bf16x8 vf1 = *(const bf16x8*)(cV + hf * DA_VSUB + (32 * k + r) * DA_VP + (32 + 16 * sp + 8 * h2) * 2); \
                        O[k] = __builtin_amdgcn_mfma_f32_32x32x16_bf16(vf1, pb1[sp], O[k], 0, 0, 0); \
                    } \
            }
        DA_FAST_HALF(Bs, -slope2, 0)
        if (it + 1 < NT) {
#pragma unroll
            for (int j = 0; j < 4; ++j) *(u32x4*)(nK + (kr_ + 32 * j) * DA_KP + kc_ * 16) = rk[j];
#pragma unroll
            for (int j = 0; j < 4; ++j) rk[j] = *(const u32x4*)(Vg + (size_t)tn * 16384 + j * 4096);
        }
        DA_FAST_HALF(Bs, -slope2, 1)
#undef DA_FAST_HALF
        if (it + 1 < NT) {
#pragma unroll
            for (int j = 0; j < 4; ++j) *(u32x4*)(nK + DA_KBYTES + (j >> 1) * DA_VSUB + (vr_ + 64 * (j & 1)) * DA_VP + vc_ * 16) = rk[j];
        }
        __syncthreads();
    }
#pragma unroll
    for (int e = 0; e < 16; ++e) Bs[e] = -Bs[e];
    for (int it = NT - qb; it < NT; ++it) {
        const int kt = tile_of(it);
        const char* cK = lds + (it & 1) * DA_STAGE;
        const char* cV = cK + DA_KBYTES;
        char* nK = lds + ((it + 1) & 1) * DA_STAGE;
        const int tn = tile_of(it + 1 < NT ? it + 1 : it);
        if (it + 1 < NT) {
#pragma unroll
            for (int j = 0; j < 4; ++j) rk[j] = *(const u32x4*)(Kg + (size_t)tn * 16384 + j * 4096);
        }
#define DA_FAST_HALF(BSEL, SGN, hf) \
            { \
                f32x16 s0, s1; \
                { const bf16x8 kf0 = *(const bf16x8*)(cK + (hf * 64 + pr) * DA_KP + c * 128 + h2 * 16); \
                  const bf16x8 kf1 = *(const bf16x8*)(cK + (hf * 64 + 32 + pr) * DA_KP + c * 128 + h2 * 16); \
                  s0 = __builtin_amdgcn_mfma_f32_32x32x16_bf16(kf0, qf[0], BSEL, 0, 0, 0); \
                  s1 = __builtin_amdgcn_mfma_f32_32x32x16_bf16(kf1, qf[0], BSEL, 0, 0, 0); } \
                _Pragma("unroll") \
                for (int t = 1; t < 4; ++t) { \
                    const bf16x8 kf0 = *(const bf16x8*)(cK + (hf * 64 + pr) * DA_KP + c * 128 + t * 32 + h2 * 16); \
                    const bf16x8 kf1 = *(const bf16x8*)(cK + (hf * 64 + 32 + pr) * DA_KP + c * 128 + t * 32 + h2 * 16); \
                    s0 = __builtin_amdgcn_mfma_f32_32x32x16_bf16(kf0, qf[t], s0, 0, 0, 0); \
                    s1 = __builtin_amdgcn_mfma_f32_32x32x16_bf16(kf1, qf[t], s1, 0, 0, 0); \
                } \
                const float A0 = (SGN) * ((float)(kt * 128 + hf * 64) + qrel), A1 = A0 + (SGN) * 32.0f; \
                const float mm0 = mrow - A0, mm1 = mrow - A1; \
                float ps0 = 0.f, ps1 = 0.f; \
                _Pragma("unroll") \
                for (int e = 0; e < 16; ++e) { s0[e] = fast_exp2(s0[e] - mm0); ps0 += s0[e]; } \
                bf16x8 pb0[2], pb1[2]; \
                _Pragma("unroll") \
                for (int sp = 0; sp < 2; ++sp) { \
                    u32x4 w; \
                    w.x = cvt_pk_bf16(s0[8 * sp + 0], s0[8 * sp + 1]); w.y = cvt_pk_bf16(s0[8 * sp + 2], s0[8 * sp + 3]); \
                    w.z = cvt_pk_bf16(s0[8 * sp + 4], s0[8 * sp + 5]); w.w = cvt_pk_bf16(s0[8 * sp + 6], s0[8 * sp + 7]); \
                    pb0[sp] = __builtin_bit_cast(bf16x8, w); \
                } \
                _Pragma("unroll") \
                for (int sp = 0; sp < 2; ++sp) \
                    _Pragma("unroll") \
                    for (int k = 0; k < 4; ++k) { \
                        const bf16x8 vf0 = *(const bf16x8*)(cV + hf * DA_VSUB + (32 * k + r) * DA_VP + (16 * sp + 8 * h2) * 2); \
                        O[k] = __builtin_amdgcn_mfma_f32_32x32x16_bf16(vf0, pb0[sp], O[k], 0, 0, 0); \
                    } \
                _Pragma("unroll") \
                for (int e = 0; e < 16; ++e) { s1[e] = fast_exp2(s1[e] - mm1); ps1 += s1[e]; } \
                lrow += ps0 + ps1; \
                _Pragma("unroll") \
                for (int sp = 0; sp < 2; ++sp) { \
                    u32x4 w; \
                    w.x = cvt_pk_bf16(s1[8 * sp + 0], s1[8 * sp + 1]); w.y = cvt_pk_bf16(s1[8 * sp + 2], s1[8 * sp + 3]); \
                    w.z = cvt_pk_bf16(s1[8 * sp + 4], s1[8 * sp + 5]); w.w = cvt_pk_bf16(s1[8 * sp + 6], s1[8 * sp + 7]); \
                    pb1[sp] = __builtin_bit_cast(bf16x8, w); \
                } \
                _Pragma("unroll") \
                for (int sp = 0; sp < 2; ++sp) \
                    _Pragma("unroll") \
                    for (int k = 0; k < 4; ++k) { \
                        const bf16x8 vf1 = *(const bf16x8*)(cV + hf * DA_VSUB + (32 * k + r) * DA_VP + (32 + 16 * sp + 8 * h2) * 2); \
                        O[k] = __builtin_amdgcn_mfma_f32_32x32x16_bf16(vf1, pb1[sp], O[k], 0, 0, 0); \
                    } \
            }
        DA_FAST_HALF(Bs, slope2, 0)
        if (it + 1 < NT) {
#pragma unroll
            for (int j = 0; j < 4; ++j) *(u32x4*)(nK + (kr_ + 32 * j) * DA_KP + kc_ * 16) = rk[j];
#pragma unroll
            for (int j = 0; j < 4; ++j) rk[j] = *(const u32x4*)(Vg + (size_t)tn * 16384 + j * 4096);
        }
        DA_FAST_HALF(Bs, slope2, 1)
#undef DA_FAST_HALF
        if (it + 1 < NT) {
#pragma unroll
            for (int j = 0; j < 4; ++j) *(u32x4*)(nK + DA_KBYTES + (j >> 1) * DA_VSUB + (vr_ + 64 * (j & 1)) * DA_VP + vc_ * 16) = rk[j];
        }
        __syncthreads();
    }
    __builtin_amdgcn_s_setprio(0);
    {
        const float lchk = lrow + __shfl_xor(lrow, 32);
        const int bad = !(lchk < 1e30f);
        volatile unsigned* bflag = (volatile unsigned*)(lds + LDS_PHASE_BYTES + 8);
        if (tid == 0) *bflag = 0u;
        __syncthreads();
        if (__any(bad) && lane == 0) *bflag = 1u;
        __syncthreads();
        if (*bflag != 0u) {
#pragma unroll
            for (int k = 0; k < 4; ++k)
#pragma unroll
                for (int e = 0; e < 16; ++e) O[k][e] = 0.f;
            mrow = -1e30f; lrow = 0.f;
            {
                const int t0 = tile_of(0);
#pragma unroll
                for (int j = 0; j < 4; ++j) { rk[j] = *(const u32x4*)(Kg + (size_t)t0 * 16384 + j * 4096); rv[j] = *(const u32x4*)(Vg + (size_t)t0 * 16384 + j * 4096); }
            }
#pragma unroll
            for (int j = 0; j < 4; ++j) {
                *(u32x4*)(lds + (kr_ + 32 * j) * DA_KP + kc_ * 16) = rk[j];
                *(u32x4*)(lds + DA_KBYTES + (j >> 1) * DA_VSUB + (vr_ + 64 * (j & 1)) * DA_VP + vc_ * 16) = rv[j];
            }
            __syncthreads();
        for (int it = 0; it < NT; ++it) {
            const int kt = tile_of(it);
        const char* cK = lds + (it & 1) * DA_STAGE;
        const char* cV = cK + DA_KBYTES;
        char* nK = lds + ((it + 1) & 1) * DA_STAGE;
        if (it + 1 < NT) {
            const int tn = tile_of(it + 1);
#pragma unroll
            for (int j = 0; j < 4; ++j) { rk[j] = *(const u32x4*)(Kg + (size_t)tn * 16384 + j * 4096); rv[j] = *(const u32x4*)(Vg + (size_t)tn * 16384 + j * 4096); }
        }
#pragma unroll
        for (int kb = 0; kb < 4; ++kb) {
            const int k0 = kt * 128 + kb * 32;
            f32x16 s; const float A = 0.f;
            const float kq = (float)k0 + qrel;
#pragma unroll
            for (int e = 0; e < 16; ++e) s[e] = 0.f;
#pragma unroll
            for (int t = 0; t < 4; ++t) {
                const bf16x8 kf = *(const bf16x8*)(cK + (kb * 32 + pr) * DA_KP + c * 128 + t * 32 + h2 * 16);
                s = __builtin_amdgcn_mfma_f32_32x32x16_bf16(kf, qf[t], s, 0, 0, 0);
            }
#pragma unroll
            for (int e = 0; e < 16; ++e) s[e] = fmaf(fabsf(kq + (float)(16 * (e >> 3) + (e & 7))), -slope2, s[e]);
            float mx = s[0];
#pragma unroll
            for (int e = 1; e < 16; ++e) mx = fmaxf(mx, s[e]);
            mx += A;
            mx = fmaxf(mx, __shfl_xor(mx, 32));
            if (!__all(mx <= mrow + 8.0f)) {
                const float mnew = fmaxf(mrow, mx);
                const float alpha = fast_exp2(mrow - mnew);
#pragma unroll
                for (int k = 0; k < 4; ++k) O[k] = O[k] * alpha;
                lrow *= alpha; mrow = mnew;
            }
            const float mm = mrow - A;
            float ps = 0.f;
#pragma unroll
            for (int e = 0; e < 16; ++e) { s[e] = fast_exp2(s[e] - mm); ps += s[e]; }
            lrow += ps;
            bf16x8 pb[2];
#pragma unroll
            for (int sp = 0; sp < 2; ++sp) {
                u32x4 w;
                w.x = cvt_pk_bf16(s[8 * sp + 0], s[8 * sp + 1]); w.y = cvt_pk_bf16(s[8 * sp + 2], s[8 * sp + 3]);
                w.z = cvt_pk_bf16(s[8 * sp + 4], s[8 * sp + 5]); w.w = cvt_pk_bf16(s[8 * sp + 6], s[8 * sp + 7]);
                pb[sp] = __builtin_bit_cast(bf16x8, w);
            }
#pragma unroll
            for (int sp = 0; sp < 2; ++sp)
#pragma unroll
                for (int k = 0; k < 4; ++k) {
                    const bf16x8 vf = *(const bf16x8*)(cV + (kb >> 1) * DA_VSUB + (32 * k + r) * DA_VP + (32 * (kb & 1) + 16 * sp + 8 * h2) * 2);
                    O[k] = __builtin_amdgcn_mfma_f32_32x32x16_bf16(vf, pb[sp], O[k], 0, 0, 0);
                }
        }

        if (it + 1 < NT) {
#pragma unroll
            for (int j = 0; j < 4; ++j) {
                *(u32x4*)(nK + (kr_ + 32 * j) * DA_KP + kc_ * 16) = rk[j];
                *(u32x4*)(nK + DA_KBYTES + (j >> 1) * DA_VSUB + (vr_ + 64 * (j & 1)) * DA_VP + vc_ * 16) = rv[j];
            }
        }
        __syncthreads();
    }
        }
    }
    u32x2 gwv[16];
    if (c == 0) {
#pragma unroll
        for (int k = 0; k < 4; ++k)
#pragma unroll
            for (int g = 0; g < 4; ++g) gwv[k * 4 + g] = *(const u32x2*)(p.z + ZS_GATE + tokq * 1024 + h * 128 + 32 * k + 8 * g + 4 * h2);
    }
    const float lsum = lrow + __shfl_xor(lrow, 32);
    float* xch = (float*)lds + qg * 4096;
    if (c == 1) {
        const float i1 = lam / lsum;
#pragma unroll
        for (int k = 0; k < 4; ++k)
#pragma unroll
            for (int e = 0; e < 16; ++e) xch[(k * 16 + e) * 64 + lane] = O[k][e] * i1;
    }
    __syncthreads();
    if (c == 0) {
        const float i0 = 1.0f / lsum;
        float ss = 0.f;
#pragma unroll
        for (int k = 0; k < 4; ++k)
#pragma unroll
            for (int e = 0; e < 16; ++e) { const float a = O[k][e] * i0 - xch[(k * 16 + e) * 64 + lane]; O[k][e] = a; ss += a * a; }
        ss += __shfl_xor(ss, 32);
        const float rstd = rsqrtf(ss * (1.0f / 128.0f) + RMS_EPS) * (1.0f - p.lam_init[layer]);
        const float* sg = (const float*)(lds + LDS_SG_OFF);
        __builtin_amdgcn_sched_barrier(0);
#pragma unroll
        for (int k = 0; k < 4; ++k)
#pragma unroll
            for (int g = 0; g < 4; ++g) {
                const int d0 = 32 * k + 8 * g + 4 * h2;
                const f32x4 gg = *(const f32x4*)(sg + d0);
                const u32x2 gw = gwv[k * 4 + g];
                const float o0 = O[k][4 * g + 0] * rstd * gg[0] * silu_f(bflo(gw.x));
                const float o1 = O[k][4 * g + 1] * rstd * gg[1] * silu_f(bfhi(gw.x));
                const float o2 = O[k][4 * g + 2] * rstd * gg[2] * silu_f(bflo(gw.y));
                const float o3 = O[k][4 * g + 3] * rstd * gg[3] * silu_f(bfhi(gw.y));
                u32x2 w; w.x = cvt_pk_bf16(o0, o1); w.y = cvt_pk_bf16(o2, o3);
                *(u32x2*)(p.o + tokq * 1024 + h * 128 + d0) = w;
            }
    }
}

__device__ void na_unit(char* lds, const Params& p, int layer, int unit) {
    int tid_ = threadIdx.x; asm volatile("" : "+v"(tid_)); const int tid = tid_, lane = tid & 63, wid = __builtin_amdgcn_readfirstlane(tid >> 6), fr = lane & 15, fq = lane >> 4;
    const int hp = unit & 3, rr0 = (unit >> 2) & 31, b = unit >> 7;
    const int h = 2 * hp + (wid >> 2), n = wid & 3;
    const float* rph = (const float*)(lds + LDS_RPB_OFF) + h * 465;
    const int r = rr0;
    const int rs = min(max(r - 4, 0), 24);
    const int kcstart = min(max(16 * n - 8, 0), 32);
    const int qcol = 16 * n + fr;
    const int qcstart = min(max(qcol - 8, 0), 48);
    const size_t tokq = (size_t)b * SEQ + r * 64 + qcol;
    bf16x8 qf[2];
#pragma unroll
    for (int t = 0; t < 2; ++t) qf[t] = *(const bf16x8*)(p.z + ZS_QN + ((size_t)((b * 8 + h) * 2048 + r * 64 + qcol)) * 64 + t * 32 + fq * 8);
    bf16x8 kfr[8][4];
    {
        const int kc = kcstart + 8 * (fr >> 2) + (fr & 3);
        const bf16_t* kg0 = p.z + ZS_KN + ((size_t)((b * 8 + h) * 2048 + rs * 64 + kc)) * 64 + fq * 8;
#pragma unroll
        for (int rr = 0; rr < 8; ++rr)
#pragma unroll
            for (int T = 0; T < 2; ++T) {
                const bf16_t* kg = kg0 + (size_t)(rr * 64 + 4 * T) * 64;
                kfr[rr][2 * T] = *(const bf16x8*)(kg); kfr[rr][2 * T + 1] = *(const bf16x8*)(kg + 32);
            }
    }
    __builtin_amdgcn_sched_barrier(0);
    const float c1 = 0.125f * LOG2E;
    float sc[8][8];
    float mx = -1e30f;
#pragma unroll
    for (int rr = 0; rr < 8; ++rr) {
#pragma unroll
        for (int T = 0; T < 2; ++T) {
            f32x4 s = (f32x4){0.f, 0.f, 0.f, 0.f};
            s = __builtin_amdgcn_mfma_f32_16x16x32_bf16(kfr[rr][2 * T], qf[0], s, 0, 0, 0);
            s = __builtin_amdgcn_mfma_f32_16x16x32_bf16(kfr[rr][2 * T + 1], qf[1], s, 0, 0, 0);
            const int dr = rs + rr - r + 7;
#pragma unroll
            for (int e = 0; e < 4; ++e) {
                const int kcol = kcstart + 8 * fq + e + 4 * T;
                const bool valid = (kcol >= qcstart) && (kcol < qcstart + 16);
                const int dc = min(max(kcol - qcol, -15), 15) + 15;
                const float bias = rph[dr * 31 + dc];
                const float v = valid ? fmaf(s[e], c1, bias) : -1e30f;
                sc[rr][4 * T + e] = v;
                mx = fmaxf(mx, v);
            }
        }
    }
    __builtin_amdgcn_sched_barrier(0);
    bf16x8 vfr[4][8];
    {
        const bf16_t* vg0 = p.vT + VS_VN + ((size_t)(((b * 8 + h) * 32 + rs) * 64 + fr)) * 64 + kcstart + 8 * fq;
#pragma unroll
        for (int dt = 0; dt < 4; ++dt)
#pragma unroll
            for (int rr = 0; rr < 8; ++rr) vfr[dt][rr] = *(const bf16x8*)(vg0 + (size_t)(rr * 64 + 16 * dt) * 64);
    }
    mx = fmaxf(mx, __shfl_xor(mx, 16)); mx = fmaxf(mx, __shfl_xor(mx, 32));
    float l = 0.f;
    bf16x8 pb[8];
#pragma unroll
    for (int rr = 0; rr < 8; ++rr) {
#pragma unroll
        for (int e = 0; e < 8; ++e) { sc[rr][e] = fast_exp2(sc[rr][e] - mx); l += sc[rr][e]; }
        u32x4 w;
        w.x = cvt_pk_bf16(sc[rr][0], sc[rr][1]); w.y = cvt_pk_bf16(sc[rr][2], sc[rr][3]);
        w.z = cvt_pk_bf16(sc[rr][4], sc[rr][5]); w.w = cvt_pk_bf16(sc[rr][6], sc[rr][7]);
        pb[rr] = __builtin_bit_cast(bf16x8, w);
    }
    l += __shfl_xor(l, 16); l += __shfl_xor(l, 32);
    const float il = 1.0f / l;
    f32x4 O[4];
#pragma unroll
    for (int dt = 0; dt < 4; ++dt) {
        O[dt] = (f32x4){0.f, 0.f, 0.f, 0.f};
#pragma unroll
        for (int rr = 0; rr < 8; ++rr) O[dt] = __builtin_amdgcn_mfma_f32_16x16x32_bf16(vfr[dt][rr], pb[rr], O[dt], 0, 0, 0);
    }
#pragma unroll
    for (int dt = 0; dt < 4; ++dt) {
        const int d0 = 16 * dt + 4 * fq;
        const u32x2 gw = *(const u32x2*)(p.z + ZS_GATE + tokq * 1024 + 512 + h * 64 + d0);
        const float o0 = O[dt][0] * il * silu_f(bflo(gw.x)), o1 = O[dt][1] * il * silu_f(bfhi(gw.x));
        const float o2 = O[dt][2] * il * silu_f(bflo(gw.y)), o3 = O[dt][3] * il * silu_f(bfhi(gw.y));
        u32x2 w; w.x = cvt_pk_bf16(o0, o1); w.y = cvt_pk_bf16(o2, o3);
        *(u32x2*)(p.o + tokq * 1024 + 512 + h * 64 + d0) = w;
    }
}


constexpr int NA_P = 144, NA_KBYTES = 128 * NA_P, NA_STAGE = 2 * NA_KBYTES;

__device__ void na_super_online(char* lds, const Params& p, int layer, int su) {
    int tid_ = threadIdx.x; asm volatile("" : "+v"(tid_)); const int tid = tid_, lane = tid & 63, wid = __builtin_amdgcn_readfirstlane(tid >> 6), fr = lane & 15, fq = lane >> 4;
    const int bh = (su & 7) * 8 + (su >> 5), g = (su >> 3) & 3, b = bh >> 3, h = bh & 7;
    const float* rph = (const float*)(lds + LDS_RPB_OFF) + h * 465;
    const float c1 = 0.125f * LOG2E;
    const int rq = 8 * g + wid, rsw = min(max(rq - 4, 0), 24);
    bf16x8 qf[4][2];
    f32x4 O[4][4];
    float mrow[4], lrow[4];
#pragma unroll
    for (int n = 0; n < 4; ++n) {
#pragma unroll
        for (int t = 0; t < 2; ++t) qf[n][t] = *(const bf16x8*)(p.z + ZS_QN + ((size_t)(bh * 2048 + rq * 64 + 16 * n + fr)) * 64 + t * 32 + fq * 8);
#pragma unroll
        for (int dt = 0; dt < 4; ++dt) O[n][dt] = (f32x4){0.f, 0.f, 0.f, 0.f};
        mrow[n] = -1e30f; lrow[n] = 0.f;
    }
    const int klo = min(max(8 * g - 4, 0), 24);
    const int nsteps = (g == 0 || g == 3) ? 6 : 8;
    const bf16_t* Kg = p.z + ZS_KN + ((size_t)(bh * 2048 + klo * 64)) * 64 + tid * 8;
    const bf16_t* Vg = p.vT + VS_VN + ((size_t)((bh * 32 + klo) * 64)) * 64 + tid * 8;
    const int lw = (tid >> 3) * NA_P + (tid & 7) * 16;
    u32x4 rk[2], rv[2];
    rk[0] = *(const u32x4*)(Kg); rk[1] = *(const u32x4*)(Kg + 4096);
    rv[0] = *(const u32x4*)(Vg); rv[1] = *(const u32x4*)(Vg + 4096);
    __syncthreads();
    *(u32x4*)(lds + lw) = rk[0]; *(u32x4*)(lds + lw + 64 * NA_P) = rk[1];
    *(u32x4*)(lds + NA_KBYTES + lw) = rv[0]; *(u32x4*)(lds + NA_KBYTES + lw + 64 * NA_P) = rv[1];
    __syncthreads();
    const int krow_off = (8 * (fr >> 2) + (fr & 3)) * NA_P + fq * 16;
    const int vrow_off = fr * NA_P + (8 * fq) * 2;
    for (int st = 0; st < nsteps; ++st) {
        const char* cur = lds + (st & 1) * NA_STAGE;
        char* nxt = lds + ((st + 1) & 1) * NA_STAGE;
        if (st + 1 < nsteps) {
            const bf16_t* kg = Kg + (size_t)(st + 1) * 8192; const bf16_t* vg = Vg + (size_t)(st + 1) * 8192;
            rk[0] = *(const u32x4*)(kg); rk[1] = *(const u32x4*)(kg + 4096);
            rv[0] = *(const u32x4*)(vg); rv[1] = *(const u32x4*)(vg + 4096);
        }
#pragma unroll 1
        for (int slot = 0; slot < 2; ++slot) {
            const int kr = klo + 2 * st + slot;
            if (kr >= rsw && kr <= rsw + 7) {
                const char* cK = cur + slot * 64 * NA_P + krow_off;
                const char* cV = cur + NA_KBYTES + slot * 64 * NA_P + vrow_off;
                const float* rpr = rph + (kr - rq + 7) * 31;
                float v[4][8], mx[4];
#pragma unroll
                for (int n = 0; n < 4; ++n) {
                    const int kcstart = n == 0 ? 0 : (n == 1 ? 8 : (n == 2 ? 24 : 32));
                    const int qcol = 16 * n + fr;
                    const int qcstart = min(max(qcol - 8, 0), 48);
                    float bias[8];
#pragma unroll
                    for (int e = 0; e < 8; ++e) bias[e] = rpr[min(max(kcstart + 8 * fq + e - qcol, -15), 15) + 15];
#pragma unroll
                    for (int e = 0; e < 8; ++e) asm volatile("" : "+v"(bias[e]));
#pragma unroll
                    for (int T = 0; T < 2; ++T) {
                        const bf16x8 k0 = *(const bf16x8*)(cK + (kcstart + T * 4) * NA_P), k1 = *(const bf16x8*)(cK + (kcstart + T * 4) * NA_P + 64);
                        f32x4 s = (f32x4){0.f, 0.f, 0.f, 0.f};
                        s = __builtin_amdgcn_mfma_f32_16x16x32_bf16(k0, qf[n][0], s, 0, 0, 0);
                        s = __builtin_amdgcn_mfma_f32_16x16x32_bf16(k1, qf[n][1], s, 0, 0, 0);
#pragma unroll
                        for (int e = 0; e < 4; ++e) {
                            const int kcol = kcstart + 8 * fq + e + 4 * T;
                            const bool valid = (kcol >= qcstart) && (kcol < qcstart + 16);
                            v[n][4 * T + e] = valid ? fmaf(s[e], c1, bias[4 * T + e]) : -1e30f;
                        }
                    }
                    mx[n] = fmaxf(fmaxf(fmaxf(v[n][0], v[n][1]), fmaxf(v[n][2], v[n][3])), fmaxf(fmaxf(v[n][4], v[n][5]), fmaxf(v[n][6], v[n][7])));
                }
#pragma unroll
                for (int n = 0; n < 4; ++n) mx[n] = fmaxf(mx[n], __shfl_xor(mx[n], 16));
#pragma unroll
                for (int n = 0; n < 4; ++n) mx[n] = fmaxf(mx[n], __shfl_xor(mx[n], 32));
#pragma unroll
                for (int n = 0; n < 4; ++n) {
                    const int kcstart = n == 0 ? 0 : (n == 1 ? 8 : (n == 2 ? 24 : 32));
                    const float mnew = fmaxf(mrow[n], mx[n]);
                    const float alpha = fast_exp2(mrow[n] - mnew);
                    mrow[n] = mnew;
                    float ps = 0.f;
#pragma unroll
                    for (int e = 0; e < 8; ++e) { v[n][e] = fast_exp2(v[n][e] - mnew); ps += v[n][e]; }
                    lrow[n] = lrow[n] * alpha + ps;
                    u32x4 w;
                    w.x = cvt_pk_bf16(v[n][0], v[n][1]); w.y = cvt_pk_bf16(v[n][2], v[n][3]); w.z = cvt_pk_bf16(v[n][4], v[n][5]); w.w = cvt_pk_bf16(v[n][6], v[n][7]);
                    const bf16x8 pb = __builtin_bit_cast(bf16x8, w);
#pragma unroll
                    for (int dt = 0; dt < 4; ++dt) {
                        const bf16x8 vf = *(const bf16x8*)(cV + dt * 16 * NA_P + kcstart * 2);
                        O[n][dt] = __builtin_amdgcn_mfma_f32_16x16x32_bf16(vf, pb, O[n][dt] * alpha, 0, 0, 0);
                    }
                }
            }
        }
        if (st + 1 < nsteps) {
            *(u32x4*)(nxt + lw) = rk[0]; *(u32x4*)(nxt + lw + 64 * NA_P) = rk[1];
            *(u32x4*)(nxt + NA_KBYTES + lw) = rv[0]; *(u32x4*)(nxt + NA_KBYTES + lw + 64 * NA_P) = rv[1];
        }
        __syncthreads();
    }
    u32x2 gwv[4][4];
#pragma unroll
    for (int n = 0; n < 4; ++n)
#pragma unroll
        for (int dt = 0; dt < 4; ++dt) gwv[n][dt] = *(const u32x2*)(p.z + ZS_GATE + ((size_t)b * SEQ + rq * 64 + 16 * n + fr) * 1024 + 512 + h * 64 + 16 * dt + 4 * fq);
    __builtin_amdgcn_sched_barrier(0);
#pragma unroll
    for (int n = 0; n < 4; ++n) {
        float l = lrow[n];
        l += __shfl_xor(l, 16); l += __shfl_xor(l, 32);
        const float il = 1.0f / l;
        const size_t tokq = (size_t)b * SEQ + rq * 64 + 16 * n + fr;
#pragma unroll
        for (int dt = 0; dt < 4; ++dt) {
            const int d0 = 16 * dt + 4 * fq;
            const u32x2 gw = gwv[n][dt];
            const float o0 = O[n][dt][0] * il * silu_f(bflo(gw.x)), o1 = O[n][dt][1] * il * silu_f(bfhi(gw.x));
            const float o2 = O[n][dt][2] * il * silu_f(bflo(gw.y)), o3 = O[n][dt][3] * il * silu_f(bfhi(gw.y));
            u32x2 w; w.x = cvt_pk_bf16(o0, o1); w.y = cvt_pk_bf16(o2, o3);
            *(u32x2*)(p.o + tokq * 1024 + 512 + h * 64 + d0) = w;
        }
    }
}

__device__ void na_super(char* lds, const Params& p, int layer, int su) {
    int tid_ = threadIdx.x; asm volatile("" : "+v"(tid_)); const int tid = tid_, lane = tid & 63, wid = __builtin_amdgcn_readfirstlane(tid >> 6), fr = lane & 15, fq = lane >> 4;
    const int bh = (su & 7) * 8 + (su >> 5), g = (su >> 3) & 3, b = bh >> 3, h = bh & 7;
    const float* rph = (const float*)(lds + LDS_RPB_OFF) + h * 465;
    const float c1 = 0.125f * LOG2E;
    const int rq = 8 * g + wid, rsw = min(max(rq - 4, 0), 24);
    bf16x8 qf[4][2];
    f32x4 O[4][4];
    float mrow[4], lrow[4];
#pragma unroll
    for (int n = 0; n < 4; ++n) {
#pragma unroll
        for (int t = 0; t < 2; ++t) qf[n][t] = *(const bf16x8*)(p.z + ZS_QN + ((size_t)(bh * 2048 + rq * 64 + 16 * n + fr)) * 64 + t * 32 + fq * 8);
#pragma unroll
        for (int dt = 0; dt < 4; ++dt) O[n][dt] = (f32x4){0.f, 0.f, 0.f, 0.f};
        lrow[n] = 0.f;
        {
            const u32x4 k0 = *(const u32x4*)(p.z + ZS_KN + ((size_t)(bh * 2048 + rq * 64 + 16 * n + fr)) * 64 + fq * 8);
            const u32x4 k1 = *(const u32x4*)(p.z + ZS_KN + ((size_t)(bh * 2048 + rq * 64 + 16 * n + fr)) * 64 + 32 + fq * 8);
            const u32x4 q0 = __builtin_bit_cast(u32x4, qf[n][0]), q1 = __builtin_bit_cast(u32x4, qf[n][1]);
            float d = 0.f;
#pragma unroll
            for (int w = 0; w < 4; ++w) { d += bflo(q0[w]) * bflo(k0[w]) + bfhi(q0[w]) * bfhi(k0[w]); d += bflo(q1[w]) * bflo(k1[w]) + bfhi(q1[w]) * bfhi(k1[w]); }
            d += __shfl_xor(d, 16); d += __shfl_xor(d, 32);
            mrow[n] = -d;
        }
    }
    const int klo = min(max(8 * g - 4, 0), 24);
    const int nsteps = (g == 0 || g == 3) ? 6 : 8;
    const bf16_t* Kg = p.z + ZS_KN + ((size_t)(bh * 2048 + klo * 64)) * 64 + tid * 8;
    const bf16_t* Vg = p.vT + VS_VN + ((size_t)((bh * 32 + klo) * 64)) * 64 + tid * 8;
    const int lw = (tid >> 3) * NA_P + (tid & 7) * 16;
    u32x4 rk[2], rv[2];
    rk[0] = *(const u32x4*)(Kg); rk[1] = *(const u32x4*)(Kg + 4096);
    rv[0] = *(const u32x4*)(Vg); rv[1] = *(const u32x4*)(Vg + 4096);
    __syncthreads();
    *(u32x4*)(lds + lw) = rk[0]; *(u32x4*)(lds + lw + 64 * NA_P) = rk[1];
    *(u32x4*)(lds + NA_KBYTES + lw) = rv[0]; *(u32x4*)(lds + NA_KBYTES + lw + 64 * NA_P) = rv[1];
    __syncthreads();
    const int krow_off = (8 * (fr >> 2) + (fr & 3)) * NA_P + fq * 16;
    const int vrow_off = fr * NA_P + (8 * fq) * 2;
    for (int st = 0; st < nsteps; ++st) {
        const char* cur = lds + (st & 1) * NA_STAGE;
        char* nxt = lds + ((st + 1) & 1) * NA_STAGE;
        if (st + 1 < nsteps) {
            const bf16_t* kg = Kg + (size_t)(st + 1) * 8192; const bf16_t* vg = Vg + (size_t)(st + 1) * 8192;
            rk[0] = *(const u32x4*)(kg); rk[1] = *(const u32x4*)(kg + 4096);
            rv[0] = *(const u32x4*)(vg); rv[1] = *(const u32x4*)(vg + 4096);
        }
#pragma unroll 1
        for (int slot = 0; slot < 2; ++slot) {
            const int kr = klo + 2 * st + slot;
            if (kr >= rsw && kr <= rsw + 7) {
                const char* cK = cur + slot * 64 * NA_P + krow_off;
                const char* cV = cur + NA_KBYTES + slot * 64 * NA_P + vrow_off;
                const float* rpr = rph + (kr - rq + 7) * 31;
                float v[4][8];
#pragma unroll
                for (int n = 0; n < 4; ++n) {
                    const int kcstart = n == 0 ? 0 : (n == 1 ? 8 : (n == 2 ? 24 : 32));
                    const int qcol = 16 * n + fr;
                    const float* bp = rpr + (kcstart + 8 * fq - qcol + 15);
#pragma unroll
                    for (int e = 0; e < 8; ++e) v[n][e] = bp[e];
                }
#pragma unroll
                for (int np = 0; np < 2; ++np) {
                    bf16x8 kfr[2][4];
#pragma unroll
                    for (int q = 0; q < 2; ++q) {
                        const int n = 2 * np + q;
                        const int kcstart = n == 0 ? 0 : (n == 1 ? 8 : (n == 2 ? 24 : 32));
#pragma unroll
                        for (int T = 0; T < 2; ++T) { kfr[q][2 * T] = *(const bf16x8*)(cK + (kcstart + T * 4) * NA_P); kfr[q][2 * T + 1] = *(const bf16x8*)(cK + (kcstart + T * 4) * NA_P + 64); }
                    }
#pragma unroll
                    for (int q = 0; q < 2; ++q) {
                        const int n = 2 * np + q;
                        const int kcstart = n == 0 ? 0 : (n == 1 ? 8 : (n == 2 ? 24 : 32));
                        const int qcol = 16 * n + fr;
                        const int qcstart = min(max(qcol - 8, 0), 48);
#pragma unroll
                        for (int T = 0; T < 2; ++T) {
                            f32x4 s = (f32x4){mrow[n], mrow[n], mrow[n], mrow[n]};
                            s = __builtin_amdgcn_mfma_f32_16x16x32_bf16(kfr[q][2 * T], qf[n][0], s, 0, 0, 0);
                            s = __builtin_amdgcn_mfma_f32_16x16x32_bf16(kfr[q][2 * T + 1], qf[n][1], s, 0, 0, 0);
#pragma unroll
                            for (int e = 0; e < 4; ++e) {
                                const int kcol = kcstart + 8 * fq + e + 4 * T;
                                const bool valid = (kcol >= qcstart) && (kcol < qcstart + 16);
                                v[n][4 * T + e] = valid ? fmaf(s[e], c1, v[n][4 * T + e]) : -1e30f;
                            }
                        }
                    }
                }
#pragma unroll
                for (int n = 0; n < 4; ++n) {
                    const int kcstart = n == 0 ? 0 : (n == 1 ? 8 : (n == 2 ? 24 : 32));
                    float ps = 0.f;
#pragma unroll
                    for (int e = 0; e < 8; ++e) { v[n][e] = fast_exp2(v[n][e]); ps += v[n][e]; }
                    lrow[n] += ps;
                    u32x4 w;
                    w.x = cvt_pk_bf16(v[n][0], v[n][1]); w.y = cvt_pk_bf16(v[n][2], v[n][3]); w.z = cvt_pk_bf16(v[n][4], v[n][5]); w.w = cvt_pk_bf16(v[n][6], v[n][7]);
                    const bf16x8 pb = __builtin_bit_cast(bf16x8, w);
#pragma unroll
                    for (int dt = 0; dt < 4; ++dt) {
                        const bf16x8 vf = *(const bf16x8*)(cV + dt * 16 * NA_P + kcstart * 2);
                        O[n][dt] = __builtin_amdgcn_mfma_f32_16x16x32_bf16(vf, pb, O[n][dt], 0, 0, 0);
                    }
                }
            }
        }
        if (st + 1 < nsteps) {
            *(u32x4*)(nxt + lw) = rk[0]; *(u32x4*)(nxt + lw + 64 * NA_P) = rk[1];
            *(u32x4*)(nxt + NA_KBYTES + lw) = rv[0]; *(u32x4*)(nxt + NA_KBYTES + lw + 64 * NA_P) = rv[1];
        }
        __syncthreads();
    }
    u32x2 gwv[4][4];
#pragma unroll
    for (int n = 0; n < 4; ++n)
#pragma unroll
        for (int dt = 0; dt < 4; ++dt) gwv[n][dt] = *(const u32x2*)(p.z + ZS_GATE + ((size_t)b * SEQ + rq * 64 + 16 * n + fr) * 1024 + 512 + h * 64 + 16 * dt + 4 * fq);
    __builtin_amdgcn_sched_barrier(0);
    int bad = 0;
#pragma unroll
    for (int n = 0; n < 4; ++n) { lrow[n] += __shfl_xor(lrow[n], 16); lrow[n] += __shfl_xor(lrow[n], 32); bad |= !(lrow[n] < 1e30f); }
    {
        volatile unsigned* bflag = (volatile unsigned*)(lds + LDS_PHASE_BYTES + 8);
        if (tid == 0) *bflag = 0u;
        __syncthreads();
        if (__any(bad) && lane == 0) *bflag = 1u;
        __syncthreads();
        if (*bflag != 0u) { if (tid == 0) *(volatile unsigned*)(lds + LDS_PHASE_BYTES + 12) = 1u; return; }
    }
#pragma unroll
    for (int n = 0; n < 4; ++n) {
        const float l = lrow[n];
        const float il = 1.0f / l;
        const size_t tokq = (size_t)b * SEQ + rq * 64 + 16 * n + fr;
#pragma unroll
        for (int dt = 0; dt < 4; ++dt) {
            const int d0 = 16 * dt + 4 * fq;
            const u32x2 gw = gwv[n][dt];
            const float o0 = O[n][dt][0] * il * silu_f(bflo(gw.x)), o1 = O[n][dt][1] * il * silu_f(bfhi(gw.x));
            const float o2 = O[n][dt][2] * il * silu_f(bflo(gw.y)), o3 = O[n][dt][3] * il * silu_f(bfhi(gw.y));
            u32x2 w; w.x = cvt_pk_bf16(o0, o1); w.y = cvt_pk_bf16(o2, o3);
            *(u32x2*)(p.o + tokq * 1024 + 512 + h * 64 + d0) = w;
        }
    }
}

__global__ void __launch_bounds__(NTHREADS) fwd_megakernel(Params p) {
    extern __shared__ __attribute__((aligned(16))) char lds[];
    if (p.never) cg::this_grid().sync();
    volatile LAS unsigned* st = (volatile LAS unsigned*)(lds + LDS_PHASE_BYTES);
    if (threadIdx.x < 4) st[threadIdx.x] = 0u;
    __syncthreads();
    const XcdBarrier gb = xcd_barrier_post(p.bar, st);
    prologue_phase(lds, p);
    xcd_barrier(gb);
    for (int layer = 0; layer < DEPTH; ++layer) {
        for (int rep = 0; rep < REP_GEMM0; ++rep) {
        { pg8::Gemm g{p.xb, p.wi_t + (size_t)layer * 4096 * 1024, NTOK, IN_W, 1024}; pg8::StaticOrder S; S.init(NTOK, IN_W, (int)gridDim.x, (int)blockIdx.x);
          pg8::EpiZ E{p.z, p.vT, p.rss};
          pg8::gemm_phase<pg8::EpiZ, pg8::StaticOrder, true, true>((PG8_LAS unsigned char*)lds, g, S, E); }
        xcd_barrier(gb);
        }
        { int t0_ = threadIdx.x; asm volatile("" : "+v"(t0_));
          for (int i = t0_; i < 8 * 465; i += NTHREADS) ((float*)(lds + LDS_RPB_OFF))[i] = p.rpb[(size_t)layer * 8 * 465 + i] * LOG2E;
          if (t0_ < 128) ((float*)(lds + LDS_SG_OFF))[t0_] = p.subln_g[layer * 128 + t0_];
          if (t0_ == 0) *(volatile unsigned*)(lds + LDS_PHASE_BYTES + 12) = 0u; }
        __syncthreads();
        for (int rep = 0; rep < REP_ATT; ++rep) {
        for (int u = blockIdx.x; u < 512 + 256; u += gridDim.x) {
            if (u < 512) { if (rep < REP_DA) da_unit(lds, p, layer, u); } else { if (rep < REP_NA) na_super(lds, p, layer, u - 512); }
        }
        __syncthreads();
        if (*(volatile unsigned*)(lds + LDS_PHASE_BYTES + 12) != 0u) {
            for (int u = blockIdx.x; u < 512 + 256; u += gridDim.x) if (u >= 512) na_super_online(lds, p, layer, u - 512);
        }
        xcd_barrier(gb);
        }
        { pg8::Gemm g{p.o, p.wo_t + (size_t)layer * 1024 * 1024, NTOK, 1024, 1024}; pg8::StaticOrder S; S.init(NTOK, 1024, (int)gridDim.x, (int)blockIdx.x);
          if (layer == 0) { pg8::EpiRes2<0, 0> E{p.x, p.xb, p.xb, p.xf, p.rss};
            pg8::gemm_phase<pg8::EpiRes2<0, 0>, pg8::StaticOrder, true, true>((PG8_LAS unsigned char*)lds, g, S, E); }
          else if (layer + 1 < DEPTH) { pg8::EpiRes2<1, 0> E{p.x, p.xb, p.xb, p.xf, p.rss};
            pg8::gemm_phase<pg8::EpiRes2<1, 0>, pg8::StaticOrder, true, true>((PG8_LAS unsigned char*)lds, g, S, E); }
          else if (gridDim.x == 256) { pg8::EpiFinal E{p.xb, p.xf, p.final_g, p.rss, p.bar + XCD_BAR_WORDS};
            pg8::gemm_phase<pg8::EpiFinal, pg8::StaticOrder, false, true>((PG8_LAS unsigned char*)lds, g, S, E); return; }
          else { pg8::EpiRes2<1, 1> E{p.x, p.xb, p.xb, p.xf, p.rss};
            pg8::gemm_phase<pg8::EpiRes2<1, 1>, pg8::StaticOrder, true, true>((PG8_LAS unsigned char*)lds, g, S, E); } }
        xcd_barrier(gb);
    }
    final_phase(p);
}

constexpr size_t LDS_BYTES = LDS_RPB_OFF + LDS_RPB_BYTES;

extern "C" void kernel_launch(void* const* d_in, const int* in_sizes, int n_in, void* d_out, int out_size, void* d_ws, size_t ws_size, hipStream_t stream) {
    static int grid_blocks = 0;
    if (!grid_blocks) {
        int dev = 0, cus = 0, per_cu = 0;
        hipGetDevice(&dev);
        hipDeviceGetAttribute(&cus, hipDeviceAttributeMultiprocessorCount, dev);
        hipFuncSetAttribute((const void*)fwd_megakernel, hipFuncAttributeMaxDynamicSharedMemorySize, (int)LDS_BYTES);
        hipOccupancyMaxActiveBlocksPerMultiprocessor(&per_cu, fwd_megakernel, NTHREADS, LDS_BYTES);
        if (per_cu < 1) per_cu = 1;
        if (per_cu > 1) per_cu = 1;
        grid_blocks = cus * per_cu;
    }
    Params p{};
    p.x = (const float*)d_in[0]; p.norm_g = (const float*)d_in[1]; p.w_in = (const float*)d_in[2]; p.w_out = (const float*)d_in[3];
    p.lq1 = (const float*)d_in[4]; p.lk1 = (const float*)d_in[5]; p.lq2 = (const float*)d_in[6]; p.lk2 = (const float*)d_in[7];
    p.subln_g = (const float*)d_in[8]; p.rpb = (const float*)d_in[9]; p.final_g = (const float*)d_in[10];
    p.xf = (float*)d_out;
    char* w = (char*)d_ws; size_t off = 0;
    auto take = [&](size_t bytes) { char* r = w + off; off += (bytes + 255) & ~(size_t)255; return r; };
    p.wi_t = (bf16_t*)take((size_t)DEPTH * 4096 * 1024 * 2);
    p.wo_t = (bf16_t*)take((size_t)DEPTH * 1024 * 1024 * 2);
    p.xb = (bf16_t*)take((size_t)NTOK * 1024 * 2);
    p.rss = (float*)take((size_t)NTOK * 16 * 4);
    p.z = (bf16_t*)take((size_t)NTOK * ZP * 2);
    p.vT = (bf16_t*)take((size_t)BATCH * 1024 * SEQ * 2);
    p.o = (bf16_t*)take((size_t)NTOK * 1024 * 2);
    p.bar = (unsigned*)take((size_t)(XCD_BAR_WORDS + 64 * 64) * 4);
    (void)hipMemsetAsync(p.bar, 0, (size_t)(XCD_BAR_WORDS + 64 * 64) * 4, stream);
    for (int l = 0; l < DEPTH; ++l) p.lam_init[l] = (float)(0.8 - 0.6 * exp(-0.3 * (double)l));
    void* args[] = {&p};
    hipError_t e = hipLaunchCooperativeKernel((const void*)fwd_megakernel, dim3(grid_blocks), dim3(NTHREADS), args, LDS_BYTES, stream);
    if (e != hipSuccess) fprintf(stderr, "cooperative launch failed: %s (grid %d)\n", hipGetErrorString(e), grid_blocks);
}
```

```cpp
#include <hip/hip_runtime.h>
#include <hip/hip_cooperative_groups.h>
#include <cstdio>
#include <cstdint>
namespace cg = cooperative_groups;

typedef unsigned short bf16_t;
typedef short bf16x8 __attribute__((ext_vector_type(8)));
typedef float f32x4 __attribute__((ext_vector_type(4)));
typedef float f32x16 __attribute__((ext_vector_type(16)));
typedef unsigned u32x4 __attribute__((ext_vector_type(4)));
typedef unsigned u32x2 __attribute__((ext_vector_type(2)));

constexpr int D_MODEL = 1024, BATCH = 8, SEQ = 2048, DEPTH = 4, NTOK = BATCH * SEQ;
constexpr int IN_W = 4096;
constexpr size_t ZS_QD = 0, ZS_KD = (size_t)NTOK * 512, ZS_QN = (size_t)NTOK * 1024, ZS_KN = (size_t)NTOK * 1536, ZS_GATE = (size_t)NTOK * 2048;
constexpr size_t VS_VD = 0, VS_VN = (size_t)NTOK * 512;
constexpr int ZP = 3072;
constexpr float RMS_EPS = 1e-6f;
constexpr float LOG2E = 1.4426950408889634f;
constexpr int NTHREADS = 512;
#ifndef REP_GEMM0
#define REP_GEMM0 1
#endif
#ifndef REP_DA
#define REP_DA 1
#endif
#ifndef REP_NA
#define REP_NA 1
#endif
#define REP_ATT (REP_DA > REP_NA ? REP_DA : REP_NA)

struct Params {
    const float* x; const float* norm_g; const float* w_in; const float* w_out;
    const float* lq1; const float* lk1; const float* lq2; const float* lk2;
    const float* subln_g; const float* rpb; const float* final_g;
    float* xf;
    bf16_t* wi_t;
    bf16_t* wo_t;
    bf16_t* xb;
    float* rss;
    bf16_t* z;
    bf16_t* vT;
    bf16_t* o;
    unsigned* bar;
    float lam_init[DEPTH];
    int never;
    int pad_;
};

typedef __bf16 bf16x2_t __attribute__((ext_vector_type(2)));
typedef float f32x2_t __attribute__((ext_vector_type(2)));
__device__ __forceinline__ unsigned cvt_pk_bf16(float lo, float hi) {
    const f32x2_t v = {lo, hi};
    return __builtin_bit_cast(unsigned, __builtin_convertvector(v, bf16x2_t));
}
__device__ __forceinline__ float bf2f(unsigned short b) { return __uint_as_float(((unsigned)b) << 16); }
__device__ __forceinline__ float bflo(unsigned w) { return __uint_as_float(w << 16); }
__device__ __forceinline__ float bfhi(unsigned w) { return __uint_as_float(w & 0xffff0000u); }
__device__ __forceinline__ float fast_exp2(float x) { return __builtin_amdgcn_exp2f(x); }


#define XB_TMO      128
#define XB_XCNT(j)  (256  + 64 * (j))
#define XB_XSUB(j)  (1280 + 64 * (j))
#define XB_XGEN(j)  (2304 + 64 * (j))
#define XB_TOP      3328
#define XB_TOPGEN   3392
#define XCD_BAR_WORDS 3456
#define XB_SPIN_CAP (1u << 20)
#define LAS __attribute__((address_space(3)))
__device__ __forceinline__ unsigned xb_ld(unsigned* p)              { return __hip_atomic_load(p, __ATOMIC_RELAXED, __HIP_MEMORY_SCOPE_AGENT); }
__device__ __forceinline__ unsigned xb_add(unsigned* p, unsigned v) { return __hip_atomic_fetch_add(p, v, __ATOMIC_RELAXED, __HIP_MEMORY_SCOPE_AGENT); }
__device__ __forceinline__ unsigned xb_xcc_id() { return (unsigned)__builtin_amdgcn_s_getreg((3 << 11) | 20) & 0xFu; }
#define XB_SPIN(cond, bar) do { unsigned _sp = 0; while (cond) { __builtin_amdgcn_s_sleep(1); \
    if ((++_sp & 255u) == 0u) { if (xb_ld(&(bar)[XB_TMO])) break; if (_sp > XB_SPIN_CAP) { atomicAdd(&(bar)[XB_TMO], 1u); break; } } } } while (0)
struct XcdBarrier { unsigned* bar; unsigned x; volatile LAS unsigned* st; };
__device__ __forceinline__ XcdBarrier xcd_barrier_post(unsigned* bar, volatile LAS unsigned* st) {
    XcdBarrier b; b.bar = bar; b.x = xb_xcc_id(); b.st = st;
    if (threadIdx.x == 0) (void)xb_add(&bar[XB_XCNT(b.x)], 1u);
    return b;
}
__device__ __forceinline__ void xcd_barrier_complete(unsigned* bar, unsigned x, unsigned& nloc, unsigned& nx) {
    const unsigned G = gridDim.x * gridDim.y * gridDim.z;
    unsigned sum, cnt, mine, sp = 0u;
    for (;;) {
        sum = 0u; cnt = 0u; mine = 0u;
#pragma unroll
        for (unsigned j = 0; j < 16; ++j) { const unsigned c = xb_ld(&bar[XB_XCNT(j)]); sum += c; cnt += (c > 0u) ? 1u : 0u; mine = (j == x) ? c : mine; }
        if (sum == G) break;
        __builtin_amdgcn_s_sleep(1);
        if ((++sp & 255u) == 0u) { if (xb_ld(&bar[XB_TMO])) break; if (sp > XB_SPIN_CAP) { atomicAdd(&bar[XB_TMO], 1u); break; } }
    }
    nloc = mine > 0u ? mine : 1u; nx = cnt > 0u ? cnt : 1u;
}
__device__ __forceinline__ void xcd_barrier(const XcdBarrier& b) {
    asm volatile("s_waitcnt vmcnt(0)" ::: "memory");
    __syncthreads();
    if (threadIdx.x == 0) {
        unsigned* bar = b.bar;
        unsigned bx = b.x; asm volatile("" : "+s"(bx));
        __builtin_amdgcn_s_waitcnt(0);
        unsigned nloc = b.st[0], nx = b.st[1];
        if (nloc == 0u) { xcd_barrier_complete(bar, bx, nloc, nx); b.st[0] = nloc; b.st[1] = nx; }
        const unsigned old = xb_add(&bar[XB_XSUB(bx)], 1u);
        const unsigned gen = old / nloc;
        if (old + 1u == (gen + 1u) * nloc) {
            __builtin_amdgcn_fence(__ATOMIC_RELEASE, "agent");
            asm volatile("s_waitcnt vmcnt(0)" ::: "memory");
            const unsigned og = xb_add(&bar[XB_TOP], 1u);
            const unsigned tg = og / nx;
            if (og + 1u == (tg + 1u) * nx) xb_add(&bar[XB_TOPGEN], 1u);
            else XB_SPIN(xb_ld(&bar[XB_TOPGEN]) == tg, bar);
            __builtin_amdgcn_fence(__ATOMIC_ACQUIRE, "agent");
            xb_add(&bar[XB_XGEN(bx)], 1u);
            asm volatile("s_waitcnt vmcnt(0)" ::: "memory");
        } else {
            XB_SPIN(xb_ld(&bar[XB_XGEN(bx)]) == gen, bar);
            __builtin_amdgcn_fence(__ATOMIC_ACQUIRE, "agent");
            asm volatile("s_waitcnt vmcnt(0)" ::: "memory");
        }
    }
    __syncthreads();
}

__device__ __forceinline__ int perm_col(int n) {
    if (n < 1024) return n;
    if (n < 2048) return n + 512;
    if (n < 3072) return n + 1024;
    if (n < 3584) return n - 2048;
    return n - 1024;
}

__device__ void prologue_phase(char* lds, const Params& p) {
    int tid_ = threadIdx.x; asm volatile("" : "+v"(tid_)); const int tid = tid_, lane = tid & 63, wid = tid >> 6;
    float* tile = (float*)lds;
    const int nt_in = DEPTH * 16 * 64, nt_out = DEPTH * 16 * 16;
    for (int t = blockIdx.x; t < nt_in + nt_out; t += gridDim.x) {
        const float* W; bf16_t* Wt; const float* g; int N, k0, n0, no0;
        if (t < nt_in) {
            const int l = t >> 10, rem = t & 1023; k0 = (rem >> 6) * 64; n0 = (rem & 63) * 64;
            W = p.w_in + (size_t)l * 1024 * 4096; N = 4096; Wt = p.wi_t + (size_t)l * 4096 * 1024; g = p.norm_g + l * 1024; no0 = perm_col(n0);
        } else {
            const int t2 = t - nt_in; const int l = t2 >> 8, rem = t2 & 255; k0 = (rem >> 4) * 64; n0 = (rem & 15) * 64;
            W = p.w_out + (size_t)l * 1024 * 1024; N = 1024; Wt = p.wo_t + (size_t)l * 1024 * 1024; g = nullptr; no0 = n0;
        }
        {
            const int i = tid >> 4, j4 = tid & 15;
#pragma unroll
            for (int ps = 0; ps < 2; ++ps) {
                const int kk = i + 32 * ps;
                const f32x4 v = *(const f32x4*)(W + (size_t)(k0 + kk) * N + no0 + 4 * j4);
                const float gg = g ? g[k0 + kk] : 1.0f;
                tile[kk * 65 + 4 * j4 + 0] = v[0] * gg; tile[kk * 65 + 4 * j4 + 1] = v[1] * gg;
                tile[kk * 65 + 4 * j4 + 2] = v[2] * gg; tile[kk * 65 + 4 * j4 + 3] = v[3] * gg;
            }
        }
        __syncthreads();
        {
            const int j = tid >> 3, i8 = tid & 7;
            float v[8];
#pragma unroll
            for (int e = 0; e < 8; ++e) v[e] = tile[(8 * i8 + e) * 65 + j];
            u32x4 w; w.x = cvt_pk_bf16(v[0], v[1]); w.y = cvt_pk_bf16(v[2], v[3]); w.z = cvt_pk_bf16(v[4], v[5]); w.w = cvt_pk_bf16(v[6], v[7]);
            *(u32x4*)(Wt + (size_t)(n0 + j) * 1024 + k0 + 8 * i8) = w;
        }
        __syncthreads();
    }
    for (int row = blockIdx.x * 8 + wid; row < NTOK; row += gridDim.x * 8) {
        float ss = 0.f;
#pragma unroll
        for (int i = 0; i < 4; ++i) {
            const int c = 4 * lane + 256 * i;
            const f32x4 v = *(const f32x4*)(p.x + (size_t)row * 1024 + c);
            ss += v[0] * v[0] + v[1] * v[1] + v[2] * v[2] + v[3] * v[3];
            u32x2 w; w.x = cvt_pk_bf16(v[0], v[1]); w.y = cvt_pk_bf16(v[2], v[3]);
            *(u32x2*)(p.xb + (size_t)row * 1024 + c) = w;
        }
#pragma unroll
        for (int s = 32; s >= 1; s >>= 1) ss += __shfl_xor(ss, s);
        if (lane < 16) p.rss[(size_t)row * 16 + lane] = lane == 0 ? ss : 0.f;
    }
}

__device__ void final_phase(const Params& p) {
    int tid_ = threadIdx.x; asm volatile("" : "+v"(tid_)); const int tid = tid_, lane = tid & 63, wid = tid >> 6;
    for (int row = blockIdx.x * 8 + wid; row < NTOK; row += gridDim.x * 8) {
        float ss = 0.f;
        if (lane < 16) ss = p.rss[(size_t)row * 16 + lane];
#pragma unroll
        for (int s = 8; s >= 1; s >>= 1) ss += __shfl_xor(ss, s);
        ss = __shfl(ss, 0);
        const float rstd = rsqrtf(ss * (1.0f / 1024.0f) + RMS_EPS);
#pragma unroll
        for (int i = 0; i < 4; ++i) {
            const int c = 4 * lane + 256 * i;
            f32x4 v = *(const f32x4*)(p.xf + (size_t)row * 1024 + c);
            const f32x4 g = *(const f32x4*)(p.final_g + c);
            v = v * rstd * g;
            *(f32x4*)(p.xf + (size_t)row * 1024 + c) = v;
        }
    }
}

namespace pg8 {
#define PG8_LAS __attribute__((address_space(3)))
typedef unsigned short bf16_t;
typedef short bf16x8 __attribute__((ext_vector_type(8)));
typedef float f32x4 __attribute__((ext_vector_type(4)));
typedef unsigned u32x4 __attribute__((ext_vector_type(4)));
constexpr int BM = 256, BK = 64, HALF = 128, HTB = HALF * BK * 2  , STAGE_BYTES = 8 * HTB, NXCD = 8, WGM = 8;

__host__ __device__ __forceinline__ int lds_byte(int r, int c) { const int st = (r >> 4) * 2 + (c >> 5), rr = r & 15, cc = c & 31, ob = rr * 64 + cc * 2; return st * 1024 + (ob ^ (((ob >> 9) & 1) << 5)); }
__host__ __device__ __forceinline__ void stage_rc(int b, int& R, int& C) { const int st = b / 1024, sb = b % 1024, swz = sb ^ (((sb >> 9) & 1) << 5); R = (st >> 1) * 16 + swz / 64; C = (st & 1) * 32 + (swz % 64) / 2; }
__host__ __device__ __forceinline__ int perm32(int rho) { const int n = rho >> 4, i = rho & 15; return 8 * (i >> 2) + 4 * n + (i & 3); }

struct Unit { int pm, pn; };
struct Gemm { const bf16_t* A; const bf16_t* Bt; int M, N, K; };

struct StaticOrder {
    int nM, nN, nwg, G, c;
    __host__ __device__ void init(int M, int N, int G_, int c_) { nM = M / BM; nN = N / BM; nwg = nM * nN; G = G_; c = c_; }
    __host__ __device__ bool next(int i, Unit& u) const {
        const long L = (long)i * G + c; if (L >= nwg) return false;
        int wgid = (int)L; { const int q = nwg / NXCD, r = nwg % NXCD, xcd = wgid % NXCD, off = wgid / NXCD; wgid = (xcd < r ? xcd * (q + 1) : r * (q + 1) + (xcd - r) * q) + off; }
        const int nig = WGM * nN, gid = wgid / nig, fm = gid * WGM, gsz = (nM - fm) < WGM ? (nM - fm) : WGM;
        u.pm = fm + ((wgid % nig) % gsz); u.pn = (wgid % nig) / gsz; return true;
    }
    __device__ __forceinline__ void a_ready(const Unit&) const {}
    __device__ __forceinline__ void done(const Unit&) const {}
};


template <class Epi, class Sched, bool ALIGN_EPI = false, bool SP2 = false>
__device__ __forceinline__ void gemm_phase(PG8_LAS unsigned char* lds, const Gemm g, const Sched& S, const Epi& E) {
    int tid_ = threadIdx.x; asm volatile("" : "+v"(tid_));
    const int tid = tid_, wid = __builtin_amdgcn_readfirstlane(tid >> 6), lane = tid & 63, wr = wid >> 2, wc = wid & 3, fr = lane & 15, fq = lane >> 4;
    const int K = g.K, nt = K / BK;
    unsigned voffA[2], voffB[2];
#pragma unroll
    for (int i = 0; i < 2; ++i) { int R, C; stage_rc(tid * 16 + i * 8192, R, C); const int Rb = Epi::PERM ? ((R & ~31) + perm32(R & 31)) : R;
        voffA[i] = (unsigned)(R * K + C) * 2u; voffB[i] = (unsigned)(Rb * K + C) * 2u; }
    const size_t kstep = (size_t)(BK * 2);
    const size_t hstep = (size_t)HALF * K * 2;
    const size_t tstep = 2 * hstep;
    const unsigned ldsw = (unsigned)wid * 1024u;
    const int aoff = lds_byte(wr * 64 + fr, fq * 8), boff = lds_byte(wc * 32 + fr, fq * 8);
#define PG8_SA(b, h) (((b) * 2 + (h)) * HTB)
#define PG8_SB(b, h) ((4 + (b) * 2 + (h)) * HTB)
#define PG8_STAGE(bufoff, gbase, voff) do { _Pragma("unroll") for (int _i = 0; _i < 2; ++_i) \
        __builtin_amdgcn_global_load_lds((const unsigned*)((const char*)(gbase) + (voff)[_i]), (PG8_LAS unsigned*)(lds + (bufoff) + ldsw + _i * 8192), 16, 0, 0); } while (0)
#define PG8_LDA(dst, b, h) do { _Pragma("unroll") for (int m = 0; m < 4; ++m) _Pragma("unroll") for (int k = 0; k < 2; ++k) dst[m][k] = *(const PG8_LAS bf16x8*)(lds + PG8_SA(b, h) + aoff + m * 2048 + k * 1024); } while (0)
#define PG8_LDB(dst, b, h) do { _Pragma("unroll") for (int n = 0; n < 2; ++n) _Pragma("unroll") for (int k = 0; k < 2; ++k) dst[n][k] = *(const PG8_LAS bf16x8*)(lds + PG8_SB(b, h) + boff + n * 2048 + k * 1024); } while (0)
#define PG8_MMA(ai, bj, At, Bt) do { __builtin_amdgcn_s_setprio(1); _Pragma("unroll") for (int m = 0; m < 4; ++m) _Pragma("unroll") for (int n = 0; n < 2; ++n) _Pragma("unroll") for (int k = 0; k < 2; ++k) \
        acc[ai][bj][m][n] = __builtin_amdgcn_mfma_f32_16x16x32_bf16(Bt[n][k], At[m][k], acc[ai][bj][m][n], 0, 0, 0); __builtin_amdgcn_s_setprio(0); } while (0)
#define PG8_WAIT_V(n) asm volatile("s_waitcnt vmcnt(" #n ")" ::: "memory")
#define PG8_WAIT_L(n) asm volatile("s_waitcnt lgkmcnt(" #n ")" ::: "memory")
#define PG8_BAR __builtin_amdgcn_s_barrier()
#define PG8_SCHED __builtin_amdgcn_sched_barrier(0)
    Unit cur, nxt; int ui = 0;
    if (!S.next(0, cur)) return;
    f32x4 acc[2][2][4][2];
#pragma unroll
    for (int a = 0; a < 2; ++a)
#pragma unroll
        for (int b = 0; b < 2; ++b)
#pragma unroll
            for (int m = 0; m < 4; ++m)
#pragma unroll
                for (int n = 0; n < 2; ++n) acc[a][b][m][n] = (f32x4){0.f, 0.f, 0.f, 0.f};
    bf16x8 At[4][2], B0[2][2], B1[2][2];
    const char* cA = (const char*)g.A + (size_t)cur.pm * tstep; const char* cB = (const char*)g.Bt + (size_t)cur.pn * tstep;
    S.a_ready(cur);
    if constexpr (SP2) {
        PG8_STAGE(PG8_SB(0, 0), cB, voffB); PG8_STAGE(PG8_SB(0, 1), cB + hstep, voffB); PG8_STAGE(PG8_SA(0, 0), cA, voffA); PG8_STAGE(PG8_SA(0, 1), cA + hstep, voffA);
        if (wr == 1) PG8_BAR;
        PG8_WAIT_V(2); PG8_BAR;
        PG8_STAGE(PG8_SB(1, 0), cB + kstep, voffB); PG8_STAGE(PG8_SA(1, 0), cA + kstep, voffA); PG8_STAGE(PG8_SB(1, 1), cB + hstep + kstep, voffB);
        PG8_WAIT_V(6); PG8_BAR;
    } else {
        PG8_STAGE(PG8_SB(0, 0), cB, voffB); PG8_STAGE(PG8_SA(0, 0), cA, voffA); PG8_STAGE(PG8_SB(0, 1), cB + hstep, voffB); PG8_STAGE(PG8_SA(0, 1), cA + hstep, voffA);
        if (wr == 1) PG8_BAR;
        PG8_WAIT_V(4); PG8_BAR;
        PG8_STAGE(PG8_SB(1, 0), cB + kstep, voffB); PG8_STAGE(PG8_SA(1, 0), cA + kstep, voffA); PG8_STAGE(PG8_SB(1, 1), cB + hstep + kstep, voffB);
        PG8_WAIT_V(6); PG8_BAR;
    }
    for (;;) {
        const bool has_next = S.next(ui + 1, nxt);
        const char* nA = has_next ? (const char*)g.A + (size_t)nxt.pm * tstep : cA; const char* nB = has_next ? (const char*)g.Bt + (size_t)nxt.pn * tstep : cB;
        for (int t = 0; t < nt; t += 2) {
            const bool last = (t == nt - 2);
            const char* a1 = cA + (size_t)(t + 1) * kstep;
            const char* a2 = last ? nA : cA + (size_t)(t + 2) * kstep; const char* b2 = last ? nB : cB + (size_t)(t + 2) * kstep;
            const char* a3 = a2 + kstep; const char* b3 = b2 + kstep;
            if (last && has_next) S.a_ready(nxt);
            if constexpr (SP2) {
            PG8_LDB(B0, 0, 0); PG8_LDB(B1, 0, 1); PG8_SCHED; PG8_LDA(At, 0, 0); PG8_STAGE(PG8_SA(1, 1), a1 + hstep, voffA);
            PG8_WAIT_V(8); PG8_WAIT_L(0); PG8_BAR; PG8_MMA(0, 0, At, B0); PG8_MMA(0, 1, At, B1); PG8_BAR; PG8_SCHED;
            PG8_LDA(At, 0, 1); PG8_STAGE(PG8_SB(0, 0), b2, voffB); PG8_STAGE(PG8_SB(0, 1), b2 + hstep, voffB); PG8_STAGE(PG8_SA(0, 0), a2, voffA);
            PG8_WAIT_V(8); PG8_WAIT_L(0); PG8_BAR; PG8_MMA(1, 0, At, B0); PG8_MMA(1, 1, At, B1); PG8_BAR; PG8_SCHED;
            PG8_LDB(B0, 1, 0); PG8_LDB(B1, 1, 1); PG8_SCHED; PG8_LDA(At, 1, 0); PG8_STAGE(PG8_SA(0, 1), a2 + hstep, voffA);
            PG8_WAIT_V(8); PG8_WAIT_L(0); PG8_BAR; PG8_MMA(0, 0, At, B0); PG8_MMA(0, 1, At, B1); PG8_BAR; PG8_SCHED;
            PG8_LDA(At, 1, 1); PG8_STAGE(PG8_SB(1, 0), b3, voffB); PG8_STAGE(PG8_SB(1, 1), b3 + hstep, voffB); PG8_STAGE(PG8_SA(1, 0), a3, voffA);
            PG8_WAIT_V(8); PG8_WAIT_L(0); PG8_BAR; PG8_MMA(1, 0, At, B0); PG8_MMA(1, 1, At, B1); PG8_BAR; PG8_SCHED;
            } else {
            PG8_LDB(B0, 0, 0); PG8_SCHED; PG8_LDA(At, 0, 0); PG8_STAGE(PG8_SA(1, 1), a1 + hstep, voffA);
            PG8_WAIT_L(8); PG8_BAR; PG8_WAIT_L(0); PG8_MMA(0, 0, At, B0); PG8_BAR; PG8_SCHED;
            PG8_LDB(B1, 0, 1); PG8_STAGE(PG8_SB(0, 0), b2, voffB);
            PG8_BAR; PG8_WAIT_L(0); PG8_MMA(0, 1, At, B1); PG8_BAR;
            PG8_LDA(At, 0, 1); PG8_STAGE(PG8_SA(0, 0), a2, voffA);
            PG8_BAR; PG8_WAIT_L(0); PG8_MMA(1, 0, At, B0); PG8_BAR; PG8_SCHED;
            PG8_STAGE(PG8_SB(0, 1), b2 + hstep, voffB);
            PG8_WAIT_V(6); PG8_BAR; PG8_MMA(1, 1, At, B1); PG8_BAR;
            PG8_LDB(B0, 1, 0); PG8_SCHED; PG8_LDA(At, 1, 0); PG8_STAGE(PG8_SA(0, 1), a2 + hstep, voffA);
            PG8_WAIT_L(8); PG8_BAR; PG8_WAIT_L(0); PG8_MMA(0, 0, At, B0); PG8_BAR; PG8_SCHED;
            PG8_LDB(B1, 1, 1); PG8_STAGE(PG8_SB(1, 0), b3, voffB);
            PG8_BAR; PG8_WAIT_L(0); PG8_MMA(0, 1, At, B1); PG8_BAR;
            PG8_LDA(At, 1, 1); PG8_STAGE(PG8_SA(1, 0), a3, voffA);
            PG8_BAR; PG8_WAIT_L(0); PG8_MMA(1, 0, At, B0); PG8_BAR; PG8_SCHED;
            PG8_STAGE(PG8_SB(1, 1), b3 + hstep, voffB);
            PG8_WAIT_V(6); PG8_BAR; PG8_MMA(1, 1, At, B1); PG8_BAR;
            }
        }
        if constexpr (ALIGN_EPI) { if (wr == 0) PG8_BAR; }
        if constexpr (!Epi::AFTER_DRAIN) { E(acc, cur, wr, wc, fr, fq); S.done(cur); }
        if (!has_next) break;
#pragma unroll
        for (int a = 0; a < 2; ++a)
#pragma unroll
            for (int b = 0; b < 2; ++b)
#pragma unroll
                for (int m = 0; m < 4; ++m)
#pragma unroll
                    for (int n = 0; n < 2; ++n) acc[a][b][m][n] = (f32x4){0.f, 0.f, 0.f, 0.f};
        cur = nxt; cA = nA; cB = nB; ++ui;
        if constexpr (ALIGN_EPI) { if (wr == 1) PG8_BAR; }
    }
    PG8_WAIT_V(0);
    if constexpr (!ALIGN_EPI) { if (wr == 0) PG8_BAR; }
    PG8_BAR;
    if constexpr (Epi::AFTER_DRAIN) { E.fused(acc, cur, wr, wc, fr, fq, lds, wid, lane); S.done(cur); }
#undef PG8_SA
#undef PG8_SB
#undef PG8_STAGE
#undef PG8_LDA
#undef PG8_LDB
#undef PG8_MMA
#undef PG8_WAIT_V
#undef PG8_WAIT_L
#undef PG8_BAR
#undef PG8_SCHED
}
}


namespace pg8 {
struct EpiZ {
    static constexpr bool PERM = true, AFTER_DRAIN = false;
    bf16_t* z; bf16_t* vT; const float* rss;
    __device__ __forceinline__ void operator()(const f32x4 (&acc)[2][2][4][2], const Unit& u, int wr, int wc, int fr, int fq) const {
        f32x4 part[2][4];
#pragma unroll
        for (int ai = 0; ai < 2; ++ai)
#pragma unroll
            for (int m = 0; m < 4; ++m) part[ai][m] = *(const f32x4*)(rss + (size_t)(u.pm * BM + ai * HALF + wr * 64 + m * 16 + fr) * 16 + 4 * fq);
        float rstdv[2][4];
#pragma unroll
        for (int ai = 0; ai < 2; ++ai)
#pragma unroll
            for (int m = 0; m < 4; ++m) {
                float s = (part[ai][m][0] + part[ai][m][1]) + (part[ai][m][2] + part[ai][m][3]);
                s += __shfl_xor(s, 16); s += __shfl_xor(s, 32);
                rstdv[ai][m] = rsqrtf(s * (1.0f / 1024.0f) + RMS_EPS);
            }
#pragma unroll
        for (int ai = 0; ai < 2; ++ai)
#pragma unroll
            for (int m = 0; m < 4; ++m) {
                const int row = u.pm * BM + ai * HALF + wr * 64 + m * 16 + fr;
                const float rstd = rstdv[ai][m];
                const int b = row >> 11, s = row & 2047;
#pragma unroll
                for (int bj = 0; bj < 2; ++bj) {
                    const int tn = 2 * u.pn + bj;
                    const int cw = 32 * wc + 8 * fq;
                    const f32x4 v0 = acc[ai][bj][m][0] * rstd, v1 = acc[ai][bj][m][1] * rstd;
                    u32x4 w; w.x = ::cvt_pk_bf16(v0[0], v0[1]); w.y = ::cvt_pk_bf16(v0[2], v0[3]); w.z = ::cvt_pk_bf16(v1[0], v1[1]); w.w = ::cvt_pk_bf16(v1[2], v1[3]);
                    if (tn < 24) {
                        bf16_t* dst;
                        if (tn < 8) dst = z + (size_t)(tn >> 2) * ZS_KD + ((size_t)((b * 4 + (tn & 3)) * 2048 + s)) * 128 + cw;
                        else if (tn < 16) dst = z + ZS_QN + (size_t)((tn - 8) >> 2) * (ZS_KN - ZS_QN) + ((size_t)((b * 8 + ((tn - 8) & 3) * 2 + (cw >> 6)) * 2048 + s)) * 64 + (cw & 63);
                        else dst = z + ZS_GATE + (size_t)row * 1024 + (tn - 16) * 128 + cw;
                        *(u32x4*)dst = w;
                    } else {
                        const unsigned ox = __shfl_xor(w.x, 1), oy = __shfl_xor(w.y, 1), oz = __shfl_xor(w.z, 1), ow = __shfl_xor(w.w, 1);
                        const bool odd = fr & 1;
                        const unsigned a0 = odd ? oz : w.x, a1 = odd ? ow : w.y;
                        const unsigned b0 = odd ? w.z : ox, b1 = odd ? w.w : oy;
                        const unsigned p0 = (a0 & 0xffffu) | (b0 << 16), p1 = (a0 >> 16) | (b0 & 0xffff0000u);
                        const unsigned p2 = (a1 & 0xffffu) | (b1 << 16), p3 = (a1 >> 16) | (b1 & 0xffff0000u);
                        const int ch0 = cw + (odd ? 4 : 0), se = s & ~1;
                        bf16_t* dst;
                        if (tn < 28) dst = vT + VS_VD + ((size_t)(((b * 4 + (tn - 24)) * 32 + (se >> 6)) * 128 + ch0)) * 64 + (se & 63);
                        else dst = vT + VS_VN + ((size_t)(((b * 8 + (tn - 28) * 2 + (ch0 >> 6)) * 32 + (se >> 6)) * 64 + (ch0 & 63))) * 64 + (se & 63);
                        *(unsigned*)(dst) = p0; *(unsigned*)(dst + 64) = p1; *(unsigned*)(dst + 128) = p2; *(unsigned*)(dst + 192) = p3;
                    }
                }
            }
    }
};
template <int XIN, int OUT> struct EpiRes2 {
    static constexpr bool PERM = true, AFTER_DRAIN = false, TOUCH = false;
    const float* xin32; const bf16_t* xinb; bf16_t* xb; float* xf; float* rss;
    __device__ __forceinline__ void operator()(const f32x4 (&acc)[2][2][4][2], const Unit& u, int wr, int wc, int fr, int fq) const {
#pragma unroll
        for (int ai = 0; ai < 2; ++ai) {
            f32x4 res[XIN == 0 ? 4 : 1][2][2]; u32x4 rb[XIN == 0 ? 1 : 4][2];
#pragma unroll
            for (int m = 0; m < 4; ++m)
#pragma unroll
                for (int bj = 0; bj < 2; ++bj) {
                    const size_t off = (size_t)(u.pm * BM + ai * HALF + wr * 64 + m * 16 + fr) * 1024 + u.pn * BM + bj * HALF + 32 * wc + 8 * fq;
                    if (XIN == 0) { res[m][bj][0] = *(const f32x4*)(xin32 + off); res[m][bj][1] = *(const f32x4*)(xin32 + off + 4); }
                    else rb[m][bj] = *(const u32x4*)(xinb + off);
                }
            __builtin_amdgcn_sched_barrier(0);
#pragma unroll
            for (int m = 0; m < 4; ++m) {
                const int row = u.pm * BM + ai * HALF + wr * 64 + m * 16 + fr;
                float ss = 0.f;
#pragma unroll
                for (int bj = 0; bj < 2; ++bj) {
                    const size_t off = (size_t)row * 1024 + u.pn * BM + bj * HALF + 32 * wc + 8 * fq;
                    f32x4 r0, r1;
                    if (XIN == 0) { r0 = res[m][bj][0]; r1 = res[m][bj][1]; }
                    else { const u32x4 w = rb[m][bj]; r0 = (f32x4){bflo(w.x), bfhi(w.x), bflo(w.y), bfhi(w.y)}; r1 = (f32x4){bflo(w.z), bfhi(w.z), bflo(w.w), bfhi(w.w)}; }
                    const f32x4 v0 = r0 + acc[ai][bj][m][0], v1 = r1 + acc[ai][bj][m][1];
                    if (OUT == 0) { u32x4 w; w.x = ::cvt_pk_bf16(v0[0], v0[1]); w.y = ::cvt_pk_bf16(v0[2], v0[3]); w.z = ::cvt_pk_bf16(v1[0], v1[1]); w.w = ::cvt_pk_bf16(v1[2], v1[3]); *(u32x4*)(xb + off) = w; }
                    else { *(f32x4*)(xf + off) = v0; *(f32x4*)(xf + off + 4) = v1; }
                    ss += (v0[0] * v0[0] + v0[1] * v0[1]) + (v0[2] * v0[2] + v0[3] * v0[3]) + (v1[0] * v1[0] + v1[1] * v1[1]) + (v1[2] * v1[2] + v1[3] * v1[3]);
                }
                ss += __shfl_xor(ss, 16); ss += __shfl_xor(ss, 32);
                if (fq == 0) rss[(size_t)row * 16 + u.pn * 4 + wc] = ss;
            }
            __builtin_amdgcn_sched_barrier(0);
        }
    }
};
struct EpiFinal {
    static constexpr bool PERM = true, AFTER_DRAIN = true;
    const bf16_t* xinb; float* out; const float* fg; float* rss; unsigned* cnt;
    __device__ __forceinline__ void fused(f32x4 (&acc)[2][2][4][2], const Unit& u, int wr, int wc, int fr, int fq, PG8_LAS unsigned char* lds, int wid, int lane) const {
        float ssv[2][4];
#pragma unroll
        for (int ai = 0; ai < 2; ++ai) {
            u32x4 rb[4][2];
#pragma unroll
            for (int m = 0; m < 4; ++m)
#pragma unroll
                for (int bj = 0; bj < 2; ++bj) {
                    const size_t off = (size_t)(u.pm * BM + ai * HALF + wr * 64 + m * 16 + fr) * 1024 + u.pn * BM + bj * HALF + 32 * wc + 8 * fq;
                    rb[m][bj] = *(const u32x4*)(xinb + off);
                }
#pragma unroll
            for (int m = 0; m < 4; ++m) {
                float ss = 0.f;
#pragma unroll
                for (int bj = 0; bj < 2; ++bj) {
                    const u32x4 w = rb[m][bj];
                    const f32x4 v0 = (f32x4){bflo(w.x), bfhi(w.x), bflo(w.y), bfhi(w.y)} + acc[ai][bj][m][0], v1 = (f32x4){bflo(w.z), bfhi(w.z), bflo(w.w), bfhi(w.w)} + acc[ai][bj][m][1];
                    acc[ai][bj][m][0] = v0; acc[ai][bj][m][1] = v1;
                    ss += (v0[0] * v0[0] + v0[1] * v0[1]) + (v0[2] * v0[2] + v0[3] * v0[3]) + (v1[0] * v1[0] + v1[1] * v1[1]) + (v1[2] * v1[2] + v1[3] * v1[3]);
                }
                ss += __shfl_xor(ss, 16); ss += __shfl_xor(ss, 32);
                ssv[ai][m] = ss;
            }
        }
        if (fq == 0) {
#pragma unroll
            for (int ai = 0; ai < 2; ++ai)
#pragma unroll
                for (int m = 0; m < 4; ++m)
                    __hip_atomic_store((unsigned*)rss + (size_t)(u.pm * BM + ai * HALF + wr * 64 + m * 16 + fr) * 16 + u.pn * 4 + wc, __float_as_uint(ssv[ai][m]), __ATOMIC_RELAXED, __HIP_MEMORY_SCOPE_AGENT);
        }
        asm volatile("s_waitcnt vmcnt(0)" ::: "memory");
        if (lane == 0) __hip_atomic_fetch_add(cnt + 64 * u.pm, 1u, __ATOMIC_RELAXED, __HIP_MEMORY_SCOPE_AGENT);
        if (wid == 0) {
            unsigned spins = 0;
            while ((unsigned)__builtin_amdgcn_readfirstlane(__hip_atomic_load(cnt + 64 * u.pm, __ATOMIC_RELAXED, __HIP_MEMORY_SCOPE_AGENT)) < 32u) {
                __builtin_amdgcn_s_sleep(2);
                if (++spins > (1u << 22)) break;
            }
            __builtin_amdgcn_fence(__ATOMIC_ACQUIRE, "agent");
        }
        asm volatile("s_waitcnt vmcnt(0) lgkmcnt(0)" ::: "memory"); __builtin_amdgcn_s_barrier(); asm volatile("" ::: "memory");
        float rstdv[2][4];
#pragma unroll
        for (int ai = 0; ai < 2; ++ai)
#pragma unroll
            for (int m = 0; m < 4; ++m) {
                const unsigned* rp = (const unsigned*)rss + (size_t)(u.pm * BM + ai * HALF + wr * 64 + m * 16 + fr) * 16 + 4 * fq;
                float s = 0.f;
#pragma unroll
                for (int k = 0; k < 4; ++k) s += __uint_as_float(__hip_atomic_load(rp + k, __ATOMIC_RELAXED, __HIP_MEMORY_SCOPE_AGENT));
                s += __shfl_xor(s, 16); s += __shfl_xor(s, 32);
                rstdv[ai][m] = rsqrtf(s * (1.0f / 1024.0f) + RMS_EPS);
            }
        f32x4 gv[2][2];
#pragma unroll
        for (int bj = 0; bj < 2; ++bj) { const int c0 = u.pn * BM + bj * HALF + 32 * wc + 8 * fq; gv[bj][0] = *(const f32x4*)(fg + c0); gv[bj][1] = *(const f32x4*)(fg + c0 + 4); }
#pragma unroll
        for (int ai = 0; ai < 2; ++ai)
#pragma unroll
            for (int m = 0; m < 4; ++m)
#pragma unroll
                for (int bj = 0; bj < 2; ++bj) {
                    const size_t off = (size_t)(u.pm * BM + ai * HALF + wr * 64 + m * 16 + fr) * 1024 + u.pn * BM + bj * HALF + 32 * wc + 8 * fq;
                    *(f32x4*)(out + off) = acc[ai][bj][m][0] * rstdv[ai][m] * gv[bj][0];
                    *(f32x4*)(out + off + 4) = acc[ai][bj][m][1] * rstdv[ai][m] * gv[bj][1];
                }
    }
};
}
constexpr int LDS_PHASE_BYTES = 143360;
constexpr int LDS_RPB_OFF = LDS_PHASE_BYTES + 16 + 128, LDS_SG_OFF = LDS_RPB_OFF + 8 * 465 * 4 + 128, LDS_RPB_BYTES = 8 * 465 * 4 + 128 + 512;

constexpr int DA_KP = 272, DA_VP = 144;
constexpr int DA_KBYTES = 128 * DA_KP, DA_VSUB = 128 * DA_VP, DA_VBYTES = 2 * DA_VSUB, DA_STAGE = DA_KBYTES + DA_VBYTES;

__device__ __forceinline__ float silu_f(float x) { return x / (1.0f + __expf(-x)); }

__device__ void da_unit(char* lds, const Params& p, int layer, int unit) {
    int tid_ = threadIdx.x; asm volatile("" : "+v"(tid_)); const int tid = tid_, lane = tid & 63, wid = __builtin_amdgcn_readfirstlane(tid >> 6), r = lane & 31, h2 = lane >> 5;
    const int c = wid & 1, qg = wid >> 1;
    const int g8 = unit >> 3, bh = (unit & 7) * 4 + (g8 >> 4), qb = g8 & 15, b = bh >> 2, h = bh & 3;
    const float slope2 = exp2f(-2.0f * (float)(h + 1)) * LOG2E;
    const float qscale = 0.125f * LOG2E;
    float lam;
    {
        const float v1 = p.lq1[layer * 64 + lane] * p.lk1[layer * 64 + lane], v2 = p.lq2[layer * 64 + lane] * p.lk2[layer * 64 + lane];
        float s1 = v1, s2 = v2;
#pragma unroll
        for (int s = 32; s >= 1; s >>= 1) { s1 += __shfl_xor(s1, s); s2 += __shfl_xor(s2, s); }
        lam = __expf(s1) - __expf(s2) + p.lam_init[layer];
    }
    const int q0 = qb * 128 + qg * 32;
    const size_t tokq = (size_t)b * SEQ + q0 + r;
    bf16x8 qf[4];
#pragma unroll
    for (int t = 0; t < 4; ++t) {
        const u32x4 w = *(const u32x4*)(p.z + ZS_QD + ((size_t)(bh * 2048 + q0 + r)) * 128 + c * 64 + t * 16 + h2 * 8);
        u32x4 o;
        o.x = cvt_pk_bf16(bflo(w.x) * qscale, bfhi(w.x) * qscale); o.y = cvt_pk_bf16(bflo(w.y) * qscale, bfhi(w.y) * qscale);
        o.z = cvt_pk_bf16(bflo(w.z) * qscale, bfhi(w.z) * qscale); o.w = cvt_pk_bf16(bflo(w.w) * qscale, bfhi(w.w) * qscale);
        qf[t] = __builtin_bit_cast(bf16x8, o);
    }
    f32x16 O[4], Bs;
#pragma unroll
    for (int k = 0; k < 4; ++k)
#pragma unroll
        for (int e = 0; e < 16; ++e) O[k][e] = 0.f;
#pragma unroll
    for (int e = 0; e < 16; ++e) Bs[e] = -slope2 * (float)(16 * (e >> 3) + (e & 7));
    float mrow = -1e30f, lrow = 0.f;
    const float qrel = (float)(8 * h2) - (float)(q0 + r);
    const bf16_t* Kg = p.z + ZS_KD + ((size_t)bh * 2048) * 128 + tid * 8;
    const bf16_t* Vg = p.vT + VS_VD + ((size_t)bh * 32) * 8192 + tid * 8;
    const int kr_ = tid >> 4, kc_ = tid & 15, vr_ = tid >> 3, vc_ = tid & 7;
    constexpr int NT = SEQ / 128;
    auto tile_of = [&](int i) { return (i < NT - qb) ? (qb + i) : (NT - 1 - i); };
    u32x4 rk[4], rv[4];
    {
        const int t0 = tile_of(0);
#pragma unroll
        for (int j = 0; j < 4; ++j) { rk[j] = *(const u32x4*)(Kg + (size_t)t0 * 16384 + j * 4096); rv[j] = *(const u32x4*)(Vg + (size_t)t0 * 16384 + j * 4096); }
    }
    __syncthreads();
#pragma unroll
    for (int j = 0; j < 4; ++j) {
        *(u32x4*)(lds + (kr_ + 32 * j) * DA_KP + kc_ * 16) = rk[j];
        *(u32x4*)(lds + DA_KBYTES + (j >> 1) * DA_VSUB + (vr_ + 64 * (j & 1)) * DA_VP + vc_ * 16) = rv[j];
    }
    __syncthreads();
    const int pr = (r & 0x13) | ((r & 4) << 1) | ((r & 8) >> 1);
    if (wid >= 4) __builtin_amdgcn_s_setprio(1);
    {
        const int it = 0; const int kt = qb;
        const char* cK = lds + (it & 1) * DA_STAGE;
        const char* cV = cK + DA_KBYTES;
        char* nK = lds + ((it + 1) & 1) * DA_STAGE;
        if (it + 1 < NT) {
            const int tn = tile_of(it + 1);
#pragma unroll
            for (int j = 0; j < 4; ++j) { rk[j] = *(const u32x4*)(Kg + (size_t)tn * 16384 + j * 4096); rv[j] = *(const u32x4*)(Vg + (size_t)tn * 16384 + j * 4096); }
        }
#pragma unroll
        for (int kb = 0; kb < 4; ++kb) {
            const int k0 = kt * 128 + kb * 32;
            f32x16 s; const float A = 0.f;
            const float kq = (float)k0 + qrel;
#pragma unroll
            for (int e = 0; e < 16; ++e) s[e] = 0.f;
#pragma unroll
            for (int t = 0; t < 4; ++t) {
                const bf16x8 kf = *(const bf16x8*)(cK + (kb * 32 + pr) * DA_KP + c * 128 + t * 32 + h2 * 16);
                s = __builtin_amdgcn_mfma_f32_32x32x16_bf16(kf, qf[t], s, 0, 0, 0);
            }
#pragma unroll
            for (int e = 0; e < 16; ++e) s[e] = fmaf(fabsf(kq + (float)(16 * (e >> 3) + (e & 7))), -slope2, s[e]);
            float mx = s[0];
#pragma unroll
            for (int e = 1; e < 16; ++e) mx = fmaxf(mx, s[e]);
            mx += A;
            mx = fmaxf(mx, __shfl_xor(mx, 32));
            if (!__all(mx <= mrow + 8.0f)) {
                const float mnew = fmaxf(mrow, mx);
                const float alpha = fast_exp2(mrow - mnew);
#pragma unroll
                for (int k = 0; k < 4; ++k) O[k] = O[k] * alpha;
                lrow *= alpha; mrow = mnew;
            }
            const float mm = mrow - A;
            float ps = 0.f;
#pragma unroll
            for (int e = 0; e < 16; ++e) { s[e] = fast_exp2(s[e] - mm); ps += s[e]; }
            lrow += ps;
            bf16x8 pb[2];
#pragma unroll
            for (int sp = 0; sp < 2; ++sp) {
                u32x4 w;
                w.x = cvt_pk_bf16(s[8 * sp + 0], s[8 * sp + 1]); w.y = cvt_pk_bf16(s[8 * sp + 2], s[8 * sp + 3]);
                w.z = cvt_pk_bf16(s[8 * sp + 4], s[8 * sp + 5]); w.w = cvt_pk_bf16(s[8 * sp + 6], s[8 * sp + 7]);
                pb[sp] = __builtin_bit_cast(bf16x8, w);
            }
#pragma unroll
            for (int sp = 0; sp < 2; ++sp)
#pragma unroll
                for (int k = 0; k < 4; ++k) {
                    const bf16x8 vf = *(const bf16x8*)(cV + (kb >> 1) * DA_VSUB + (32 * k + r) * DA_VP + (32 * (kb & 1) + 16 * sp + 8 * h2) * 2);
                    O[k] = __builtin_amdgcn_mfma_f32_32x32x16_bf16(vf, pb[sp], O[k], 0, 0, 0);
                }
        }

        if (it + 1 < NT) {
#pragma unroll
            for (int j = 0; j < 4; ++j) {
                *(u32x4*)(nK + (kr_ + 32 * j) * DA_KP + kc_ * 16) = rk[j];
                *(u32x4*)(nK + DA_KBYTES + (j >> 1) * DA_VSUB + (vr_ + 64 * (j & 1)) * DA_VP + vc_ * 16) = rv[j];
            }
        }
        __syncthreads();
    }
    for (int it = 1; it < NT - qb; ++it) {
        const int kt = tile_of(it);
        const char* cK = lds + (it & 1) * DA_STAGE;
        const char* cV = cK + DA_KBYTES;
        char* nK = lds + ((it + 1) & 1) * DA_STAGE;
        const int tn = tile_of(it + 1 < NT ? it + 1 : it);
        if (it + 1 < NT) {
#pragma unroll
            for (int j = 0; j < 4; ++j) rk[j] = *(const u32x4*)(Kg + (size_t)tn * 16384 + j * 4096);
        }
#define DA_FAST_HALF(BSEL, SGN, hf) \
            { \
                f32x16 s0, s1; \
                { const bf16x8 kf0 = *(const bf16x8*)(cK + (hf * 64 + pr) * DA_KP + c * 128 + h2 * 16); \
                  const bf16x8 kf1 = *(const bf16x8*)(cK + (hf * 64 + 32 + pr) * DA_KP + c * 128 + h2 * 16); \
                  s0 = __builtin_amdgcn_mfma_f32_32x32x16_bf16(kf0, qf[0], BSEL, 0, 0, 0); \
                  s1 = __builtin_amdgcn_mfma_f32_32x32x16_bf16(kf1, qf[0], BSEL, 0, 0, 0); } \
                _Pragma("unroll") \
                for (int t = 1; t < 4; ++t) { \
                    const bf16x8 kf0 = *(const bf16x8*)(cK + (hf * 64 + pr) * DA_KP + c * 128 + t * 32 + h2 * 16); \
                    const bf16x8 kf1 = *(const bf16x8*)(cK + (hf * 64 + 32 + pr) * DA_KP + c * 128 + t * 32 + h2 * 16); \
                    s0 = __builtin_amdgcn_mfma_f32_32x32x16_bf16(kf0, qf[t], s0, 0, 0, 0); \
                    s1 = __builtin_amdgcn_mfma_f32_32x32x16_bf16(kf1, qf[t], s1, 0, 0, 0); \
                } \
                const float A0 = (SGN) * ((float)(kt * 128 + hf * 64) + qrel), A1 = A0 + (SGN) * 32.0f; \
                const float mm0 = mrow - A0, mm1 = mrow - A1; \
                float ps0 = 0.f, ps1 = 0.f; \
                _Pragma("unroll") \
                for (int e = 0; e < 16; ++e) { s0[e] = fast_exp2(s0[e] - mm0); ps0 += s0[e]; } \
                bf16x8 pb0[2], pb1[2]; \
                _Pragma("unroll") \
                for (int sp = 0; sp < 2; ++sp) { \
                    u32x4 w; \
                    w.x = cvt_pk_bf16(s0[8 * sp + 0], s0[8 * sp + 1]); w.y = cvt_pk_bf16(s0[8 * sp + 2], s0[8 * sp + 3]); \
                    w.z = cvt_pk_bf16(s0[8 * sp + 4], s0[8 * sp + 5]); w.w = cvt_pk_bf16(s0[8 * sp + 6], s0[8 * sp + 7]); \
                    pb0[sp] = __builtin_bit_cast(bf16x8, w); \
                } \
                _Pragma("unroll") \
                for (int sp = 0; sp < 2; ++sp) \
                    _Pragma("unroll") \
                    for (int k = 0; k < 4; ++k) { \
                        const bf16x8 vf0 = *(const bf16x8*)(cV + hf * DA_VSUB + (32 * k + r) * DA_VP + (16 * sp + 8 * h2) * 2); \
                        O[k] = __builtin_amdgcn_mfma_f32_32x32x16_bf16(vf0, pb0[sp], O[k], 0, 0, 0); \
                    } \
                _Pragma("unroll") \
                for (int e = 0; e < 16; ++e) { s1[e] = fast_exp2(s1[e] - mm1); ps1 += s1[e]; } \
                lrow += ps0 + ps1; \
                _Pragma("unroll") \
                for (int sp = 0; sp < 2; ++sp) { \
                    u32x4 w; \
                    w.x = cvt_pk_bf16(s1[8 * sp + 0], s1[8 * sp + 1]); w.y = cvt_pk_bf16(s1[8 * sp + 2], s1[8 * sp + 3]); \
                    w.z = cvt_pk_bf16(s1[8 * sp + 4], s1[8 * sp + 5]); w.w = cvt_pk_bf16(s1[8 * sp + 6], s1[8 * sp + 7]); \
                    pb1[sp] = __builtin_bit_cast(bf16x8, w); \
                } \
                _Pragma("unroll") \
                for (int sp = 0; sp < 2; ++sp) \
                    _Pragma("unroll") \
                    for (int k = 0; k < 4; ++k) { \
                        const bf16x8 vf1 = *(const bf16x8*)(cV + hf * DA_VSUB + (32 * k + r) * DA_VP + (32 + 16 * sp + 8 * h2) * 2); \
                        O[k] = __builtin_amdgcn_mfma_f32_32x32x16_bf16(vf1, pb1[sp], O[k], 0, 0, 0); \
                    } \
            }
        DA_FAST_HALF(Bs, -slope2, 0)
        if (it + 1 < NT) {
#pragma unroll
            for (int j = 0; j < 4; ++j) *(u32x4*)(nK + (kr_ + 32 * j) * DA_KP + kc_ * 16) = rk[j];
#pragma unroll
            for (int j = 0; j < 4; ++j) rk[j] = *(const u32x4*)(Vg + (size_t)tn * 16384 + j * 4096);
        }
        DA_FAST_HALF(Bs, -slope2, 1)
#undef DA_FAST_HALF
        if (it + 1 < NT) {
#pragma unroll
            for (int j = 0; j < 4; ++j) *(u32x4*)(nK + DA_KBYTES + (j >> 1) * DA_VSUB + (vr_ + 64 * (j & 1)) * DA_VP + vc_ * 16) = rk[j];
        }
        __syncthreads();
    }
#pragma unroll
    for (int e = 0; e < 16; ++e) Bs[e] = -Bs[e];
    for (int it = NT - qb; it < NT; ++it) {
        const int kt = tile_of(it);
        const char* cK = lds + (it & 1) * DA_STAGE;
        const char* cV = cK + DA_KBYTES;
        char* nK = lds + ((it + 1) & 1) * DA_STAGE;
        const int tn = tile_of(it + 1 < NT ? it + 1 : it);
        if (it + 1 < NT) {
#pragma unroll
            for (int j = 0; j < 4; ++j) rk[j] = *(const u32x4*)(Kg + (size_t)tn * 16384 + j * 4096);
        }
#define DA_FAST_HALF(BSEL, SGN, hf) \
            { \
                f32x16 s0, s1; \
                { const bf16x8 kf0 = *(const bf16x8*)(cK + (hf * 64 + pr) * DA_KP + c * 128 + h2 * 16); \
                  const bf16x8 kf1 = *(const bf16x8*)(cK + (hf * 64 + 32 + pr) * DA_KP + c * 128 + h2 * 16); \
                  s0 = __builtin_amdgcn_mfma_f32_32x32x16_bf16(kf0, qf[0], BSEL, 0, 0, 0); \
                  s1 = __builtin_amdgcn_mfma_f32_32x32x16_bf16(kf1, qf[0], BSEL, 0, 0, 0); } \
                _Pragma("unroll") \
                for (int t = 1; t < 4; ++t) { \
                    const bf16x8 kf0 = *(const bf16x8*)(cK + (hf * 64 + pr) * DA_KP + c * 128 + t * 32 + h2 * 16); \
                    const bf16x8 kf1 = *(const bf16x8*)(cK + (hf * 64 + 32 + pr) * DA_KP + c * 128 + t * 32 + h2 * 16); \
                    s0 = __builtin_amdgcn_mfma_f32_32x32x16_bf16(kf0, qf[t], s0, 0, 0, 0); \
                    s1 = __builtin_amdgcn_mfma_f32_32x32x16_bf16(kf1, qf[t], s1, 0, 0, 0); \
                } \
                const float A0 = (SGN) * ((float)(kt * 128 + hf * 64) + qrel), A1 = A0 + (SGN) * 32.0f; \
                const float mm0 = mrow - A0, mm1 = mrow - A1; \
                float ps0 = 0.f, ps1 = 0.f; \
                _Pragma("unroll") \
                for (int e = 0; e < 16; ++e) { s0[e] = fast_exp2(s0[e] - mm0); ps0 += s0[e]; } \
                bf16x8 pb0[2], pb1[2]; \
                _Pragma("unroll") \
                for (int sp = 0; sp < 2; ++sp) { \
                    u32x4 w; \
                    w.x = cvt_pk_bf16(s0[8 * sp + 0], s0[8 * sp + 1]); w.y = cvt_pk_bf16(s0[8 * sp + 2], s0[8 * sp + 3]); \
                    w.z = cvt_pk_bf16(s0[8 * sp + 4], s0[8 * sp + 5]); w.w = cvt_pk_bf16(s0[8 * sp + 6], s0[8 * sp + 7]); \
                    pb0[sp] = __builtin_bit_cast(bf16x8, w); \
                } \
                _Pragma("unroll") \
                for (int sp = 0; sp < 2; ++sp) \
                    _Pragma("unroll") \
                    for (int k = 0; k < 4; ++k) { \
                        const bf16x8 vf0 = *(const bf16x8*)(cV + hf * DA_VSUB + (32 * k + r) * DA_VP + (16 * sp + 8 * h2) * 2); \
                        O[k] = __builtin_amdgcn_mfma_f32_32x32x16_bf16(vf0, pb0[sp], O[k], 0, 0, 0); \
                    } \
                _Pragma("unroll") \
                for (int e = 0; e < 16; ++e) { s1[e] = fast_exp2(s1[e] - mm1); ps1 += s1[e]; } \
                lrow += ps0 + ps1; \
                _Pragma("unroll") \
                for (int sp = 0; sp < 2; ++sp) { \
                    u32x4 w; \
                    w.x = cvt_pk_bf16(s1[8 * sp + 0], s1[8 * sp + 1]); w.y = cvt_pk_bf16(s1[8 * sp + 2], s1[8 * sp + 3]); \
                    w.z = cvt_pk_bf16(s1[8 * sp + 4], s1[8 * sp + 5]); w.w = cvt_pk_bf16(s1[8 * sp + 6], s1[8 * sp + 7]); \
                    pb1[sp] = __builtin_bit_cast(bf16x8, w); \
                } \
                _Pragma("unroll") \
                for (int sp = 0; sp < 2; ++sp) \
                    _Pragma("unroll") \
                    for (int k = 0; k < 4; ++k) { \
                        const bf16x8 vf1 = *(const bf16x8*)(cV + hf * DA_VSUB + (32 * k + r) * DA_VP + (32 + 16 * sp + 8 * h2) * 2); \
                        O[k] = __builtin_amdgcn_mfma_f32_32x32x16_bf16(vf1, pb1[sp], O[k], 0, 0, 0); \
                    } \
            }
        DA_FAST_HALF(Bs, slope2, 0)
        if (it + 1 < NT) {
#pragma unroll
            for (int j = 0; j < 4; ++j) *(u32x4*)(nK + (kr_ + 32 * j) * DA_KP + kc_ * 16) = rk[j];
#pragma unroll
            for (int j = 0; j < 4; ++j) rk[j] = *(const u32x4*)(Vg + (size_t)tn * 16384 + j * 4096);
        }
        DA_FAST_HALF(Bs, slope2, 1)
#undef DA_FAST_HALF
        if (it + 1 < NT) {
#pragma unroll
            for (int j = 0; j < 4; ++j) *(u32x4*)(nK + DA_KBYTES + (j >> 1) * DA_VSUB + (vr_ + 64 * (j & 1)) * DA_VP + vc_ * 16) = rk[j];
        }
        __syncthreads();
    }
    __builtin_amdgcn_s_setprio(0);
    {
        const float lchk = lrow + __shfl_xor(lrow, 32);
        const int bad = !(lchk < 1e30f);
        volatile unsigned* bflag = (volatile unsigned*)(lds + LDS_PHASE_BYTES + 8);
        if (tid == 0) *bflag = 0u;
        __syncthreads();
        if (__any(bad) && lane == 0) *bflag = 1u;
        __syncthreads();
        if (*bflag != 0u) {
#pragma unroll
            for (int k = 0; k < 4; ++k)
#pragma unroll
                for (int e = 0; e < 16; ++e) O[k][e] = 0.f;
            mrow = -1e30f; lrow = 0.f;
            {
                const int t0 = tile_of(0);
#pragma unroll
                for (int j = 0; j < 4; ++j) { rk[j] = *(const u32x4*)(Kg + (size_t)t0 * 16384 + j * 4096); rv[j] = *(const u32x4*)(Vg + (size_t)t0 * 16384 + j * 4096); }
            }
#pragma unroll
            for (int j = 0; j < 4; ++j) {
                *(u32x4*)(lds + (kr_ + 32 * j) * DA_KP + kc_ * 16) = rk[j];
                *(u32x4*)(lds + DA_KBYTES + (j >> 1) * DA_VSUB + (vr_ + 64 * (j & 1)) * DA_VP + vc_ * 16) = rv[j];
            }
            __syncthreads();
        for (int it = 0; it < NT; ++it) {
            const int kt = tile_of(it);
        const char* cK = lds + (it & 1) * DA_STAGE;
        const char* cV = cK + DA_KBYTES;
        char* nK = lds + ((it + 1) & 1) * DA_STAGE;
        if (it + 1 < NT) {
            const int tn = tile_of(it + 1);
#pragma unroll
            for (int j = 0; j < 4; ++j) { rk[j] = *(const u32x4*)(Kg + (size_t)tn * 16384 + j * 4096); rv[j] = *(const u32x4*)(Vg + (size_t)tn * 16384 + j * 4096); }
        }
#pragma unroll
        for (int kb = 0; kb < 4; ++kb) {
            const int k0 = kt * 128 + kb * 32;
            f32x16 s; const float A = 0.f;
            const float kq = (float)k0 + qrel;
#pragma unroll
            for (int e = 0; e < 16; ++e) s[e] = 0.f;
#pragma unroll
            for (int t = 0; t < 4; ++t) {
                const bf16x8 kf = *(const bf16x8*)(cK + (kb * 32 + pr) * DA_KP + c * 128 + t * 32 + h2 * 16);
                s = __builtin_amdgcn_mfma_f32_32x32x16_bf16(kf, qf[t], s, 0, 0, 0);
            }
#pragma unroll
            for (int e = 0; e < 16; ++e) s[e] = fmaf(fabsf(kq + (float)(16 * (e >> 3) + (e & 7))), -slope2, s[e]);
            float mx = s[0];
#pragma unroll
            for (int e = 1; e < 16; ++e) mx = fmaxf(mx, s[e]);
            mx += A;
            mx = fmaxf(mx, __shfl_xor(mx, 32));
            if (!__all(mx <= mrow + 8.0f)) {
                const float mnew = fmaxf(mrow, mx);
                const float alpha = fast_exp2(mrow - mnew);
#pragma unroll
                for (int k = 0; k < 4; ++k) O[k] = O[k] * alpha;
                lrow *= alpha; mrow = mnew;
            }
            const float mm = mrow - A;
            float ps = 0.f;
#pragma unroll
            for (int e = 0; e < 16; ++e) { s[e] = fast_exp2(s[e] - mm); ps += s[e]; }
            lrow += ps;
            bf16x8 pb[2];
#pragma unroll
            for (int sp = 0; sp < 2; ++sp) {
                u32x4 w;
                w.x = cvt_pk_bf16(s[8 * sp + 0], s[8 * sp + 1]); w.y = cvt_pk_bf16(s[8 * sp + 2], s[8 * sp + 3]);
                w.z = cvt_pk_bf16(s[8 * sp + 4], s[8 * sp + 5]); w.w = cvt_pk_bf16(s[8 * sp + 6], s[8 * sp + 7]);
                pb[sp] = __builtin_bit_cast(bf16x8, w);
            }
#pragma unroll
            for (int sp = 0; sp < 2; ++sp)
#pragma unroll
                for (int k = 0; k < 4; ++k) {
                    const bf16x8 vf = *(const bf16x8*)(cV + (kb >> 1) * DA_VSUB + (32 * k + r) * DA_VP + (32 * (kb & 1) + 16 * sp + 8 * h2) * 2);
                    O[k] = __builtin_amdgcn_mfma_f32_32x32x16_bf16(vf, pb[sp], O[k], 0, 0, 0);
                }
        }

        if (it + 1 < NT) {
#pragma unroll
            for (int j = 0; j < 4; ++j) {
                *(u32x4*)(nK + (kr_ + 32 * j) * DA_KP + kc_ * 16) = rk[j];
                *(u32x4*)(nK + DA_KBYTES + (j >> 1) * DA_VSUB + (vr_ + 64 * (j & 1)) * DA_VP + vc_ * 16) = rv[j];
            }
        }
        __syncthreads();
    }
        }
    }
    u32x2 gwv[16];
    if (c == 0) {
#pragma unroll
        for (int k = 0; k < 4; ++k)
#pragma unroll
            for (int g = 0; g < 4; ++g) gwv[k * 4 + g] = *(const u32x2*)(p.z + ZS_GATE + tokq * 1024 + h * 128 + 32 * k + 8 * g + 4 * h2);
    }
    const float lsum = lrow + __shfl_xor(lrow, 32);
    float* xch = (float*)lds + qg * 4096;
    if (c == 1) {
        const float i1 = lam / lsum;
#pragma unroll
        for (int k = 0; k < 4; ++k)
#pragma unroll
            for (int e = 0; e < 16; ++e) xch[(k * 16 + e) * 64 + lane] = O[k][e] * i1;
    }
    __syncthreads();
    if (c == 0) {
        const float i0 = 1.0f / lsum;
        float ss = 0.f;
#pragma unroll
        for (int k = 0; k < 4; ++k)
#pragma unroll
            for (int e = 0; e < 16; ++e) { const float a = O[k][e] * i0 - xch[(k * 16 + e) * 64 + lane]; O[k][e] = a; ss += a * a; }
        ss += __shfl_xor(ss, 32);
        const float rstd = rsqrtf(ss * (1.0f / 128.0f) + RMS_EPS) * (1.0f - p.lam_init[layer]);
        const float* sg = (const float*)(lds + LDS_SG_OFF);
        __builtin_amdgcn_sched_barrier(0);
#pragma unroll
        for (int k = 0; k < 4; ++k)
#pragma unroll
            for (int j = 0; j < 2; ++j) {
                u32x2 wq[2];
#pragma unroll
                for (int q = 0; q < 2; ++q) {
                    const int g = 2 * j + q, d0 = 32 * k + 8 * g + 4 * h2;
                    const f32x4 gg = *(const f32x4*)(sg + d0);
                    const u32x2 gw = gwv[k * 4 + g];
                    const float o0 = O[k][4 * g + 0] * rstd * gg[0] * silu_f(bflo(gw.x));
                    const float o1 = O[k][4 * g + 1] * rstd * gg[1] * silu_f(bfhi(gw.x));
                    const float o2 = O[k][4 * g + 2] * rstd * gg[2] * silu_f(bflo(gw.y));
                    const float o3 = O[k][4 * g + 3] * rstd * gg[3] * silu_f(bfhi(gw.y));
                    wq[q].x = cvt_pk_bf16(o0, o1); wq[q].y = cvt_pk_bf16(o2, o3);
                }
                const auto sx = __builtin_amdgcn_permlane32_swap(wq[0].x, wq[1].x, false, false), sy = __builtin_amdgcn_permlane32_swap(wq[0].y, wq[1].y, false, false);
                u32x4 w16; w16.x = sx[0]; w16.y = sy[0]; w16.z = sx[1]; w16.w = sy[1];
                *(u32x4*)(p.o + tokq * 1024 + h * 128 + 32 * k + 16 * j + 8 * h2) = w16;
            }
    }
}

__device__ void na_unit(char* lds, const Params& p, int layer, int unit) {
    int tid_ = threadIdx.x; asm volatile("" : "+v"(tid_)); const int tid = tid_, lane = tid & 63, wid = __builtin_amdgcn_readfirstlane(tid >> 6), fr = lane & 15, fq = lane >> 4;
    const int hp = unit & 3, rr0 = (unit >> 2) & 31, b = unit >> 7;
    const int h = 2 * hp + (wid >> 2), n = wid & 3;
    const float* rph = (const float*)(lds + LDS_RPB_OFF) + h * 465;
    const int r = rr0;
    const int rs = min(max(r - 4, 0), 24);
    const int kcstart = min(max(16 * n - 8, 0), 32);
    const int qcol = 16 * n + fr;
    const int qcstart = min(max(qcol - 8, 0), 48);
    const size_t tokq = (size_t)b * SEQ + r * 64 + qcol;
    bf16x8 qf[2];
#pragma unroll
    for (int t = 0; t < 2; ++t) qf[t] = *(const bf16x8*)(p.z + ZS_QN + ((size_t)((b * 8 + h) * 2048 + r * 64 + qcol)) * 64 + t * 32 + fq * 8);
    bf16x8 kfr[8][4];
    {
        const int kc = kcstart + 8 * (fr >> 2) + (fr & 3);
        const bf16_t* kg0 = p.z + ZS_KN + ((size_t)((b * 8 + h) * 2048 + rs * 64 + kc)) * 64 + fq * 8;
#pragma unroll
        for (int rr = 0; rr < 8; ++rr)
#pragma unroll
            for (int T = 0; T < 2; ++T) {
                const bf16_t* kg = kg0 + (size_t)(rr * 64 + 4 * T) * 64;
                kfr[rr][2 * T] = *(const bf16x8*)(kg); kfr[rr][2 * T + 1] = *(const bf16x8*)(kg + 32);
            }
    }
    __builtin_amdgcn_sched_barrier(0);
    const float c1 = 0.125f * LOG2E;
    float sc[8][8];
    float mx = -1e30f;
#pragma unroll
    for (int rr = 0; rr < 8; ++rr) {
#pragma unroll
        for (int T = 0; T < 2; ++T) {
            f32x4 s = (f32x4){0.f, 0.f, 0.f, 0.f};
            s = __builtin_amdgcn_mfma_f32_16x16x32_bf16(kfr[rr][2 * T], qf[0], s, 0, 0, 0);
            s = __builtin_amdgcn_mfma_f32_16x16x32_bf16(kfr[rr][2 * T + 1], qf[1], s, 0, 0, 0);
            const int dr = rs + rr - r + 7;
#pragma unroll
            for (int e = 0; e < 4; ++e) {
                const int kcol = kcstart + 8 * fq + e + 4 * T;
                const bool valid = (kcol >= qcstart) && (kcol < qcstart + 16);
                const int dc = min(max(kcol - qcol, -15), 15) + 15;
                const float bias = rph[dr * 31 + dc];
                const float v = valid ? fmaf(s[e], c1, bias) : -1e30f;
                sc[rr][4 * T + e] = v;
                mx = fmaxf(mx, v);
            }
        }
    }
    __builtin_amdgcn_sched_barrier(0);
    bf16x8 vfr[4][8];
    {
        const bf16_t* vg0 = p.vT + VS_VN + ((size_t)(((b * 8 + h) * 32 + rs) * 64 + fr)) * 64 + kcstart + 8 * fq;
#pragma unroll
        for (int dt = 0; dt < 4; ++dt)
#pragma unroll
            for (int rr = 0; rr < 8; ++rr) vfr[dt][rr] = *(const bf16x8*)(vg0 + (size_t)(rr * 64 + 16 * dt) * 64);
    }
    mx = fmaxf(mx, __shfl_xor(mx, 16)); mx = fmaxf(mx, __shfl_xor(mx, 32));
    float l = 0.f;
    bf16x8 pb[8];
#pragma unroll
    for (int rr = 0; rr < 8; ++rr) {
#pragma unroll
        for (int e = 0; e < 8; ++e) { sc[rr][e] = fast_exp2(sc[rr][e] - mx); l += sc[rr][e]; }
        u32x4 w;
        w.x = cvt_pk_bf16(sc[rr][0], sc[rr][1]); w.y = cvt_pk_bf16(sc[rr][2], sc[rr][3]);
        w.z = cvt_pk_bf16(sc[rr][4], sc[rr][5]); w.w = cvt_pk_bf16(sc[rr][6], sc[rr][7]);
        pb[rr] = __builtin_bit_cast(bf16x8, w);
    }
    l += __shfl_xor(l, 16); l += __shfl_xor(l, 32);
    const float il = 1.0f / l;
    f32x4 O[4];
#pragma unroll
    for (int dt = 0; dt < 4; ++dt) {
        O[dt] = (f32x4){0.f, 0.f, 0.f, 0.f};
#pragma unroll
        for (int rr = 0; rr < 8; ++rr) O[dt] = __builtin_amdgcn_mfma_f32_16x16x32_bf16(vfr[dt][rr], pb[rr], O[dt], 0, 0, 0);
    }
#pragma unroll
    for (int dt = 0; dt < 4; ++dt) {
        const int d0 = 16 * dt + 4 * fq;
        const u32x2 gw = *(const u32x2*)(p.z + ZS_GATE + tokq * 1024 + 512 + h * 64 + d0);
        const float o0 = O[dt][0] * il * silu_f(bflo(gw.x)), o1 = O[dt][1] * il * silu_f(bfhi(gw.x));
        const float o2 = O[dt][2] * il * silu_f(bflo(gw.y)), o3 = O[dt][3] * il * silu_f(bfhi(gw.y));
        u32x2 w; w.x = cvt_pk_bf16(o0, o1); w.y = cvt_pk_bf16(o2, o3);
        *(u32x2*)(p.o + tokq * 1024 + 512 + h * 64 + d0) = w;
    }
}


constexpr int NA_P = 144, NA_KBYTES = 128 * NA_P, NA_STAGE = 2 * NA_KBYTES;

__device__ void na_super_online(char* lds, const Params& p, int layer, int su) {
    int tid_ = threadIdx.x; asm volatile("" : "+v"(tid_)); const int tid = tid_, lane = tid & 63, wid = __builtin_amdgcn_readfirstlane(tid >> 6), fr = lane & 15, fq = lane >> 4;
    const int bh = (su & 7) * 8 + (su >> 5), g = (su >> 3) & 3, b = bh >> 3, h = bh & 7;
    const float* rph = (const float*)(lds + LDS_RPB_OFF) + h * 465;
    const float c1 = 0.125f * LOG2E;
    const int rq = 8 * g + wid, rsw = min(max(rq - 4, 0), 24);
    bf16x8 qf[4][2];
    f32x4 O[4][4];
    float mrow[4], lrow[4];
#pragma unroll
    for (int n = 0; n < 4; ++n) {
#pragma unroll
        for (int t = 0; t < 2; ++t) qf[n][t] = *(const bf16x8*)(p.z + ZS_QN + ((size_t)(bh * 2048 + rq * 64 + 16 * n + fr)) * 64 + t * 32 + fq * 8);
#pragma unroll
        for (int dt = 0; dt < 4; ++dt) O[n][dt] = (f32x4){0.f, 0.f, 0.f, 0.f};
        mrow[n] = -1e30f; lrow[n] = 0.f;
    }
    const int klo = min(max(8 * g - 4, 0), 24);
    const int nsteps = (g == 0 || g == 3) ? 6 : 8;
    const bf16_t* Kg = p.z + ZS_KN + ((size_t)(bh * 2048 + klo * 64)) * 64 + tid * 8;
    const bf16_t* Vg = p.vT + VS_VN + ((size_t)((bh * 32 + klo) * 64)) * 64 + tid * 8;
    const int lw = (tid >> 3) * NA_P + (tid & 7) * 16;
    u32x4 rk[2], rv[2];
    rk[0] = *(const u32x4*)(Kg); rk[1] = *(const u32x4*)(Kg + 4096);
    rv[0] = *(const u32x4*)(Vg); rv[1] = *(const u32x4*)(Vg + 4096);
    __syncthreads();
    *(u32x4*)(lds + lw) = rk[0]; *(u32x4*)(lds + lw + 64 * NA_P) = rk[1];
    *(u32x4*)(lds + NA_KBYTES + lw) = rv[0]; *(u32x4*)(lds + NA_KBYTES + lw + 64 * NA_P) = rv[1];
    __syncthreads();
    const int krow_off = (8 * (fr >> 2) + (fr & 3)) * NA_P + fq * 16;
    const int vrow_off = fr * NA_P + (8 * fq) * 2;
    for (int st = 0; st < nsteps; ++st) {
        const char* cur = lds + (st & 1) * NA_STAGE;
        char* nxt = lds + ((st + 1) & 1) * NA_STAGE;
        if (st + 1 < nsteps) {
            const bf16_t* kg = Kg + (size_t)(st + 1) * 8192; const bf16_t* vg = Vg + (size_t)(st + 1) * 8192;
            rk[0] = *(const u32x4*)(kg); rk[1] = *(const u32x4*)(kg + 4096);
            rv[0] = *(const u32x4*)(vg); rv[1] = *(const u32x4*)(vg + 4096);
        }
#pragma unroll 1
        for (int slot = 0; slot < 2; ++slot) {
            const int kr = klo + 2 * st + slot;
            if (kr >= rsw && kr <= rsw + 7) {
                const char* cK = cur + slot * 64 * NA_P + krow_off;
                const char* cV = cur + NA_KBYTES + slot * 64 * NA_P + vrow_off;
                const float* rpr = rph + (kr - rq + 7) * 31;
                float v[4][8], mx[4];
#pragma unroll
                for (int n = 0; n < 4; ++n) {
                    const int kcstart = n == 0 ? 0 : (n == 1 ? 8 : (n == 2 ? 24 : 32));
                    const int qcol = 16 * n + fr;
                    const int qcstart = min(max(qcol - 8, 0), 48);
                    float bias[8];
#pragma unroll
                    for (int e = 0; e < 8; ++e) bias[e] = rpr[min(max(kcstart + 8 * fq + e - qcol, -15), 15) + 15];
#pragma unroll
                    for (int e = 0; e < 8; ++e) asm volatile("" : "+v"(bias[e]));
#pragma unroll
                    for (int T = 0; T < 2; ++T) {
                        const bf16x8 k0 = *(const bf16x8*)(cK + (kcstart + T * 4) * NA_P), k1 = *(const bf16x8*)(cK + (kcstart + T * 4) * NA_P + 64);
                        f32x4 s = (f32x4){0.f, 0.f, 0.f, 0.f};
                        s = __builtin_amdgcn_mfma_f32_16x16x32_bf16(k0, qf[n][0], s, 0, 0, 0);
                        s = __builtin_amdgcn_mfma_f32_16x16x32_bf16(k1, qf[n][1], s, 0, 0, 0);
#pragma unroll
                        for (int e = 0; e < 4; ++e) {
                            const int kcol = kcstart + 8 * fq + e + 4 * T;
                            const bool valid = (kcol >= qcstart) && (kcol < qcstart + 16);
                            v[n][4 * T + e] = valid ? fmaf(s[e], c1, bias[4 * T + e]) : -1e30f;
                        }
                    }
                    mx[n] = fmaxf(fmaxf(fmaxf(v[n][0], v[n][1]), fmaxf(v[n][2], v[n][3])), fmaxf(fmaxf(v[n][4], v[n][5]), fmaxf(v[n][6], v[n][7])));
                }
#pragma unroll
                for (int n = 0; n < 4; ++n) mx[n] = fmaxf(mx[n], __shfl_xor(mx[n], 16));
#pragma unroll
                for (int n = 0; n < 4; ++n) mx[n] = fmaxf(mx[n], __shfl_xor(mx[n], 32));
#pragma unroll
                for (int n = 0; n < 4; ++n) {
                    const int kcstart = n == 0 ? 0 : (n == 1 ? 8 : (n == 2 ? 24 : 32));
                    const float mnew = fmaxf(mrow[n], mx[n]);
                    const float alpha = fast_exp2(mrow[n] - mnew);
                    mrow[n] = mnew;
                    float ps = 0.f;
#pragma unroll
                    for (int e = 0; e < 8; ++e) { v[n][e] = fast_exp2(v[n][e] - mnew); ps += v[n][e]; }
                    lrow[n] = lrow[n] * alpha + ps;
                    u32x4 w;
                    w.x = cvt_pk_bf16(v[n][0], v[n][1]); w.y = cvt_pk_bf16(v[n][2], v[n][3]); w.z = cvt_pk_bf16(v[n][4], v[n][5]); w.w = cvt_pk_bf16(v[n][6], v[n][7]);
                    const bf16x8 pb = __builtin_bit_cast(bf16x8, w);
#pragma unroll
                    for (int dt = 0; dt < 4; ++dt) {
                        const bf16x8 vf = *(const bf16x8*)(cV + dt * 16 * NA_P + kcstart * 2);
                        O[n][dt] = __builtin_amdgcn_mfma_f32_16x16x32_bf16(vf, pb, O[n][dt] * alpha, 0, 0, 0);
                    }
                }
            }
        }
        if (st + 1 < nsteps) {
            *(u32x4*)(nxt + lw) = rk[0]; *(u32x4*)(nxt + lw + 64 * NA_P) = rk[1];
            *(u32x4*)(nxt + NA_KBYTES + lw) = rv[0]; *(u32x4*)(nxt + NA_KBYTES + lw + 64 * NA_P) = rv[1];
        }
        __syncthreads();
    }
    u32x2 gwv[4][4];
#pragma unroll
    for (int n = 0; n < 4; ++n)
#pragma unroll
        for (int dt = 0; dt < 4; ++dt) gwv[n][dt] = *(const u32x2*)(p.z + ZS_GATE + ((size_t)b * SEQ + rq * 64 + 16 * n + fr) * 1024 + 512 + h * 64 + 16 * dt + 4 * fq);
    __builtin_amdgcn_sched_barrier(0);
#pragma unroll
    for (int n = 0; n < 4; ++n) {
        float l = lrow[n];
        l += __shfl_xor(l, 16); l += __shfl_xor(l, 32);
        const float il = 1.0f / l;
        const size_t tokq = (size_t)b * SEQ + rq * 64 + 16 * n + fr;
#pragma unroll
        for (int dt = 0; dt < 4; ++dt) {
            const int d0 = 16 * dt + 4 * fq;
            const u32x2 gw = gwv[n][dt];
            const float o0 = O[n][dt][0] * il * silu_f(bflo(gw.x)), o1 = O[n][dt][1] * il * silu_f(bfhi(gw.x));
            const float o2 = O[n][dt][2] * il * silu_f(bflo(gw.y)), o3 = O[n][dt][3] * il * silu_f(bfhi(gw.y));
            u32x2 w; w.x = cvt_pk_bf16(o0, o1); w.y = cvt_pk_bf16(o2, o3);
            *(u32x2*)(p.o + tokq * 1024 + 512 + h * 64 + d0) = w;
        }
    }
}

__device__ void na_super(char* lds, const Params& p, int layer, int su) {
    int tid_ = threadIdx.x; asm volatile("" : "+v"(tid_)); const int tid = tid_, lane = tid & 63, wid = __builtin_amdgcn_readfirstlane(tid >> 6), fr = lane & 15, fq = lane >> 4;
    const int bh = (su & 7) * 8 + (su >> 5), g = (su >> 3) & 3, b = bh >> 3, h = bh & 7;
    const float* rph = (const float*)(lds + LDS_RPB_OFF) + h * 465;
    const float c1 = 0.125f * LOG2E;
    const int rq = 8 * g + wid, rsw = min(max(rq - 4, 0), 24);
    bf16x8 qf[4][2];
    f32x4 O[4][4];
    float mrow[4], lrow[4];
#pragma unroll
    for (int n = 0; n < 4; ++n) {
#pragma unroll
        for (int t = 0; t < 2; ++t) qf[n][t] = *(const bf16x8*)(p.z + ZS_QN + ((size_t)(bh * 2048 + rq * 64 + 16 * n + fr)) * 64 + t * 32 + fq * 8);
#pragma unroll
        for (int dt = 0; dt < 4; ++dt) O[n][dt] = (f32x4){0.f, 0.f, 0.f, 0.f};
        lrow[n] = 0.f;
        {
            const u32x4 k0 = *(const u32x4*)(p.z + ZS_KN + ((size_t)(bh * 2048 + rq * 64 + 16 * n + fr)) * 64 + fq * 8);
            const u32x4 k1 = *(const u32x4*)(p.z + ZS_KN + ((size_t)(bh * 2048 + rq * 64 + 16 * n + fr)) * 64 + 32 + fq * 8);
            const u32x4 q0 = __builtin_bit_cast(u32x4, qf[n][0]), q1 = __builtin_bit_cast(u32x4, qf[n][1]);
            float d = 0.f;
#pragma unroll
            for (int w = 0; w < 4; ++w) { d += bflo(q0[w]) * bflo(k0[w]) + bfhi(q0[w]) * bfhi(k0[w]); d += bflo(q1[w]) * bflo(k1[w]) + bfhi(q1[w]) * bfhi(k1[w]); }
            d += __shfl_xor(d, 16); d += __shfl_xor(d, 32);
            mrow[n] = -d;
        }
    }
    const int klo = min(max(8 * g - 4, 0), 24);
    const int nsteps = (g == 0 || g == 3) ? 6 : 8;
    const bf16_t* Kg = p.z + ZS_KN + ((size_t)(bh * 2048 + klo * 64)) * 64 + tid * 8;
    const bf16_t* Vg = p.vT + VS_VN + ((size_t)((bh * 32 + klo) * 64)) * 64 + tid * 8;
    const int lw = (tid >> 3) * NA_P + (tid & 7) * 16;
    u32x4 rk[2], rv[2];
    rk[0] = *(const u32x4*)(Kg); rk[1] = *(const u32x4*)(Kg + 4096);
    rv[0] = *(const u32x4*)(Vg); rv[1] = *(const u32x4*)(Vg + 4096);
    __syncthreads();
    *(u32x4*)(lds + lw) = rk[0]; *(u32x4*)(lds + lw + 64 * NA_P) = rk[1];
    *(u32x4*)(lds + NA_KBYTES + lw) = rv[0]; *(u32x4*)(lds + NA_KBYTES + lw + 64 * NA_P) = rv[1];
    __syncthreads();
    const int krow_off = (8 * (fr >> 2) + (fr & 3)) * NA_P + fq * 16;
    const int vrow_off = fr * NA_P + (8 * fq) * 2;
    for (int st = 0; st < nsteps; ++st) {
        const char* cur = lds + (st & 1) * NA_STAGE;
        char* nxt = lds + ((st + 1) & 1) * NA_STAGE;
        if (st + 1 < nsteps) {
            const bf16_t* kg = Kg + (size_t)(st + 1) * 8192; const bf16_t* vg = Vg + (size_t)(st + 1) * 8192;
            rk[0] = *(const u32x4*)(kg); rk[1] = *(const u32x4*)(kg + 4096);
            rv[0] = *(const u32x4*)(vg); rv[1] = *(const u32x4*)(vg + 4096);
        }
#pragma unroll 1
        for (int slot = 0; slot < 2; ++slot) {
            const int kr = klo + 2 * st + slot;
            if (kr >= rsw && kr <= rsw + 7) {
                const char* cK = cur + slot * 64 * NA_P + krow_off;
                const char* cV = cur + NA_KBYTES + slot * 64 * NA_P + vrow_off;
                const float* rpr = rph + (kr - rq + 7) * 31;
                float v[4][8];
#pragma unroll
                for (int n = 0; n < 4; ++n) {
                    const int kcstart = n == 0 ? 0 : (n == 1 ? 8 : (n == 2 ? 24 : 32));
                    const int qcol = 16 * n + fr;
                    const float* bp = rpr + (kcstart + 8 * fq - qcol + 15);
#pragma unroll
                    for (int e = 0; e < 8; ++e) v[n][e] = bp[e];
                }
#pragma unroll
                for (int np = 0; np < 2; ++np) {
                    bf16x8 kfr[2][4];
#pragma unroll
                    for (int q = 0; q < 2; ++q) {
                        const int n = 2 * np + q;
                        const int kcstart = n == 0 ? 0 : (n == 1 ? 8 : (n == 2 ? 24 : 32));
#pragma unroll
                        for (int T = 0; T < 2; ++T) { kfr[q][2 * T] = *(const bf16x8*)(cK + (kcstart + T * 4) * NA_P); kfr[q][2 * T + 1] = *(const bf16x8*)(cK + (kcstart + T * 4) * NA_P + 64); }
                    }
#pragma unroll
                    for (int q = 0; q < 2; ++q) {
                        const int n = 2 * np + q;
                        const int kcstart = n == 0 ? 0 : (n == 1 ? 8 : (n == 2 ? 24 : 32));
                        const int qcol = 16 * n + fr;
                        const int qcstart = min(max(qcol - 8, 0), 48);
#pragma unroll
                        for (int T = 0; T < 2; ++T) {
                            f32x4 s = (f32x4){mrow[n], mrow[n], mrow[n], mrow[n]};
                            s = __builtin_amdgcn_mfma_f32_16x16x32_bf16(kfr[q][2 * T], qf[n][0], s, 0, 0, 0);
                            s = __builtin_amdgcn_mfma_f32_16x16x32_bf16(kfr[q][2 * T + 1], qf[n][1], s, 0, 0, 0);
#pragma unroll
                            for (int e = 0; e < 4; ++e) {
                                const int kcol = kcstart + 8 * fq + e + 4 * T;
                                const bool valid = (kcol >= qcstart) && (kcol < qcstart + 16);
                                v[n][4 * T + e] = valid ? fmaf(s[e], c1, v[n][4 * T + e]) : -1e30f;
                            }
                        }
                    }
                }
#pragma unroll
                for (int n = 0; n < 4; ++n) {
                    const int kcstart = n == 0 ? 0 : (n == 1 ? 8 : (n == 2 ? 24 : 32));
                    float ps = 0.f;
#pragma unroll
                    for (int e = 0; e < 8; ++e) { v[n][e] = fast_exp2(v[n][e]); ps += v[n][e]; }
                    lrow[n] += ps;
                    u32x4 w;
                    w.x = cvt_pk_bf16(v[n][0], v[n][1]); w.y = cvt_pk_bf16(v[n][2], v[n][3]); w.z = cvt_pk_bf16(v[n][4], v[n][5]); w.w = cvt_pk_bf16(v[n][6], v[n][7]);
                    const bf16x8 pb = __builtin_bit_cast(bf16x8, w);
#pragma unroll
                    for (int dt = 0; dt < 4; ++dt) {
                        const bf16x8 vf = *(const bf16x8*)(cV + dt * 16 * NA_P + kcstart * 2);
                        O[n][dt] = __builtin_amdgcn_mfma_f32_16x16x32_bf16(vf, pb, O[n][dt], 0, 0, 0);
                    }
                }
            }
        }
        if (st + 1 < nsteps) {
            *(u32x4*)(nxt + lw) = rk[0]; *(u32x4*)(nxt + lw + 64 * NA_P) = rk[1];
            *(u32x4*)(nxt + NA_KBYTES + lw) = rv[0]; *(u32x4*)(nxt + NA_KBYTES + lw + 64 * NA_P) = rv[1];
        }
        __syncthreads();
    }
    u32x2 gwv[4][4];
#pragma unroll
    for (int n = 0; n < 4; ++n)
#pragma unroll
        for (int dt = 0; dt < 4; ++dt) gwv[n][dt] = *(const u32x2*)(p.z + ZS_GATE + ((size_t)b * SEQ + rq * 64 + 16 * n + fr) * 1024 + 512 + h * 64 + 16 * dt + 4 * fq);
    __builtin_amdgcn_sched_barrier(0);
    int bad = 0;
#pragma unroll
    for (int n = 0; n < 4; ++n) { lrow[n] += __shfl_xor(lrow[n], 16); lrow[n] += __shfl_xor(lrow[n], 32); bad |= !(lrow[n] < 1e30f); }
    {
        volatile unsigned* bflag = (volatile unsigned*)(lds + LDS_PHASE_BYTES + 8);
        if (tid == 0) *bflag = 0u;
        __syncthreads();
        if (__any(bad) && lane == 0) *bflag = 1u;
        __syncthreads();
        if (*bflag != 0u) { if (tid == 0) *(volatile unsigned*)(lds + LDS_PHASE_BYTES + 12) = 1u; return; }
    }
#pragma unroll
    for (int n = 0; n < 4; ++n) {
        const float l = lrow[n];
        const float il = 1.0f / l;
        const size_t tokq = (size_t)b * SEQ + rq * 64 + 16 * n + fr;
#pragma unroll
        for (int dt = 0; dt < 4; ++dt) {
            const int d0 = 16 * dt + 4 * fq;
            const u32x2 gw = gwv[n][dt];
            const float o0 = O[n][dt][0] * il * silu_f(bflo(gw.x)), o1 = O[n][dt][1] * il * silu_f(bfhi(gw.x));
            const float o2 = O[n][dt][2] * il * silu_f(bflo(gw.y)), o3 = O[n][dt][3] * il * silu_f(bfhi(gw.y));
            u32x2 w; w.x = cvt_pk_bf16(o0, o1); w.y = cvt_pk_bf16(o2, o3);
            *(u32x2*)(p.o + tokq * 1024 + 512 + h * 64 + d0) = w;
        }
    }
}

__global__ void __launch_bounds__(NTHREADS) fwd_megakernel(Params p) {
    extern __shared__ __attribute__((aligned(16))) char lds[];
    if (p.never) cg::this_grid().sync();
    volatile LAS unsigned* st = (volatile LAS unsigned*)(lds + LDS_PHASE_BYTES);
    if (threadIdx.x < 4) st[threadIdx.x] = 0u;
    __syncthreads();
    const XcdBarrier gb = xcd_barrier_post(p.bar, st);
    prologue_phase(lds, p);
    xcd_barrier(gb);
    for (int layer = 0; layer < DEPTH; ++layer) {
        for (int rep = 0; rep < REP_GEMM0; ++rep) {
        { pg8::Gemm g{p.xb, p.wi_t + (size_t)layer * 4096 * 1024, NTOK, IN_W, 1024}; pg8::StaticOrder S; S.init(NTOK, IN_W, (int)gridDim.x, (int)blockIdx.x);
          pg8::EpiZ E{p.z, p.vT, p.rss};
          pg8::gemm_phase<pg8::EpiZ, pg8::StaticOrder, true, true>((PG8_LAS unsigned char*)lds, g, S, E); }
        xcd_barrier(gb);
        }
        { int t0_ = threadIdx.x; asm volatile("" : "+v"(t0_));
          for (int i = t0_; i < 8 * 465; i += NTHREADS) ((float*)(lds + LDS_RPB_OFF))[i] = p.rpb[(size_t)layer * 8 * 465 + i] * LOG2E;
          if (t0_ < 128) ((float*)(lds + LDS_SG_OFF))[t0_] = p.subln_g[layer * 128 + t0_];
          if (t0_ == 0) *(volatile unsigned*)(lds + LDS_PHASE_BYTES + 12) = 0u; }
        __syncthreads();
        for (int rep = 0; rep < REP_ATT; ++rep) {
        for (int u = blockIdx.x; u < 512 + 256; u += gridDim.x) {
            if (u < 512) { if (rep < REP_DA) da_unit(lds, p, layer, u); } else { if (rep < REP_NA) na_super(lds, p, layer, u - 512); }
        }
        __syncthreads();
        if (*(volatile unsigned*)(lds + LDS_PHASE_BYTES + 12) != 0u) {
            for (int u = blockIdx.x; u < 512 + 256; u += gridDim.x) if (u >= 512) na_super_online(lds, p, layer, u - 512);
        }
        xcd_barrier(gb);
        }
        { pg8::Gemm g{p.o, p.wo_t + (size_t)layer * 1024 * 1024, NTOK, 1024, 1024}; pg8::StaticOrder S; S.init(NTOK, 1024, (int)gridDim.x, (int)blockIdx.x);
          if (layer == 0) { pg8::EpiRes2<0, 0> E{p.x, p.xb, p.xb, p.xf, p.rss};
            pg8::gemm_phase<pg8::EpiRes2<0, 0>, pg8::StaticOrder, true, true>((PG8_LAS unsigned char*)lds, g, S, E); }
          else if (layer + 1 < DEPTH) { pg8::EpiRes2<1, 0> E{p.x, p.xb, p.xb, p.xf, p.rss};
            pg8::gemm_phase<pg8::EpiRes2<1, 0>, pg8::StaticOrder, true, true>((PG8_LAS unsigned char*)lds, g, S, E); }
          else if (gridDim.x == 256) { pg8::EpiFinal E{p.xb, p.xf, p.final_g, p.rss, p.bar + XCD_BAR_WORDS};
            pg8::gemm_phase<pg8::EpiFinal, pg8::StaticOrder, false, true>((PG8_LAS unsigned char*)lds, g, S, E); return; }
          else { pg8::EpiRes2<1, 1> E{p.x, p.xb, p.xb, p.xf, p.rss};
            pg8::gemm_phase<pg8::EpiRes2<1, 1>, pg8::StaticOrder, true, true>((PG8_LAS unsigned char*)lds, g, S, E); } }
        xcd_barrier(gb);
    }
    final_phase(p);
}

constexpr size_t LDS_BYTES = LDS_RPB_OFF + LDS_RPB_BYTES;

extern "C" void kernel_launch(void* const* d_in, const int* in_sizes, int n_in, void* d_out, int out_size, void* d_ws, size_t ws_size, hipStream_t stream) {
    static int grid_blocks = 0;
    if (!grid_blocks) {
        int dev = 0, cus = 0, per_cu = 0;
        hipGetDevice(&dev);
        hipDeviceGetAttribute(&cus, hipDeviceAttributeMultiprocessorCount, dev);
        hipFuncSetAttribute((const void*)fwd_megakernel, hipFuncAttributeMaxDynamicSharedMemorySize, (int)LDS_BYTES);
        hipOccupancyMaxActiveBlocksPerMultiprocessor(&per_cu, fwd_megakernel, NTHREADS, LDS_BYTES);
        if (per_cu < 1) per_cu = 1;
        if (per_cu > 1) per_cu = 1;
        grid_blocks = cus * per_cu;
    }
    Params p{};
    p.x = (const float*)d_in[0]; p.norm_g = (const float*)d_in[1]; p.w_in = (const float*)d_in[2]; p.w_out = (const float*)d_in[3];
    p.lq1 = (const float*)d_in[4]; p.lk1 = (const float*)d_in[5]; p.lq2 = (const float*)d_in[6]; p.lk2 = (const float*)d_in[7];
    p.subln_g = (const float*)d_in[8]; p.rpb = (const float*)d_in[9]; p.final_g = (const float*)d_in[10];
    p.xf = (float*)d_out;
    char* w = (char*)d_ws; size_t off = 0;
    auto take = [&](size_t bytes) { char* r = w + off; off += (bytes + 255) & ~(size_t)255; return r; };
    p.wi_t = (bf16_t*)take((size_t)DEPTH * 4096 * 1024 * 2);
    p.wo_t = (bf16_t*)take((size_t)DEPTH * 1024 * 1024 * 2);
    p.xb = (bf16_t*)take((size_t)NTOK * 1024 * 2);
    p.rss = (float*)take((size_t)NTOK * 16 * 4);
    p.z = (bf16_t*)take((size_t)NTOK * ZP * 2);
    p.vT = (bf16_t*)take((size_t)BATCH * 1024 * SEQ * 2);
    p.o = (bf16_t*)take((size_t)NTOK * 1024 * 2);
    p.bar = (unsigned*)take((size_t)(XCD_BAR_WORDS + 64 * 64) * 4);
    (void)hipMemsetAsync(p.bar, 0, (size_t)(XCD_BAR_WORDS + 64 * 64) * 4, stream);
    for (int l = 0; l < DEPTH; ++l) p.lam_init[l] = (float)(0.8 - 0.6 * exp(-0.3 * (double)l));
    void* args[] = {&p};
    hipError_t e = hipLaunchCooperativeKernel((const void*)fwd_megakernel, dim3(grid_blocks), dim3(NTHREADS), args, LDS_BYTES, stream);
    if (e != hipSuccess) fprintf(stderr, "cooperative launch failed: %s (grid %d)\n", hipGetErrorString(e), grid_blocks);
}
```
